# Optimizing an MI355X kernel written in HIP

```python
import math
import jax, jax.numpy as jnp
from jax import lax
import numpy as np

D_MODEL = 1024
BATCH = 8
SEQ = 2048
DEPTH = 1

MIX_WIDTH = D_MODEL
M_HEADS = 4
M_HEAD_DIM = (MIX_WIDTH // 2) // M_HEADS
M_WIDTH = M_HEADS * M_HEAD_DIM
CONV_WIDTH = 4
CHUNK = 64
D_HEADS = 4
D_HEAD_DIM = (MIX_WIDTH // 2) // (2 * D_HEADS)
D_WIDTH = D_HEADS * 2 * D_HEAD_DIM
Q_BLOCK = 128
P_HEADS = 8
N_KEYS = 128
N_EXPERTS = N_KEYS * N_KEYS
P_TOPK = 16
P_QUERY_DIM = 256
P_HALF = P_QUERY_DIM // 2
TOKEN_BLOCK = 128

EPS = 1e-6
NEG = -1e30

kernel_name = "hybrid_mlstm_diffattn_peer_block"


def rmsnorm(x, g):
    xf = x.astype(jnp.float32)
    y = xf * lax.rsqrt(jnp.mean(xf * xf, axis=-1, keepdims=True) + EPS)
    return (y * g.astype(jnp.float32)).astype(x.dtype)


def causal_dwconv(u, w, b):
    C = u.shape[-1]
    y = lax.conv_general_dilated(
        u, w[:, None, :].astype(u.dtype), window_strides=(1,),
        padding=[(CONV_WIDTH - 1, 0)],
        dimension_numbers=("NWC", "WIO", "NWC"),
        feature_group_count=C)
    return y + b.astype(u.dtype)


def mlstm_chunkwise(q, k, v, ig, lf):
    Bb, H, S, d = q.shape
    nc = S // CHUNK

    def to_chunks(a):
        a = a.reshape(a.shape[:2] + (nc, CHUNK) + a.shape[3:])
        return jnp.moveaxis(a, 2, 0)

    qc, kc, vc, ic, fc = (to_chunks(a) for a in (q, k, v, ig, lf))
    causal = jnp.tril(jnp.ones((CHUNK, CHUNK), dtype=bool))

    def step(carry, inp):
        C, n, m = carry
        qb, kb, vb, ib, fb = inp
        b = jnp.cumsum(fb, axis=-1)
        logD = jnp.where(causal, b[..., :, None] - b[..., None, :] + ib[..., None, :], -jnp.inf)
        m_t = jnp.maximum(b + m[..., None], jnp.max(logD, axis=-1))
        Dw = jnp.exp(logD - m_t[..., None])
        inter = jnp.exp(b + m[..., None] - m_t)
        sqk = jnp.einsum('bhtd,bhsd->bhts', qb, kb) * Dw
        num = (jnp.einsum('bhts,bhsv->bhtv', sqk, vb)
               + inter[..., None] * jnp.einsum('bhtd,bhdv->bhtv', qb, C))
        den = jnp.sum(sqk, axis=-1) + inter * jnp.einsum('bhtd,bhd->bht', qb, n)
        h = num / jnp.maximum(jnp.abs(den), jnp.exp(-m_t))[..., None]
        bL = b[..., -1]
        logw = bL[..., None] - b + ib
        m_new = jnp.maximum(bL + m, jnp.max(logw, axis=-1))
        w = jnp.exp(logw - m_new[..., None])
        decay = jnp.exp(bL + m - m_new)
        C_new = decay[..., None, None] * C + jnp.einsum('bhs,bhsd,bhsv->bhdv', w, kb, vb)
        n_new = decay[..., None] * n + jnp.einsum('bhs,bhsd->bhd', w, kb)
        return (C_new, n_new, m_new), h

    init = (jnp.zeros((Bb, H, d, d), jnp.float32),
            jnp.zeros((Bb, H, d), jnp.float32),
            jnp.zeros((Bb, H), jnp.float32))
    _, hs = lax.scan(step, init, (qc, kc, vc, ic, fc))
    return jnp.moveaxis(hs, 0, 2).reshape(Bb, H, S, d)


def diff_attention(q, k, v, lam):
    Bb, H, _, S, dh = q.shape
    nb = S // Q_BLOCK
    kpos = jnp.arange(S)
    scale = D_HEAD_DIM ** -0.5

    def block(i):
        qb = lax.dynamic_slice_in_dim(q, i * Q_BLOCK, Q_BLOCK, axis=3)
        s = jnp.einsum('bhptd,bhpsd->bhpts', qb, k) * scale
        qpos = i * Q_BLOCK + jnp.arange(Q_BLOCK)
        mask = kpos[None, :] <= qpos[:, None]
        a = jax.nn.softmax(jnp.where(mask, s, NEG), axis=-1)
        att = a[:, :, 0] - lam * a[:, :, 1]
        return jnp.einsum('bhts,bhsv->bhtv', att, v)

    o = lax.map(block, jnp.arange(nb))
    return jnp.moveaxis(o, 0, 2).reshape(Bb, H, S, v.shape[-1])


def peer(h, w_query, sub_keys, u_tab, v_tab):
    Bb, S, D = h.shape
    xt = h.reshape(-1, TOKEN_BLOCK, D)

    def block(xb):
        q = (xb @ w_query).reshape(TOKEN_BLOCK, P_HEADS, 2, P_HALF)
        s = jnp.einsum('thpk,hpnk->thpn', q, sub_keys).astype(jnp.float32)
        sv, si = lax.top_k(s, P_TOPK)
        cand = (sv[:, :, 0, :, None] + sv[:, :, 1, None, :]).reshape(TOKEN_BLOCK, P_HEADS, P_TOPK * P_TOPK)
        cidx = (si[:, :, 0, :, None] * N_KEYS + si[:, :, 1, None, :]).reshape(TOKEN_BLOCK, P_HEADS, P_TOPK * P_TOPK)
        fv, fpos = lax.top_k(cand, P_TOPK)
        eidx = jnp.take_along_axis(cidx, fpos, axis=-1)
        g = jax.nn.softmax(fv, axis=-1)
        u = u_tab[eidx]
        act = jax.nn.gelu(jnp.einsum('td,thkd->thk', xb, u).astype(jnp.float32), approximate=False)
        return jnp.einsum('thk,thkd->td', (g * act).astype(xb.dtype), v_tab[eidx])

    return lax.map(block, xt).reshape(Bb, S, D)


def setup_inputs(seed: int = 0) -> dict:
    key = jax.random.key(seed)
    ks = jax.random.split(key, 24)
    L, D = DEPTH, D_MODEL
    n_in = 4 * M_WIDTH + 2 * M_HEADS + 3 * D_WIDTH
    nrm = lambda k, shape, s: jax.random.normal(k, shape, jnp.float32) * s
    f_bias = jnp.linspace(3.0, 6.0, M_HEADS, dtype=jnp.float32)
    gate_b = jnp.concatenate([
        nrm(ks[7], (L, M_HEADS), 0.1),
        f_bias[None, :] + nrm(ks[8], (L, M_HEADS), 0.1)], axis=-1)
    return {
        "x": nrm(ks[0], (BATCH, SEQ, D), 1.0),
        "c": nrm(ks[1], (BATCH, D), 1.0),
        "ada_w": nrm(ks[2], (L, D, 6 * D), 0.5 * D ** -0.5),
        "ada_b": nrm(ks[3], (L, 6 * D), 0.02),
        "norm1_g": 1.0 + nrm(ks[4], (L, D), 0.02),
        "w_in": nrm(ks[5], (L, D, n_in), D ** -0.5),
        "conv_w": nrm(ks[6], (L, CONV_WIDTH, 2 * M_WIDTH), CONV_WIDTH ** -0.5),
        "conv_b": nrm(ks[9], (L, 2 * M_WIDTH), 0.02),
        "mlstm_gate_b": gate_b,
        "mlstm_norm_g": 1.0 + nrm(ks[10], (L, M_WIDTH), 0.02),
        "lambda_q1": nrm(ks[11], (L, D_HEAD_DIM), 0.1),
        "lambda_k1": nrm(ks[12], (L, D_HEAD_DIM), 0.1),
        "lambda_q2": nrm(ks[13], (L, D_HEAD_DIM), 0.1),
        "lambda_k2": nrm(ks[14], (L, D_HEAD_DIM), 0.1),
        "diff_norm_g": 1.0 + nrm(ks[15], (L, 2 * D_HEAD_DIM), 0.02),
        "w_out": nrm(ks[16], (L, MIX_WIDTH, D), MIX_WIDTH ** -0.5),
        "norm2_g": 1.0 + nrm(ks[17], (L, D), 0.02),
        "peer_w_query": nrm(ks[18], (L, D, P_HEADS * P_QUERY_DIM), D ** -0.5),
        "peer_sub_keys": nrm(ks[19], (L, P_HEADS, 2, N_KEYS, P_HALF), P_HALF ** -0.5),
        "peer_u": nrm(ks[20], (L, N_EXPERTS, D), D ** -0.5),
        "peer_v": nrm(ks[21], (L, N_EXPERTS, D), 0.1),
        "final_g": 1.0 + nrm(ks[22], (D,), 0.02),
    }


def reference(x, c, ada_w, ada_b, norm1_g, w_in, conv_w, conv_b, mlstm_gate_b,
              mlstm_norm_g, lambda_q1, lambda_k1, lambda_q2, lambda_k2, diff_norm_g,
              w_out, norm2_g, peer_w_query, peer_sub_keys, peer_u, peer_v, final_g):
    Bb, S, D = x.shape
    split_pts = [M_WIDTH, 2 * M_WIDTH, 3 * M_WIDTH, 4 * M_WIDTH,
                 4 * M_WIDTH + M_HEADS, 4 * M_WIDTH + 2 * M_HEADS,
                 4 * M_WIDTH + 2 * M_HEADS + D_WIDTH,
                 4 * M_WIDTH + 2 * M_HEADS + 2 * D_WIDTH]
    for l in range(DEPTH):
        mod = jax.nn.silu(c) @ ada_w[l] + ada_b[l]
        sh1, sc1, g1, sh2, sc2, g2 = jnp.split(mod[:, None, :], 6, axis=-1)

        h = rmsnorm(x, norm1_g[l]) * (1.0 + sc1) + sh1
        p = h @ w_in[l]
        mq, mk, mv, mo, mi, mf, dq, dk, dv = jnp.split(p, split_pts, axis=-1)

        qk = jax.nn.silu(causal_dwconv(jnp.concatenate([mq, mk], axis=-1), conv_w[l], conv_b[l]))
        mq, mk = jnp.split(qk, 2, axis=-1)
        heads = lambda a: a.reshape(Bb, S, M_HEADS, M_HEAD_DIM).transpose(0, 2, 1, 3).astype(jnp.float32)
        q_m = heads(mq)
        k_m = heads(mk) * (M_HEAD_DIM ** -0.5)
        v_m = heads(mv)
        gb = mlstm_gate_b[l].astype(jnp.float32)
        ig = (mi.astype(jnp.float32) + gb[:M_HEADS]).transpose(0, 2, 1)
        lf = jax.nn.log_sigmoid(mf.astype(jnp.float32) + gb[M_HEADS:]).transpose(0, 2, 1)
        hm = mlstm_chunkwise(q_m, k_m, v_m, ig, lf).transpose(0, 2, 1, 3)
        hm = rmsnorm(hm, mlstm_norm_g[l].reshape(M_HEADS, M_HEAD_DIM)).reshape(Bb, S, M_WIDTH)
        hm = (hm * jax.nn.sigmoid(mo.astype(jnp.float32))).astype(x.dtype)

        lam_init = 0.8 - 0.6 * math.exp(-0.3 * l)
        lam = (jnp.exp(jnp.sum(lambda_q1[l].astype(jnp.float32) * lambda_k1[l].astype(jnp.float32)))
               - jnp.exp(jnp.sum(lambda_q2[l].astype(jnp.float32) * lambda_k2[l].astype(jnp.float32)))
               + lam_init)
        qk_heads = lambda a: a.reshape(Bb, S, D_HEADS, 2, D_HEAD_DIM).transpose(0, 2, 3, 1, 4).astype(jnp.float32)
        q_d, k_d = qk_heads(dq), qk_heads(dk)
        v_d = dv.reshape(Bb, S, D_HEADS, 2 * D_HEAD_DIM).transpose(0, 2, 1, 3).astype(jnp.float32)
        od = diff_attention(q_d, k_d, v_d, lam)
        od = rmsnorm(od, diff_norm_g[l]) * (1.0 - lam_init)
        od = od.transpose(0, 2, 1, 3).reshape(Bb, S, D_WIDTH).astype(x.dtype)

        y = jnp.concatenate([hm, od], axis=-1) @ w_out[l]
        x = x + g1 * y

        h2 = rmsnorm(x, norm2_g[l]) * (1.0 + sc2) + sh2
        x = x + g2 * peer(h2, peer_w_query[l], peer_sub_keys[l], peer_u[l], peer_v[l])

    return rmsnorm(x, final_g)
```

```cpp
#include <hip/hip_runtime.h>
#include <hip/hip_cooperative_groups.h>
#include <cstdio>
#include <cstdint>
namespace cg = cooperative_groups;

namespace pg8 {
#define PG8_LAS __attribute__((address_space(3)))
typedef unsigned short bf16_t;
typedef short bf16x8 __attribute__((ext_vector_type(8)));
typedef float f32x4 __attribute__((ext_vector_type(4)));
typedef unsigned u32x4 __attribute__((ext_vector_type(4)));
constexpr int BM = 256, BK = 64, HALF = 128, HTB = HALF * BK * 2  , STAGE_BYTES = 8 * HTB, NXCD = 8, WGM = 8;

__host__ __device__ __forceinline__ int lds_byte(int r, int c) { const int st = (r >> 4) * 2 + (c >> 5), rr = r & 15, cc = c & 31, ob = rr * 64 + cc * 2; return st * 1024 + (ob ^ (((ob >> 9) & 1) << 5)); }
__host__ __device__ __forceinline__ void stage_rc(int b, int& R, int& C) { const int st = b / 1024, sb = b % 1024, swz = sb ^ (((sb >> 9) & 1) << 5); R = (st >> 1) * 16 + swz / 64; C = (st & 1) * 32 + (swz % 64) / 2; }
__host__ __device__ __forceinline__ int perm32(int rho) { const int n = rho >> 4, i = rho & 15; return 8 * (i >> 2) + 4 * n + (i & 3); }

struct Unit { int pm, pn; };
struct Gemm { const bf16_t* A; const bf16_t* Bt; int M, N, K; };

struct StaticOrder {
    int nM, nN, nwg, G, c;
    __host__ __device__ void init(int M, int N, int G_, int c_) { nM = M / BM; nN = N / BM; nwg = nM * nN; G = G_; c = c_; }
    __host__ __device__ bool next(int i, Unit& u) const {
        const long L = (long)i * G + c; if (L >= nwg) return false;
        int wgid = (int)L; { const int q = nwg / NXCD, r = nwg % NXCD, xcd = wgid % NXCD, off = wgid / NXCD; wgid = (xcd < r ? xcd * (q + 1) : r * (q + 1) + (xcd - r) * q) + off; }
        const int nig = WGM * nN, gid = wgid / nig, fm = gid * WGM, gsz = (nM - fm) < WGM ? (nM - fm) : WGM;
        u.pm = fm + ((wgid % nig) % gsz); u.pn = (wgid % nig) / gsz; return true;
    }
    __device__ __forceinline__ void a_ready(const Unit&) const {}
    __device__ __forceinline__ void done(const Unit&) const {}
};

__device__ __forceinline__ unsigned cvt_pk_bf16(float lo, float hi) { unsigned r; asm volatile("v_cvt_pk_bf16_f32 %0, %1, %2" : "=v"(r) : "v"(lo), "v"(hi)); return r; }

struct EpiStoreBf16 {
    static constexpr bool PERM = true, AFTER_DRAIN = false;
    bf16_t* O; int ldc;
    __device__ __forceinline__ void operator()(const f32x4 (&acc)[2][2][4][2], const Unit& u, int wr, int wc, int fr, int fq) const {
        const int row0 = u.pm * BM + wr * 64 + fr, col0 = u.pn * BM + wc * 32 + 8 * fq;
#pragma unroll
        for (int ai = 0; ai < 2; ++ai)
#pragma unroll
            for (int m = 0; m < 4; ++m) { bf16_t* rowp = O + (size_t)(row0 + ai * HALF + m * 16) * ldc + col0;
#pragma unroll
                for (int bj = 0; bj < 2; ++bj) { const f32x4 v0 = acc[ai][bj][m][0], v1 = acc[ai][bj][m][1];
                    u32x4 w; w.x = cvt_pk_bf16(v0[0], v0[1]); w.y = cvt_pk_bf16(v0[2], v0[3]); w.z = cvt_pk_bf16(v1[0], v1[1]); w.w = cvt_pk_bf16(v1[2], v1[3]);
                    *(u32x4*)(rowp + bj * HALF) = w; } }
    }
};
struct EpiStoreF16 {
    static constexpr bool PERM = true, AFTER_DRAIN = false;
    bf16_t* O; int ldc;
    static __device__ __forceinline__ unsigned pkh(float a, float b) { return (unsigned)__builtin_bit_cast(unsigned short, (_Float16)a) | ((unsigned)__builtin_bit_cast(unsigned short, (_Float16)b) << 16); }
    __device__ __forceinline__ void operator()(const f32x4 (&acc)[2][2][4][2], const Unit& u, int wr, int wc, int fr, int fq) const {
        const int row0 = u.pm * BM + wr * 64 + fr, col0 = u.pn * BM + wc * 32 + 8 * fq;
#pragma unroll
        for (int ai = 0; ai < 2; ++ai)
#pragma unroll
            for (int m = 0; m < 4; ++m) { bf16_t* rowp = O + (size_t)(row0 + ai * HALF + m * 16) * ldc + col0;
#pragma unroll
                for (int bj = 0; bj < 2; ++bj) { const f32x4 v0 = acc[ai][bj][m][0], v1 = acc[ai][bj][m][1];
                    u32x4 w; w.x = pkh(v0[0], v0[1]); w.y = pkh(v0[2], v0[3]); w.z = pkh(v1[0], v1[1]); w.w = pkh(v1[2], v1[3]);
                    *(u32x4*)(rowp + bj * HALF) = w; } }
    }
};
struct EpiResid {
    static constexpr bool PERM = true, AFTER_DRAIN = false;
    const float* x; const float* gate; float* out;
    __device__ __forceinline__ void operator()(const f32x4 (&acc)[2][2][4][2], const Unit& u, int wr, int wc, int fr, int fq) const {
        const int row0 = u.pm * BM + wr * 64 + fr, col0 = u.pn * BM + wc * 32 + 8 * fq;
#pragma unroll
        for (int ai = 0; ai < 2; ++ai)
#pragma unroll
            for (int m = 0; m < 4; ++m) { const int r = row0 + ai * HALF + m * 16; const float* gp = gate + (size_t)(r >> 11) * 6144;
#pragma unroll
                for (int bj = 0; bj < 2; ++bj) { const int c = col0 + bj * HALF;
                    const f32x4 xa = *(const f32x4*)(x + (size_t)r * 1024 + c), xb = *(const f32x4*)(x + (size_t)r * 1024 + c + 4);
                    const f32x4 ga = *(const f32x4*)(gp + c), gb = *(const f32x4*)(gp + c + 4);
                    *(f32x4*)(out + (size_t)r * 1024 + c) = xa + ga * acc[ai][bj][m][0];
                    *(f32x4*)(out + (size_t)r * 1024 + c + 4) = xb + gb * acc[ai][bj][m][1]; } }
    }
};
struct EpiResidNorm {
    static constexpr bool PERM = true, AFTER_DRAIN = false;
    const float* x; const float* mod; const float* ng; float* out; bf16_t* a3; float* rs;
    __device__ __forceinline__ void operator()(const f32x4 (&acc)[2][2][4][2], const Unit& u, int wr, int wc, int fr, int fq) const {
        const int row0 = u.pm * BM + wr * 64 + fr, col0 = u.pn * BM + wc * 32 + 8 * fq;
        const float* mp = mod + (size_t)((u.pm * BM) >> 11) * 6144;
        f32x4 g1v[2][2], csv[2][2];
#pragma unroll
        for (int bj = 0; bj < 2; ++bj)
#pragma unroll
            for (int n = 0; n < 2; ++n) { const int c = col0 + bj * HALF + 4 * n; g1v[bj][n] = *(const f32x4*)(mp + 2048 + c); csv[bj][n] = *(const f32x4*)(ng + c) * (*(const f32x4*)(mp + 4096 + c) + 1.0f); }
#pragma unroll
        for (int ai = 0; ai < 2; ++ai)
#pragma unroll
            for (int m = 0; m < 4; ++m) { const int r = row0 + ai * HALF + m * 16; float ss = 0.f;
#pragma unroll
                for (int bj = 0; bj < 2; ++bj) { const int c = col0 + bj * HALF;
                    const f32x4 xa = *(const f32x4*)(x + (size_t)r * 1024 + c), xb = *(const f32x4*)(x + (size_t)r * 1024 + c + 4);
                    const f32x4 v0 = xa + g1v[bj][0] * acc[ai][bj][m][0], v1 = xb + g1v[bj][1] * acc[ai][bj][m][1];
                    *(f32x4*)(out + (size_t)r * 1024 + c) = v0; *(f32x4*)(out + (size_t)r * 1024 + c + 4) = v1;
                    ss += (v0[0] * v0[0] + v0[1] * v0[1]) + (v0[2] * v0[2] + v0[3] * v0[3]) + (v1[0] * v1[0] + v1[1] * v1[1]) + (v1[2] * v1[2] + v1[3] * v1[3]);
                    const f32x4 a0 = v0 * csv[bj][0], a1 = v1 * csv[bj][1];
                    u32x4 w; w.x = cvt_pk_bf16(a0[0], a0[1]); w.y = cvt_pk_bf16(a0[2], a0[3]); w.z = cvt_pk_bf16(a1[0], a1[1]); w.w = cvt_pk_bf16(a1[2], a1[3]);
                    *(u32x4*)(a3 + (size_t)r * 1024 + c) = w; }
                ss += __shfl_xor(ss, 16); ss += __shfl_xor(ss, 32);
                if (fq == 0) rs[(size_t)r * 16 + (u.pn & 3) * 4 + wc] = ss; }
    }
};
struct EpiScoreF16 {
    static constexpr bool PERM = true, AFTER_DRAIN = false;
    bf16_t* O; int ldc; const float* rs; const float* sb;
    static __device__ __forceinline__ unsigned pkh(float a, float b) { return (unsigned)__builtin_bit_cast(unsigned short, (_Float16)a) | ((unsigned)__builtin_bit_cast(unsigned short, (_Float16)b) << 16); }
    __device__ __forceinline__ void operator()(const f32x4 (&acc)[2][2][4][2], const Unit& u, int wr, int wc, int fr, int fq) const {
        const int row0 = u.pm * BM + wr * 64 + fr, col0 = u.pn * BM + wc * 32 + 8 * fq;
        const float* sbp = sb + (size_t)((u.pm * BM) >> 11) * 2048;
        f32x4 bv[2][2];
#pragma unroll
        for (int bj = 0; bj < 2; ++bj)
#pragma unroll
            for (int n = 0; n < 2; ++n) bv[bj][n] = *(const f32x4*)(sbp + col0 + bj * HALF + 4 * n);
#pragma unroll
        for (int ai = 0; ai < 2; ++ai)
#pragma unroll
            for (int m = 0; m < 4; ++m) { const int r = row0 + ai * HALF + m * 16;
                float rstd; { const f32x4 p0 = *(const f32x4*)(rs + (size_t)r * 16), p1 = *(const f32x4*)(rs + (size_t)r * 16 + 4), p2 = *(const f32x4*)(rs + (size_t)r * 16 + 8), p3 = *(const f32x4*)(rs + (size_t)r * 16 + 12);
                  const f32x4 ps = (p0 + p1) + (p2 + p3); rstd = rsqrtf(((ps[0] + ps[1]) + (ps[2] + ps[3])) * (1.f / 1024.f) + 1e-6f); }
                bf16_t* rowp = O + (size_t)r * ldc + col0;
#pragma unroll
                for (int bj = 0; bj < 2; ++bj) { const f32x4 v0 = acc[ai][bj][m][0] * rstd + bv[bj][0], v1 = acc[ai][bj][m][1] * rstd + bv[bj][1];
                    u32x4 w; w.x = pkh(v0[0], v0[1]); w.y = pkh(v0[2], v0[3]); w.z = pkh(v1[0], v1[1]); w.w = pkh(v1[2], v1[3]);
                    *(u32x4*)(rowp + bj * HALF) = w; } }
    }
};
template <class Epi, class Sched, bool ALIGN_EPI = false, bool SP2 = false>
__device__ __forceinline__ void gemm_phase(PG8_LAS unsigned char* lds, const Gemm g, const Sched& S, const Epi& E) {
    int tid_o = threadIdx.x; asm volatile("" : "+v"(tid_o)); const int tid = tid_o, wid = __builtin_amdgcn_readfirstlane(tid >> 6), lane = tid & 63, wr = wid >> 2, wc = wid & 3, fr = lane & 15, fq = lane >> 4;
    const int K = g.K, nt = K / BK;
    unsigned voffA[2], voffB[2];
#pragma unroll
    for (int i = 0; i < 2; ++i) { int R, C; stage_rc(tid * 16 + i * 8192, R, C); const int Rb = Epi::PERM ? ((R & ~31) + perm32(R & 31)) : R;
        voffA[i] = (unsigned)(R * K + C) * 2u; voffB[i] = (unsigned)(Rb * K + C) * 2u; }
    const size_t kstep = (size_t)(BK * 2);
    const size_t hstep = (size_t)HALF * K * 2;
    const size_t tstep = 2 * hstep;
    const unsigned ldsw = (unsigned)wid * 1024u;
    const int aoff = lds_byte(wr * 64 + fr, fq * 8), boff = lds_byte(wc * 32 + fr, fq * 8);
#define PG8_SA(b, h) (((b) * 2 + (h)) * HTB)
#define PG8_SB(b, h) ((4 + (b) * 2 + (h)) * HTB)
#define PG8_STAGE(bufoff, gbase, voff) do { _Pragma("unroll") for (int _i = 0; _i < 2; ++_i) \
        __builtin_amdgcn_global_load_lds((const unsigned*)((const char*)(gbase) + (voff)[_i]), (PG8_LAS unsigned*)(lds + (bufoff) + ldsw + _i * 8192), 16, 0, 0); } while (0)
#define PG8_LDA(dst, b, h) do { _Pragma("unroll") for (int m = 0; m < 4; ++m) _Pragma("unroll") for (int k = 0; k < 2; ++k) dst[m][k] = *(const PG8_LAS bf16x8*)(lds + PG8_SA(b, h) + aoff + m * 2048 + k * 1024); } while (0)
#define PG8_LDB(dst, b, h) do { _Pragma("unroll") for (int n = 0; n < 2; ++n) _Pragma("unroll") for (int k = 0; k < 2; ++k) dst[n][k] = *(const PG8_LAS bf16x8*)(lds + PG8_SB(b, h) + boff + n * 2048 + k * 1024); } while (0)
#define PG8_MMA(ai, bj, At, Bt) do { __builtin_amdgcn_s_setprio(1); _Pragma("unroll") for (int m = 0; m < 4; ++m) _Pragma("unroll") for (int n = 0; n < 2; ++n) _Pragma("unroll") for (int k = 0; k < 2; ++k) \
        acc[ai][bj][m][n] = __builtin_amdgcn_mfma_f32_16x16x32_bf16(Bt[n][k], At[m][k], acc[ai][bj][m][n], 0, 0, 0); __builtin_amdgcn_s_setprio(0); } while (0)
#define PG8_WAIT_V(n) asm volatile("s_waitcnt vmcnt(" #n ")" ::: "memory")
#define PG8_WAIT_L(n) asm volatile("s_waitcnt lgkmcnt(" #n ")" ::: "memory")
#define PG8_BAR __builtin_amdgcn_s_barrier()
#define PG8_SCHED __builtin_amdgcn_sched_barrier(0)
    Unit cur, nxt; int ui = 0;
    if (!S.next(0, cur)) return;
    f32x4 acc[2][2][4][2];
#pragma unroll
    for (int a = 0; a < 2; ++a)
#pragma unroll
        for (int b = 0; b < 2; ++b)
#pragma unroll
            for (int m = 0; m < 4; ++m)
#pragma unroll
                for (int n = 0; n < 2; ++n) acc[a][b][m][n] = (f32x4){0.f, 0.f, 0.f, 0.f};
    bf16x8 At[4][2], B0[2][2], B1[2][2];
    const char* cA = (const char*)g.A + (size_t)cur.pm * tstep; const char* cB = (const char*)g.Bt + (size_t)cur.pn * tstep;
    S.a_ready(cur);
    if constexpr (SP2) {
        PG8_STAGE(PG8_SB(0, 0), cB, voffB); PG8_STAGE(PG8_SB(0, 1), cB + hstep, voffB); PG8_STAGE(PG8_SA(0, 0), cA, voffA); PG8_STAGE(PG8_SA(0, 1), cA + hstep, voffA);
        if (wr == 1) PG8_BAR;
        PG8_WAIT_V(2); PG8_BAR;
        PG8_STAGE(PG8_SB(1, 0), cB + kstep, voffB); PG8_STAGE(PG8_SA(1, 0), cA + kstep, voffA); PG8_STAGE(PG8_SB(1, 1), cB + hstep + kstep, voffB);
        PG8_WAIT_V(6); PG8_BAR;
    } else {
        PG8_STAGE(PG8_SB(0, 0), cB, voffB); PG8_STAGE(PG8_SA(0, 0), cA, voffA); PG8_STAGE(PG8_SB(0, 1), cB + hstep, voffB); PG8_STAGE(PG8_SA(0, 1), cA + hstep, voffA);
        if (wr == 1) PG8_BAR;
        PG8_WAIT_V(4); PG8_BAR;
        PG8_STAGE(PG8_SB(1, 0), cB + kstep, voffB); PG8_STAGE(PG8_SA(1, 0), cA + kstep, voffA); PG8_STAGE(PG8_SB(1, 1), cB + hstep + kstep, voffB);
        PG8_WAIT_V(6); PG8_BAR;
    }
    for (;;) {
        const bool has_next = S.next(ui + 1, nxt);
        const char* nA = has_next ? (const char*)g.A + (size_t)nxt.pm * tstep : cA; const char* nB = has_next ? (const char*)g.Bt + (size_t)nxt.pn * tstep : cB;
        for (int t = 0; t < nt; t += 2) {
            const bool last = (t == nt - 2);
            const char* a1 = cA + (size_t)(t + 1) * kstep;
            const char* a2 = last ? nA : cA + (size_t)(t + 2) * kstep; const char* b2 = last ? nB : cB + (size_t)(t + 2) * kstep;
            const char* a3 = a2 + kstep; const char* b3 = b2 + kstep;
            if (last && has_next) S.a_ready(nxt);
            if constexpr (SP2) {
            PG8_LDB(B0, 0, 0); PG8_LDB(B1, 0, 1); PG8_SCHED; PG8_LDA(At, 0, 0); PG8_STAGE(PG8_SA(1, 1), a1 + hstep, voffA);
            PG8_WAIT_V(8); PG8_WAIT_L(0); PG8_BAR; PG8_MMA(0, 0, At, B0); PG8_MMA(0, 1, At, B1); PG8_BAR; PG8_SCHED;
            PG8_LDA(At, 0, 1); PG8_STAGE(PG8_SB(0, 0), b2, voffB); PG8_STAGE(PG8_SB(0, 1), b2 + hstep, voffB); PG8_STAGE(PG8_SA(0, 0), a2, voffA);
            PG8_WAIT_V(8); PG8_WAIT_L(0); PG8_BAR; PG8_MMA(1, 0, At, B0); PG8_MMA(1, 1, At, B1); PG8_BAR; PG8_SCHED;
            PG8_LDB(B0, 1, 0); PG8_LDB(B1, 1, 1); PG8_SCHED; PG8_LDA(At, 1, 0); PG8_STAGE(PG8_SA(0, 1), a2 + hstep, voffA);
            PG8_WAIT_V(8); PG8_WAIT_L(0); PG8_BAR; PG8_MMA(0, 0, At, B0); PG8_MMA(0, 1, At, B1); PG8_BAR; PG8_SCHED;
            PG8_LDA(At, 1, 1); PG8_STAGE(PG8_SB(1, 0), b3, voffB); PG8_STAGE(PG8_SB(1, 1), b3 + hstep, voffB); PG8_STAGE(PG8_SA(1, 0), a3, voffA);
            PG8_WAIT_V(8); PG8_WAIT_L(0); PG8_BAR; PG8_MMA(1, 0, At, B0); PG8_MMA(1, 1, At, B1); PG8_BAR; PG8_SCHED;
            } else {
            PG8_LDB(B0, 0, 0); PG8_SCHED; PG8_LDA(At, 0, 0); PG8_STAGE(PG8_SA(1, 1), a1 + hstep, voffA);
            PG8_WAIT_L(8); PG8_BAR; PG8_WAIT_L(0); PG8_MMA(0, 0, At, B0); PG8_BAR; PG8_SCHED;
            PG8_LDB(B1, 0, 1); PG8_STAGE(PG8_SB(0, 0), b2, voffB);
            PG8_BAR; PG8_WAIT_L(0); PG8_MMA(0, 1, At, B1); PG8_BAR;
            PG8_LDA(At, 0, 1); PG8_STAGE(PG8_SA(0, 0), a2, voffA);
            PG8_BAR; PG8_WAIT_L(0); PG8_MMA(1, 0, At, B0); PG8_BAR; PG8_SCHED;
            PG8_STAGE(PG8_SB(0, 1), b2 + hstep, voffB);
            PG8_WAIT_V(6); PG8_BAR; PG8_MMA(1, 1, At, B1); PG8_BAR;
            PG8_LDB(B0, 1, 0); PG8_SCHED; PG8_LDA(At, 1, 0); PG8_STAGE(PG8_SA(0, 1), a2 + hstep, voffA);
            PG8_WAIT_L(8); PG8_BAR; PG8_WAIT_L(0); PG8_MMA(0, 0, At, B0); PG8_BAR; PG8_SCHED;
            PG8_LDB(B1, 1, 1); PG8_STAGE(PG8_SB(1, 0), b3, voffB);
            PG8_BAR; PG8_WAIT_L(0); PG8_MMA(0, 1, At, B1); PG8_BAR;
            PG8_LDA(At, 1, 1); PG8_STAGE(PG8_SA(1, 0), a3, voffA);
            PG8_BAR; PG8_WAIT_L(0); PG8_MMA(1, 0, At, B0); PG8_BAR; PG8_SCHED;
            PG8_STAGE(PG8_SB(1, 1), b3 + hstep, voffB);
            PG8_WAIT_V(6); PG8_BAR; PG8_MMA(1, 1, At, B1); PG8_BAR;
            }
        }
        if constexpr (ALIGN_EPI) { if (wr == 0) PG8_BAR; }
        if constexpr (!Epi::AFTER_DRAIN) { E(acc, cur, wr, wc, fr, fq); S.done(cur); }
        if (!has_next) break;
#pragma unroll
        for (int a = 0; a < 2; ++a)
#pragma unroll
            for (int b = 0; b < 2; ++b)
#pragma unroll
                for (int m = 0; m < 4; ++m)
#pragma unroll
                    for (int n = 0; n < 2; ++n) acc[a][b][m][n] = (f32x4){0.f, 0.f, 0.f, 0.f};
        cur = nxt; cA = nA; cB = nB; ++ui;
        if constexpr (ALIGN_EPI) { if (wr == 1) PG8_BAR; }
    }
    PG8_WAIT_V(0);
    if constexpr (!ALIGN_EPI) { if (wr == 0) PG8_BAR; }
    PG8_BAR;
    if constexpr (Epi::AFTER_DRAIN) { E.fused(acc, cur, wr, wc, fr, fq, lds, wid, lane); S.done(cur); }
#undef PG8_SA
#undef PG8_SB
#undef PG8_STAGE
#undef PG8_LDA
#undef PG8_LDB
#undef PG8_MMA
#undef PG8_WAIT_V
#undef PG8_WAIT_L
#undef PG8_BAR
#undef PG8_SCHED
}
}


#define LAS __attribute__((address_space(3)))
typedef unsigned short bf16_t;
typedef short bf16x8 __attribute__((ext_vector_type(8)));
typedef short s16x4 __attribute__((ext_vector_type(4)));
typedef short v4i16_t __attribute__((ext_vector_type(4)));
typedef float f32x4 __attribute__((ext_vector_type(4)));
typedef unsigned u32x4 __attribute__((ext_vector_type(4)));
typedef unsigned u32x2 __attribute__((ext_vector_type(2)));
typedef float f32x2 __attribute__((ext_vector_type(2)));

constexpr int T = 16384, DM = 1024, SEQ = 2048, NP = 3584;
constexpr size_t MiB = 1u << 20;
constexpr size_t WS_CTL = 0, WS_MOD = 4096, WS_GATES = 262144, WS_KEYS = 1 * MiB, WS_WIN = 2 * MiB, WS_WOUT = 9 * MiB, WS_WQ = 11 * MiB,
                 WS_T8 = 16 * MiB, WS_SC = 48 * MiB, WS_ACT = 80 * MiB, WS_P = 112 * MiB, WS_QRY = 112 * MiB, WS_END = 256 * MiB;
constexpr size_t WS_RS = 208 * MiB, WS_SB = 851968, WS_A3 = 176 * MiB;
constexpr int LDS_BYTES = 147456;

__device__ __forceinline__ unsigned f2bf(float f) { unsigned u = __float_as_uint(f); return (u + 0x7fffu + ((u >> 16) & 1u)) >> 16; }
typedef __bf16 bf16x2_t __attribute__((ext_vector_type(2)));
__device__ __forceinline__ unsigned pk2(float lo, float hi) { const f32x2 v = {lo, hi}; const bf16x2_t b = __builtin_convertvector(v, bf16x2_t); return __builtin_bit_cast(unsigned, b); }
__device__ __forceinline__ float bflo(unsigned u) { return __uint_as_float(u << 16); }
__device__ __forceinline__ float bfhi(unsigned u) { return __uint_as_float(u & 0xffff0000u); }
__device__ __forceinline__ float wave_sum(float v) {
    { const auto r = __builtin_amdgcn_permlane32_swap(__float_as_uint(v), __float_as_uint(v), false, false); v = __uint_as_float(r[0]) + __uint_as_float(r[1]); }
    { const auto r = __builtin_amdgcn_permlane16_swap(__float_as_uint(v), __float_as_uint(v), false, false); v = __uint_as_float(r[0]) + __uint_as_float(r[1]); }
    v += __int_as_float(__builtin_amdgcn_mov_dpp(__float_as_int(v), 0xB1, 0xF, 0xF, true));
    v += __int_as_float(__builtin_amdgcn_mov_dpp(__float_as_int(v), 0x4E, 0xF, 0xF, true));
    v += __int_as_float(__builtin_amdgcn_mov_dpp(__float_as_int(v), 0x141, 0xF, 0xF, true));
    v += __int_as_float(__builtin_amdgcn_mov_dpp(__float_as_int(v), 0x140, 0xF, 0xF, true));
    return v;
}
__device__ __forceinline__ float xrow_max(float v) {
    { const auto r = __builtin_amdgcn_permlane16_swap(__float_as_uint(v), __float_as_uint(v), false, false); v = fmaxf(__uint_as_float(r[0]), __uint_as_float(r[1])); }
    { const auto r = __builtin_amdgcn_permlane32_swap(__float_as_uint(v), __float_as_uint(v), false, false); v = fmaxf(__uint_as_float(r[0]), __uint_as_float(r[1])); }
    return v;
}
__device__ __forceinline__ float xrow_sum(float v) {
    { const auto r = __builtin_amdgcn_permlane16_swap(__float_as_uint(v), __float_as_uint(v), false, false); v = __uint_as_float(r[0]) + __uint_as_float(r[1]); }
    { const auto r = __builtin_amdgcn_permlane32_swap(__float_as_uint(v), __float_as_uint(v), false, false); v = __uint_as_float(r[0]) + __uint_as_float(r[1]); }
    return v;
}
#define LDS_WAIT() asm volatile("s_waitcnt lgkmcnt(0)" ::: "memory")
__device__ __forceinline__ s16x4 vtr(LAS unsigned char* p) { return __builtin_bit_cast(s16x4, __builtin_amdgcn_ds_read_tr16_b64_v4i16((LAS v4i16_t*)p)); }
__device__ __forceinline__ bf16x8 cat8(s16x4 a, s16x4 b) { bf16x8 r; r[0] = a[0]; r[1] = a[1]; r[2] = a[2]; r[3] = a[3]; r[4] = b[0]; r[5] = b[1]; r[6] = b[2]; r[7] = b[3]; return r; }
__device__ __forceinline__ bf16x8 pack8(const f32x4 a, const f32x4 b) { u32x4 w; w.x = pk2(a[0], a[1]); w.y = pk2(a[2], a[3]); w.z = pk2(b[0], b[1]); w.w = pk2(b[2], b[3]); return __builtin_bit_cast(bf16x8, w); }
#define MFMA16(a, b, c) __builtin_amdgcn_mfma_f32_16x16x32_bf16((a), (b), (c), 0, 0, 0)

struct Args {
    const float *x, *c, *ada_w, *ada_b, *norm1_g, *w_in, *conv_w, *conv_b, *gate_b, *mnorm_g, *lq1, *lk1, *lq2, *lk2, *dnorm_g, *w_out, *norm2_g, *wq, *keys, *pu, *pv, *final_g;
    float* out; unsigned char* ws;
};

__device__ __forceinline__ void transpose_item(const float* W, int srcN, int soff, bf16_t* WT, LAS float* scr, int kb, int nb, int lane) {
    const int k0 = 64 * kb, n0 = 32 * nb;
    { f32x4 wv[8];
#pragma unroll
      for (int i = 0; i < 8; ++i) wv[i] = *(const f32x4*)(W + (size_t)(k0 + 8 * i + (lane >> 3)) * srcN + n0 + soff + 4 * (lane & 7));
#pragma unroll
      for (int i = 0; i < 8; ++i) { LAS float* d = scr + (8 * i + (lane >> 3)) * 33 + 4 * (lane & 7); d[0] = wv[i][0]; d[1] = wv[i][1]; d[2] = wv[i][2]; d[3] = wv[i][3]; } }
    LDS_WAIT(); asm volatile("" ::: "memory");
    const int c = lane & 7;
#pragma unroll
    for (int j = 0; j < 4; ++j) { const int n = (lane >> 3) + 8 * j; const LAS float* s = scr + (8 * c) * 33 + n;
        u32x4 o; o.x = pk2(s[0 * 33], s[1 * 33]); o.y = pk2(s[2 * 33], s[3 * 33]); o.z = pk2(s[4 * 33], s[5 * 33]); o.w = pk2(s[6 * 33], s[7 * 33]);
        *(u32x4*)(WT + (size_t)(n0 + n) * 1024 + k0 + 8 * c) = o; }
    LDS_WAIT(); asm volatile("" ::: "memory");
}

__device__ __forceinline__ bf16x8 pack8_sw(const f32x4 a, const f32x4 b) {
    u32x4 w; w.x = f2bf(a[0]) | (f2bf(a[1]) << 16); w.y = f2bf(a[2]) | (f2bf(a[3]) << 16); w.z = f2bf(b[0]) | (f2bf(b[1]) << 16); w.w = f2bf(b[2]) | (f2bf(b[3]) << 16); return __builtin_bit_cast(bf16x8, w); }
__device__ __forceinline__ void wprime_item(const Args& A, int hp, int kt, int lane) {
    const int g = lane >> 4, l15 = lane & 15;
    f32x4 acc[8];
#pragma unroll
    for (int nt = 0; nt < 8; ++nt) acc[nt] = (f32x4){0.f, 0.f, 0.f, 0.f};
#pragma unroll
    for (int ks = 0; ks < 4; ++ks) {
        const float* ap = A.wq + (size_t)(16 * kt + l15) * 2048 + hp * 128 + 32 * ks + 8 * g;
        const bf16x8 a = pack8(*(const f32x4*)ap, *(const f32x4*)(ap + 4));
#pragma unroll
        for (int nt = 0; nt < 8; ++nt) { const float* bp = A.keys + (size_t)(hp * 128 + 16 * nt + l15) * 128 + 32 * ks + 8 * g;
            const bf16x8 b = pack8(*(const f32x4*)bp, *(const f32x4*)(bp + 4)); acc[nt] = MFMA16(a, b, acc[nt]); }
    }
    bf16_t* WT = (bf16_t*)(A.ws + WS_WQ);
#pragma unroll
    for (int nt = 0; nt < 8; ++nt) { u32x2 o; o.x = pk2(acc[nt][0], acc[nt][1]); o.y = pk2(acc[nt][2], acc[nt][3]);
        *(u32x2*)(WT + (size_t)(hp * 128 + 16 * nt + l15) * 1024 + 16 * kt + 4 * g) = o; }
}

__device__ __forceinline__ void phase0(const Args& A, LAS unsigned char* lds) {
    int tid_o = threadIdx.x; asm volatile("" : "+v"(tid_o)); const int tid = tid_o, lane = tid & 63, wave = tid >> 6, G = gridDim.x;
    float* MOD = (float*)(A.ws + WS_MOD);
    if ((int)blockIdx.x < 192) {
        LAS float* sc = (LAS float*)lds;
        for (int i = tid; i < 8192; i += 512) { const float v = A.c[i]; sc[i] = v * __builtin_amdgcn_rcpf(1.f + __expf(-v)); }
        __syncthreads();
        for (int item = blockIdx.x; item < 192; item += G) {
            const int j0 = item * 32, kg = tid >> 3, cq = tid & 7;
            f32x4 wv[16];
#pragma unroll
            for (int kk = 0; kk < 16; ++kk) wv[kk] = *(const f32x4*)(A.ada_w + (size_t)(kg * 16 + kk) * 6144 + j0 + 4 * cq);
            f32x4 acc[8];
#pragma unroll
            for (int b = 0; b < 8; ++b) acc[b] = (f32x4){0.f, 0.f, 0.f, 0.f};
#pragma unroll
            for (int b = 0; b < 8; ++b)
#pragma unroll
                for (int k4 = 0; k4 < 4; ++k4) { const f32x4 s4 = *(const LAS f32x4*)(sc + b * 1024 + kg * 16 + 4 * k4);
                    acc[b] += wv[4 * k4] * s4[0]; acc[b] += wv[4 * k4 + 1] * s4[1]; acc[b] += wv[4 * k4 + 2] * s4[2]; acc[b] += wv[4 * k4 + 3] * s4[3]; }
            LAS float* part = (LAS float*)(lds + 32768);
#pragma unroll
            for (int b = 0; b < 8; ++b) *(LAS f32x4*)(part + (kg * 8 + b) * 32 + 4 * cq) = acc[b];
            __syncthreads();
            if (tid < 256) { const int b = tid >> 5, col = tid & 31; float s = A.ada_b[j0 + col];
              for (int k2 = 0; k2 < 64; ++k2) s += part[(k2 * 8 + b) * 32 + col];
              MOD[b * 6144 + j0 + col] = s; }
            __syncthreads();
        }
    }
    if (blockIdx.x == 0 && tid == 0) {
        float s1 = 0.f, s2 = 0.f;
        for (int i = 0; i < 64; ++i) { s1 += A.lq1[i] * A.lk1[i]; s2 += A.lq2[i] * A.lk2[i]; }
        ((float*)(A.ws + WS_CTL))[1] = expf(s1) - expf(s2) + 0.2f;
        ((unsigned*)(A.ws + WS_CTL))[0] = 0u; ((unsigned*)(A.ws + WS_CTL))[2] = 0u;
    }
}

__device__ __forceinline__ void phase0b(const Args& A, LAS unsigned char* lds) {
    int tid_o = threadIdx.x; asm volatile("" : "+v"(tid_o)); const int tid = tid_o, lane = tid & 63, wave = tid >> 6, G = gridDim.x;
    __syncthreads();
    {
        LAS float* scr = (LAS float*)(lds + wave * 16384);
        const int gw = blockIdx.x * 8 + wave, NGW = G * 8;
        for (int it = gw; it < 3328; it += NGW) {
            int r = it;
            if (r < 1792) { const int kb = r / 112, nb = r % 112; transpose_item(A.w_in, 3592, nb >= 64 ? 8 : 0, (bf16_t*)(A.ws + WS_WIN), scr, kb, nb, lane); continue; }
            r -= 1792;
            if (r < 512) { transpose_item(A.w_out, 1024, 0, (bf16_t*)(A.ws + WS_WOUT), scr, r / 32, r % 32, lane); continue; }
            r -= 512;
            wprime_item(A, r >> 6, r & 63, lane);
        }
    }
    {
        for (int i = blockIdx.x * 512 + tid; i < 32768; i += G * 512) {
            const f32x4 a = *(const f32x4*)(A.keys + (size_t)i * 8), b = *(const f32x4*)(A.keys + (size_t)i * 8 + 4);
            u32x4 o; o.x = pk2(a[0], a[1]); o.y = pk2(a[2], a[3]); o.z = pk2(b[0], b[1]); o.w = pk2(b[2], b[3]);
            *(u32x4*)((bf16_t*)(A.ws + WS_KEYS) + (size_t)i * 8) = o;
        }
    }
}

__device__ __forceinline__ void quantise_tables(const Args& A, int gw, int NGW) {
    int tid_o = threadIdx.x; asm volatile("" : "+v"(tid_o)); const int lane = tid_o & 63;
    {
        unsigned char* T8 = A.ws + WS_T8; float* SC = (float*)(A.ws + WS_SC);
        for (int row = gw; row < 32768; row += 2 * NGW) {
            const int row2 = row + NGW; const bool has2 = row2 < 32768;
            const float* s0 = (row < 16384 ? A.pu + (size_t)row * 1024 : A.pv + (size_t)(row - 16384) * 1024) + 16 * lane;
            const int r2 = has2 ? row2 : row;
            const float* s1 = (r2 < 16384 ? A.pu + (size_t)r2 * 1024 : A.pv + (size_t)(r2 - 16384) * 1024) + 16 * lane;
            f32x4 v0[4], v1[4];
#pragma unroll
            for (int j = 0; j < 4; ++j) { v0[j] = *(const f32x4*)(s0 + 4 * j); v1[j] = *(const f32x4*)(s1 + 4 * j); }
            float m0 = 0.f, m1 = 0.f;
#pragma unroll
            for (int j = 0; j < 4; ++j)
#pragma unroll
                for (int e = 0; e < 4; ++e) { m0 = fmaxf(m0, fabsf(v0[j][e])); m1 = fmaxf(m1, fabsf(v1[j][e])); }
#pragma unroll
            for (int o = 1; o < 64; o <<= 1) { m0 = fmaxf(m0, __shfl_xor(m0, o)); m1 = fmaxf(m1, __shfl_xor(m1, o)); }
            const float sc0 = fmaxf(m0, 1e-30f) * (1.f / 256.f), sc1 = fmaxf(m1, 1e-30f) * (1.f / 256.f);
            const float i0 = 1.f / sc0, i1 = 1.f / sc1;
            u32x4 o0, o1;
#pragma unroll
            for (int j = 0; j < 4; ++j) {
                int w0 = __builtin_amdgcn_cvt_pk_fp8_f32(v0[j][0] * i0, v0[j][1] * i0, 0, false); w0 = __builtin_amdgcn_cvt_pk_fp8_f32(v0[j][2] * i0, v0[j][3] * i0, w0, true);
                int w1 = __builtin_amdgcn_cvt_pk_fp8_f32(v1[j][0] * i1, v1[j][1] * i1, 0, false); w1 = __builtin_amdgcn_cvt_pk_fp8_f32(v1[j][2] * i1, v1[j][3] * i1, w1, true);
                o0[j] = (unsigned)w0; o1[j] = (unsigned)w1; }
            *(u32x4*)(T8 + (size_t)row * 1024 + 16 * lane) = o0;
            if (lane == 0) SC[row] = sc0;
            if (has2) { *(u32x4*)(T8 + (size_t)row2 * 1024 + 16 * lane) = o1; if (lane == 0) SC[row2] = sc1; }
        }
    }
}

__device__ __forceinline__ void phase1(const Args& A, LAS unsigned char* lds) {
    int tid_o = threadIdx.x; asm volatile("" : "+v"(tid_o)); const int tid = tid_o, lane = tid & 63, wave = tid >> 6, G = gridDim.x;
    const float* MOD = (const float*)(A.ws + WS_MOD);
    bf16_t* ACT = (bf16_t*)(A.ws + WS_ACT);
    float* GATES = (float*)(A.ws + WS_GATES);
    LAS float* WG = (LAS float*)lds;
    for (int i = tid; i < 8192; i += 512) { const int k = i >> 3, gc = i & 7; WG[gc * 1024 + k] = A.w_in[(size_t)k * 3592 + 2048 + gc]; }
    __syncthreads();
    f32x4 vn[4];
    { const int m0 = blockIdx.x * 8 + wave; if (m0 < T) { const f32x4* xr = (const f32x4*)(A.x + (size_t)m0 * 1024) + lane;
#pragma unroll
        for (int j = 0; j < 4; ++j) vn[j] = xr[64 * j]; } }
    for (int m = blockIdx.x * 8 + wave; m < T; m += G * 8) {
        const int b = m >> 11;
        f32x4 v[4]; float ss = 0.f;
#pragma unroll
        for (int j = 0; j < 4; ++j) { v[j] = vn[j]; ss += (v[j][0] * v[j][0] + v[j][1] * v[j][1]) + (v[j][2] * v[j][2] + v[j][3] * v[j][3]); }
        if (m + G * 8 < T) { const f32x4* xr = (const f32x4*)(A.x + (size_t)(m + G * 8) * 1024) + lane;
#pragma unroll
            for (int j = 0; j < 4; ++j) vn[j] = xr[64 * j]; }
        const float rstd = rsqrtf(wave_sum(ss) * (1.f / 1024.f) + 1e-6f);
        unsigned long long* o8 = (unsigned long long*)(ACT + (size_t)m * 1024) + lane;
#pragma unroll
        for (int j = 0; j < 4; ++j) { const int col = 4 * lane + 256 * j;
            const f32x4 g = *(const f32x4*)(A.norm1_g + col), sc = *(const f32x4*)(MOD + b * 6144 + 1024 + col), sh = *(const f32x4*)(MOD + b * 6144 + col);
            v[j] = v[j] * rstd * g * (sc + 1.0f) + sh;
            o8[64 * j] = (unsigned long long)pk2(v[j][0], v[j][1]) | ((unsigned long long)pk2(v[j][2], v[j][3]) << 32); }
        float gd[8];
#pragma unroll
        for (int gc = 0; gc < 8; ++gc) { float d = 0.f;
#pragma unroll
            for (int j = 0; j < 4; ++j) { const f32x4 w = *(const LAS f32x4*)(WG + gc * 1024 + 256 * j + 4 * lane); d += (v[j][0] * w[0] + v[j][1] * w[1]) + (v[j][2] * w[2] + v[j][3] * w[3]); }
            gd[gc] = wave_sum(d); }
        if (lane == 0) {
            f32x4 ig, lf;
#pragma unroll
            for (int h = 0; h < 4; ++h) { ig[h] = gd[h] + A.gate_b[h]; const float z = gd[4 + h] + A.gate_b[4 + h]; lf[h] = fminf(z, 0.f) - log1pf(expf(-fabsf(z))); }
            *(f32x4*)(GATES + (size_t)m * 8) = ig; *(f32x4*)(GATES + (size_t)m * 8 + 4) = lf;
        }
    }
}

constexpr int AK_STRIDE = 272, AV_STRIDE = 288, AK_BYTES = 64 * AK_STRIDE, AV_BYTES = 64 * AV_STRIDE;
__device__ __forceinline__ void attn_item(const Args& A, LAS unsigned char* lds, int b, int h, int qb, float lam) {
    int tid_o = threadIdx.x; asm volatile("" : "+v"(tid_o)); const int tid = tid_o, lane = tid & 63, w = tid >> 6, g = lane >> 4, l15 = lane & 15;
    const bf16_t* P = (const bf16_t*)(A.ws + WS_P);
    bf16_t* ACT = (bf16_t*)(A.ws + WS_ACT);
    const int t0 = qb * 128, ntiles = 2 * (qb + 1);
    const size_t rowbase = (size_t)b * SEQ;
    bf16x8 qf[2][2];
    { const bf16_t* qp = P + (rowbase + t0 + 16 * w + l15) * NP + 2048 + h * 128 + 8 * g;
#pragma unroll
      for (int p = 0; p < 2; ++p)
#pragma unroll
          for (int ks = 0; ks < 2; ++ks) qf[p][ks] = *(const bf16x8*)(qp + p * 64 + ks * 32); }
    f32x4 o[2][8];
#pragma unroll
    for (int p = 0; p < 2; ++p)
#pragma unroll
        for (int vt = 0; vt < 8; ++vt) o[p][vt] = (f32x4){0.f, 0.f, 0.f, 0.f};
    float mrun[2] = {-1e30f, -1e30f}, lrun[2] = {0.f, 0.f};
    const int srow = tid >> 3, sseg = tid & 7;
    const bf16_t* kg = P + (rowbase + srow) * NP + 2560 + h * 128 + sseg * 16;
    const bf16_t* vg = P + (rowbase + srow) * NP + 3072 + h * 128 + sseg * 16;
    u32x4 kr0, kr1, vr0, vr1;
    kr0 = *(const u32x4*)(kg); kr1 = *(const u32x4*)(kg + 8); vr0 = *(const u32x4*)(vg); vr1 = *(const u32x4*)(vg + 8);
    { LAS unsigned char* kb = lds + srow * AK_STRIDE + sseg * 32; LAS unsigned char* vb = lds + 2 * AK_BYTES + srow * AV_STRIDE + sseg * 32;
      *(LAS u32x4*)kb = kr0; *(LAS u32x4*)(kb + 16) = kr1; *(LAS u32x4*)vb = vr0; *(LAS u32x4*)(vb + 16) = vr1; }
    __syncthreads();
    const float cs = 0.125f * 1.4426950408889634f;
    const int qabs = t0 + 16 * w + l15;
    for (int kt = 0; kt < ntiles; ++kt) {
        const int cur = kt & 1;
        if (kt + 1 < ntiles) { const size_t off = (size_t)(kt + 1) * 64 * NP;
            kr0 = *(const u32x4*)(kg + off); kr1 = *(const u32x4*)(kg + off + 8); vr0 = *(const u32x4*)(vg + off); vr1 = *(const u32x4*)(vg + off + 8); }
        if (64 * kt <= t0 + 16 * w + 15) {
            LAS unsigned char* Kb = lds + cur * AK_BYTES; LAS unsigned char* Vb = lds + 2 * AK_BYTES + cur * AV_BYTES;
            f32x4 s[2][4];
#pragma unroll
            for (int p = 0; p < 2; ++p)
#pragma unroll
                for (int k4 = 0; k4 < 4; ++k4) { f32x4 a = (f32x4){0.f, 0.f, 0.f, 0.f};
#pragma unroll
                    for (int ks = 0; ks < 2; ++ks) { const bf16x8 kf = *(const LAS bf16x8*)(Kb + (16 * k4 + l15) * AK_STRIDE + (p * 64 + ks * 32 + 8 * g) * 2); a = MFMA16(kf, qf[p][ks], a); }
                    s[p][k4] = a; }
            if (64 * kt + 63 > t0 + 16 * w) {
#pragma unroll
                for (int p = 0; p < 2; ++p)
#pragma unroll
                    for (int k4 = 0; k4 < 4; ++k4)
#pragma unroll
                        for (int r = 0; r < 4; ++r) { const int key = 64 * kt + 16 * k4 + 4 * g + r; if (key > qabs) s[p][k4][r] = -1e30f; }
            }
            bf16x8 pf[2][2];
#pragma unroll
            for (int p = 0; p < 2; ++p) {
                float mx = -1e30f;
#pragma unroll
                for (int k4 = 0; k4 < 4; ++k4)
#pragma unroll
                    for (int r = 0; r < 4; ++r) mx = fmaxf(mx, s[p][k4][r]);
                mx = xrow_max(mx);
                const float mnew = fmaxf(mrun[p], mx * cs), alpha = __builtin_amdgcn_exp2f(mrun[p] - mnew);
                mrun[p] = mnew;
                float ls = 0.f;
#pragma unroll
                for (int k4 = 0; k4 < 4; ++k4)
#pragma unroll
                    for (int r = 0; r < 4; ++r) { const float pv = __builtin_amdgcn_exp2f(s[p][k4][r] * cs - mnew); ls += pv; s[p][k4][r] = pv; }
                lrun[p] = lrun[p] * alpha + ls;
                if (__any(alpha != 1.f)) {
#pragma unroll
                    for (int vt = 0; vt < 8; ++vt) o[p][vt] = o[p][vt] * alpha; }
                pf[p][0] = pack8(s[p][0], s[p][1]); pf[p][1] = pack8(s[p][2], s[p][3]);
            }
#pragma unroll
            for (int ks2 = 0; ks2 < 2; ++ks2)
#pragma unroll
                for (int vt = 0; vt < 8; ++vt) {
                    LAS unsigned char* a0 = Vb + (32 * ks2 + 4 * g + (l15 >> 2)) * AV_STRIDE + (16 * vt + 4 * (lane & 3)) * 2;
                    const bf16x8 vf = cat8(vtr(a0), vtr(a0 + 16 * AV_STRIDE));
                    o[0][vt] = MFMA16(vf, pf[0][ks2], o[0][vt]);
                    o[1][vt] = MFMA16(vf, pf[1][ks2], o[1][vt]);
                }
        }
        if (kt + 1 < ntiles) { const int nx = cur ^ 1;
            LAS unsigned char* kb = lds + nx * AK_BYTES + srow * AK_STRIDE + sseg * 32; LAS unsigned char* vb = lds + 2 * AK_BYTES + nx * AV_BYTES + srow * AV_STRIDE + sseg * 32;
            *(LAS u32x4*)kb = kr0; *(LAS u32x4*)(kb + 16) = kr1; *(LAS u32x4*)vb = vr0; *(LAS u32x4*)(vb + 16) = vr1; }
        __syncthreads();
    }
    float inv[2];
#pragma unroll
    for (int p = 0; p < 2; ++p) { const float lt = xrow_sum(lrun[p]); inv[p] = 1.f / lt; }
    float ss = 0.f;
#pragma unroll
    for (int vt = 0; vt < 8; ++vt)
#pragma unroll
        for (int r = 0; r < 4; ++r) { const float ov = o[0][vt][r] * inv[0] - lam * (o[1][vt][r] * inv[1]); o[0][vt][r] = ov; ss += ov * ov; }
    ss = xrow_sum(ss);
    const float rstd = rsqrtf(ss * (1.f / 128.f) + 1e-6f) * 0.8f;
    bf16_t* op = ACT + (rowbase + qabs) * 1024 + 512 + h * 128 + 4 * g;
#pragma unroll
    for (int vt = 0; vt < 8; ++vt) { const f32x4 gn = *(const f32x4*)(A.dnorm_g + 16 * vt + 4 * g);
        u32x2 wv; wv.x = pk2(o[0][vt][0] * rstd * gn[0], o[0][vt][1] * rstd * gn[1]); wv.y = pk2(o[0][vt][2] * rstd * gn[2], o[0][vt][3] * rstd * gn[3]);
        *(u32x2*)(op + 16 * vt) = wv; }
}

constexpr int MQ_STRIDE = 272, MV_STRIDE = 288, MP_STRIDE = 144, MH_STRIDE = 132;
constexpr int ML_Q = 0, ML_K = 17408, ML_V = 34816, ML_P = 53248, ML_H = 62464, ML_CW = 96256, ML_SM = 101376;
constexpr int SM_E = 0, SM_G = 64, SM_B = 128, SM_W = 192, SM_I = 256, SM_R = 320, SM_N = 384, SM_NP = 512, SM_X = 1024;
constexpr size_t WS_CST = 224 * MiB, WS_NST = 15 * MiB, WS_MC = 15 * MiB + 512 * 1024, WS_BAR = 15 * MiB + 768 * 1024;

__device__ __forceinline__ void mlstm_state(const Args& A, LAS unsigned char* lds, int b, int h) {
    int tid_o = threadIdx.x; asm volatile("" : "+v"(tid_o)); const int tid = tid_o, lane = tid & 63, w = tid >> 6, g = lane >> 4, l15 = lane & 15;
    const bf16_t* P = (const bf16_t*)(A.ws + WS_P);
    const float* GATES = (const float*)(A.ws + WS_GATES);
    u32x4* CST = (u32x4*)(A.ws + WS_CST); float* NST = (float*)(A.ws + WS_NST); float* MCg = (float*)(A.ws + WS_MC);
    LAS float* sm = (LAS float*)(lds + ML_SM);
    LAS float* cw = (LAS float*)(lds + ML_CW);
    LAS unsigned char* Ks = lds + ML_K; LAS unsigned char* Vs = lds + ML_V;
    const size_t rowbase = (size_t)b * SEQ; const int bh = b * 4 + h;
    for (int i = tid; i < 640; i += 512) { const int j = i >> 7, ch = i & 127, cch = 512 + h * 128 + ch; cw[i] = (j < 4) ? A.conv_w[j * 1024 + cch] : A.conv_b[cch]; }
    if (tid < 128) sm[SM_N + tid] = 0.f;
    const int rg = tid >> 4, cs = tid & 15;
    const int ccol = 512 + h * 128 + 8 * cs;
    const int srow = tid >> 3, sseg = tid & 7;
    u32x4 cr[5], vr0, vr1; float gi = 0.f, gf = 0.f;
#define MS_PREFETCH(c) do { const int _r0 = (c) * 64 + 2 * rg - 3; \
        _Pragma("unroll") for (int _i = 0; _i < 5; ++_i) { const int _r = _r0 + _i; const u32x4 _v = *(const u32x4*)(P + (rowbase + (_r >= 0 ? _r : 0)) * NP + ccol); cr[_i] = (_r >= 0) ? _v : (u32x4){0u, 0u, 0u, 0u}; } \
        const bf16_t* _vp = P + (rowbase + (c) * 64 + srow) * NP + 1024 + h * 128 + sseg * 16; \
        vr0 = *(const u32x4*)(_vp); vr1 = *(const u32x4*)(_vp + 8); \
        } while (0)
    MS_PREFETCH(0);
    LAS float* Eall = (LAS float*)(lds + ML_Q);
#pragma unroll
    for (int cc = 0; cc < 4; ++cc) { const int c = w + 8 * cc;
        const float* gp = GATES + (rowbase + c * 64 + lane) * 8 + h; gi = gp[0]; gf = gp[4];
        float bc = gf;
#pragma unroll
        for (int o = 1; o < 64; o <<= 1) { const float t = __shfl_up(bc, o); if (lane >= o) bc += t; }
        const float e = gi - bc; float cm = e;
#pragma unroll
        for (int o = 1; o < 64; o <<= 1) { const float t = __shfl_up(cm, o); if (lane >= o) cm = fmaxf(cm, t); }
        Eall[c * 64 + lane] = e;
        if (lane == 63) { Eall[2048 + c] = bc; Eall[2048 + 32 + c] = cm; } }
    f32x4 C[8];
#pragma unroll
    for (int kt = 0; kt < 8; ++kt) C[kt] = (f32x4){0.f, 0.f, 0.f, 0.f};
    float mc = 0.f;
    __syncthreads();
    for (int c = 0; c < 32; ++c) {
        {
            float wt[5][8];
#pragma unroll
            for (int j = 0; j < 5; ++j) { const f32x4 a = *(const LAS f32x4*)(cw + j * 128 + 8 * cs), bb = *(const LAS f32x4*)(cw + j * 128 + 8 * cs + 4);
                wt[j][0] = a[0]; wt[j][1] = a[1]; wt[j][2] = a[2]; wt[j][3] = a[3]; wt[j][4] = bb[0]; wt[j][5] = bb[1]; wt[j][6] = bb[2]; wt[j][7] = bb[3]; }
            LAS unsigned char* dst = Ks + (2 * rg) * MQ_STRIDE + 16 * cs;
#pragma unroll
            for (int r = 0; r < 2; ++r) {
                float ov[8];
#pragma unroll
                for (int e = 0; e < 8; ++e) ov[e] = wt[4][e];
#pragma unroll
                for (int j = 0; j < 4; ++j) { const u32x4 x = cr[r + j];
                    ov[0] += wt[j][0] * bflo(x.x); ov[1] += wt[j][1] * bfhi(x.x); ov[2] += wt[j][2] * bflo(x.y); ov[3] += wt[j][3] * bfhi(x.y);
                    ov[4] += wt[j][4] * bflo(x.z); ov[5] += wt[j][5] * bfhi(x.z); ov[6] += wt[j][6] * bflo(x.w); ov[7] += wt[j][7] * bfhi(x.w); }
#pragma unroll
                for (int e = 0; e < 8; ++e) ov[e] = 0.08838834764831845f * ov[e] * __builtin_amdgcn_rcpf(1.f + __expf(-ov[e]));
                u32x4 o4; o4.x = pk2(ov[0], ov[1]); o4.y = pk2(ov[2], ov[3]); o4.z = pk2(ov[4], ov[5]); o4.w = pk2(ov[6], ov[7]);
                *(LAS u32x4*)(dst + r * MQ_STRIDE) = o4;
            }
            LAS unsigned char* vd = Vs + srow * MV_STRIDE + sseg * 32; *(LAS u32x4*)vd = vr0; *(LAS u32x4*)(vd + 16) = vr1;
            if (w == 0) {
                const float g63 = fmaxf(mc, Eall[2048 + 32 + c]);
                sm[SM_W + lane] = __expf(Eall[c * 64 + lane] - g63);
                if (lane == 63) { sm[SM_X] = __expf(mc - g63); sm[SM_X + 1] = Eall[2048 + c] + g63; }
            }
        }
        __syncthreads();
        { const int cn = (c + 1 < 32) ? c + 1 : 31; MS_PREFETCH(cn); }
        {
            const int item = bh * 32 + c;
#pragma unroll
            for (int k2 = 0; k2 < 4; ++k2) CST[((size_t)(item * 8 + w) * 4 + k2) * 64 + lane] = __builtin_bit_cast(u32x4, pack8(C[2 * k2], C[2 * k2 + 1]));
            if (tid < 128) NST[item * 128 + tid] = sm[SM_N + tid];
            if (tid == 0) MCg[item] = mc;
            LAS float* wS = sm + SM_W;
            const float decay = sm[SM_X];
            bf16x8 vfw[2];
#pragma unroll
            for (int ks = 0; ks < 2; ++ks) {
                LAS unsigned char* a0 = Vs + (32 * ks + 8 * g + (l15 >> 2)) * MV_STRIDE + (16 * w + 4 * (lane & 3)) * 2;
                const bf16x8 vf = cat8(vtr(a0), vtr(a0 + 4 * MV_STRIDE));
                const f32x4 w0 = *(const LAS f32x4*)(wS + 32 * ks + 8 * g), w1 = *(const LAS f32x4*)(wS + 32 * ks + 8 * g + 4);
                const u32x4 vu = __builtin_bit_cast(u32x4, vf);
                u32x4 o4; o4.x = pk2(bflo(vu.x) * w0[0], bfhi(vu.x) * w0[1]); o4.y = pk2(bflo(vu.y) * w0[2], bfhi(vu.y) * w0[3]);
                o4.z = pk2(bflo(vu.z) * w1[0], bfhi(vu.z) * w1[1]); o4.w = pk2(bflo(vu.w) * w1[2], bfhi(vu.w) * w1[3]);
                vfw[ks] = __builtin_bit_cast(bf16x8, o4);
            }
#pragma unroll
            for (int kt = 0; kt < 8; ++kt) C[kt] = C[kt] * decay;
#pragma unroll
            for (int ks = 0; ks < 2; ++ks)
#pragma unroll
                for (int kt = 0; kt < 8; ++kt) { LAS unsigned char* a0 = Ks + (32 * ks + 8 * g + (l15 >> 2)) * MQ_STRIDE + (16 * kt + 4 * (lane & 3)) * 2;
                    const bf16x8 ka = cat8(vtr(a0), vtr(a0 + 4 * MQ_STRIDE)); C[kt] = MFMA16(ka, vfw[ks], C[kt]); }
            { const int kd = tid & 127, sq = tid >> 7; float s = 0.f;
#pragma unroll
              for (int i = 0; i < 16; ++i) { const int s_ = 16 * sq + i; s += wS[s_] * __uint_as_float((unsigned)(*(const LAS bf16_t*)(Ks + s_ * MQ_STRIDE + kd * 2)) << 16); }
              sm[SM_NP + sq * 128 + kd] = s; }
            mc = sm[SM_X + 1];
            __syncthreads();
            if (tid < 128) sm[SM_N + tid] = decay * sm[SM_N + tid] + ((sm[SM_NP + tid] + sm[SM_NP + 128 + tid]) + (sm[SM_NP + 256 + tid] + sm[SM_NP + 384 + tid]));
        }
    }
#undef MS_PREFETCH
    __syncthreads();
}

__device__ __forceinline__ void mlstm_out(const Args& A, LAS unsigned char* lds, int item, int& last_h) {
    int tid_o = threadIdx.x; asm volatile("" : "+v"(tid_o)); const int tid = tid_o, lane = tid & 63, w = tid >> 6, g = lane >> 4, l15 = lane & 15;
    const int bh = item >> 5, c = item & 31, b = bh >> 2, h = bh & 3;
    const bf16_t* P = (const bf16_t*)(A.ws + WS_P);
    bf16_t* ACT = (bf16_t*)(A.ws + WS_ACT);
    const float* GATES = (const float*)(A.ws + WS_GATES);
    const u32x4* CST = (const u32x4*)(A.ws + WS_CST); const float* NST = (const float*)(A.ws + WS_NST); const float* MCg = (const float*)(A.ws + WS_MC);
    LAS float* sm = (LAS float*)(lds + ML_SM);
    LAS float* cw = (LAS float*)(lds + ML_CW);
    LAS unsigned char* Qs = lds + ML_Q; LAS unsigned char* Ks = lds + ML_K; LAS unsigned char* Vs = lds + ML_V; LAS unsigned char* Ps = lds + ML_P;
    LAS float* Hn = (LAS float*)(lds + ML_H);
    LAS float* eS = sm + SM_E; LAS float* gS = sm + SM_G; LAS float* bS = sm + SM_B; LAS float* iS = sm + SM_I; LAS float* nS = sm + SM_N;
    const size_t rowbase = (size_t)b * SEQ;
    const int rg = tid >> 5, cs = tid & 31;
    const int ccol = (cs < 16 ? 0 : 512) + h * 128 + 8 * (cs & 15);
    const int srow = tid >> 3, sseg = tid & 7;
    u32x4 cr[7], vr0, vr1, mc0, mc1, cfr[4]; float gi = 0.f, gf = 0.f, nval = 0.f;
    { const int r0 = c * 64 + 4 * rg - 3;
#pragma unroll
      for (int i = 0; i < 7; ++i) { const int r = r0 + i; const u32x4 v_ = *(const u32x4*)(P + (rowbase + (r >= 0 ? r : 0)) * NP + ccol); cr[i] = (r >= 0) ? v_ : (u32x4){0u, 0u, 0u, 0u}; }
      const bf16_t* vp = P + (rowbase + c * 64 + srow) * NP + h * 128 + sseg * 16;
      vr0 = *(const u32x4*)(vp + 1024); vr1 = *(const u32x4*)(vp + 1032); mc0 = *(const u32x4*)(vp + 1536); mc1 = *(const u32x4*)(vp + 1544);
      if (w == 0) { const float* gp = GATES + (rowbase + c * 64 + lane) * 8 + h; gi = gp[0]; gf = gp[4]; }
#pragma unroll
      for (int k2 = 0; k2 < 4; ++k2) cfr[k2] = CST[((size_t)(item * 8 + w) * 4 + k2) * 64 + lane];
      if (tid < 128) nval = NST[item * 128 + tid]; }
    const float mc = MCg[item];
    if (h != last_h) {
        for (int i = tid; i < 1280; i += 512) { const int j = i >> 8, ch = i & 255, cch = (ch < 128 ? h * 128 + ch : 512 + h * 128 + ch - 128);
            cw[i] = (j < 4) ? A.conv_w[j * 1024 + cch] : A.conv_b[cch]; }
        last_h = h;
        __syncthreads();
    }
    {
        float wt[5][8];
#pragma unroll
        for (int j = 0; j < 5; ++j) { const f32x4 a = *(const LAS f32x4*)(cw + j * 256 + 8 * cs), bb = *(const LAS f32x4*)(cw + j * 256 + 8 * cs + 4);
            wt[j][0] = a[0]; wt[j][1] = a[1]; wt[j][2] = a[2]; wt[j][3] = a[3]; wt[j][4] = bb[0]; wt[j][5] = bb[1]; wt[j][6] = bb[2]; wt[j][7] = bb[3]; }
        const float osc = (cs < 16) ? 1.0f : 0.08838834764831845f;
        LAS unsigned char* dst = (cs < 16 ? Qs : Ks) + (4 * rg) * MQ_STRIDE + 16 * (cs & 15);
#pragma unroll
        for (int r = 0; r < 4; ++r) {
            float ov[8];
#pragma unroll
            for (int e = 0; e < 8; ++e) ov[e] = wt[4][e];
#pragma unroll
            for (int j = 0; j < 4; ++j) { const u32x4 x = cr[r + j];
                ov[0] += wt[j][0] * bflo(x.x); ov[1] += wt[j][1] * bfhi(x.x); ov[2] += wt[j][2] * bflo(x.y); ov[3] += wt[j][3] * bfhi(x.y);
                ov[4] += wt[j][4] * bflo(x.z); ov[5] += wt[j][5] * bfhi(x.z); ov[6] += wt[j][6] * bflo(x.w); ov[7] += wt[j][7] * bfhi(x.w); }
#pragma unroll
            for (int e = 0; e < 8; ++e) ov[e] = osc * ov[e] * __builtin_amdgcn_rcpf(1.f + __expf(-ov[e]));
            u32x4 o4; o4.x = pk2(ov[0], ov[1]); o4.y = pk2(ov[2], ov[3]); o4.z = pk2(ov[4], ov[5]); o4.w = pk2(ov[6], ov[7]);
            *(LAS u32x4*)(dst + r * MQ_STRIDE) = o4;
        }
        LAS unsigned char* vd = Vs + srow * MV_STRIDE + sseg * 32; *(LAS u32x4*)vd = vr0; *(LAS u32x4*)(vd + 16) = vr1;
        if (tid < 128) nS[tid] = nval;
        if (w == 0) {
            float bc = gf;
#pragma unroll
            for (int o = 1; o < 64; o <<= 1) { const float t = __shfl_up(bc, o); if (lane >= o) bc += t; }
            const float e = gi - bc; float cm = e;
#pragma unroll
            for (int o = 1; o < 64; o <<= 1) { const float t = __shfl_up(cm, o); if (lane >= o) cm = fmaxf(cm, t); }
            const float gt = fmaxf(mc, cm);
            eS[lane] = e; gS[lane] = gt; bS[lane] = bc; iS[lane] = __expf(mc - gt);
        }
    }
    __syncthreads();
    {
        const int st = w >> 1;
#pragma unroll
        for (int ti = 0; ti < 2; ++ti) { const int tt = 2 * (w & 1) + ti;
            f32x4 a = (f32x4){0.f, 0.f, 0.f, 0.f};
#pragma unroll
            for (int ks = 0; ks < 4; ++ks) { const bf16x8 kf = *(const LAS bf16x8*)(Ks + (16 * st + l15) * MQ_STRIDE + (32 * ks + 8 * g) * 2);
                const bf16x8 qf = *(const LAS bf16x8*)(Qs + (16 * tt + l15) * MQ_STRIDE + (32 * ks + 8 * g) * 2); a = MFMA16(kf, qf, a); }
            const int t = 16 * tt + l15; const float gt = gS[t];
            float pv[4];
#pragma unroll
            for (int r = 0; r < 4; ++r) { const int s_ = 16 * st + 4 * g + r; pv[r] = (s_ <= t) ? a[r] * __expf(eS[s_] - gt) : 0.f; }
            u32x2 pw; pw.x = pk2(pv[0], pv[1]); pw.y = pk2(pv[2], pv[3]);
            *(LAS u32x2*)(Ps + t * MP_STRIDE + (16 * st + 4 * g) * 2) = pw;
        }
    }
    __syncthreads();
    {
        f32x4 apv[4], aqc[4];
#pragma unroll
        for (int tt = 0; tt < 4; ++tt) { apv[tt] = (f32x4){0.f, 0.f, 0.f, 0.f}; aqc[tt] = (f32x4){0.f, 0.f, 0.f, 0.f}; }
#pragma unroll
        for (int ks = 0; ks < 2; ++ks) {
            LAS unsigned char* a0 = Vs + (32 * ks + 8 * g + (l15 >> 2)) * MV_STRIDE + (16 * w + 4 * (lane & 3)) * 2;
            const bf16x8 vf = cat8(vtr(a0), vtr(a0 + 4 * MV_STRIDE));
#pragma unroll
            for (int tt = 0; tt < 4; ++tt) { const bf16x8 pf = *(const LAS bf16x8*)(Ps + (16 * tt + l15) * MP_STRIDE + (32 * ks + 8 * g) * 2); apv[tt] = MFMA16(pf, vf, apv[tt]); }
        }
#pragma unroll
        for (int k2 = 0; k2 < 4; ++k2) {
            const bf16x8 cf = __builtin_bit_cast(bf16x8, cfr[k2]);
#pragma unroll
            for (int tt = 0; tt < 4; ++tt) { LAS unsigned char* qa = Qs + (16 * tt + l15) * MQ_STRIDE + (32 * k2 + 4 * g) * 2;
                const bf16x8 qf = cat8(*(const LAS s16x4*)qa, *(const LAS s16x4*)(qa + 32)); aqc[tt] = MFMA16(qf, cf, aqc[tt]); }
        }
#pragma unroll
        for (int tt = 0; tt < 4; ++tt)
#pragma unroll
            for (int r = 0; r < 4; ++r) { const int t = 16 * tt + 4 * g + r; Hn[t * MH_STRIDE + 16 * w + l15] = apv[tt][r] + iS[t] * aqc[tt][r]; }
        { const int t = srow, j = sseg;
          const u32x4 pr = *(const LAS u32x4*)(Ps + t * MP_STRIDE + 16 * j);
          float rs = (bflo(pr.x) + bfhi(pr.x)) + (bflo(pr.y) + bfhi(pr.y)) + (bflo(pr.z) + bfhi(pr.z)) + (bflo(pr.w) + bfhi(pr.w));
          const u32x4 q0 = *(const LAS u32x4*)(Qs + t * MQ_STRIDE + 32 * j), q1 = *(const LAS u32x4*)(Qs + t * MQ_STRIDE + 32 * j + 16);
          const f32x4 n0 = *(const LAS f32x4*)(nS + 16 * j), n1 = *(const LAS f32x4*)(nS + 16 * j + 4), n2 = *(const LAS f32x4*)(nS + 16 * j + 8), n3 = *(const LAS f32x4*)(nS + 16 * j + 12);
          float qn = bflo(q0.x) * n0[0] + bfhi(q0.x) * n0[1] + bflo(q0.y) * n0[2] + bfhi(q0.y) * n0[3] + bflo(q0.z) * n1[0] + bfhi(q0.z) * n1[1] + bflo(q0.w) * n1[2] + bfhi(q0.w) * n1[3]
                   + bflo(q1.x) * n2[0] + bfhi(q1.x) * n2[1] + bflo(q1.y) * n2[2] + bfhi(q1.y) * n2[3] + bflo(q1.z) * n3[0] + bfhi(q1.z) * n3[1] + bflo(q1.w) * n3[2] + bfhi(q1.w) * n3[3];
          float d = rs + iS[t] * qn;
          d += __shfl_xor(d, 1); d += __shfl_xor(d, 2); d += __shfl_xor(d, 4);
          if (j == 0) { const float fl = __expf(-(bS[t] + gS[t])); sm[SM_R + t] = 1.f / fmaxf(fabsf(d), fl); } }
    }
    __syncthreads();
    {
        const int t = srow, j = sseg; const float rd = sm[SM_R + t];
        float hv[16]; float ss = 0.f;
#pragma unroll
        for (int q = 0; q < 4; ++q) { const f32x4 x = *(const LAS f32x4*)(Hn + t * MH_STRIDE + 16 * j + 4 * q);
#pragma unroll
            for (int e = 0; e < 4; ++e) { const float v = x[e] * rd; hv[4 * q + e] = v; ss += v * v; } }
        ss += __shfl_xor(ss, 1); ss += __shfl_xor(ss, 2); ss += __shfl_xor(ss, 4);
        const float rstd = rsqrtf(ss * (1.f / 128.f) + 1e-6f);
        const unsigned mo[8] = {mc0.x, mc0.y, mc0.z, mc0.w, mc1.x, mc1.y, mc1.z, mc1.w};
        unsigned ow[8];
#pragma unroll
        for (int q = 0; q < 8; ++q) { const float g0 = A.mnorm_g[h * 128 + 16 * j + 2 * q], g1 = A.mnorm_g[h * 128 + 16 * j + 2 * q + 1];
            const float z0 = bflo(mo[q]), z1 = bfhi(mo[q]);
            ow[q] = pk2(hv[2 * q] * rstd * g0 * __builtin_amdgcn_rcpf(1.f + __expf(-z0)), hv[2 * q + 1] * rstd * g1 * __builtin_amdgcn_rcpf(1.f + __expf(-z1))); }
        bf16_t* op = ACT + (rowbase + c * 64 + t) * 1024 + h * 128 + 16 * j;
        *(u32x4*)op = (u32x4){ow[0], ow[1], ow[2], ow[3]}; *(u32x4*)(op + 8) = (u32x4){ow[4], ow[5], ow[6], ow[7]};
    }
}

__device__ __forceinline__ void phase3(const Args& A, LAS unsigned char* lds, int rep = 0) {
    const int tid = threadIdx.x;
    const float lam = ((const float*)(A.ws + WS_CTL))[1];
    unsigned* ctr = (unsigned*)(A.ws + WS_CTL) + 2 * rep;
    LAS int* slot = (LAS int*)(lds + LDS_BYTES - 64);
    {
        const int lane = tid & 63, wave = tid >> 6;
        const bf16_t* WT = (const bf16_t*)(A.ws + WS_WQ); const float* MOD = (const float*)(A.ws + WS_MOD); float* SB = (float*)(A.ws + WS_SB);
        for (int n = blockIdx.x * 8 + wave; n < 2048; n += gridDim.x * 8) {
            const u32x4 w0 = *(const u32x4*)(WT + (size_t)n * 1024 + 16 * lane), w1 = *(const u32x4*)(WT + (size_t)n * 1024 + 16 * lane + 8);
            const unsigned ww[8] = {w0.x, w0.y, w0.z, w0.w, w1.x, w1.y, w1.z, w1.w};
            float sbv[8];
#pragma unroll
            for (int b = 0; b < 8; ++b) { const float* sp = MOD + b * 6144 + 3072 + 16 * lane; float d = 0.f;
#pragma unroll
                for (int q = 0; q < 4; ++q) { const f32x4 s4 = *(const f32x4*)(sp + 4 * q); d += bflo(ww[2 * q]) * s4[0] + bfhi(ww[2 * q]) * s4[1] + bflo(ww[2 * q + 1]) * s4[2] + bfhi(ww[2 * q + 1]) * s4[3]; }
                sbv[b] = wave_sum(d); }
            if (lane == 0) {
#pragma unroll
                for (int b = 0; b < 8; ++b) SB[b * 2048 + n] = sbv[b]; }
        }
    }
    const int nml = ((int)gridDim.x > 64) ? 32 : 1;
    if ((int)blockIdx.x < nml) for (int bh = blockIdx.x; bh < 32; bh += nml) mlstm_state(A, lds, bh >> 2, bh & 3);
    for (;;) {
        if (tid == 0) slot[0] = (int)atomicAdd(ctr, 1u);
        __syncthreads();
        const int it = slot[0];
        __syncthreads();
        if (it >= 512) break;
        attn_item(A, lds, (it & 31) >> 2, it & 3, 15 - (it >> 5), lam);
    }
}
__device__ __forceinline__ void phase3b(const Args& A, LAS unsigned char* lds) {
    int last_h = -1;
    for (int item = blockIdx.x; item < 1024; item += gridDim.x) mlstm_out(A, lds, item, last_h);
    __syncthreads();
}

__device__ __forceinline__ void phase5(const Args& A) {
    int tid_o = threadIdx.x; asm volatile("" : "+v"(tid_o)); const int tid = tid_o, lane = tid & 63, wave = tid >> 6, G = gridDim.x;
    const float* MOD = (const float*)(A.ws + WS_MOD);
    bf16_t* ACT = (bf16_t*)(A.ws + WS_ACT);
    for (int m = blockIdx.x * 8 + wave; m < T; m += G * 8) {
        const int b = m >> 11;
        const f32x4* xr = (const f32x4*)(A.out + (size_t)m * 1024) + lane;
        f32x4 v[4]; float ss = 0.f;
#pragma unroll
        for (int j = 0; j < 4; ++j) { v[j] = xr[64 * j]; ss += (v[j][0] * v[j][0] + v[j][1] * v[j][1]) + (v[j][2] * v[j][2] + v[j][3] * v[j][3]); }
        const float rstd = rsqrtf(wave_sum(ss) * (1.f / 1024.f) + 1e-6f);
        unsigned long long* o8 = (unsigned long long*)(ACT + (size_t)m * 1024) + lane;
#pragma unroll
        for (int j = 0; j < 4; ++j) { const int col = 4 * lane + 256 * j;
            const f32x4 g = *(const f32x4*)(A.norm2_g + col), sc = *(const f32x4*)(MOD + b * 6144 + 4096 + col), sh = *(const f32x4*)(MOD + b * 6144 + 3072 + col);
            v[j] = v[j] * rstd * g * (sc + 1.0f) + sh;
            o8[64 * j] = (unsigned long long)pk2(v[j][0], v[j][1]) | ((unsigned long long)pk2(v[j][2], v[j][3]) << 32); }
    }
}

__device__ __forceinline__ unsigned f2key(float f) { const unsigned u = __float_as_uint(f); return (u & 0x80000000u) ? ~u : (u | 0x80000000u); }
__device__ __forceinline__ float key2f(unsigned k) { const unsigned u = (k & 0x80000000u) ? (k & 0x7fffffffu) : ~k; return __uint_as_float(u); }
#define CE_DESC(a, b) do { const unsigned _mx = (a) > (b) ? (a) : (b), _mn = (a) > (b) ? (b) : (a); (a) = _mx; (b) = _mn; } while (0)
__device__ __forceinline__ void sort16_desc(unsigned (&k)[16]) {
#pragma unroll
    for (int size = 2; size <= 16; size <<= 1)
#pragma unroll
        for (int stride = size >> 1; stride > 0; stride >>= 1)
#pragma unroll
            for (int i = 0; i < 16; ++i) { const int j = i ^ stride;
                if (j > i) { if ((i & size) == 0) CE_DESC(k[i], k[j]); else CE_DESC(k[j], k[i]); } }
}
__device__ __forceinline__ void merge16(unsigned (&a)[16], const unsigned (&b)[16]) {
#pragma unroll
    for (int i = 0; i < 16; ++i) a[i] = a[i] > b[15 - i] ? a[i] : b[15 - i];
#pragma unroll
    for (int stride = 8; stride > 0; stride >>= 1)
#pragma unroll
        for (int i = 0; i < 16; ++i) { const int j = i ^ stride; if (j > i) CE_DESC(a[i], a[j]); }
}
constexpr int PE_IDX = 0, PE_SEL = 69632;
__device__ __forceinline__ float gelu_erf(float v) { return 0.5f * v * (1.f + erff(v * 0.70710678118654752f)); }
__device__ __forceinline__ float gelu_fast(float v) {
    const float av = fabsf(v), tt = __builtin_amdgcn_rcpf(av * 0.2316418882f + 1.0f);
    float q = tt * 0.5307027145f + (-0.7265760135f); q = q * tt + 0.7107068705f; q = q * tt + (-0.142248368f); q = q * tt + 0.127414796f; q = q * tt;
    const float e = __builtin_amdgcn_exp2f((v * v) * (-0.72134752044f));
    const float m = v * (q * e);
    return v < 0.f ? m : v - m;
}

__device__ __forceinline__ void peer_tile(const Args& A, LAS unsigned char* lds, int tile) {
    int tid_o = threadIdx.x; asm volatile("" : "+v"(tid_o)); const int tid = tid_o, lane = tid & 63, w = tid >> 6, g = lane >> 4, l15 = lane & 15;
    const bf16_t* QRY = (const bf16_t*)(A.ws + WS_QRY);
    const bf16_t* KEYS = (const bf16_t*)(A.ws + WS_KEYS);
    const bf16_t* ACT = (const bf16_t*)(A.ws + WS_ACT);
    const float* MOD = (const float*)(A.ws + WS_MOD);
    LAS unsigned* idx = (LAS unsigned*)(lds + PE_IDX) + (w * 64 + lane) * 33;
    LAS u32x2* SEL = (LAS u32x2*)(lds + PE_SEL);
    {
        const int tg = w & 3, hg = w >> 2, tl = 16 * tg + l15;
        const size_t m = (size_t)tile * 64 + tl;
        for (int hh = 0; hh < 4; ++hh) {
            const int h = 4 * hg + hh;
            unsigned L2[2][16];
#pragma unroll
            for (int p = 0; p < 2; ++p) {
                const int hp = 2 * h + p;
                unsigned k0[16], k1[16];
                { const bf16_t* sp = QRY + m * 2048 + hp * 128 + 32 * g;
                  const u32x4 s0 = *(const u32x4*)sp, s1 = *(const u32x4*)(sp + 8), s2 = *(const u32x4*)(sp + 16), s3 = *(const u32x4*)(sp + 24);
                  const unsigned sw[16] = {s0.x, s0.y, s0.z, s0.w, s1.x, s1.y, s1.z, s1.w, s2.x, s2.y, s2.z, s2.w, s3.x, s3.y, s3.z, s3.w};
#pragma unroll
                  for (int i = 0; i < 16; ++i) {
                      const float lo = (float)__builtin_bit_cast(_Float16, (unsigned short)(sw[i] & 0xffffu)), hi = (float)__builtin_bit_cast(_Float16, (unsigned short)(sw[i] >> 16));
                      const unsigned klo = (f2key(lo) & ~127u) | (unsigned)(127 - (32 * g + 2 * i)), khi = (f2key(hi) & ~127u) | (unsigned)(127 - (32 * g + 2 * i + 1));
                      if (i < 8) { k0[2 * i] = klo; k0[2 * i + 1] = khi; } else { k1[2 * (i - 8)] = klo; k1[2 * (i - 8) + 1] = khi; } } }
                sort16_desc(k0); sort16_desc(k1); merge16(k0, k1);
#pragma unroll
                for (int msk = 16; msk <= 32; msk <<= 1) {
#pragma unroll
                    for (int i = 0; i < 16; ++i) k1[i] = (unsigned)__shfl_xor((int)k0[i], msk);
                    merge16(k0, k1); }
#pragma unroll
                for (int i = 0; i < 16; ++i) L2[p][i] = k0[i];
            }
            float va[16], vb[16];
#pragma unroll
            for (int i = 0; i < 16; ++i) { va[i] = key2f(L2[0][i] & ~127u); vb[i] = key2f(L2[1][i] & ~127u); idx[i] = 127u - (L2[0][i] & 127u); idx[16 + i] = 127u - (L2[1][i] & 127u); }
#define CK(i, j) ((f2key(va[i] + vb[j]) & ~255u) | (unsigned)(255 - (16 * (i) + (j))))
            unsigned Lf[16], Bt[16];
#pragma unroll
            for (int j = 0; j < 16; ++j) Lf[j] = CK(0, j);
#pragma unroll
            for (int j = 0; j < 8; ++j) Bt[j] = CK(1, j);
#pragma unroll
            for (int j = 0; j < 5; ++j) Bt[8 + j] = CK(2, j);
#pragma unroll
            for (int j = 0; j < 3; ++j) Bt[13 + j] = CK(4, j);
            sort16_desc(Bt); merge16(Lf, Bt);
#pragma unroll
            for (int j = 0; j < 4; ++j) Bt[j] = CK(3, j);
            Bt[4] = CK(5, 0); Bt[5] = CK(5, 1); Bt[6] = CK(6, 0); Bt[7] = CK(6, 1); Bt[8] = CK(7, 0); Bt[9] = CK(7, 1);
            Bt[10] = CK(8, 0); Bt[11] = CK(9, 0); Bt[12] = CK(10, 0); Bt[13] = CK(11, 0); Bt[14] = CK(12, 0); Bt[15] = CK(13, 0);
            sort16_desc(Bt); merge16(Lf, Bt);
            { unsigned x0 = CK(14, 0), x1 = CK(15, 0);
#pragma unroll
              for (int i = 0; i < 16; ++i) CE_DESC(Lf[i], x0);
#pragma unroll
              for (int i = 0; i < 16; ++i) CE_DESC(Lf[i], x1); }
#undef CK
            float fv[16], den = 0.f; const float f0 = key2f(Lf[0] & ~255u);
#pragma unroll
            for (int k = 0; k < 16; ++k) { fv[k] = __expf(key2f(Lf[k] & ~255u) - f0); den += fv[k]; }
            const float rden = 1.f / den;
            LDS_WAIT();
            if (g == 0) {
#pragma unroll
                for (int k = 0; k < 16; ++k) { const unsigned code = 255u - (Lf[k] & 255u); const unsigned e = idx[code >> 4] * 128u + idx[16 + (code & 15u)];
                    u32x2 sv; sv.x = e; sv.y = __float_as_uint(fv[k] * rden); SEL[(tl * 8 + h) * 16 + k] = sv; }
            }
        }
    }
    __syncthreads();
    const unsigned char* T8 = A.ws + WS_T8; const float* SC = (const float*)(A.ws + WS_SC);
    LAS u32x2* SORT = (LAS u32x2*)(lds + PE_IDX);
    LAS int* OFFS = (LAS int*)(lds + PE_SEL + 65536);
    for (int ti = 0; ti < 8; ++ti) {
        const int tl = 8 * w + ti;
        const u32x2 e0 = SEL[tl * 128 + lane], e1 = SEL[tl * 128 + 64 + lane];
        const int p0 = (int)(e0.x >> 10), p1 = (int)(e1.x >> 10);
        int off = 0;
        for (int p = 0; p < 16; ++p) {
            const unsigned long long m0 = __ballot(p0 == p), m1 = __ballot(p1 == p);
            const int c0 = __popcll(m0), c1 = __popcll(m1);
            const int r0 = __builtin_amdgcn_mbcnt_hi((unsigned)(m0 >> 32), __builtin_amdgcn_mbcnt_lo((unsigned)m0, 0u));
            const int r1 = __builtin_amdgcn_mbcnt_hi((unsigned)(m1 >> 32), __builtin_amdgcn_mbcnt_lo((unsigned)m1, 0u));
            if (p0 == p) SORT[tl * 128 + off + r0] = e0;
            if (p1 == p) SORT[tl * 128 + off + c0 + r1] = e1;
            if (lane == 0) OFFS[tl * 17 + p] = off;
            off += c0 + c1;
        }
        if (lane == 0) OFFS[tl * 17 + 16] = off;
    }
    LDS_WAIT(); __builtin_amdgcn_wave_barrier();
    const unsigned char* T8v = T8 + (size_t)16384 * 1024;
    const bf16_t* A3 = (const bf16_t*)(A.ws + WS_A3); const float* RSq = (const float*)(A.ws + WS_RS);
    for (int pass = 0; pass < 2; ++pass) {
        const int tb = 8 * w + 4 * pass;
        u32x4 xpa[4], xpb[4]; f32x2 oacc[4][8];
#pragma unroll
        for (int tk = 0; tk < 4; ++tk) { const size_t m = (size_t)tile * 64 + tb + tk;
            { const u32x4 ra = *(const u32x4*)(A3 + m * 1024 + 16 * lane), rb = *(const u32x4*)(A3 + m * 1024 + 16 * lane + 8);
              float xr_; { const f32x4 p0 = *(const f32x4*)(RSq + m * 16), p1 = *(const f32x4*)(RSq + m * 16 + 4), p2 = *(const f32x4*)(RSq + m * 16 + 8), p3 = *(const f32x4*)(RSq + m * 16 + 12);
                const f32x4 ps = (p0 + p1) + (p2 + p3); xr_ = rsqrtf(((ps[0] + ps[1]) + (ps[2] + ps[3])) * (1.f / 1024.f) + 1e-6f); }
              const unsigned rr[8] = {ra.x, ra.y, ra.z, ra.w, rb.x, rb.y, rb.z, rb.w}; unsigned hh[8];
              const float* sp = MOD + (int)(m >> 11) * 6144 + 3072 + 16 * lane;
#pragma unroll
              for (int q = 0; q < 8; ++q) { const f32x2 sh = *(const f32x2*)(sp + 2 * q); hh[q] = pk2(bflo(rr[q]) * xr_ + sh[0], bfhi(rr[q]) * xr_ + sh[1]); }
              xpa[tk] = (u32x4){hh[0], hh[1], hh[2], hh[3]}; xpb[tk] = (u32x4){hh[4], hh[5], hh[6], hh[7]}; }
#pragma unroll
            for (int q = 0; q < 8; ++q) oacc[tk][q] = (f32x2){0.f, 0.f}; }
        int it_p = 0, it_tk = -1, it_j = 0, it_end = 0; bool it_done = false;
#define IT_ADVANCE() do { it_j += 4; while (it_j >= it_end) { if (it_done) break; ++it_tk; if (it_tk == 4) { it_tk = 0; ++it_p; if (it_p == 16) { it_done = true; it_p = 15; it_j = 0; it_end = 1; break; } } \
            it_j = __builtin_amdgcn_readfirstlane(OFFS[(tb + it_tk) * 17 + it_p]); it_end = __builtin_amdgcn_readfirstlane(OFFS[(tb + it_tk) * 17 + it_p + 1]); } } while (0)
#define LOAD_SET(U, V, CG, SU, SV) do { const int _tl = tb + it_tk; \
            _Pragma("unroll") for (int _k = 0; _k < 4; ++_k) { const int _jj = (it_j + _k < it_end) ? it_j + _k : it_end - 1; const unsigned _e = SORT[_tl * 128 + _jj].x; \
                U[_k] = *(const u32x4*)(T8 + (size_t)_e * 1024 + 16 * lane); V[_k] = *(const u32x4*)(T8v + (size_t)_e * 1024 + 16 * lane); } \
            const int _ms = lane >> 4; const bool _valid = it_j + _ms < it_end; const u32x2 _se = SORT[_tl * 128 + (_valid ? it_j + _ms : it_end - 1)]; \
            CG = _valid ? __uint_as_float(_se.y) : 0.f; SU = SC[_se.x]; SV = SC[16384 + _se.x]; } while (0)
        u32x4 uA[4], vA[4], uB[4], vB[4]; float cgA = 0.f, suA = 0.f, svA = 0.f, cgB = 0.f, suB = 0.f, svB = 0.f;
#pragma unroll
        for (int k = 0; k < 4; ++k) { uA[k] = (u32x4){0u, 0u, 0u, 0u}; vA[k] = uA[k]; uB[k] = uA[k]; vB[k] = uA[k]; }
        IT_ADVANCE();
        LOAD_SET(uA, vA, cgA, suA, svA);
        for (int p = 0; p < 16; ++p) {
#pragma unroll
            for (int tk = 0; tk < 4; ++tk) {
                const int tl = tb + tk;
                const int beg = __builtin_amdgcn_readfirstlane(OFFS[tl * 17 + p]), end = __builtin_amdgcn_readfirstlane(OFFS[tl * 17 + p + 1]);
                f32x2 xf[8];
                { const unsigned xx[8] = {xpa[tk].x, xpa[tk].y, xpa[tk].z, xpa[tk].w, xpb[tk].x, xpb[tk].y, xpb[tk].z, xpb[tk].w};
#pragma unroll
                  for (int q = 0; q < 8; ++q) xf[q] = (f32x2){bflo(xx[q]), bfhi(xx[q])}; }
#define COMPUTE_SET(U, V, CG, SU, SV) do { float pd[4]; \
                    _Pragma("unroll") for (int k = 0; k < 4; ++k) { f32x2 d = (f32x2){0.f, 0.f}; \
                        _Pragma("unroll") for (int q = 0; q < 4; ++q) { const int dw = (int)U[k][q]; \
                            d += __builtin_amdgcn_cvt_pk_f32_fp8(dw, false) * xf[2 * q]; d += __builtin_amdgcn_cvt_pk_f32_fp8(dw, true) * xf[2 * q + 1]; } \
                        pd[k] = d[0] + d[1]; } \
                    float s; \
                    { const auto r0 = __builtin_amdgcn_permlane32_swap(__float_as_uint(pd[0]), __float_as_uint(pd[2]), false, false); \
                      const auto r1 = __builtin_amdgcn_permlane32_swap(__float_as_uint(pd[1]), __float_as_uint(pd[3]), false, false); \
                      const float a0 = __uint_as_float(r0[0]) + __uint_as_float(r0[1]), a1 = __uint_as_float(r1[0]) + __uint_as_float(r1[1]); \
                      const auto r2 = __builtin_amdgcn_permlane16_swap(__float_as_uint(a0), __float_as_uint(a1), false, false); \
                      s = __uint_as_float(r2[0]) + __uint_as_float(r2[1]); \
                      s += __int_as_float(__builtin_amdgcn_mov_dpp(__float_as_int(s), 0xB1, 0xF, 0xF, true)); \
                      s += __int_as_float(__builtin_amdgcn_mov_dpp(__float_as_int(s), 0x4E, 0xF, 0xF, true)); \
                      s += __int_as_float(__builtin_amdgcn_mov_dpp(__float_as_int(s), 0x141, 0xF, 0xF, true)); \
                      s += __int_as_float(__builtin_amdgcn_mov_dpp(__float_as_int(s), 0x140, 0xF, 0xF, true)); } \
                    const float coef = CG * gelu_fast(s * SU) * SV; \
                    _Pragma("unroll") for (int k = 0; k < 4; ++k) { const float ck = __int_as_float(__builtin_amdgcn_readlane(__float_as_int(coef), 16 * k)); const f32x2 ck2 = (f32x2){ck, ck}; \
                        _Pragma("unroll") for (int qq = 0; qq < 4; ++qq) { const int dw = (int)V[k][qq]; \
                            oacc[tk][2 * qq] += ck2 * __builtin_amdgcn_cvt_pk_f32_fp8(dw, false); oacc[tk][2 * qq + 1] += ck2 * __builtin_amdgcn_cvt_pk_f32_fp8(dw, true); } } } while (0)
                for (int j0 = beg; j0 < end; j0 += 8) {
                    IT_ADVANCE();
                    LOAD_SET(uB, vB, cgB, suB, svB);
                    COMPUTE_SET(uA, vA, cgA, suA, svA);
                    if (j0 + 4 < end) {
                        IT_ADVANCE();
                        LOAD_SET(uA, vA, cgA, suA, svA);
                        COMPUTE_SET(uB, vB, cgB, suB, svB);
                    } else {
#pragma unroll
                        for (int k = 0; k < 4; ++k) { uA[k] = uB[k]; vA[k] = vB[k]; }
                        cgA = cgB; suA = suB; svA = svB;
                    }
                }
            }
        }
#undef COMPUTE_SET
#undef IT_ADVANCE
#undef LOAD_SET
#pragma unroll
        for (int tk = 0; tk < 4; ++tk) {
            const size_t m = (size_t)tile * 64 + tb + tk; const int b = (int)(m >> 11);
            float* orow = A.out + m * 1024 + 16 * lane;
            const float* g2 = MOD + b * 6144 + 5120 + 16 * lane;
            f32x4 xv[4]; float ss = 0.f;
#pragma unroll
            for (int j = 0; j < 4; ++j) { const f32x4 x1 = *(const f32x4*)(orow + 4 * j), gg = *(const f32x4*)(g2 + 4 * j);
                const f32x4 pe = (f32x4){oacc[tk][2 * j][0], oacc[tk][2 * j][1], oacc[tk][2 * j + 1][0], oacc[tk][2 * j + 1][1]};
                xv[j] = x1 + gg * pe; ss += (xv[j][0] * xv[j][0] + xv[j][1] * xv[j][1]) + (xv[j][2] * xv[j][2] + xv[j][3] * xv[j][3]); }
            const float rstd = rsqrtf(wave_sum(ss) * (1.f / 1024.f) + 1e-6f);
#pragma unroll
            for (int j = 0; j < 4; ++j) { const f32x4 fg = *(const f32x4*)(A.final_g + 16 * lane + 4 * j); *(f32x4*)(orow + 4 * j) = xv[j] * rstd * fg; }
        }
    }
    __syncthreads();
}


#define XB_TMO      128
#define XB_XCNT(j)  (256  + 64 * (j))
#define XB_XSUB(j)  (1280 + 64 * (j))
#define XB_XGEN(j)  (2304 + 64 * (j))
#define XB_TOP      3328
#define XB_TOPGEN   3392
#define XCD_BAR_WORDS 3456
#define XB_SPIN_CAP (1u << 18)

__device__ __forceinline__ unsigned xb_ld(unsigned* p)              { return __hip_atomic_load(p, __ATOMIC_RELAXED, __HIP_MEMORY_SCOPE_AGENT); }
__device__ __forceinline__ unsigned xb_add(unsigned* p, unsigned v) { return __hip_atomic_fetch_add(p, v, __ATOMIC_RELAXED, __HIP_MEMORY_SCOPE_AGENT); }
__device__ __forceinline__ unsigned xb_xcc_id() { return (unsigned)__builtin_amdgcn_s_getreg((3 << 11) | 20) & 0xFu; }
#define XB_SPIN(cond, bar) do { unsigned _sp = 0; while (cond) { __builtin_amdgcn_s_sleep(1); \
    if ((++_sp & 255u) == 0u) { if (xb_ld(&(bar)[XB_TMO])) break; if (_sp > XB_SPIN_CAP) { atomicAdd(&(bar)[XB_TMO], 1u); break; } } } } while (0)

struct XcdBarrier {
    unsigned* bar; unsigned x;
    volatile LAS unsigned* st;
};

__device__ __forceinline__ XcdBarrier xcd_barrier_post(unsigned* bar, volatile LAS unsigned* st) {
    XcdBarrier b; b.bar = bar; b.x = xb_xcc_id(); b.st = st;
    if (threadIdx.x == 0) (void)xb_add(&bar[XB_XCNT(b.x)], 1u);
    return b;
}
__device__ __forceinline__ void xcd_barrier_complete(unsigned* bar, unsigned x, unsigned& nloc, unsigned& nx) {
    const unsigned G = gridDim.x * gridDim.y * gridDim.z;
    unsigned sum, cnt, mine, sp = 0u;
    for (;;) {
        sum = 0u; cnt = 0u; mine = 0u;
#pragma unroll
        for (unsigned j = 0; j < 16; ++j) { const unsigned c = xb_ld(&bar[XB_XCNT(j)]); sum += c; cnt += (c > 0u) ? 1u : 0u; mine = (j == x) ? c : mine; }
        if (sum == G) break;
        __builtin_amdgcn_s_sleep(1);
        if ((++sp & 255u) == 0u) { if (xb_ld(&bar[XB_TMO])) break; if (sp > XB_SPIN_CAP) { atomicAdd(&bar[XB_TMO], 1u); break; } }
    }
    nloc = mine > 0u ? mine : 1u; nx = cnt > 0u ? cnt : 1u;
}

__device__ __forceinline__ void xcd_barrier(const XcdBarrier& b) {
    asm volatile("s_waitcnt vmcnt(0)" ::: "memory");
    __syncthreads();
    if (threadIdx.x == 0) {
        unsigned* bar = b.bar;
        __builtin_amdgcn_s_waitcnt(0);
        unsigned nloc = b.st[0], nx = b.st[1];
        if (nloc == 0u) { xcd_barrier_complete(bar, b.x, nloc, nx); b.st[0] = nloc; b.st[1] = nx; }
        const unsigned old = xb_add(&bar[XB_XSUB(b.x)], 1u);
        const unsigned gen = old / nloc;
        if (old + 1u == (gen + 1u) * nloc) {
            __builtin_amdgcn_fence(__ATOMIC_RELEASE, "agent");
            asm volatile("s_waitcnt vmcnt(0)" ::: "memory");
            const unsigned og = xb_add(&bar[XB_TOP], 1u);
            const unsigned tg = og / nx;
            if (og + 1u == (tg + 1u) * nx) xb_add(&bar[XB_TOPGEN], 1u);
            else XB_SPIN(xb_ld(&bar[XB_TOPGEN]) == tg, bar);
            __builtin_amdgcn_fence(__ATOMIC_ACQUIRE, "agent");
            xb_add(&bar[XB_XGEN(b.x)], 1u);
            asm volatile("s_waitcnt vmcnt(0)" ::: "memory");
        } else {
            XB_SPIN(xb_ld(&bar[XB_XGEN(b.x)]) == gen, bar);
            __builtin_amdgcn_fence(__ATOMIC_ACQUIRE, "agent");
            asm volatile("s_waitcnt vmcnt(0)" ::: "memory");
        }
    }
    __syncthreads();
}

__global__ void __launch_bounds__(512, 2) mega_fwd(Args A) {
    extern __shared__ __attribute__((aligned(16))) unsigned char lds_raw[];
    LAS unsigned char* lds = (LAS unsigned char*)lds_raw;
    cg::grid_group grid = cg::this_grid();
    const int G = gridDim.x;
    if (threadIdx.x < 4) ((LAS unsigned*)(lds + LDS_BYTES - 32))[threadIdx.x] = 0u;
    __syncthreads();
    if (A.ws == nullptr) grid.sync();
    const XcdBarrier xb = xcd_barrier_post((unsigned*)(A.ws + WS_BAR), (volatile LAS unsigned*)(lds + LDS_BYTES - 32));
    phase0(A, lds);
    xcd_barrier(xb);
    phase1(A, lds);
    phase0b(A, lds);
    xcd_barrier(xb);
    { pg8::Gemm gm{(const pg8::bf16_t*)(A.ws + WS_ACT), (const pg8::bf16_t*)(A.ws + WS_WIN), T, NP, DM}; pg8::StaticOrder S; S.init(T, NP, G, (int)blockIdx.x);
      pg8::EpiStoreBf16 E{(pg8::bf16_t*)(A.ws + WS_P), NP};
      pg8::gemm_phase<pg8::EpiStoreBf16, pg8::StaticOrder, true, true>((PG8_LAS unsigned char*)lds, gm, S, E); }
    { const int nshort = G - (896 % G == 0 ? 0 : 896 % G);
      const int first = G - nshort;
      if ((int)blockIdx.x >= first) quantise_tables(A, ((int)blockIdx.x - first) * 8 + (int)(threadIdx.x >> 6), nshort * 8); }
    xcd_barrier(xb);
    phase3(A, lds);
    xcd_barrier(xb);
    phase3b(A, lds);
    xcd_barrier(xb);
    { pg8::Gemm gm{(const pg8::bf16_t*)(A.ws + WS_ACT), (const pg8::bf16_t*)(A.ws + WS_WOUT), T, DM, DM}; pg8::StaticOrder S; S.init(T, DM, G, (int)blockIdx.x);
      pg8::EpiResidNorm E{A.x, (const float*)(A.ws + WS_MOD), A.norm2_g, A.out, (pg8::bf16_t*)(A.ws + WS_A3), (float*)(A.ws + WS_RS)};
      pg8::gemm_phase<pg8::EpiResidNorm, pg8::StaticOrder, true, true>((PG8_LAS unsigned char*)lds, gm, S, E); }
    xcd_barrier(xb);
    { pg8::Gemm gm{(const pg8::bf16_t*)(A.ws + WS_A3), (const pg8::bf16_t*)(A.ws + WS_WQ), T, 2048, DM}; pg8::StaticOrder S; S.init(T, 2048, G, (int)blockIdx.x);
      pg8::EpiScoreF16 E{(pg8::bf16_t*)(A.ws + WS_QRY), 2048, (const float*)(A.ws + WS_RS), (const float*)(A.ws + WS_SB)};
      pg8::gemm_phase<pg8::EpiScoreF16, pg8::StaticOrder, true, true>((PG8_LAS unsigned char*)lds, gm, S, E); }
    xcd_barrier(xb);
    for (int tile = blockIdx.x; tile < T / 64; tile += G) peer_tile(A, lds, tile);
}

extern "C" void kernel_launch(void* const* d_in, const int* in_sizes, int n_in, void* d_out, int out_size, void* d_ws, size_t ws_size, hipStream_t stream) {
    static int grid = 0;
    if (grid == 0) {
        if (n_in != 22 || out_size != T * DM || ws_size < WS_END) { fprintf(stderr, "kernel_launch: unexpected shapes (n_in %d out %d ws %zu)\n", n_in, out_size, ws_size); grid = -1; return; }
        int dev = 0, cus = 0, per_cu = 0;
        if (hipGetDevice(&dev) != hipSuccess || hipDeviceGetAttribute(&cus, hipDeviceAttributeMultiprocessorCount, dev) != hipSuccess) { grid = -1; return; }
        if (hipFuncSetAttribute((const void*)mega_fwd, hipFuncAttributeMaxDynamicSharedMemorySize, LDS_BYTES) != hipSuccess) { fprintf(stderr, "kernel_launch: hipFuncSetAttribute failed\n"); grid = -1; return; }
        if (hipOccupancyMaxActiveBlocksPerMultiprocessor(&per_cu, (const void*)mega_fwd, 512, LDS_BYTES) != hipSuccess || per_cu < 1) { fprintf(stderr, "kernel_launch: occupancy query gave %d\n", per_cu); per_cu = 1; }
        (void)hipGetLastError();
        grid = cus * per_cu;
    }
    if (grid < 0) return;
    Args a{};
    const float** ap = (const float**)&a;
    for (int i = 0; i < 22; ++i) ap[i] = (const float*)d_in[i];
    a.out = (float*)d_out; a.ws = (unsigned char*)d_ws;
    if (hipMemsetAsync((unsigned char*)d_ws + WS_BAR, 0, XCD_BAR_WORDS * sizeof(unsigned), stream) != hipSuccess) { fprintf(stderr, "kernel_launch: memset of the barrier words failed\n"); return; }
    void* args[] = {&a};
    hipError_t e = hipLaunchCooperativeKernel((const void*)mega_fwd, dim3(grid), dim3(512), args, LDS_BYTES, stream);
    if (e != hipSuccess) fprintf(stderr, "kernel_launch: cooperative launch failed: %s (grid %d)\n", hipGetErrorString(e), grid);
}
```

```cpp
#include <hip/hip_runtime.h>
#include <hip/hip_cooperative_groups.h>
#include <cstdio>
#include <cstdint>
namespace cg = cooperative_groups;

namespace pg8 {
#define PG8_LAS __attribute__((address_space(3)))
typedef unsigned short bf16_t;
typedef short bf16x8 __attribute__((ext_vector_type(8)));
typedef float f32x4 __attribute__((ext_vector_type(4)));
typedef unsigned u32x4 __attribute__((ext_vector_type(4)));
constexpr int BM = 256, BK = 64, HALF = 128, HTB = HALF * BK * 2  , STAGE_BYTES = 8 * HTB, NXCD = 8, WGM = 8;

__host__ __device__ __forceinline__ int lds_byte(int r, int c) { const int st = (r >> 4) * 2 + (c >> 5), rr = r & 15, cc = c & 31, ob = rr * 64 + cc * 2; return st * 1024 + (ob ^ (((ob >> 9) & 1) << 5)); }
__host__ __device__ __forceinline__ void stage_rc(int b, int& R, int& C) { const int st = b / 1024, sb = b % 1024, swz = sb ^ (((sb >> 9) & 1) << 5); R = (st >> 1) * 16 + swz / 64; C = (st & 1) * 32 + (swz % 64) / 2; }
__host__ __device__ __forceinline__ int perm32(int rho) { const int n = rho >> 4, i = rho & 15; return 8 * (i >> 2) + 4 * n + (i & 3); }

struct Unit { int pm, pn; };
struct Gemm { const bf16_t* A; const bf16_t* Bt; int M, N, K; };

struct StaticOrder {
    int nM, nN, nwg, G, c;
    __host__ __device__ void init(int M, int N, int G_, int c_) { nM = M / BM; nN = N / BM; nwg = nM * nN; G = G_; c = c_; }
    __host__ __device__ bool next(int i, Unit& u) const {
        const long L = (long)i * G + c; if (L >= nwg) return false;
        int wgid = (int)L; { const int q = nwg / NXCD, r = nwg % NXCD, xcd = wgid % NXCD, off = wgid / NXCD; wgid = (xcd < r ? xcd * (q + 1) : r * (q + 1) + (xcd - r) * q) + off; }
        const int nig = WGM * nN, gid = wgid / nig, fm = gid * WGM, gsz = (nM - fm) < WGM ? (nM - fm) : WGM;
        u.pm = fm + ((wgid % nig) % gsz); u.pn = (wgid % nig) / gsz; return true;
    }
    __device__ __forceinline__ void a_ready(const Unit&) const {}
    __device__ __forceinline__ void done(const Unit&) const {}
};

__device__ __forceinline__ unsigned cvt_pk_bf16(float lo, float hi) { unsigned r; asm volatile("v_cvt_pk_bf16_f32 %0, %1, %2" : "=v"(r) : "v"(lo), "v"(hi)); return r; }

struct EpiStoreBf16 {
    static constexpr bool PERM = true, AFTER_DRAIN = false;
    bf16_t* O; int ldc;
    __device__ __forceinline__ void operator()(const f32x4 (&acc)[2][2][4][2], const Unit& u, int wr, int wc, int fr, int fq) const {
        const int row0 = u.pm * BM + wr * 64 + fr, col0 = u.pn * BM + wc * 32 + 8 * fq;
#pragma unroll
        for (int ai = 0; ai < 2; ++ai)
#pragma unroll
            for (int m = 0; m < 4; ++m) { bf16_t* rowp = O + (size_t)(row0 + ai * HALF + m * 16) * ldc + col0;
#pragma unroll
                for (int bj = 0; bj < 2; ++bj) { const f32x4 v0 = acc[ai][bj][m][0], v1 = acc[ai][bj][m][1];
                    u32x4 w; w.x = cvt_pk_bf16(v0[0], v0[1]); w.y = cvt_pk_bf16(v0[2], v0[3]); w.z = cvt_pk_bf16(v1[0], v1[1]); w.w = cvt_pk_bf16(v1[2], v1[3]);
                    *(u32x4*)(rowp + bj * HALF) = w; } }
    }
};
struct EpiStoreF16 {
    static constexpr bool PERM = true, AFTER_DRAIN = false;
    bf16_t* O; int ldc;
    static __device__ __forceinline__ unsigned pkh(float a, float b) { return (unsigned)__builtin_bit_cast(unsigned short, (_Float16)a) | ((unsigned)__builtin_bit_cast(unsigned short, (_Float16)b) << 16); }
    __device__ __forceinline__ void operator()(const f32x4 (&acc)[2][2][4][2], const Unit& u, int wr, int wc, int fr, int fq) const {
        const int row0 = u.pm * BM + wr * 64 + fr, col0 = u.pn * BM + wc * 32 + 8 * fq;
#pragma unroll
        for (int ai = 0; ai < 2; ++ai)
#pragma unroll
            for (int m = 0; m < 4; ++m) { bf16_t* rowp = O + (size_t)(row0 + ai * HALF + m * 16) * ldc + col0;
#pragma unroll
                for (int bj = 0; bj < 2; ++bj) { const f32x4 v0 = acc[ai][bj][m][0], v1 = acc[ai][bj][m][1];
                    u32x4 w; w.x = pkh(v0[0], v0[1]); w.y = pkh(v0[2], v0[3]); w.z = pkh(v1[0], v1[1]); w.w = pkh(v1[2], v1[3]);
                    *(u32x4*)(rowp + bj * HALF) = w; } }
    }
};
struct EpiResid {
    static constexpr bool PERM = true, AFTER_DRAIN = false;
    const float* x; const float* gate; float* out;
    __device__ __forceinline__ void operator()(const f32x4 (&acc)[2][2][4][2], const Unit& u, int wr, int wc, int fr, int fq) const {
        const int row0 = u.pm * BM + wr * 64 + fr, col0 = u.pn * BM + wc * 32 + 8 * fq;
#pragma unroll
        for (int ai = 0; ai < 2; ++ai)
#pragma unroll
            for (int m = 0; m < 4; ++m) { const int r = row0 + ai * HALF + m * 16; const float* gp = gate + (size_t)(r >> 11) * 6144;
#pragma unroll
                for (int bj = 0; bj < 2; ++bj) { const int c = col0 + bj * HALF;
                    const f32x4 xa = *(const f32x4*)(x + (size_t)r * 1024 + c), xb = *(const f32x4*)(x + (size_t)r * 1024 + c + 4);
                    const f32x4 ga = *(const f32x4*)(gp + c), gb = *(const f32x4*)(gp + c + 4);
                    *(f32x4*)(out + (size_t)r * 1024 + c) = xa + ga * acc[ai][bj][m][0];
                    *(f32x4*)(out + (size_t)r * 1024 + c + 4) = xb + gb * acc[ai][bj][m][1]; } }
    }
};
struct EpiResidNorm {
    static constexpr bool PERM = true, AFTER_DRAIN = false;
    const float* x; const float* mod; const float* ng; float* out; bf16_t* a3; float* rs;
    __device__ __forceinline__ void operator()(const f32x4 (&acc)[2][2][4][2], const Unit& u, int wr, int wc, int fr, int fq) const {
        const int row0 = u.pm * BM + wr * 64 + fr, col0 = u.pn * BM + wc * 32 + 8 * fq;
        const float* mp = mod + (size_t)((u.pm * BM) >> 11) * 6144;
        f32x4 g1v[2][2], csv[2][2];
#pragma unroll
        for (int bj = 0; bj < 2; ++bj)
#pragma unroll
            for (int n = 0; n < 2; ++n) { const int c = col0 + bj * HALF + 4 * n; g1v[bj][n] = *(const f32x4*)(mp + 2048 + c); csv[bj][n] = *(const f32x4*)(ng + c) * (*(const f32x4*)(mp + 4096 + c) + 1.0f); }
#pragma unroll
        for (int ai = 0; ai < 2; ++ai)
#pragma unroll
            for (int m = 0; m < 4; ++m) { const int r = row0 + ai * HALF + m * 16; float ss = 0.f;
#pragma unroll
                for (int bj = 0; bj < 2; ++bj) { const int c = col0 + bj * HALF;
                    const f32x4 xa = *(const f32x4*)(x + (size_t)r * 1024 + c), xb = *(const f32x4*)(x + (size_t)r * 1024 + c + 4);
                    const f32x4 v0 = xa + g1v[bj][0] * acc[ai][bj][m][0], v1 = xb + g1v[bj][1] * acc[ai][bj][m][1];
                    *(f32x4*)(out + (size_t)r * 1024 + c) = v0; *(f32x4*)(out + (size_t)r * 1024 + c + 4) = v1;
                    ss += (v0[0] * v0[0] + v0[1] * v0[1]) + (v0[2] * v0[2] + v0[3] * v0[3]) + (v1[0] * v1[0] + v1[1] * v1[1]) + (v1[2] * v1[2] + v1[3] * v1[3]);
                    const f32x4 a0 = v0 * csv[bj][0], a1 = v1 * csv[bj][1];
                    u32x4 w; w.x = cvt_pk_bf16(a0[0], a0[1]); w.y = cvt_pk_bf16(a0[2], a0[3]); w.z = cvt_pk_bf16(a1[0], a1[1]); w.w = cvt_pk_bf16(a1[2], a1[3]);
                    *(u32x4*)(a3 + (size_t)r * 1024 + c) = w; }
                ss += __shfl_xor(ss, 16); ss += __shfl_xor(ss, 32);
                if (fq == 0) rs[(size_t)r * 16 + (u.pn & 3) * 4 + wc] = ss; }
    }
};
struct EpiScoreF16 {
    static constexpr bool PERM = true, AFTER_DRAIN = false;
    bf16_t* O; int ldc; const float* rs; const float* sb;
    static __device__ __forceinline__ unsigned pkh(float a, float b) { return (unsigned)__builtin_bit_cast(unsigned short, (_Float16)a) | ((unsigned)__builtin_bit_cast(unsigned short, (_Float16)b) << 16); }
    __device__ __forceinline__ void operator()(const f32x4 (&acc)[2][2][4][2], const Unit& u, int wr, int wc, int fr, int fq) const {
        const int row0 = u.pm * BM + wr * 64 + fr, col0 = u.pn * BM + wc * 32 + 8 * fq;
        const float* sbp = sb + (size_t)((u.pm * BM) >> 11) * 2048;
        f32x4 bv[2][2];
#pragma unroll
        for (int bj = 0; bj < 2; ++bj)
#pragma unroll
            for (int n = 0; n < 2; ++n) bv[bj][n] = *(const f32x4*)(sbp + col0 + bj * HALF + 4 * n);
#pragma unroll
        for (int ai = 0; ai < 2; ++ai)
#pragma unroll
            for (int m = 0; m < 4; ++m) { const int r = row0 + ai * HALF + m * 16;
                float rstd; { const f32x4 p0 = *(const f32x4*)(rs + (size_t)r * 16), p1 = *(const f32x4*)(rs + (size_t)r * 16 + 4), p2 = *(const f32x4*)(rs + (size_t)r * 16 + 8), p3 = *(const f32x4*)(rs + (size_t)r * 16 + 12);
                  const f32x4 ps = (p0 + p1) + (p2 + p3); rstd = rsqrtf(((ps[0] + ps[1]) + (ps[2] + ps[3])) * (1.f / 1024.f) + 1e-6f); }
                bf16_t* rowp = O + (size_t)r * ldc + col0;
#pragma unroll
                for (int bj = 0; bj < 2; ++bj) { const f32x4 v0 = acc[ai][bj][m][0] * rstd + bv[bj][0], v1 = acc[ai][bj][m][1] * rstd + bv[bj][1];
                    u32x4 w; w.x = pkh(v0[0], v0[1]); w.y = pkh(v0[2], v0[3]); w.z = pkh(v1[0], v1[1]); w.w = pkh(v1[2], v1[3]);
                    *(u32x4*)(rowp + bj * HALF) = w; } }
    }
};
template <class Epi, class Sched, bool ALIGN_EPI = false, bool SP2 = false>
__device__ __forceinline__ void gemm_phase(PG8_LAS unsigned char* lds, const Gemm g, const Sched& S, const Epi& E) {
    int tid_o = threadIdx.x; asm volatile("" : "+v"(tid_o)); const int tid = tid_o, wid = __builtin_amdgcn_readfirstlane(tid >> 6), lane = tid & 63, wr = wid >> 2, wc = wid & 3, fr = lane & 15, fq = lane >> 4;
    const int K = g.K, nt = K / BK;
    unsigned voffA[2], voffB[2];
#pragma unroll
    for (int i = 0; i < 2; ++i) { int R, C; stage_rc(tid * 16 + i * 8192, R, C); const int Rb = Epi::PERM ? ((R & ~31) + perm32(R & 31)) : R;
        voffA[i] = (unsigned)(R * K + C) * 2u; voffB[i] = (unsigned)(Rb * K + C) * 2u; }
    const size_t kstep = (size_t)(BK * 2);
    const size_t hstep = (size_t)HALF * K * 2;
    const size_t tstep = 2 * hstep;
    const unsigned ldsw = (unsigned)wid * 1024u;
    const int aoff = lds_byte(wr * 64 + fr, fq * 8), boff = lds_byte(wc * 32 + fr, fq * 8);
#define PG8_SA(b, h) (((b) * 2 + (h)) * HTB)
#define PG8_SB(b, h) ((4 + (b) * 2 + (h)) * HTB)
#define PG8_STAGE(bufoff, gbase, voff) do { _Pragma("unroll") for (int _i = 0; _i < 2; ++_i) \
        __builtin_amdgcn_global_load_lds((const unsigned*)((const char*)(gbase) + (voff)[_i]), (PG8_LAS unsigned*)(lds + (bufoff) + ldsw + _i * 8192), 16, 0, 0); } while (0)
#define PG8_LDA(dst, b, h) do { _Pragma("unroll") for (int m = 0; m < 4; ++m) _Pragma("unroll") for (int k = 0; k < 2; ++k) dst[m][k] = *(const PG8_LAS bf16x8*)(lds + PG8_SA(b, h) + aoff + m * 2048 + k * 1024); } while (0)
#define PG8_LDB(dst, b, h) do { _Pragma("unroll") for (int n = 0; n < 2; ++n) _Pragma("unroll") for (int k = 0; k < 2; ++k) dst[n][k] = *(const PG8_LAS bf16x8*)(lds + PG8_SB(b, h) + boff + n * 2048 + k * 1024); } while (0)
#define PG8_MMA(ai, bj, At, Bt) do { __builtin_amdgcn_s_setprio(1); _Pragma("unroll") for (int m = 0; m < 4; ++m) _Pragma("unroll") for (int n = 0; n < 2; ++n) _Pragma("unroll") for (int k = 0; k < 2; ++k) \
        acc[ai][bj][m][n] = __builtin_amdgcn_mfma_f32_16x16x32_bf16(Bt[n][k], At[m][k], acc[ai][bj][m][n], 0, 0, 0); __builtin_amdgcn_s_setprio(0); } while (0)
#define PG8_WAIT_V(n) asm volatile("s_waitcnt vmcnt(" #n ")" ::: "memory")
#define PG8_WAIT_L(n) asm volatile("s_waitcnt lgkmcnt(" #n ")" ::: "memory")
#define PG8_BAR __builtin_amdgcn_s_barrier()
#define PG8_SCHED __builtin_amdgcn_sched_barrier(0)
    Unit cur, nxt; int ui = 0;
    if (!S.next(0, cur)) return;
    f32x4 acc[2][2][4][2];
#pragma unroll
    for (int a = 0; a < 2; ++a)
#pragma unroll
        for (int b = 0; b < 2; ++b)
#pragma unroll
            for (int m = 0; m < 4; ++m)
#pragma unroll
                for (int n = 0; n < 2; ++n) acc[a][b][m][n] = (f32x4){0.f, 0.f, 0.f, 0.f};
    bf16x8 At[4][2], B0[2][2], B1[2][2];
    const char* cA = (const char*)g.A + (size_t)cur.pm * tstep; const char* cB = (const char*)g.Bt + (size_t)cur.pn * tstep;
    S.a_ready(cur);
    if constexpr (SP2) {
        PG8_STAGE(PG8_SB(0, 0), cB, voffB); PG8_STAGE(PG8_SB(0, 1), cB + hstep, voffB); PG8_STAGE(PG8_SA(0, 0), cA, voffA); PG8_STAGE(PG8_SA(0, 1), cA + hstep, voffA);
        if (wr == 1) PG8_BAR;
        PG8_WAIT_V(2); PG8_BAR;
        PG8_STAGE(PG8_SB(1, 0), cB + kstep, voffB); PG8_STAGE(PG8_SA(1, 0), cA + kstep, voffA); PG8_STAGE(PG8_SB(1, 1), cB + hstep + kstep, voffB);
        PG8_WAIT_V(6); PG8_BAR;
    } else {
        PG8_STAGE(PG8_SB(0, 0), cB, voffB); PG8_STAGE(PG8_SA(0, 0), cA, voffA); PG8_STAGE(PG8_SB(0, 1), cB + hstep, voffB); PG8_STAGE(PG8_SA(0, 1), cA + hstep, voffA);
        if (wr == 1) PG8_BAR;
        PG8_WAIT_V(4); PG8_BAR;
        PG8_STAGE(PG8_SB(1, 0), cB + kstep, voffB); PG8_STAGE(PG8_SA(1, 0), cA + kstep, voffA); PG8_STAGE(PG8_SB(1, 1), cB + hstep + kstep, voffB);
        PG8_WAIT_V(6); PG8_BAR;
    }
    for (;;) {
        const bool has_next = S.next(ui + 1, nxt);
        const char* nA = has_next ? (const char*)g.A + (size_t)nxt.pm * tstep : cA; const char* nB = has_next ? (const char*)g.Bt + (size_t)nxt.pn * tstep : cB;
        for (int t = 0; t < nt; t += 2) {
            const bool last = (t == nt - 2);
            const char* a1 = cA + (size_t)(t + 1) * kstep;
            const char* a2 = last ? nA : cA + (size_t)(t + 2) * kstep; const char* b2 = last ? nB : cB + (size_t)(t + 2) * kstep;
            const char* a3 = a2 + kstep; const char* b3 = b2 + kstep;
            if (last && has_next) S.a_ready(nxt);
            if constexpr (SP2) {
            PG8_LDB(B0, 0, 0); PG8_LDB(B1, 0, 1); PG8_SCHED; PG8_LDA(At, 0, 0); PG8_STAGE(PG8_SA(1, 1), a1 + hstep, voffA);
            PG8_WAIT_V(8); PG8_WAIT_L(0); PG8_BAR; PG8_MMA(0, 0, At, B0); PG8_MMA(0, 1, At, B1); PG8_BAR; PG8_SCHED;
            PG8_LDA(At, 0, 1); PG8_STAGE(PG8_SB(0, 0), b2, voffB); PG8_STAGE(PG8_SB(0, 1), b2 + hstep, voffB); PG8_STAGE(PG8_SA(0, 0), a2, voffA);
            PG8_WAIT_V(8); PG8_WAIT_L(0); PG8_BAR; PG8_MMA(1, 0, At, B0); PG8_MMA(1, 1, At, B1); PG8_BAR; PG8_SCHED;
            PG8_LDB(B0, 1, 0); PG8_LDB(B1, 1, 1); PG8_SCHED; PG8_LDA(At, 1, 0); PG8_STAGE(PG8_SA(0, 1), a2 + hstep, voffA);
            PG8_WAIT_V(8); PG8_WAIT_L(0); PG8_BAR; PG8_MMA(0, 0, At, B0); PG8_MMA(0, 1, At, B1); PG8_BAR; PG8_SCHED;
            PG8_LDA(At, 1, 1); PG8_STAGE(PG8_SB(1, 0), b3, voffB); PG8_STAGE(PG8_SB(1, 1), b3 + hstep, voffB); PG8_STAGE(PG8_SA(1, 0), a3, voffA);
            PG8_WAIT_V(8); PG8_WAIT_L(0); PG8_BAR; PG8_MMA(1, 0, At, B0); PG8_MMA(1, 1, At, B1); PG8_BAR; PG8_SCHED;
            } else {
            PG8_LDB(B0, 0, 0); PG8_SCHED; PG8_LDA(At, 0, 0); PG8_STAGE(PG8_SA(1, 1), a1 + hstep, voffA);
            PG8_WAIT_L(8); PG8_BAR; PG8_WAIT_L(0); PG8_MMA(0, 0, At, B0); PG8_BAR; PG8_SCHED;
            PG8_LDB(B1, 0, 1); PG8_STAGE(PG8_SB(0, 0), b2, voffB);
            PG8_BAR; PG8_WAIT_L(0); PG8_MMA(0, 1, At, B1); PG8_BAR;
            PG8_LDA(At, 0, 1); PG8_STAGE(PG8_SA(0, 0), a2, voffA);
            PG8_BAR; PG8_WAIT_L(0); PG8_MMA(1, 0, At, B0); PG8_BAR; PG8_SCHED;
            PG8_STAGE(PG8_SB(0, 1), b2 + hstep, voffB);
            PG8_WAIT_V(6); PG8_BAR; PG8_MMA(1, 1, At, B1); PG8_BAR;
            PG8_LDB(B0, 1, 0); PG8_SCHED; PG8_LDA(At, 1, 0); PG8_STAGE(PG8_SA(0, 1), a2 + hstep, voffA);
            PG8_WAIT_L(8); PG8_BAR; PG8_WAIT_L(0); PG8_MMA(0, 0, At, B0); PG8_BAR; PG8_SCHED;
            PG8_LDB(B1, 1, 1); PG8_STAGE(PG8_SB(1, 0), b3, voffB);
            PG8_BAR; PG8_WAIT_L(0); PG8_MMA(0, 1, At, B1); PG8_BAR;
            PG8_LDA(At, 1, 1); PG8_STAGE(PG8_SA(1, 0), a3, voffA);
            PG8_BAR; PG8_WAIT_L(0); PG8_MMA(1, 0, At, B0); PG8_BAR; PG8_SCHED;
            PG8_STAGE(PG8_SB(1, 1), b3 + hstep, voffB);
            PG8_WAIT_V(6); PG8_BAR; PG8_MMA(1, 1, At, B1); PG8_BAR;
            }
        }
        if constexpr (ALIGN_EPI) { if (wr == 0) PG8_BAR; }
        if constexpr (!Epi::AFTER_DRAIN) { E(acc, cur, wr, wc, fr, fq); S.done(cur); }
        if (!has_next) break;
#pragma unroll
        for (int a = 0; a < 2; ++a)
#pragma unroll
            for (int b = 0; b < 2; ++b)
#pragma unroll
                for (int m = 0; m < 4; ++m)
#pragma unroll
                    for (int n = 0; n < 2; ++n) acc[a][b][m][n] = (f32x4){0.f, 0.f, 0.f, 0.f};
        cur = nxt; cA = nA; cB = nB; ++ui;
        if constexpr (ALIGN_EPI) { if (wr == 1) PG8_BAR; }
    }
    PG8_WAIT_V(0);
    if constexpr (!ALIGN_EPI) { if (wr == 0) PG8_BAR; }
    PG8_BAR;
    if constexpr (Epi::AFTER_DRAIN) { E.fused(acc, cur, wr, wc, fr, fq, lds, wid, lane); S.done(cur); }
#undef PG8_SA
#undef PG8_SB
#undef PG8_STAGE
#undef PG8_LDA
#undef PG8_LDB
#undef PG8_MMA
#undef PG8_WAIT_V
#undef PG8_WAIT_L
#undef PG8_BAR
#undef PG8_SCHED
}
}


#define LAS __attribute__((address_space(3)))
typedef unsigned short bf16_t;
typedef short bf16x8 __attribute__((ext_vector_type(8)));
typedef short s16x4 __attribute__((ext_vector_type(4)));
typedef short v4i16_t __attribute__((ext_vector_type(4)));
typedef float f32x4 __attribute__((ext_vector_type(4)));
typedef unsigned u32x4 __attribute__((ext_vector_type(4)));
typedef unsigned u32x2 __attribute__((ext_vector_type(2)));
typedef float f32x2 __attribute__((ext_vector_type(2)));

constexpr int T = 16384, DM = 1024, SEQ = 2048, NP = 3584;
constexpr size_t MiB = 1u << 20;
constexpr size_t WS_CTL = 0, WS_MOD = 4096, WS_GATES = 262144, WS_KEYS = 1 * MiB, WS_WIN = 2 * MiB, WS_WOUT = 9 * MiB, WS_WQ = 11 * MiB,
                 WS_T8 = 16 * MiB, WS_SC = 48 * MiB, WS_ACT = 80 * MiB, WS_P = 112 * MiB, WS_QRY = 112 * MiB, WS_END = 256 * MiB;
constexpr size_t WS_RS = 208 * MiB, WS_SB = 851968, WS_A3 = 176 * MiB;
constexpr int LDS_BYTES = 147456;

__device__ __forceinline__ unsigned f2bf(float f) { unsigned u = __float_as_uint(f); return (u + 0x7fffu + ((u >> 16) & 1u)) >> 16; }
typedef __bf16 bf16x2_t __attribute__((ext_vector_type(2)));
__device__ __forceinline__ unsigned pk2(float lo, float hi) { const f32x2 v = {lo, hi}; const bf16x2_t b = __builtin_convertvector(v, bf16x2_t); return __builtin_bit_cast(unsigned, b); }
__device__ __forceinline__ float bflo(unsigned u) { return __uint_as_float(u << 16); }
__device__ __forceinline__ float bfhi(unsigned u) { return __uint_as_float(u & 0xffff0000u); }
__device__ __forceinline__ float wave_sum(float v) {
    { const auto r = __builtin_amdgcn_permlane32_swap(__float_as_uint(v), __float_as_uint(v), false, false); v = __uint_as_float(r[0]) + __uint_as_float(r[1]); }
    { const auto r = __builtin_amdgcn_permlane16_swap(__float_as_uint(v), __float_as_uint(v), false, false); v = __uint_as_float(r[0]) + __uint_as_float(r[1]); }
    v += __int_as_float(__builtin_amdgcn_mov_dpp(__float_as_int(v), 0xB1, 0xF, 0xF, true));
    v += __int_as_float(__builtin_amdgcn_mov_dpp(__float_as_int(v), 0x4E, 0xF, 0xF, true));
    v += __int_as_float(__builtin_amdgcn_mov_dpp(__float_as_int(v), 0x141, 0xF, 0xF, true));
    v += __int_as_float(__builtin_amdgcn_mov_dpp(__float_as_int(v), 0x140, 0xF, 0xF, true));
    return v;
}
__device__ __forceinline__ float xrow_max(float v) {
    { const auto r = __builtin_amdgcn_permlane16_swap(__float_as_uint(v), __float_as_uint(v), false, false); v = fmaxf(__uint_as_float(r[0]), __uint_as_float(r[1])); }
    { const auto r = __builtin_amdgcn_permlane32_swap(__float_as_uint(v), __float_as_uint(v), false, false); v = fmaxf(__uint_as_float(r[0]), __uint_as_float(r[1])); }
    return v;
}
__device__ __forceinline__ float xrow_sum(float v) {
    { const auto r = __builtin_amdgcn_permlane16_swap(__float_as_uint(v), __float_as_uint(v), false, false); v = __uint_as_float(r[0]) + __uint_as_float(r[1]); }
    { const auto r = __builtin_amdgcn_permlane32_swap(__float_as_uint(v), __float_as_uint(v), false, false); v = __uint_as_float(r[0]) + __uint_as_float(r[1]); }
    return v;
}
#define LDS_WAIT() asm volatile("s_waitcnt lgkmcnt(0)" ::: "memory")
__device__ __forceinline__ s16x4 vtr(LAS unsigned char* p) { return __builtin_bit_cast(s16x4, __builtin_amdgcn_ds_read_tr16_b64_v4i16((LAS v4i16_t*)p)); }
__device__ __forceinline__ bf16x8 cat8(s16x4 a, s16x4 b) { bf16x8 r; r[0] = a[0]; r[1] = a[1]; r[2] = a[2]; r[3] = a[3]; r[4] = b[0]; r[5] = b[1]; r[6] = b[2]; r[7] = b[3]; return r; }
__device__ __forceinline__ bf16x8 pack8(const f32x4 a, const f32x4 b) { u32x4 w; w.x = pk2(a[0], a[1]); w.y = pk2(a[2], a[3]); w.z = pk2(b[0], b[1]); w.w = pk2(b[2], b[3]); return __builtin_bit_cast(bf16x8, w); }
#define MFMA16(a, b, c) __builtin_amdgcn_mfma_f32_16x16x32_bf16((a), (b), (c), 0, 0, 0)

struct Args {
    const float *x, *c, *ada_w, *ada_b, *norm1_g, *w_in, *conv_w, *conv_b, *gate_b, *mnorm_g, *lq1, *lk1, *lq2, *lk2, *dnorm_g, *w_out, *norm2_g, *wq, *keys, *pu, *pv, *final_g;
    float* out; unsigned char* ws;
};

__device__ __forceinline__ void transpose_item(const float* W, int srcN, int soff, bf16_t* WT, LAS float* scr, int kb, int nb, int lane) {
    const int k0 = 64 * kb, n0 = 32 * nb;
    { f32x4 wv[8];
#pragma unroll
      for (int i = 0; i < 8; ++i) wv[i] = *(const f32x4*)(W + (size_t)(k0 + 8 * i + (lane >> 3)) * srcN + n0 + soff + 4 * (lane & 7));
#pragma unroll
      for (int i = 0; i < 8; ++i) { LAS float* d = scr + (8 * i + (lane >> 3)) * 33 + 4 * (lane & 7); d[0] = wv[i][0]; d[1] = wv[i][1]; d[2] = wv[i][2]; d[3] = wv[i][3]; } }
    LDS_WAIT(); asm volatile("" ::: "memory");
    const int c = lane & 7;
#pragma unroll
    for (int j = 0; j < 4; ++j) { const int n = (lane >> 3) + 8 * j; const LAS float* s = scr + (8 * c) * 33 + n;
        u32x4 o; o.x = pk2(s[0 * 33], s[1 * 33]); o.y = pk2(s[2 * 33], s[3 * 33]); o.z = pk2(s[4 * 33], s[5 * 33]); o.w = pk2(s[6 * 33], s[7 * 33]);
        *(u32x4*)(WT + (size_t)(n0 + n) * 1024 + k0 + 8 * c) = o; }
    LDS_WAIT(); asm volatile("" ::: "memory");
}

__device__ __forceinline__ bf16x8 pack8_sw(const f32x4 a, const f32x4 b) {
    u32x4 w; w.x = f2bf(a[0]) | (f2bf(a[1]) << 16); w.y = f2bf(a[2]) | (f2bf(a[3]) << 16); w.z = f2bf(b[0]) | (f2bf(b[1]) << 16); w.w = f2bf(b[2]) | (f2bf(b[3]) << 16); return __builtin_bit_cast(bf16x8, w); }
__device__ __forceinline__ void wprime_item(const Args& A, int hp, int kt, int lane) {
    const int g = lane >> 4, l15 = lane & 15;
    f32x4 acc[8];
#pragma unroll
    for (int nt = 0; nt < 8; ++nt) acc[nt] = (f32x4){0.f, 0.f, 0.f, 0.f};
#pragma unroll
    for (int ks = 0; ks < 4; ++ks) {
        const float* ap = A.wq + (size_t)(16 * kt + l15) * 2048 + hp * 128 + 32 * ks + 8 * g;
        const bf16x8 a = pack8(*(const f32x4*)ap, *(const f32x4*)(ap + 4));
#pragma unroll
        for (int nt = 0; nt < 8; ++nt) { const float* bp = A.keys + (size_t)(hp * 128 + 16 * nt + l15) * 128 + 32 * ks + 8 * g;
            const bf16x8 b = pack8(*(const f32x4*)bp, *(const f32x4*)(bp + 4)); acc[nt] = MFMA16(a, b, acc[nt]); }
    }
    bf16_t* WT = (bf16_t*)(A.ws + WS_WQ);
#pragma unroll
    for (int nt = 0; nt < 8; ++nt) { u32x2 o; o.x = pk2(acc[nt][0], acc[nt][1]); o.y = pk2(acc[nt][2], acc[nt][3]);
        *(u32x2*)(WT + (size_t)(hp * 128 + 16 * nt + l15) * 1024 + 16 * kt + 4 * g) = o; }
}

__device__ __forceinline__ void phase0(const Args& A, LAS unsigned char* lds) {
    int tid_o = threadIdx.x; asm volatile("" : "+v"(tid_o)); const int tid = tid_o, lane = tid & 63, wave = tid >> 6, G = gridDim.x;
    float* MOD = (float*)(A.ws + WS_MOD);
    if ((int)blockIdx.x < 192) {
        LAS float* sc = (LAS float*)lds;
        for (int i = tid; i < 8192; i += 512) { const float v = A.c[i]; sc[i] = v * __builtin_amdgcn_rcpf(1.f + __expf(-v)); }
        __syncthreads();
        for (int item = blockIdx.x; item < 192; item += G) {
            const int j0 = item * 32, kg = tid >> 3, cq = tid & 7;
            f32x4 wv[16];
#pragma unroll
            for (int kk = 0; kk < 16; ++kk) wv[kk] = *(const f32x4*)(A.ada_w + (size_t)(kg * 16 + kk) * 6144 + j0 + 4 * cq);
            f32x4 acc[8];
#pragma unroll
            for (int b = 0; b < 8; ++b) acc[b] = (f32x4){0.f, 0.f, 0.f, 0.f};
#pragma unroll
            for (int b = 0; b < 8; ++b)
#pragma unroll
                for (int k4 = 0; k4 < 4; ++k4) { const f32x4 s4 = *(const LAS f32x4*)(sc + b * 1024 + kg * 16 + 4 * k4);
                    acc[b] += wv[4 * k4] * s4[0]; acc[b] += wv[4 * k4 + 1] * s4[1]; acc[b] += wv[4 * k4 + 2] * s4[2]; acc[b] += wv[4 * k4 + 3] * s4[3]; }
            LAS float* part = (LAS float*)(lds + 32768);
#pragma unroll
            for (int b = 0; b < 8; ++b) *(LAS f32x4*)(part + (kg * 8 + b) * 32 + 4 * cq) = acc[b];
            __syncthreads();
            if (tid < 256) { const int b = tid >> 5, col = tid & 31; float s = A.ada_b[j0 + col];
              for (int k2 = 0; k2 < 64; ++k2) s += part[(k2 * 8 + b) * 32 + col];
              MOD[b * 6144 + j0 + col] = s; }
            __syncthreads();
        }
    }
    if (blockIdx.x == 0 && tid == 0) {
        float s1 = 0.f, s2 = 0.f;
        for (int i = 0; i < 64; ++i) { s1 += A.lq1[i] * A.lk1[i]; s2 += A.lq2[i] * A.lk2[i]; }
        ((float*)(A.ws + WS_CTL))[1] = expf(s1) - expf(s2) + 0.2f;
        ((unsigned*)(A.ws + WS_CTL))[0] = 0u; ((unsigned*)(A.ws + WS_CTL))[2] = 0u;
    }
}

__device__ __forceinline__ void phase0b(const Args& A, LAS unsigned char* lds) {
    int tid_o = threadIdx.x; asm volatile("" : "+v"(tid_o)); const int tid = tid_o, lane = tid & 63, wave = tid >> 6, G = gridDim.x;
    __syncthreads();
    {
        LAS float* scr = (LAS float*)(lds + wave * 16384);
        const int gw = blockIdx.x * 8 + wave, NGW = G * 8;
        for (int it = gw; it < 3328; it += NGW) {
            int r = it;
            if (r < 1792) { const int kb = r / 112, nb = r % 112; transpose_item(A.w_in, 3592, nb >= 64 ? 8 : 0, (bf16_t*)(A.ws + WS_WIN), scr, kb, nb, lane); continue; }
            r -= 1792;
            if (r < 512) { transpose_item(A.w_out, 1024, 0, (bf16_t*)(A.ws + WS_WOUT), scr, r / 32, r % 32, lane); continue; }
            r -= 512;
            wprime_item(A, r >> 6, r & 63, lane);
        }
    }
    {
        for (int i = blockIdx.x * 512 + tid; i < 32768; i += G * 512) {
            const f32x4 a = *(const f32x4*)(A.keys + (size_t)i * 8), b = *(const f32x4*)(A.keys + (size_t)i * 8 + 4);
            u32x4 o; o.x = pk2(a[0], a[1]); o.y = pk2(a[2], a[3]); o.z = pk2(b[0], b[1]); o.w = pk2(b[2], b[3]);
            *(u32x4*)((bf16_t*)(A.ws + WS_KEYS) + (size_t)i * 8) = o;
        }
    }
}

__device__ __forceinline__ void quantise_tables(const Args& A, int gw, int NGW) {
    int tid_o = threadIdx.x; asm volatile("" : "+v"(tid_o)); const int lane = tid_o & 63;
    unsigned char* T8 = A.ws + WS_T8; float* SC = (float*)(A.ws + WS_SC);
#pragma unroll 1
    for (int row = gw; row < 32768; row += 4 * NGW) {
        f32x4 v[4][4]; int rr[4];
#pragma unroll
        for (int q = 0; q < 4; ++q) { const int r = row + q * NGW; rr[q] = r; const int rc = r < 32768 ? r : row;
            const float* s = (rc < 16384 ? A.pu + (size_t)rc * 1024 : A.pv + (size_t)(rc - 16384) * 1024) + 16 * lane;
#pragma unroll
            for (int j = 0; j < 4; ++j) v[q][j] = *(const f32x4*)(s + 4 * j); }
#pragma unroll
        for (int q = 0; q < 4; ++q) {
            float mx = 0.f;
#pragma unroll
            for (int j = 0; j < 4; ++j)
#pragma unroll
                for (int e = 0; e < 4; ++e) mx = fmaxf(mx, fabsf(v[q][j][e]));
#pragma unroll
            for (int o = 1; o < 64; o <<= 1) mx = fmaxf(mx, __shfl_xor(mx, o));
            const float sc = fmaxf(mx, 1e-30f) * (1.f / 256.f), inv = 1.f / sc;
            u32x4 o4;
#pragma unroll
            for (int j = 0; j < 4; ++j) { int w0 = __builtin_amdgcn_cvt_pk_fp8_f32(v[q][j][0] * inv, v[q][j][1] * inv, 0, false); w0 = __builtin_amdgcn_cvt_pk_fp8_f32(v[q][j][2] * inv, v[q][j][3] * inv, w0, true); o4[j] = (unsigned)w0; }
            if (rr[q] < 32768) { *(u32x4*)(T8 + (size_t)rr[q] * 1024 + 16 * lane) = o4; if (lane == 0) SC[rr[q]] = sc; }
        }
    }
}

__device__ __forceinline__ void phase1(const Args& A, LAS unsigned char* lds) {
    int tid_o = threadIdx.x; asm volatile("" : "+v"(tid_o)); const int tid = tid_o, lane = tid & 63, wave = tid >> 6, G = gridDim.x;
    const float* MOD = (const float*)(A.ws + WS_MOD);
    bf16_t* ACT = (bf16_t*)(A.ws + WS_ACT);
    float* GATES = (float*)(A.ws + WS_GATES);
    LAS float* WG = (LAS float*)lds;
    for (int i = tid; i < 8192; i += 512) { const int k = i >> 3, gc = i & 7; WG[gc * 1024 + k] = A.w_in[(size_t)k * 3592 + 2048 + gc]; }
    __syncthreads();
    f32x4 vn[4];
    { const int m0 = blockIdx.x * 8 + wave; if (m0 < T) { const f32x4* xr = (const f32x4*)(A.x + (size_t)m0 * 1024) + lane;
#pragma unroll
        for (int j = 0; j < 4; ++j) vn[j] = xr[64 * j]; } }
    for (int m = blockIdx.x * 8 + wave; m < T; m += G * 8) {
        const int b = m >> 11;
        f32x4 v[4]; float ss = 0.f;
#pragma unroll
        for (int j = 0; j < 4; ++j) { v[j] = vn[j]; ss += (v[j][0] * v[j][0] + v[j][1] * v[j][1]) + (v[j][2] * v[j][2] + v[j][3] * v[j][3]); }
        if (m + G * 8 < T) { const f32x4* xr = (const f32x4*)(A.x + (size_t)(m + G * 8) * 1024) + lane;
#pragma unroll
            for (int j = 0; j < 4; ++j) vn[j] = xr[64 * j]; }
        const float rstd = rsqrtf(wave_sum(ss) * (1.f / 1024.f) + 1e-6f);
        unsigned long long* o8 = (unsigned long long*)(ACT + (size_t)m * 1024) + lane;
#pragma unroll
        for (int j = 0; j < 4; ++j) { const int col = 4 * lane + 256 * j;
            const f32x4 g = *(const f32x4*)(A.norm1_g + col), sc = *(const f32x4*)(MOD + b * 6144 + 1024 + col), sh = *(const f32x4*)(MOD + b * 6144 + col);
            v[j] = v[j] * rstd * g * (sc + 1.0f) + sh;
            o8[64 * j] = (unsigned long long)pk2(v[j][0], v[j][1]) | ((unsigned long long)pk2(v[j][2], v[j][3]) << 32); }
        float gd[8];
#pragma unroll
        for (int gc = 0; gc < 8; ++gc) { float d = 0.f;
#pragma unroll
            for (int j = 0; j < 4; ++j) { const f32x4 w = *(const LAS f32x4*)(WG + gc * 1024 + 256 * j + 4 * lane); d += (v[j][0] * w[0] + v[j][1] * w[1]) + (v[j][2] * w[2] + v[j][3] * w[3]); }
            gd[gc] = wave_sum(d); }
        if (lane == 0) {
            f32x4 ig, lf;
#pragma unroll
            for (int h = 0; h < 4; ++h) { ig[h] = gd[h] + A.gate_b[h]; const float z = gd[4 + h] + A.gate_b[4 + h]; lf[h] = fminf(z, 0.f) - log1pf(expf(-fabsf(z))); }
            *(f32x4*)(GATES + (size_t)m * 8) = ig; *(f32x4*)(GATES + (size_t)m * 8 + 4) = lf;
        }
    }
}

constexpr int AK_STRIDE = 272, AV_STRIDE = 288, AK_BYTES = 64 * AK_STRIDE, AV_BYTES = 64 * AV_STRIDE;
__device__ __forceinline__ void attn_item(const Args& A, LAS unsigned char* lds, int b, int h, int qb, float lam) {
    int tid_o = threadIdx.x; asm volatile("" : "+v"(tid_o)); const int tid = tid_o, lane = tid & 63, w = tid >> 6, g = lane >> 4, l15 = lane & 15;
    const bf16_t* P = (const bf16_t*)(A.ws + WS_P);
    bf16_t* ACT = (bf16_t*)(A.ws + WS_ACT);
    const int t0 = qb * 128, ntiles = 2 * (qb + 1);
    const size_t rowbase = (size_t)b * SEQ;
    bf16x8 qf[2][2];
    { const bf16_t* qp = P + (rowbase + t0 + 16 * w + l15) * NP + 2048 + h * 128 + 8 * g;
#pragma unroll
      for (int p = 0; p < 2; ++p)
#pragma unroll
          for (int ks = 0; ks < 2; ++ks) qf[p][ks] = *(const bf16x8*)(qp + p * 64 + ks * 32); }
    f32x4 o[2][8];
#pragma unroll
    for (int p = 0; p < 2; ++p)
#pragma unroll
        for (int vt = 0; vt < 8; ++vt) o[p][vt] = (f32x4){0.f, 0.f, 0.f, 0.f};
    float mrun[2] = {-1e30f, -1e30f}, lrun[2] = {0.f, 0.f};
    const int srow = tid >> 3, sseg = tid & 7;
    const bf16_t* kg = P + (rowbase + srow) * NP + 2560 + h * 128 + sseg * 16;
    const bf16_t* vg = P + (rowbase + srow) * NP + 3072 + h * 128 + sseg * 16;
    u32x4 kr0, kr1, vr0, vr1;
    kr0 = *(const u32x4*)(kg); kr1 = *(const u32x4*)(kg + 8); vr0 = *(const u32x4*)(vg); vr1 = *(const u32x4*)(vg + 8);
    { LAS unsigned char* kb = lds + srow * AK_STRIDE + sseg * 32; LAS unsigned char* vb = lds + 2 * AK_BYTES + srow * AV_STRIDE + sseg * 32;
      *(LAS u32x4*)kb = kr0; *(LAS u32x4*)(kb + 16) = kr1; *(LAS u32x4*)vb = vr0; *(LAS u32x4*)(vb + 16) = vr1; }
    __syncthreads();
    const float cs = 0.125f * 1.4426950408889634f;
    const int qabs = t0 + 16 * w + l15;
    for (int kt = 0; kt < ntiles; ++kt) {
        const int cur = kt & 1;
        if (kt + 1 < ntiles) { const size_t off = (size_t)(kt + 1) * 64 * NP;
            kr0 = *(const u32x4*)(kg + off); kr1 = *(const u32x4*)(kg + off + 8); vr0 = *(const u32x4*)(vg + off); vr1 = *(const u32x4*)(vg + off + 8); }
        if (64 * kt <= t0 + 16 * w + 15) {
            LAS unsigned char* Kb = lds + cur * AK_BYTES; LAS unsigned char* Vb = lds + 2 * AK_BYTES + cur * AV_BYTES;
            f32x4 s[2][4];
#pragma unroll
            for (int p = 0; p < 2; ++p)
#pragma unroll
                for (int k4 = 0; k4 < 4; ++k4) { f32x4 a = (f32x4){0.f, 0.f, 0.f, 0.f};
#pragma unroll
                    for (int ks = 0; ks < 2; ++ks) { const bf16x8 kf = *(const LAS bf16x8*)(Kb + (16 * k4 + l15) * AK_STRIDE + (p * 64 + ks * 32 + 8 * g) * 2); a = MFMA16(kf, qf[p][ks], a); }
                    s[p][k4] = a; }
            if (64 * kt + 63 > t0 + 16 * w) {
#pragma unroll
                for (int p = 0; p < 2; ++p)
#pragma unroll
                    for (int k4 = 0; k4 < 4; ++k4)
#pragma unroll
                        for (int r = 0; r < 4; ++r) { const int key = 64 * kt + 16 * k4 + 4 * g + r; if (key > qabs) s[p][k4][r] = -1e30f; }
            }
            bf16x8 pf[2][2];
#pragma unroll
            for (int p = 0; p < 2; ++p) {
                float mx = -1e30f;
#pragma unroll
                for (int k4 = 0; k4 < 4; ++k4)
#pragma unroll
                    for (int r = 0; r < 4; ++r) mx = fmaxf(mx, s[p][k4][r]);
                mx = xrow_max(mx);
                const float mnew = fmaxf(mrun[p], mx * cs), alpha = __builtin_amdgcn_exp2f(mrun[p] - mnew);
                mrun[p] = mnew;
                float ls = 0.f;
#pragma unroll
                for (int k4 = 0; k4 < 4; ++k4)
#pragma unroll
                    for (int r = 0; r < 4; ++r) { const float pv = __builtin_amdgcn_exp2f(s[p][k4][r] * cs - mnew); ls += pv; s[p][k4][r] = pv; }
                lrun[p] = lrun[p] * alpha + ls;
                if (__any(alpha != 1.f)) {
#pragma unroll
                    for (int vt = 0; vt < 8; ++vt) o[p][vt] = o[p][vt] * alpha; }
                pf[p][0] = pack8(s[p][0], s[p][1]); pf[p][1] = pack8(s[p][2], s[p][3]);
            }
#pragma unroll
            for (int ks2 = 0; ks2 < 2; ++ks2)
#pragma unroll
                for (int vt = 0; vt < 8; ++vt) {
                    LAS unsigned char* a0 = Vb + (32 * ks2 + 4 * g + (l15 >> 2)) * AV_STRIDE + (16 * vt + 4 * (lane & 3)) * 2;
                    const bf16x8 vf = cat8(vtr(a0), vtr(a0 + 16 * AV_STRIDE));
                    o[0][vt] = MFMA16(vf, pf[0][ks2], o[0][vt]);
                    o[1][vt] = MFMA16(vf, pf[1][ks2], o[1][vt]);
                }
        }
        if (kt + 1 < ntiles) { const int nx = cur ^ 1;
            LAS unsigned char* kb = lds + nx * AK_BYTES + srow * AK_STRIDE + sseg * 32; LAS unsigned char* vb = lds + 2 * AK_BYTES + nx * AV_BYTES + srow * AV_STRIDE + sseg * 32;
            *(LAS u32x4*)kb = kr0; *(LAS u32x4*)(kb + 16) = kr1; *(LAS u32x4*)vb = vr0; *(LAS u32x4*)(vb + 16) = vr1; }
        __syncthreads();
    }
    float inv[2];
#pragma unroll
    for (int p = 0; p < 2; ++p) { const float lt = xrow_sum(lrun[p]); inv[p] = 1.f / lt; }
    float ss = 0.f;
#pragma unroll
    for (int vt = 0; vt < 8; ++vt)
#pragma unroll
        for (int r = 0; r < 4; ++r) { const float ov = o[0][vt][r] * inv[0] - lam * (o[1][vt][r] * inv[1]); o[0][vt][r] = ov; ss += ov * ov; }
    ss = xrow_sum(ss);
    const float rstd = rsqrtf(ss * (1.f / 128.f) + 1e-6f) * 0.8f;
    bf16_t* op = ACT + (rowbase + qabs) * 1024 + 512 + h * 128 + 4 * g;
#pragma unroll
    for (int vt = 0; vt < 8; ++vt) { const f32x4 gn = *(const f32x4*)(A.dnorm_g + 16 * vt + 4 * g);
        u32x2 wv; wv.x = pk2(o[0][vt][0] * rstd * gn[0], o[0][vt][1] * rstd * gn[1]); wv.y = pk2(o[0][vt][2] * rstd * gn[2], o[0][vt][3] * rstd * gn[3]);
        *(u32x2*)(op + 16 * vt) = wv; }
}

constexpr int MQ_STRIDE = 272, MV_STRIDE = 288, MP_STRIDE = 144, MH_STRIDE = 132;
constexpr int ML_Q = 0, ML_K = 17408, ML_V = 34816, ML_P = 53248, ML_H = 62464, ML_CW = 96256, ML_SM = 101376;
constexpr int SM_E = 0, SM_G = 64, SM_B = 128, SM_W = 192, SM_I = 256, SM_R = 320, SM_N = 384, SM_NP = 512, SM_X = 1024;
constexpr size_t WS_CST = 224 * MiB, WS_NST = 15 * MiB, WS_MC = 15 * MiB + 512 * 1024, WS_BAR = 15 * MiB + 768 * 1024;

__device__ __forceinline__ void mlstm_state(const Args& A, LAS unsigned char* lds, int b, int h) {
    int tid_o = threadIdx.x; asm volatile("" : "+v"(tid_o)); const int tid = tid_o, lane = tid & 63, w = tid >> 6, g = lane >> 4, l15 = lane & 15;
    const bf16_t* P = (const bf16_t*)(A.ws + WS_P);
    const float* GATES = (const float*)(A.ws + WS_GATES);
    u32x4* CST = (u32x4*)(A.ws + WS_CST); float* NST = (float*)(A.ws + WS_NST); float* MCg = (float*)(A.ws + WS_MC);
    LAS float* sm = (LAS float*)(lds + ML_SM);
    LAS float* cw = (LAS float*)(lds + ML_CW);
    LAS unsigned char* Ks = lds + ML_K; LAS unsigned char* Vs = lds + ML_V;
    const size_t rowbase = (size_t)b * SEQ; const int bh = b * 4 + h;
    for (int i = tid; i < 640; i += 512) { const int j = i >> 7, ch = i & 127, cch = 512 + h * 128 + ch; cw[i] = (j < 4) ? A.conv_w[j * 1024 + cch] : A.conv_b[cch]; }
    if (tid < 128) sm[SM_N + tid] = 0.f;
    const int rg = tid >> 4, cs = tid & 15;
    const int ccol = 512 + h * 128 + 8 * cs;
    const int srow = tid >> 3, sseg = tid & 7;
    u32x4 cr[5], vr0, vr1; float gi = 0.f, gf = 0.f;
#define MS_PREFETCH(c) do { const int _r0 = (c) * 64 + 2 * rg - 3; \
        _Pragma("unroll") for (int _i = 0; _i < 5; ++_i) { const int _r = _r0 + _i; const u32x4 _v = *(const u32x4*)(P + (rowbase + (_r >= 0 ? _r : 0)) * NP + ccol); cr[_i] = (_r >= 0) ? _v : (u32x4){0u, 0u, 0u, 0u}; } \
        const bf16_t* _vp = P + (rowbase + (c) * 64 + srow) * NP + 1024 + h * 128 + sseg * 16; \
        vr0 = *(const u32x4*)(_vp); vr1 = *(const u32x4*)(_vp + 8); \
        } while (0)
    MS_PREFETCH(0);
    LAS float* Eall = (LAS float*)(lds + ML_Q);
#pragma unroll
    for (int cc = 0; cc < 4; ++cc) { const int c = w + 8 * cc;
        const float* gp = GATES + (rowbase + c * 64 + lane) * 8 + h; gi = gp[0]; gf = gp[4];
        float bc = gf;
#pragma unroll
        for (int o = 1; o < 64; o <<= 1) { const float t = __shfl_up(bc, o); if (lane >= o) bc += t; }
        const float e = gi - bc; float cm = e;
#pragma unroll
        for (int o = 1; o < 64; o <<= 1) { const float t = __shfl_up(cm, o); if (lane >= o) cm = fmaxf(cm, t); }
        Eall[c * 64 + lane] = e;
        if (lane == 63) { Eall[2048 + c] = bc; Eall[2048 + 32 + c] = cm; } }
    f32x4 C[8];
#pragma unroll
    for (int kt = 0; kt < 8; ++kt) C[kt] = (f32x4){0.f, 0.f, 0.f, 0.f};
    float mc = 0.f;
    __syncthreads();
    for (int c = 0; c < 32; ++c) {
        {
            float wt[5][8];
#pragma unroll
            for (int j = 0; j < 5; ++j) { const f32x4 a = *(const LAS f32x4*)(cw + j * 128 + 8 * cs), bb = *(const LAS f32x4*)(cw + j * 128 + 8 * cs + 4);
                wt[j][0] = a[0]; wt[j][1] = a[1]; wt[j][2] = a[2]; wt[j][3] = a[3]; wt[j][4] = bb[0]; wt[j][5] = bb[1]; wt[j][6] = bb[2]; wt[j][7] = bb[3]; }
            LAS unsigned char* dst = Ks + (2 * rg) * MQ_STRIDE + 16 * cs;
#pragma unroll
            for (int r = 0; r < 2; ++r) {
                float ov[8];
#pragma unroll
                for (int e = 0; e < 8; ++e) ov[e] = wt[4][e];
#pragma unroll
                for (int j = 0; j < 4; ++j) { const u32x4 x = cr[r + j];
                    ov[0] += wt[j][0] * bflo(x.x); ov[1] += wt[j][1] * bfhi(x.x); ov[2] += wt[j][2] * bflo(x.y); ov[3] += wt[j][3] * bfhi(x.y);
                    ov[4] += wt[j][4] * bflo(x.z); ov[5] += wt[j][5] * bfhi(x.z); ov[6] += wt[j][6] * bflo(x.w); ov[7] += wt[j][7] * bfhi(x.w); }
#pragma unroll
                for (int e = 0; e < 8; ++e) ov[e] = 0.08838834764831845f * ov[e] * __builtin_amdgcn_rcpf(1.f + __expf(-ov[e]));
                u32x4 o4; o4.x = pk2(ov[0], ov[1]); o4.y = pk2(ov[2], ov[3]); o4.z = pk2(ov[4], ov[5]); o4.w = pk2(ov[6], ov[7]);
                *(LAS u32x4*)(dst + r * MQ_STRIDE) = o4;
            }
            LAS unsigned char* vd = Vs + srow * MV_STRIDE + sseg * 32; *(LAS u32x4*)vd = vr0; *(LAS u32x4*)(vd + 16) = vr1;
            if (w == 0) {
                const float g63 = fmaxf(mc, Eall[2048 + 32 + c]);
                sm[SM_W + lane] = __expf(Eall[c * 64 + lane] - g63);
                if (lane == 63) { sm[SM_X] = __expf(mc - g63); sm[SM_X + 1] = Eall[2048 + c] + g63; }
            }
        }
        __syncthreads();
        { const int cn = (c + 1 < 32) ? c + 1 : 31; MS_PREFETCH(cn); }
        {
            const int item = bh * 32 + c;
#pragma unroll
            for (int k2 = 0; k2 < 4; ++k2) CST[((size_t)(item * 8 + w) * 4 + k2) * 64 + lane] = __builtin_bit_cast(u32x4, pack8(C[2 * k2], C[2 * k2 + 1]));
            if (tid < 128) NST[item * 128 + tid] = sm[SM_N + tid];
            if (tid == 0) MCg[item] = mc;
            LAS float* wS = sm + SM_W;
            const float decay = sm[SM_X];
            bf16x8 vfw[2];
#pragma unroll
            for (int ks = 0; ks < 2; ++ks) {
                LAS unsigned char* a0 = Vs + (32 * ks + 8 * g + (l15 >> 2)) * MV_STRIDE + (16 * w + 4 * (lane & 3)) * 2;
                const bf16x8 vf = cat8(vtr(a0), vtr(a0 + 4 * MV_STRIDE));
                const f32x4 w0 = *(const LAS f32x4*)(wS + 32 * ks + 8 * g), w1 = *(const LAS f32x4*)(wS + 32 * ks + 8 * g + 4);
                const u32x4 vu = __builtin_bit_cast(u32x4, vf);
                u32x4 o4; o4.x = pk2(bflo(vu.x) * w0[0], bfhi(vu.x) * w0[1]); o4.y = pk2(bflo(vu.y) * w0[2], bfhi(vu.y) * w0[3]);
                o4.z = pk2(bflo(vu.z) * w1[0], bfhi(vu.z) * w1[1]); o4.w = pk2(bflo(vu.w) * w1[2], bfhi(vu.w) * w1[3]);
                vfw[ks] = __builtin_bit_cast(bf16x8, o4);
            }
#pragma unroll
            for (int kt = 0; kt < 8; ++kt) C[kt] = C[kt] * decay;
#pragma unroll
            for (int ks = 0; ks < 2; ++ks)
#pragma unroll
                for (int kt = 0; kt < 8; ++kt) { LAS unsigned char* a0 = Ks + (32 * ks + 8 * g + (l15 >> 2)) * MQ_STRIDE + (16 * kt + 4 * (lane & 3)) * 2;
                    const bf16x8 ka = cat8(vtr(a0), vtr(a0 + 4 * MQ_STRIDE)); C[kt] = MFMA16(ka, vfw[ks], C[kt]); }
            { const int kd = tid & 127, sq = tid >> 7; float s = 0.f;
#pragma unroll
              for (int i = 0; i < 16; ++i) { const int s_ = 16 * sq + i; s += wS[s_] * __uint_as_float((unsigned)(*(const LAS bf16_t*)(Ks + s_ * MQ_STRIDE + kd * 2)) << 16); }
              sm[SM_NP + sq * 128 + kd] = s; }
            mc = sm[SM_X + 1];
            __syncthreads();
            if (tid < 128) sm[SM_N + tid] = decay * sm[SM_N + tid] + ((sm[SM_NP + tid] + sm[SM_NP + 128 + tid]) + (sm[SM_NP + 256 + tid] + sm[SM_NP + 384 + tid]));
        }
    }
#undef MS_PREFETCH
    __syncthreads();
}

__device__ __forceinline__ void mlstm_out(const Args& A, LAS unsigned char* lds, int item, int& last_h) {
    int tid_o = threadIdx.x; asm volatile("" : "+v"(tid_o)); const int tid = tid_o, lane = tid & 63, w = tid >> 6, g = lane >> 4, l15 = lane & 15;
    const int bh = item >> 5, c = item & 31, b = bh >> 2, h = bh & 3;
    const bf16_t* P = (const bf16_t*)(A.ws + WS_P);
    bf16_t* ACT = (bf16_t*)(A.ws + WS_ACT);
    const float* GATES = (const float*)(A.ws + WS_GATES);
    const u32x4* CST = (const u32x4*)(A.ws + WS_CST); const float* NST = (const float*)(A.ws + WS_NST); const float* MCg = (const float*)(A.ws + WS_MC);
    LAS float* sm = (LAS float*)(lds + ML_SM);
    LAS float* cw = (LAS float*)(lds + ML_CW);
    LAS unsigned char* Qs = lds + ML_Q; LAS unsigned char* Ks = lds + ML_K; LAS unsigned char* Vs = lds + ML_V; LAS unsigned char* Ps = lds + ML_P;
    LAS float* Hn = (LAS float*)(lds + ML_H);
    LAS float* eS = sm + SM_E; LAS float* gS = sm + SM_G; LAS float* bS = sm + SM_B; LAS float* iS = sm + SM_I; LAS float* nS = sm + SM_N;
    const size_t rowbase = (size_t)b * SEQ;
    const int rg = tid >> 5, cs = tid & 31;
    const int ccol = (cs < 16 ? 0 : 512) + h * 128 + 8 * (cs & 15);
    const int srow = tid >> 3, sseg = tid & 7;
    u32x4 cr[7], vr0, vr1, mc0, mc1, cfr[4]; float gi = 0.f, gf = 0.f, nval = 0.f;
    { const int r0 = c * 64 + 4 * rg - 3;
#pragma unroll
      for (int i = 0; i < 7; ++i) { const int r = r0 + i; const u32x4 v_ = *(const u32x4*)(P + (rowbase + (r >= 0 ? r : 0)) * NP + ccol); cr[i] = (r >= 0) ? v_ : (u32x4){0u, 0u, 0u, 0u}; }
      const bf16_t* vp = P + (rowbase + c * 64 + srow) * NP + h * 128 + sseg * 16;
      vr0 = *(const u32x4*)(vp + 1024); vr1 = *(const u32x4*)(vp + 1032); mc0 = *(const u32x4*)(vp + 1536); mc1 = *(const u32x4*)(vp + 1544);
      if (w == 0) { const float* gp = GATES + (rowbase + c * 64 + lane) * 8 + h; gi = gp[0]; gf = gp[4]; }
#pragma unroll
      for (int k2 = 0; k2 < 4; ++k2) cfr[k2] = CST[((size_t)(item * 8 + w) * 4 + k2) * 64 + lane];
      if (tid < 128) nval = NST[item * 128 + tid]; }
    const float mc = MCg[item];
    if (h != last_h) {
        for (int i = tid; i < 1280; i += 512) { const int j = i >> 8, ch = i & 255, cch = (ch < 128 ? h * 128 + ch : 512 + h * 128 + ch - 128);
            cw[i] = (j < 4) ? A.conv_w[j * 1024 + cch] : A.conv_b[cch]; }
        last_h = h;
        __syncthreads();
    }
    {
        float wt[5][8];
#pragma unroll
        for (int j = 0; j < 5; ++j) { const f32x4 a = *(const LAS f32x4*)(cw + j * 256 + 8 * cs), bb = *(const LAS f32x4*)(cw + j * 256 + 8 * cs + 4);
            wt[j][0] = a[0]; wt[j][1] = a[1]; wt[j][2] = a[2]; wt[j][3] = a[3]; wt[j][4] = bb[0]; wt[j][5] = bb[1]; wt[j][6] = bb[2]; wt[j][7] = bb[3]; }
        const float osc = (cs < 16) ? 1.0f : 0.08838834764831845f;
        LAS unsigned char* dst = (cs < 16 ? Qs : Ks) + (4 * rg) * MQ_STRIDE + 16 * (cs & 15);
#pragma unroll
        for (int r = 0; r < 4; ++r) {
            float ov[8];
#pragma unroll
            for (int e = 0; e < 8; ++e) ov[e] = wt[4][e];
#pragma unroll
            for (int j = 0; j < 4; ++j) { const u32x4 x = cr[r + j];
                ov[0] += wt[j][0] * bflo(x.x); ov[1] += wt[j][1] * bfhi(x.x); ov[2] += wt[j][2] * bflo(x.y); ov[3] += wt[j][3] * bfhi(x.y);
                ov[4] += wt[j][4] * bflo(x.z); ov[5] += wt[j][5] * bfhi(x.z); ov[6] += wt[j][6] * bflo(x.w); ov[7] += wt[j][7] * bfhi(x.w); }
#pragma unroll
            for (int e = 0; e < 8; ++e) ov[e] = osc * ov[e] * __builtin_amdgcn_rcpf(1.f + __expf(-ov[e]));
            u32x4 o4; o4.x = pk2(ov[0], ov[1]); o4.y = pk2(ov[2], ov[3]); o4.z = pk2(ov[4], ov[5]); o4.w = pk2(ov[6], ov[7]);
            *(LAS u32x4*)(dst + r * MQ_STRIDE) = o4;
        }
        LAS unsigned char* vd = Vs + srow * MV_STRIDE + sseg * 32; *(LAS u32x4*)vd = vr0; *(LAS u32x4*)(vd + 16) = vr1;
        if (tid < 128) nS[tid] = nval;
        if (w == 0) {
            float bc = gf;
#pragma unroll
            for (int o = 1; o < 64; o <<= 1) { const float t = __shfl_up(bc, o); if (lane >= o) bc += t; }
            const float e = gi - bc; float cm = e;
#pragma unroll
            for (int o = 1; o < 64; o <<= 1) { const float t = __shfl_up(cm, o); if (lane >= o) cm = fmaxf(cm, t); }
            const float gt = fmaxf(mc, cm);
            eS[lane] = e; gS[lane] = gt; bS[lane] = bc; iS[lane] = __expf(mc - gt);
        }
    }
    __syncthreads();
    {
        const int st = w >> 1;
#pragma unroll
        for (int ti = 0; ti < 2; ++ti) { const int tt = 2 * (w & 1) + ti;
            f32x4 a = (f32x4){0.f, 0.f, 0.f, 0.f};
#pragma unroll
            for (int ks = 0; ks < 4; ++ks) { const bf16x8 kf = *(const LAS bf16x8*)(Ks + (16 * st + l15) * MQ_STRIDE + (32 * ks + 8 * g) * 2);
                const bf16x8 qf = *(const LAS bf16x8*)(Qs + (16 * tt + l15) * MQ_STRIDE + (32 * ks + 8 * g) * 2); a = MFMA16(kf, qf, a); }
            const int t = 16 * tt + l15; const float gt = gS[t];
            float pv[4];
#pragma unroll
            for (int r = 0; r < 4; ++r) { const int s_ = 16 * st + 4 * g + r; pv[r] = (s_ <= t) ? a[r] * __expf(eS[s_] - gt) : 0.f; }
            u32x2 pw; pw.x = pk2(pv[0], pv[1]); pw.y = pk2(pv[2], pv[3]);
            *(LAS u32x2*)(Ps + t * MP_STRIDE + (16 * st + 4 * g) * 2) = pw;
        }
    }
    __syncthreads();
    {
        f32x4 apv[4], aqc[4];
#pragma unroll
        for (int tt = 0; tt < 4; ++tt) { apv[tt] = (f32x4){0.f, 0.f, 0.f, 0.f}; aqc[tt] = (f32x4){0.f, 0.f, 0.f, 0.f}; }
#pragma unroll
        for (int ks = 0; ks < 2; ++ks) {
            LAS unsigned char* a0 = Vs + (32 * ks + 8 * g + (l15 >> 2)) * MV_STRIDE + (16 * w + 4 * (lane & 3)) * 2;
            const bf16x8 vf = cat8(vtr(a0), vtr(a0 + 4 * MV_STRIDE));
#pragma unroll
            for (int tt = 0; tt < 4; ++tt) { const bf16x8 pf = *(const LAS bf16x8*)(Ps + (16 * tt + l15) * MP_STRIDE + (32 * ks + 8 * g) * 2); apv[tt] = MFMA16(pf, vf, apv[tt]); }
        }
#pragma unroll
        for (int k2 = 0; k2 < 4; ++k2) {
            const bf16x8 cf = __builtin_bit_cast(bf16x8, cfr[k2]);
#pragma unroll
            for (int tt = 0; tt < 4; ++tt) { LAS unsigned char* qa = Qs + (16 * tt + l15) * MQ_STRIDE + (32 * k2 + 4 * g) * 2;
                const bf16x8 qf = cat8(*(const LAS s16x4*)qa, *(const LAS s16x4*)(qa + 32)); aqc[tt] = MFMA16(qf, cf, aqc[tt]); }
        }
#pragma unroll
        for (int tt = 0; tt < 4; ++tt)
#pragma unroll
            for (int r = 0; r < 4; ++r) { const int t = 16 * tt + 4 * g + r; Hn[t * MH_STRIDE + 16 * w + l15] = apv[tt][r] + iS[t] * aqc[tt][r]; }
        { const int t = srow, j = sseg;
          const u32x4 pr = *(const LAS u32x4*)(Ps + t * MP_STRIDE + 16 * j);
          float rs = (bflo(pr.x) + bfhi(pr.x)) + (bflo(pr.y) + bfhi(pr.y)) + (bflo(pr.z) + bfhi(pr.z)) + (bflo(pr.w) + bfhi(pr.w));
          const u32x4 q0 = *(const LAS u32x4*)(Qs + t * MQ_STRIDE + 32 * j), q1 = *(const LAS u32x4*)(Qs + t * MQ_STRIDE + 32 * j + 16);
          const f32x4 n0 = *(const LAS f32x4*)(nS + 16 * j), n1 = *(const LAS f32x4*)(nS + 16 * j + 4), n2 = *(const LAS f32x4*)(nS + 16 * j + 8), n3 = *(const LAS f32x4*)(nS + 16 * j + 12);
          float qn = bflo(q0.x) * n0[0] + bfhi(q0.x) * n0[1] + bflo(q0.y) * n0[2] + bfhi(q0.y) * n0[3] + bflo(q0.z) * n1[0] + bfhi(q0.z) * n1[1] + bflo(q0.w) * n1[2] + bfhi(q0.w) * n1[3]
                   + bflo(q1.x) * n2[0] + bfhi(q1.x) * n2[1] + bflo(q1.y) * n2[2] + bfhi(q1.y) * n2[3] + bflo(q1.z) * n3[0] + bfhi(q1.z) * n3[1] + bflo(q1.w) * n3[2] + bfhi(q1.w) * n3[3];
          float d = rs + iS[t] * qn;
          d += __shfl_xor(d, 1); d += __shfl_xor(d, 2); d += __shfl_xor(d, 4);
          if (j == 0) { const float fl = __expf(-(bS[t] + gS[t])); sm[SM_R + t] = 1.f / fmaxf(fabsf(d), fl); } }
    }
    __syncthreads();
    {
        const int t = srow, j = sseg; const float rd = sm[SM_R + t];
        float hv[16]; float ss = 0.f;
#pragma unroll
        for (int q = 0; q < 4; ++q) { const f32x4 x = *(const LAS f32x4*)(Hn + t * MH_STRIDE + 16 * j + 4 * q);
#pragma unroll
            for (int e = 0; e < 4; ++e) { const float v = x[e] * rd; hv[4 * q + e] = v; ss += v * v; } }
        ss += __shfl_xor(ss, 1); ss += __shfl_xor(ss, 2); ss += __shfl_xor(ss, 4);
        const float rstd = rsqrtf(ss * (1.f / 128.f) + 1e-6f);
        const unsigned mo[8] = {mc0.x, mc0.y, mc0.z, mc0.w, mc1.x, mc1.y, mc1.z, mc1.w};
        unsigned ow[8];
#pragma unroll
        for (int q = 0; q < 8; ++q) { const float g0 = A.mnorm_g[h * 128 + 16 * j + 2 * q], g1 = A.mnorm_g[h * 128 + 16 * j + 2 * q + 1];
            const float z0 = bflo(mo[q]), z1 = bfhi(mo[q]);
            ow[q] = pk2(hv[2 * q] * rstd * g0 * __builtin_amdgcn_rcpf(1.f + __expf(-z0)), hv[2 * q + 1] * rstd * g1 * __builtin_amdgcn_rcpf(1.f + __expf(-z1))); }
        bf16_t* op = ACT + (rowbase + c * 64 + t) * 1024 + h * 128 + 16 * j;
        *(u32x4*)op = (u32x4){ow[0], ow[1], ow[2], ow[3]}; *(u32x4*)(op + 8) = (u32x4){ow[4], ow[5], ow[6], ow[7]};
    }
}

__device__ __forceinline__ void phase3(const Args& A, LAS unsigned char* lds, int rep = 0) {
    const int tid = threadIdx.x;
    const float lam = ((const float*)(A.ws + WS_CTL))[1];
    unsigned* ctr = (unsigned*)(A.ws + WS_CTL) + 2 * rep;
    LAS int* slot = (LAS int*)(lds + LDS_BYTES - 64);
    {
        const int lane = tid & 63, wave = tid >> 6;
        const bf16_t* WT = (const bf16_t*)(A.ws + WS_WQ); const float* MOD = (const float*)(A.ws + WS_MOD); float* SB = (float*)(A.ws + WS_SB);
        for (int n = blockIdx.x * 8 + wave; n < 2048; n += gridDim.x * 8) {
            const u32x4 w0 = *(const u32x4*)(WT + (size_t)n * 1024 + 16 * lane), w1 = *(const u32x4*)(WT + (size_t)n * 1024 + 16 * lane + 8);
            const unsigned ww[8] = {w0.x, w0.y, w0.z, w0.w, w1.x, w1.y, w1.z, w1.w};
            float sbv[8];
#pragma unroll
            for (int b = 0; b < 8; ++b) { const float* sp = MOD + b * 6144 + 3072 + 16 * lane; float d = 0.f;
#pragma unroll
                for (int q = 0; q < 4; ++q) { const f32x4 s4 = *(const f32x4*)(sp + 4 * q); d += bflo(ww[2 * q]) * s4[0] + bfhi(ww[2 * q]) * s4[1] + bflo(ww[2 * q + 1]) * s4[2] + bfhi(ww[2 * q + 1]) * s4[3]; }
                sbv[b] = wave_sum(d); }
            if (lane == 0) {
#pragma unroll
                for (int b = 0; b < 8; ++b) SB[b * 2048 + n] = sbv[b]; }
        }
    }
    const int nml = ((int)gridDim.x > 64) ? 32 : 1;
    if ((int)blockIdx.x < nml) for (int bh = blockIdx.x; bh < 32; bh += nml) mlstm_state(A, lds, bh >> 2, bh & 3);
    for (;;) {
        if (tid == 0) slot[0] = (int)atomicAdd(ctr, 1u);
        __syncthreads();
        const int it = slot[0];
        __syncthreads();
        if (it >= 512) break;
        attn_item(A, lds, (it & 31) >> 2, it & 3, 15 - (it >> 5), lam);
    }
}
__device__ __forceinline__ void phase3b(const Args& A, LAS unsigned char* lds) {
    int last_h = -1;
    for (int item = blockIdx.x; item < 1024; item += gridDim.x) mlstm_out(A, lds, item, last_h);
    __syncthreads();
}

__device__ __forceinline__ void phase5(const Args& A) {
    int tid_o = threadIdx.x; asm volatile("" : "+v"(tid_o)); const int tid = tid_o, lane = tid & 63, wave = tid >> 6, G = gridDim.x;
    const float* MOD = (const float*)(A.ws + WS_MOD);
    bf16_t* ACT = (bf16_t*)(A.ws + WS_ACT);
    for (int m = blockIdx.x * 8 + wave; m < T; m += G * 8) {
        const int b = m >> 11;
        const f32x4* xr = (const f32x4*)(A.out + (size_t)m * 1024) + lane;
        f32x4 v[4]; float ss = 0.f;
#pragma unroll
        for (int j = 0; j < 4; ++j) { v[j] = xr[64 * j]; ss += (v[j][0] * v[j][0] + v[j][1] * v[j][1]) + (v[j][2] * v[j][2] + v[j][3] * v[j][3]); }
        const float rstd = rsqrtf(wave_sum(ss) * (1.f / 1024.f) + 1e-6f);
        unsigned long long* o8 = (unsigned long long*)(ACT + (size_t)m * 1024) + lane;
#pragma unroll
        for (int j = 0; j < 4; ++j) { const int col = 4 * lane + 256 * j;
            const f32x4 g = *(const f32x4*)(A.norm2_g + col), sc = *(const f32x4*)(MOD + b * 6144 + 4096 + col), sh = *(const f32x4*)(MOD + b * 6144 + 3072 + col);
            v[j] = v[j] * rstd * g * (sc + 1.0f) + sh;
            o8[64 * j] = (unsigned long long)pk2(v[j][0], v[j][1]) | ((unsigned long long)pk2(v[j][2], v[j][3]) << 32); }
    }
}

__device__ __forceinline__ unsigned f2key(float f) { const unsigned u = __float_as_uint(f); return (u & 0x80000000u) ? ~u : (u | 0x80000000u); }
__device__ __forceinline__ float key2f(unsigned k) { const unsigned u = (k & 0x80000000u) ? (k & 0x7fffffffu) : ~k; return __uint_as_float(u); }
#define CE_DESC(a, b) do { const unsigned _mx = (a) > (b) ? (a) : (b), _mn = (a) > (b) ? (b) : (a); (a) = _mx; (b) = _mn; } while (0)
__device__ __forceinline__ void sort16_desc(unsigned (&k)[16]) {
#pragma unroll
    for (int size = 2; size <= 16; size <<= 1)
#pragma unroll
        for (int stride = size >> 1; stride > 0; stride >>= 1)
#pragma unroll
            for (int i = 0; i < 16; ++i) { const int j = i ^ stride;
                if (j > i) { if ((i & size) == 0) CE_DESC(k[i], k[j]); else CE_DESC(k[j], k[i]); } }
}
__device__ __forceinline__ void merge16(unsigned (&a)[16], const unsigned (&b)[16]) {
#pragma unroll
    for (int i = 0; i < 16; ++i) a[i] = a[i] > b[15 - i] ? a[i] : b[15 - i];
#pragma unroll
    for (int stride = 8; stride > 0; stride >>= 1)
#pragma unroll
        for (int i = 0; i < 16; ++i) { const int j = i ^ stride; if (j > i) CE_DESC(a[i], a[j]); }
}
constexpr int PE_IDX = 0, PE_SEL = 69632;
__device__ __forceinline__ float gelu_erf(float v) { return 0.5f * v * (1.f + erff(v * 0.70710678118654752f)); }
__device__ __forceinline__ float gelu_fast(float v) {
    const float av = fabsf(v), tt = __builtin_amdgcn_rcpf(av * 0.2316418882f + 1.0f);
    float q = tt * 0.5307027145f + (-0.7265760135f); q = q * tt + 0.7107068705f; q = q * tt + (-0.142248368f); q = q * tt + 0.127414796f; q = q * tt;
    const float e = __builtin_amdgcn_exp2f((v * v) * (-0.72134752044f));
    const float m = v * (q * e);
    return v < 0.f ? m : v - m;
}

__device__ __forceinline__ void peer_tile(const Args& A, LAS unsigned char* lds, int tile) {
    int tid_o = threadIdx.x; asm volatile("" : "+v"(tid_o)); const int tid = tid_o, lane = tid & 63, w = tid >> 6, g = lane >> 4, l15 = lane & 15;
    const bf16_t* QRY = (const bf16_t*)(A.ws + WS_QRY);
    const bf16_t* KEYS = (const bf16_t*)(A.ws + WS_KEYS);
    const bf16_t* ACT = (const bf16_t*)(A.ws + WS_ACT);
    const float* MOD = (const float*)(A.ws + WS_MOD);
    LAS unsigned* idx = (LAS unsigned*)(lds + PE_IDX) + (w * 64 + lane) * 33;
    LAS u32x2* SEL = (LAS u32x2*)(lds + PE_SEL);
    {
        const int tg = w & 3, hg = w >> 2, tl = 16 * tg + l15;
        const size_t m = (size_t)tile * 64 + tl;
        for (int hh = 0; hh < 4; ++hh) {
            const int h = 4 * hg + hh;
            unsigned L2[2][16];
#pragma unroll
            for (int p = 0; p < 2; ++p) {
                const int hp = 2 * h + p;
                unsigned k0[16], k1[16];
                { const bf16_t* sp = QRY + m * 2048 + hp * 128 + 32 * g;
                  const u32x4 s0 = *(const u32x4*)sp, s1 = *(const u32x4*)(sp + 8), s2 = *(const u32x4*)(sp + 16), s3 = *(const u32x4*)(sp + 24);
                  const unsigned sw[16] = {s0.x, s0.y, s0.z, s0.w, s1.x, s1.y, s1.z, s1.w, s2.x, s2.y, s2.z, s2.w, s3.x, s3.y, s3.z, s3.w};
#pragma unroll
                  for (int i = 0; i < 16; ++i) {
                      const float lo = (float)__builtin_bit_cast(_Float16, (unsigned short)(sw[i] & 0xffffu)), hi = (float)__builtin_bit_cast(_Float16, (unsigned short)(sw[i] >> 16));
                      const unsigned klo = (f2key(lo) & ~127u) | (unsigned)(127 - (32 * g + 2 * i)), khi = (f2key(hi) & ~127u) | (unsigned)(127 - (32 * g + 2 * i + 1));
                      if (i < 8) { k0[2 * i] = klo; k0[2 * i + 1] = khi; } else { k1[2 * (i - 8)] = klo; k1[2 * (i - 8) + 1] = khi; } } }
                sort16_desc(k0); sort16_desc(k1); merge16(k0, k1);
#pragma unroll
                for (int msk = 16; msk <= 32; msk <<= 1) {
#pragma unroll
                    for (int i = 0; i < 16; ++i) k1[i] = (unsigned)__shfl_xor((int)k0[i], msk);
                    merge16(k0, k1); }
#pragma unroll
                for (int i = 0; i < 16; ++i) L2[p][i] = k0[i];
            }
            float va[16], vb[16];
#pragma unroll
            for (int i = 0; i < 16; ++i) { va[i] = key2f(L2[0][i] & ~127u); vb[i] = key2f(L2[1][i] & ~127u); idx[i] = 127u - (L2[0][i] & 127u); idx[16 + i] = 127u - (L2[1][i] & 127u); }
#define CK(i, j) ((f2key(va[i] + vb[j]) & ~255u) | (unsigned)(255 - (16 * (i) + (j))))
            unsigned Lf[16], Bt[16];
#pragma unroll
            for (int j = 0; j < 16; ++j) Lf[j] = CK(0, j);
#pragma unroll
            for (int j = 0; j < 8; ++j) Bt[j] = CK(1, j);
#pragma unroll
            for (int j = 0; j < 5; ++j) Bt[8 + j] = CK(2, j);
#pragma unroll
            for (int j = 0; j < 3; ++j) Bt[13 + j] = CK(4, j);
            sort16_desc(Bt); merge16(Lf, Bt);
#pragma unroll
            for (int j = 0; j < 4; ++j) Bt[j] = CK(3, j);
            Bt[4] = CK(5, 0); Bt[5] = CK(5, 1); Bt[6] = CK(6, 0); Bt[7] = CK(6, 1); Bt[8] = CK(7, 0); Bt[9] = CK(7, 1);
            Bt[10] = CK(8, 0); Bt[11] = CK(9, 0); Bt[12] = CK(10, 0); Bt[13] = CK(11, 0); Bt[14] = CK(12, 0); Bt[15] = CK(13, 0);
            sort16_desc(Bt); merge16(Lf, Bt);
            { unsigned x0 = CK(14, 0), x1 = CK(15, 0);
#pragma unroll
              for (int i = 0; i < 16; ++i) CE_DESC(Lf[i], x0);
#pragma unroll
              for (int i = 0; i < 16; ++i) CE_DESC(Lf[i], x1); }
#undef CK
            float fv[16], den = 0.f; const float f0 = key2f(Lf[0] & ~255u);
#pragma unroll
            for (int k = 0; k < 16; ++k) { fv[k] = __expf(key2f(Lf[k] & ~255u) - f0); den += fv[k]; }
            const float rden = 1.f / den;
            LDS_WAIT();
            if (g == 0) {
#pragma unroll
                for (int k = 0; k < 16; ++k) { const unsigned code = 255u - (Lf[k] & 255u); const unsigned e = idx[code >> 4] * 128u + idx[16 + (code & 15u)];
                    u32x2 sv; sv.x = e; sv.y = __float_as_uint(fv[k] * rden); SEL[(tl * 8 + h) * 16 + k] = sv; }
            }
        }
    }
    __syncthreads();
    const unsigned char* T8 = A.ws + WS_T8; const float* SC = (const float*)(A.ws + WS_SC);
    LAS u32x2* SORT = (LAS u32x2*)(lds + PE_IDX);
    LAS int* OFFS = (LAS int*)(lds + PE_SEL + 65536);
    for (int ti = 0; ti < 8; ++ti) {
        const int tl = 8 * w + ti;
        const u32x2 e0 = SEL[tl * 128 + lane], e1 = SEL[tl * 128 + 64 + lane];
        const int p0 = (int)(e0.x >> 10), p1 = (int)(e1.x >> 10);
        int off = 0;
        for (int p = 0; p < 16; ++p) {
            const unsigned long long m0 = __ballot(p0 == p), m1 = __ballot(p1 == p);
            const int c0 = __popcll(m0), c1 = __popcll(m1);
            const int r0 = __builtin_amdgcn_mbcnt_hi((unsigned)(m0 >> 32), __builtin_amdgcn_mbcnt_lo((unsigned)m0, 0u));
            const int r1 = __builtin_amdgcn_mbcnt_hi((unsigned)(m1 >> 32), __builtin_amdgcn_mbcnt_lo((unsigned)m1, 0u));
            if (p0 == p) SORT[tl * 128 + off + r0] = e0;
            if (p1 == p) SORT[tl * 128 + off + c0 + r1] = e1;
            if (lane == 0) OFFS[tl * 17 + p] = off;
            off += c0 + c1;
        }
        if (lane == 0) OFFS[tl * 17 + 16] = off;
    }
    LDS_WAIT(); __builtin_amdgcn_wave_barrier();
    const unsigned char* T8v = T8 + (size_t)16384 * 1024;
    const bf16_t* A3 = (const bf16_t*)(A.ws + WS_A3); const float* RSq = (const float*)(A.ws + WS_RS);
    for (int pass = 0; pass < 2; ++pass) {
        const int tb = 8 * w + 4 * pass;
        u32x4 xpa[4], xpb[4]; f32x2 oacc[4][8];
#pragma unroll
        for (int tk = 0; tk < 4; ++tk) { const size_t m = (size_t)tile * 64 + tb + tk;
            { const u32x4 ra = *(const u32x4*)(A3 + m * 1024 + 16 * lane), rb = *(const u32x4*)(A3 + m * 1024 + 16 * lane + 8);
              float xr_; { const f32x4 p0 = *(const f32x4*)(RSq + m * 16), p1 = *(const f32x4*)(RSq + m * 16 + 4), p2 = *(const f32x4*)(RSq + m * 16 + 8), p3 = *(const f32x4*)(RSq + m * 16 + 12);
                const f32x4 ps = (p0 + p1) + (p2 + p3); xr_ = rsqrtf(((ps[0] + ps[1]) + (ps[2] + ps[3])) * (1.f / 1024.f) + 1e-6f); }
              const unsigned rr[8] = {ra.x, ra.y, ra.z, ra.w, rb.x, rb.y, rb.z, rb.w}; unsigned hh[8];
              const float* sp = MOD + (int)(m >> 11) * 6144 + 3072 + 16 * lane;
#pragma unroll
              for (int q = 0; q < 8; ++q) { const f32x2 sh = *(const f32x2*)(sp + 2 * q); hh[q] = pk2(bflo(rr[q]) * xr_ + sh[0], bfhi(rr[q]) * xr_ + sh[1]); }
              xpa[tk] = (u32x4){hh[0], hh[1], hh[2], hh[3]}; xpb[tk] = (u32x4){hh[4], hh[5], hh[6], hh[7]}; }
#pragma unroll
            for (int q = 0; q < 8; ++q) oacc[tk][q] = (f32x2){0.f, 0.f}; }
        int it_p = 0, it_tk = -1, it_j = 0, it_end = 0; bool it_done = false;
#define IT_ADVANCE() do { it_j += 4; while (it_j >= it_end) { if (it_done) break; ++it_tk; if (it_tk == 4) { it_tk = 0; ++it_p; if (it_p == 16) { it_done = true; it_p = 15; it_j = 0; it_end = 1; break; } } \
            it_j = __builtin_amdgcn_readfirstlane(OFFS[(tb + it_tk) * 17 + it_p]); it_end = __builtin_amdgcn_readfirstlane(OFFS[(tb + it_tk) * 17 + it_p + 1]); } } while (0)
#define LOAD_SET(U, V, CG, SU, SV) do { const int _tl = tb + it_tk; \
            _Pragma("unroll") for (int _k = 0; _k < 4; ++_k) { const int _jj = (it_j + _k < it_end) ? it_j + _k : it_end - 1; const unsigned _e = SORT[_tl * 128 + _jj].x; \
                U[_k] = *(const u32x4*)(T8 + (size_t)_e * 1024 + 16 * lane); V[_k] = *(const u32x4*)(T8v + (size_t)_e * 1024 + 16 * lane); } \
            const int _ms = lane >> 4; const bool _valid = it_j + _ms < it_end; const u32x2 _se = SORT[_tl * 128 + (_valid ? it_j + _ms : it_end - 1)]; \
            CG = _valid ? __uint_as_float(_se.y) : 0.f; SU = SC[_se.x]; SV = SC[16384 + _se.x]; } while (0)
        u32x4 uA[4], vA[4], uB[4], vB[4]; float cgA = 0.f, suA = 0.f, svA = 0.f, cgB = 0.f, suB = 0.f, svB = 0.f;
#pragma unroll
        for (int k = 0; k < 4; ++k) { uA[k] = (u32x4){0u, 0u, 0u, 0u}; vA[k] = uA[k]; uB[k] = uA[k]; vB[k] = uA[k]; }
        IT_ADVANCE();
        LOAD_SET(uA, vA, cgA, suA, svA);
        for (int p = 0; p < 16; ++p) {
#pragma unroll
            for (int tk = 0; tk < 4; ++tk) {
                const int tl = tb + tk;
                const int beg = __builtin_amdgcn_readfirstlane(OFFS[tl * 17 + p]), end = __builtin_amdgcn_readfirstlane(OFFS[tl * 17 + p + 1]);
                f32x2 xf[8];
                { const unsigned xx[8] = {xpa[tk].x, xpa[tk].y, xpa[tk].z, xpa[tk].w, xpb[tk].x, xpb[tk].y, xpb[tk].z, xpb[tk].w};
#pragma unroll
                  for (int q = 0; q < 8; ++q) xf[q] = (f32x2){bflo(xx[q]), bfhi(xx[q])}; }
#define COMPUTE_SET(U, V, CG, SU, SV) do { float pd[4]; \
                    _Pragma("unroll") for (int k = 0; k < 4; ++k) { f32x2 d = (f32x2){0.f, 0.f}; \
                        _Pragma("unroll") for (int q = 0; q < 4; ++q) { const int dw = (int)U[k][q]; \
                            d += __builtin_amdgcn_cvt_pk_f32_fp8(dw, false) * xf[2 * q]; d += __builtin_amdgcn_cvt_pk_f32_fp8(dw, true) * xf[2 * q + 1]; } \
                        pd[k] = d[0] + d[1]; } \
                    float s; \
                    { const auto r0 = __builtin_amdgcn_permlane32_swap(__float_as_uint(pd[0]), __float_as_uint(pd[2]), false, false); \
                      const auto r1 = __builtin_amdgcn_permlane32_swap(__float_as_uint(pd[1]), __float_as_uint(pd[3]), false, false); \
                      const float a0 = __uint_as_float(r0[0]) + __uint_as_float(r0[1]), a1 = __uint_as_float(r1[0]) + __uint_as_float(r1[1]); \
                      const auto r2 = __builtin_amdgcn_permlane16_swap(__float_as_uint(a0), __float_as_uint(a1), false, false); \
                      s = __uint_as_float(r2[0]) + __uint_as_float(r2[1]); \
                      s += __int_as_float(__builtin_amdgcn_mov_dpp(__float_as_int(s), 0xB1, 0xF, 0xF, true)); \
                      s += __int_as_float(__builtin_amdgcn_mov_dpp(__float_as_int(s), 0x4E, 0xF, 0xF, true)); \
                      s += __int_as_float(__builtin_amdgcn_mov_dpp(__float_as_int(s), 0x141, 0xF, 0xF, true)); \
                      s += __int_as_float(__builtin_amdgcn_mov_dpp(__float_as_int(s), 0x140, 0xF, 0xF, true)); } \
                    const float coef = CG * gelu_fast(s * SU) * SV; \
                    _Pragma("unroll") for (int k = 0; k < 4; ++k) { const float ck = __int_as_float(__builtin_amdgcn_readlane(__float_as_int(coef), 16 * k)); const f32x2 ck2 = (f32x2){ck, ck}; \
                        _Pragma("unroll") for (int qq = 0; qq < 4; ++qq) { const int dw = (int)V[k][qq]; \
                            oacc[tk][2 * qq] += ck2 * __builtin_amdgcn_cvt_pk_f32_fp8(dw, false); oacc[tk][2 * qq + 1] += ck2 * __builtin_amdgcn_cvt_pk_f32_fp8(dw, true); } } } while (0)
                for (int j0 = beg; j0 < end; j0 += 8) {
                    IT_ADVANCE();
                    LOAD_SET(uB, vB, cgB, suB, svB);
                    COMPUTE_SET(uA, vA, cgA, suA, svA);
                    if (j0 + 4 < end) {
                        IT_ADVANCE();
                        LOAD_SET(uA, vA, cgA, suA, svA);
                        COMPUTE_SET(uB, vB, cgB, suB, svB);
                    } else {
#pragma unroll
                        for (int k = 0; k < 4; ++k) { uA[k] = uB[k]; vA[k] = vB[k]; }
                        cgA = cgB; suA = suB; svA = svB;
                    }
                }
            }
        }
#undef COMPUTE_SET
#undef IT_ADVANCE
#undef LOAD_SET
#pragma unroll
        for (int tk = 0; tk < 4; ++tk) {
            const size_t m = (size_t)tile * 64 + tb + tk; const int b = (int)(m >> 11);
            float* orow = A.out + m * 1024 + 16 * lane;
            const float* g2 = MOD + b * 6144 + 5120 + 16 * lane;
            f32x4 xv[4]; float ss = 0.f;
#pragma unroll
            for (int j = 0; j < 4; ++j) { const f32x4 x1 = *(const f32x4*)(orow + 4 * j), gg = *(const f32x4*)(g2 + 4 * j);
                const f32x4 pe = (f32x4){oacc[tk][2 * j][0], oacc[tk][2 * j][1], oacc[tk][2 * j + 1][0], oacc[tk][2 * j + 1][1]};
                xv[j] = x1 + gg * pe; ss += (xv[j][0] * xv[j][0] + xv[j][1] * xv[j][1]) + (xv[j][2] * xv[j][2] + xv[j][3] * xv[j][3]); }
            const float rstd = rsqrtf(wave_sum(ss) * (1.f / 1024.f) + 1e-6f);
#pragma unroll
            for (int j = 0; j < 4; ++j) { const f32x4 fg = *(const f32x4*)(A.final_g + 16 * lane + 4 * j); *(f32x4*)(orow + 4 * j) = xv[j] * rstd * fg; }
        }
    }
    __syncthreads();
}


#define XB_TMO      128
#define XB_XCNT(j)  (256  + 64 * (j))
#define XB_XSUB(j)  (1280 + 64 * (j))
#define XB_XGEN(j)  (2304 + 64 * (j))
#define XB_TOP      3328
#define XB_TOPGEN   3392
#define XCD_BAR_WORDS 3456
#define XB_SPIN_CAP (1u << 18)

__device__ __forceinline__ unsigned xb_ld(unsigned* p)              { return __hip_atomic_load(p, __ATOMIC_RELAXED, __HIP_MEMORY_SCOPE_AGENT); }
__device__ __forceinline__ unsigned xb_add(unsigned* p, unsigned v) { return __hip_atomic_fetch_add(p, v, __ATOMIC_RELAXED, __HIP_MEMORY_SCOPE_AGENT); }
__device__ __forceinline__ unsigned xb_xcc_id() { return (unsigned)__builtin_amdgcn_s_getreg((3 << 11) | 20) & 0xFu; }
#define XB_SPIN(cond, bar) do { unsigned _sp = 0; while (cond) { __builtin_amdgcn_s_sleep(1); \
    if ((++_sp & 255u) == 0u) { if (xb_ld(&(bar)[XB_TMO])) break; if (_sp > XB_SPIN_CAP) { atomicAdd(&(bar)[XB_TMO], 1u); break; } } } } while (0)

struct XcdBarrier {
    unsigned* bar; unsigned x;
    volatile LAS unsigned* st;
};

__device__ __forceinline__ XcdBarrier xcd_barrier_post(unsigned* bar, volatile LAS unsigned* st) {
    XcdBarrier b; b.bar = bar; b.x = xb_xcc_id(); b.st = st;
    if (threadIdx.x == 0) (void)xb_add(&bar[XB_XCNT(b.x)], 1u);
    return b;
}
__device__ __forceinline__ void xcd_barrier_complete(unsigned* bar, unsigned x, unsigned& nloc, unsigned& nx) {
    const unsigned G = gridDim.x * gridDim.y * gridDim.z;
    unsigned sum, cnt, mine, sp = 0u;
    for (;;) {
        sum = 0u; cnt = 0u; mine = 0u;
#pragma unroll
        for (unsigned j = 0; j < 16; ++j) { const unsigned c = xb_ld(&bar[XB_XCNT(j)]); sum += c; cnt += (c > 0u) ? 1u : 0u; mine = (j == x) ? c : mine; }
        if (sum == G) break;
        __builtin_amdgcn_s_sleep(1);
        if ((++sp & 255u) == 0u) { if (xb_ld(&bar[XB_TMO])) break; if (sp > XB_SPIN_CAP) { atomicAdd(&bar[XB_TMO], 1u); break; } }
    }
    nloc = mine > 0u ? mine : 1u; nx = cnt > 0u ? cnt : 1u;
}

__device__ __forceinline__ void xcd_barrier(const XcdBarrier& b) {
    asm volatile("s_waitcnt vmcnt(0)" ::: "memory");
    __syncthreads();
    if (threadIdx.x == 0) {
        unsigned* bar = b.bar;
        __builtin_amdgcn_s_waitcnt(0);
        unsigned nloc = b.st[0], nx = b.st[1];
        if (nloc == 0u) { xcd_barrier_complete(bar, b.x, nloc, nx); b.st[0] = nloc; b.st[1] = nx; }
        const unsigned old = xb_add(&bar[XB_XSUB(b.x)], 1u);
        const unsigned gen = old / nloc;
        if (old + 1u == (gen + 1u) * nloc) {
            __builtin_amdgcn_fence(__ATOMIC_RELEASE, "agent");
            asm volatile("s_waitcnt vmcnt(0)" ::: "memory");
            const unsigned og = xb_add(&bar[XB_TOP], 1u);
            const unsigned tg = og / nx;
            if (og + 1u == (tg + 1u) * nx) xb_add(&bar[XB_TOPGEN], 1u);
            else XB_SPIN(xb_ld(&bar[XB_TOPGEN]) == tg, bar);
            __builtin_amdgcn_fence(__ATOMIC_ACQUIRE, "agent");
            xb_add(&bar[XB_XGEN(b.x)], 1u);
            asm volatile("s_waitcnt vmcnt(0)" ::: "memory");
        } else {
            XB_SPIN(xb_ld(&bar[XB_XGEN(b.x)]) == gen, bar);
            __builtin_amdgcn_fence(__ATOMIC_ACQUIRE, "agent");
            asm volatile("s_waitcnt vmcnt(0)" ::: "memory");
        }
    }
    __syncthreads();
}

__global__ void __launch_bounds__(512, 2) mega_fwd(Args A) {
    extern __shared__ __attribute__((aligned(16))) unsigned char lds_raw[];
    LAS unsigned char* lds = (LAS unsigned char*)lds_raw;
    cg::grid_group grid = cg::this_grid();
    const int G = gridDim.x;
    if (threadIdx.x < 4) ((LAS unsigned*)(lds + LDS_BYTES - 32))[threadIdx.x] = 0u;
    __syncthreads();
    if (A.ws == nullptr) grid.sync();
    const XcdBarrier xb = xcd_barrier_post((unsigned*)(A.ws + WS_BAR), (volatile LAS unsigned*)(lds + LDS_BYTES - 32));
    phase0(A, lds);
    xcd_barrier(xb);
    phase1(A, lds);
    phase0b(A, lds);
    xcd_barrier(xb);
    { pg8::Gemm gm{(const pg8::bf16_t*)(A.ws + WS_ACT), (const pg8::bf16_t*)(A.ws + WS_WIN), T, NP, DM}; pg8::StaticOrder S; S.init(T, NP, G, (int)blockIdx.x);
      pg8::EpiStoreBf16 E{(pg8::bf16_t*)(A.ws + WS_P), NP};
      pg8::gemm_phase<pg8::EpiStoreBf16, pg8::StaticOrder, true, true>((PG8_LAS unsigned char*)lds, gm, S, E); }
    { const int nshort = G - (896 % G == 0 ? 0 : 896 % G);
      const int first = G - nshort;
      if ((int)blockIdx.x >= first) quantise_tables(A, ((int)blockIdx.x - first) * 8 + (int)(threadIdx.x >> 6), nshort * 8); }
    xcd_barrier(xb);
    phase3(A, lds);
    xcd_barrier(xb);
    phase3b(A, lds);
    xcd_barrier(xb);
    { pg8::Gemm gm{(const pg8::bf16_t*)(A.ws + WS_ACT), (const pg8::bf16_t*)(A.ws + WS_WOUT), T, DM, DM}; pg8::StaticOrder S; S.init(T, DM, G, (int)blockIdx.x);
      pg8::EpiResidNorm E{A.x, (const float*)(A.ws + WS_MOD), A.norm2_g, A.out, (pg8::bf16_t*)(A.ws + WS_A3), (float*)(A.ws + WS_RS)};
      pg8::gemm_phase<pg8::EpiResidNorm, pg8::StaticOrder, true, true>((PG8_LAS unsigned char*)lds, gm, S, E); }
    xcd_barrier(xb);
    { pg8::Gemm gm{(const pg8::bf16_t*)(A.ws + WS_A3), (const pg8::bf16_t*)(A.ws + WS_WQ), T, 2048, DM}; pg8::StaticOrder S; S.init(T, 2048, G, (int)blockIdx.x);
      pg8::EpiScoreF16 E{(pg8::bf16_t*)(A.ws + WS_QRY), 2048, (const float*)(A.ws + WS_RS), (const float*)(A.ws + WS_SB)};
      pg8::gemm_phase<pg8::EpiScoreF16, pg8::StaticOrder, true, true>((PG8_LAS unsigned char*)lds, gm, S, E); }
    xcd_barrier(xb);
    for (int tile = blockIdx.x; tile < T / 64; tile += G) peer_tile(A, lds, tile);
}

extern "C" void kernel_launch(void* const* d_in, const int* in_sizes, int n_in, void* d_out, int out_size, void* d_ws, size_t ws_size, hipStream_t stream) {
    static int grid = 0;
    if (grid == 0) {
        if (n_in != 22 || out_size != T * DM || ws_size < WS_END) { fprintf(stderr, "kernel_launch: unexpected shapes (n_in %d out %d ws %zu)\n", n_in, out_size, ws_size); grid = -1; return; }
        int dev = 0, cus = 0, per_cu = 0;
        if (hipGetDevice(&dev) != hipSuccess || hipDeviceGetAttribute(&cus, hipDeviceAttributeMultiprocessorCount, dev) != hipSuccess) { grid = -1; return; }
        if (hipFuncSetAttribute((const void*)mega_fwd, hipFuncAttributeMaxDynamicSharedMemorySize, LDS_BYTES) != hipSuccess) { fprintf(stderr, "kernel_launch: hipFuncSetAttribute failed\n"); grid = -1; return; }
        if (hipOccupancyMaxActiveBlocksPerMultiprocessor(&per_cu, (const void*)mega_fwd, 512, LDS_BYTES) != hipSuccess || per_cu < 1) { fprintf(stderr, "kernel_launch: occupancy query gave %d\n", per_cu); per_cu = 1; }
        (void)hipGetLastError();
        grid = cus * per_cu;
    }
    if (grid < 0) return;
    Args a{};
    const float** ap = (const float**)&a;
    for (int i = 0; i < 22; ++i) ap[i] = (const float*)d_in[i];
    a.out = (float*)d_out; a.ws = (unsigned char*)d_ws;
    if (hipMemsetAsync((unsigned char*)d_ws + WS_BAR, 0, XCD_BAR_WORDS * sizeof(unsigned), stream) != hipSuccess) { fprintf(stderr, "kernel_launch: memset of the barrier words failed\n"); return; }
    void* args[] = {&a};
    hipError_t e = hipLaunchCooperativeKernel((const void*)mega_fwd, dim3(grid), dim3(512), args, LDS_BYTES, stream);
    if (e != hipSuccess) fprintf(stderr, "kernel_launch: cooperative launch failed: %s (grid %d)\n", hipGetErrorString(e), grid);
}
```

```cpp
#include <hip/hip_runtime.h>
#include <hip/hip_cooperative_groups.h>
#include <cstdio>
#include <cstdint>
namespace cg = cooperative_groups;

namespace pg8 {
#define PG8_LAS __attribute__((address_space(3)))
typedef unsigned short bf16_t;
typedef short bf16x8 __attribute__((ext_vector_type(8)));
typedef float f32x4 __attribute__((ext_vector_type(4)));
typedef unsigned u32x4 __attribute__((ext_vector_type(4)));
constexpr int BM = 256, BK = 64, HALF = 128, HTB = HALF * BK * 2  , STAGE_BYTES = 8 * HTB, NXCD = 8, WGM = 8;

__host__ __device__ __forceinline__ int lds_byte(int r, int c) { const int st = (r >> 4) * 2 + (c >> 5), rr = r & 15, cc = c & 31, ob = rr * 64 + cc * 2; return st * 1024 + (ob ^ (((ob >> 9) & 1) << 5)); }
__host__ __device__ __forceinline__ void stage_rc(int b, int& R, int& C) { const int st = b / 1024, sb = b % 1024, swz = sb ^ (((sb >> 9) & 1) << 5); R = (st >> 1) * 16 + swz / 64; C = (st & 1) * 32 + (swz % 64) / 2; }
__host__ __device__ __forceinline__ int perm32(int rho) { const int n = rho >> 4, i = rho & 15; return 8 * (i >> 2) + 4 * n + (i & 3); }

struct Unit { int pm, pn; };
struct Gemm { const bf16_t* A; const bf16_t* Bt; int M, N, K; };

struct StaticOrder {
    int nM, nN, nwg, G, c;
    __host__ __device__ void init(int M, int N, int G_, int c_) { nM = M / BM; nN = N / BM; nwg = nM * nN; G = G_; c = c_; }
    __host__ __device__ bool next(int i, Unit& u) const {
        const long L = (long)i * G + c; if (L >= nwg) return false;
        int wgid = (int)L; { const int q = nwg / NXCD, r = nwg % NXCD, xcd = wgid % NXCD, off = wgid / NXCD; wgid = (xcd < r ? xcd * (q + 1) : r * (q + 1) + (xcd - r) * q) + off; }
        const int nig = WGM * nN, gid = wgid / nig, fm = gid * WGM, gsz = (nM - fm) < WGM ? (nM - fm) : WGM;
        u.pm = fm + ((wgid % nig) % gsz); u.pn = (wgid % nig) / gsz; return true;
    }
    __device__ __forceinline__ void a_ready(const Unit&) const {}
    __device__ __forceinline__ void done(const Unit&) const {}
};

__device__ __forceinline__ unsigned cvt_pk_bf16(float lo, float hi) { unsigned r; asm volatile("v_cvt_pk_bf16_f32 %0, %1, %2" : "=v"(r) : "v"(lo), "v"(hi)); return r; }

struct EpiStoreBf16 {
    static constexpr bool PERM = true, AFTER_DRAIN = false;
    bf16_t* O; int ldc;
    __device__ __forceinline__ void operator()(const f32x4 (&acc)[2][2][4][2], const Unit& u, int wr, int wc, int fr, int fq) const {
        const int row0 = u.pm * BM + wr * 64 + fr, col0 = u.pn * BM + wc * 32 + 8 * fq;
#pragma unroll
        for (int ai = 0; ai < 2; ++ai)
#pragma unroll
            for (int m = 0; m < 4; ++m) { bf16_t* rowp = O + (size_t)(row0 + ai * HALF + m * 16) * ldc + col0;
#pragma unroll
                for (int bj = 0; bj < 2; ++bj) { const f32x4 v0 = acc[ai][bj][m][0], v1 = acc[ai][bj][m][1];
                    u32x4 w; w.x = cvt_pk_bf16(v0[0], v0[1]); w.y = cvt_pk_bf16(v0[2], v0[3]); w.z = cvt_pk_bf16(v1[0], v1[1]); w.w = cvt_pk_bf16(v1[2], v1[3]);
                    *(u32x4*)(rowp + bj * HALF) = w; } }
    }
};
struct EpiStoreF16 {
    static constexpr bool PERM = true, AFTER_DRAIN = false;
    bf16_t* O; int ldc;
    static __device__ __forceinline__ unsigned pkh(float a, float b) { return (unsigned)__builtin_bit_cast(unsigned short, (_Float16)a) | ((unsigned)__builtin_bit_cast(unsigned short, (_Float16)b) << 16); }
    __device__ __forceinline__ void operator()(const f32x4 (&acc)[2][2][4][2], const Unit& u, int wr, int wc, int fr, int fq) const {
        const int row0 = u.pm * BM + wr * 64 + fr, col0 = u.pn * BM + wc * 32 + 8 * fq;
#pragma unroll
        for (int ai = 0; ai < 2; ++ai)
#pragma unroll
            for (int m = 0; m < 4; ++m) { bf16_t* rowp = O + (size_t)(row0 + ai * HALF + m * 16) * ldc + col0;
#pragma unroll
                for (int bj = 0; bj < 2; ++bj) { const f32x4 v0 = acc[ai][bj][m][0], v1 = acc[ai][bj][m][1];
                    u32x4 w; w.x = pkh(v0[0], v0[1]); w.y = pkh(v0[2], v0[3]); w.z = pkh(v1[0], v1[1]); w.w = pkh(v1[2], v1[3]);
                    *(u32x4*)(rowp + bj * HALF) = w; } }
    }
};
struct EpiResid {
    static constexpr bool PERM = true, AFTER_DRAIN = false;
    const float* x; const float* gate; float* out;
    __device__ __forceinline__ void operator()(const f32x4 (&acc)[2][2][4][2], const Unit& u, int wr, int wc, int fr, int fq) const {
        const int row0 = u.pm * BM + wr * 64 + fr, col0 = u.pn * BM + wc * 32 + 8 * fq;
#pragma unroll
        for (int ai = 0; ai < 2; ++ai)
#pragma unroll
            for (int m = 0; m < 4; ++m) { const int r = row0 + ai * HALF + m * 16; const float* gp = gate + (size_t)(r >> 11) * 6144;
#pragma unroll
                for (int bj = 0; bj < 2; ++bj) { const int c = col0 + bj * HALF;
                    const f32x4 xa = *(const f32x4*)(x + (size_t)r * 1024 + c), xb = *(const f32x4*)(x + (size_t)r * 1024 + c + 4);
                    const f32x4 ga = *(const f32x4*)(gp + c), gb = *(const f32x4*)(gp + c + 4);
                    *(f32x4*)(out + (size_t)r * 1024 + c) = xa + ga * acc[ai][bj][m][0];
                    *(f32x4*)(out + (size_t)r * 1024 + c + 4) = xb + gb * acc[ai][bj][m][1]; } }
    }
};
struct EpiResidNorm {
    static constexpr bool PERM = true, AFTER_DRAIN = false;
    const float* x; const float* mod; const float* ng; float* out; bf16_t* a3; float* rs;
    __device__ __forceinline__ void operator()(const f32x4 (&acc)[2][2][4][2], const Unit& u, int wr, int wc, int fr, int fq) const {
        const int row0 = u.pm * BM + wr * 64 + fr, col0 = u.pn * BM + wc * 32 + 8 * fq;
        const float* mp = mod + (size_t)((u.pm * BM) >> 11) * 6144;
        f32x4 g1v[2][2], csv[2][2];
#pragma unroll
        for (int bj = 0; bj < 2; ++bj)
#pragma unroll
            for (int n = 0; n < 2; ++n) { const int c = col0 + bj * HALF + 4 * n; g1v[bj][n] = *(const f32x4*)(mp + 2048 + c); csv[bj][n] = *(const f32x4*)(ng + c) * (*(const f32x4*)(mp + 4096 + c) + 1.0f); }
#pragma unroll
        for (int ai = 0; ai < 2; ++ai)
#pragma unroll
            for (int m = 0; m < 4; ++m) { const int r = row0 + ai * HALF + m * 16; float ss = 0.f;
#pragma unroll
                for (int bj = 0; bj < 2; ++bj) { const int c = col0 + bj * HALF;
                    const f32x4 xa = *(const f32x4*)(x + (size_t)r * 1024 + c), xb = *(const f32x4*)(x + (size_t)r * 1024 + c + 4);
                    const f32x4 v0 = xa + g1v[bj][0] * acc[ai][bj][m][0], v1 = xb + g1v[bj][1] * acc[ai][bj][m][1];
                    *(f32x4*)(out + (size_t)r * 1024 + c) = v0; *(f32x4*)(out + (size_t)r * 1024 + c + 4) = v1;
                    ss += (v0[0] * v0[0] + v0[1] * v0[1]) + (v0[2] * v0[2] + v0[3] * v0[3]) + (v1[0] * v1[0] + v1[1] * v1[1]) + (v1[2] * v1[2] + v1[3] * v1[3]);
                    const f32x4 a0 = v0 * csv[bj][0], a1 = v1 * csv[bj][1];
                    u32x4 w; w.x = cvt_pk_bf16(a0[0], a0[1]); w.y = cvt_pk_bf16(a0[2], a0[3]); w.z = cvt_pk_bf16(a1[0], a1[1]); w.w = cvt_pk_bf16(a1[2], a1[3]);
                    *(u32x4*)(a3 + (size_t)r * 1024 + c) = w; }
                ss += __shfl_xor(ss, 16); ss += __shfl_xor(ss, 32);
                if (fq == 0) rs[(size_t)r * 16 + (u.pn & 3) * 4 + wc] = ss; }
    }
};
struct EpiScoreF16 {
    static constexpr bool PERM = true, AFTER_DRAIN = false;
    bf16_t* O; int ldc; const float* rs; const float* sb;
    static __device__ __forceinline__ unsigned pkh(float a, float b) { return (unsigned)__builtin_bit_cast(unsigned short, (_Float16)a) | ((unsigned)__builtin_bit_cast(unsigned short, (_Float16)b) << 16); }
    __device__ __forceinline__ void operator()(const f32x4 (&acc)[2][2][4][2], const Unit& u, int wr, int wc, int fr, int fq) const {
        const int row0 = u.pm * BM + wr * 64 + fr, col0 = u.pn * BM + wc * 32 + 8 * fq;
        const float* sbp = sb + (size_t)((u.pm * BM) >> 11) * 2048;
        f32x4 bv[2][2];
#pragma unroll
        for (int bj = 0; bj < 2; ++bj)
#pragma unroll
            for (int n = 0; n < 2; ++n) bv[bj][n] = *(const f32x4*)(sbp + col0 + bj * HALF + 4 * n);
#pragma unroll
        for (int ai = 0; ai < 2; ++ai)
#pragma unroll
            for (int m = 0; m < 4; ++m) { const int r = row0 + ai * HALF + m * 16;
                float rstd; { const f32x4 p0 = *(const f32x4*)(rs + (size_t)r * 16), p1 = *(const f32x4*)(rs + (size_t)r * 16 + 4), p2 = *(const f32x4*)(rs + (size_t)r * 16 + 8), p3 = *(const f32x4*)(rs + (size_t)r * 16 + 12);
                  const f32x4 ps = (p0 + p1) + (p2 + p3); rstd = rsqrtf(((ps[0] + ps[1]) + (ps[2] + ps[3])) * (1.f / 1024.f) + 1e-6f); }
                bf16_t* rowp = O + (size_t)r * ldc + col0;
#pragma unroll
                for (int bj = 0; bj < 2; ++bj) { const f32x4 v0 = acc[ai][bj][m][0] * rstd + bv[bj][0], v1 = acc[ai][bj][m][1] * rstd + bv[bj][1];
                    u32x4 w; w.x = pkh(v0[0], v0[1]); w.y = pkh(v0[2], v0[3]); w.z = pkh(v1[0], v1[1]); w.w = pkh(v1[2], v1[3]);
                    *(u32x4*)(rowp + bj * HALF) = w; } }
    }
};
template <class Epi, class Sched, bool ALIGN_EPI = false, bool SP2 = false>
__device__ __forceinline__ void gemm_phase(PG8_LAS unsigned char* lds, const Gemm g, const Sched& S, const Epi& E) {
    int tid_o = threadIdx.x; asm volatile("" : "+v"(tid_o)); const int tid = tid_o, wid = __builtin_amdgcn_readfirstlane(tid >> 6), lane = tid & 63, wr = wid >> 2, wc = wid & 3, fr = lane & 15, fq = lane >> 4;
    const int K = g.K, nt = K / BK;
    unsigned voffA[2], voffB[2];
#pragma unroll
    for (int i = 0; i < 2; ++i) { int R, C; stage_rc(tid * 16 + i * 8192, R, C); const int Rb = Epi::PERM ? ((R & ~31) + perm32(R & 31)) : R;
        voffA[i] = (unsigned)(R * K + C) * 2u; voffB[i] = (unsigned)(Rb * K + C) * 2u; }
    const size_t kstep = (size_t)(BK * 2);
    const size_t hstep = (size_t)HALF * K * 2;
    const size_t tstep = 2 * hstep;
    const unsigned ldsw = (unsigned)wid * 1024u;
    const int aoff = lds_byte(wr * 64 + fr, fq * 8), boff = lds_byte(wc * 32 + fr, fq * 8);
#define PG8_SA(b, h) (((b) * 2 + (h)) * HTB)
#define PG8_SB(b, h) ((4 + (b) * 2 + (h)) * HTB)
#define PG8_STAGE(bufoff, gbase, voff) do { _Pragma("unroll") for (int _i = 0; _i < 2; ++_i) \
        __builtin_amdgcn_global_load_lds((const unsigned*)((const char*)(gbase) + (voff)[_i]), (PG8_LAS unsigned*)(lds + (bufoff) + ldsw + _i * 8192), 16, 0, 0); } while (0)
#define PG8_LDA(dst, b, h) do { _Pragma("unroll") for (int m = 0; m < 4; ++m) _Pragma("unroll") for (int k = 0; k < 2; ++k) dst[m][k] = *(const PG8_LAS bf16x8*)(lds + PG8_SA(b, h) + aoff + m * 2048 + k * 1024); } while (0)
#define PG8_LDB(dst, b, h) do { _Pragma("unroll") for (int n = 0; n < 2; ++n) _Pragma("unroll") for (int k = 0; k < 2; ++k) dst[n][k] = *(const PG8_LAS bf16x8*)(lds + PG8_SB(b, h) + boff + n * 2048 + k * 1024); } while (0)
#define PG8_MMA(ai, bj, At, Bt) do { __builtin_amdgcn_s_setprio(1); _Pragma("unroll") for (int m = 0; m < 4; ++m) _Pragma("unroll") for (int n = 0; n < 2; ++n) _Pragma("unroll") for (int k = 0; k < 2; ++k) \
        acc[ai][bj][m][n] = __builtin_amdgcn_mfma_f32_16x16x32_bf16(Bt[n][k], At[m][k], acc[ai][bj][m][n], 0, 0, 0); __builtin_amdgcn_s_setprio(0); } while (0)
#define PG8_WAIT_V(n) asm volatile("s_waitcnt vmcnt(" #n ")" ::: "memory")
#define PG8_WAIT_L(n) asm volatile("s_waitcnt lgkmcnt(" #n ")" ::: "memory")
#define PG8_BAR __builtin_amdgcn_s_barrier()
#define PG8_SCHED __builtin_amdgcn_sched_barrier(0)
    Unit cur, nxt; int ui = 0;
    if (!S.next(0, cur)) return;
    f32x4 acc[2][2][4][2];
#pragma unroll
    for (int a = 0; a < 2; ++a)
#pragma unroll
        for (int b = 0; b < 2; ++b)
#pragma unroll
            for (int m = 0; m < 4; ++m)
#pragma unroll
                for (int n = 0; n < 2; ++n) acc[a][b][m][n] = (f32x4){0.f, 0.f, 0.f, 0.f};
    bf16x8 At[4][2], B0[2][2], B1[2][2];
    const char* cA = (const char*)g.A + (size_t)cur.pm * tstep; const char* cB = (const char*)g.Bt + (size_t)cur.pn * tstep;
    S.a_ready(cur);
    if constexpr (SP2) {
        PG8_STAGE(PG8_SB(0, 0), cB, voffB); PG8_STAGE(PG8_SB(0, 1), cB + hstep, voffB); PG8_STAGE(PG8_SA(0, 0), cA, voffA); PG8_STAGE(PG8_SA(0, 1), cA + hstep, voffA);
        if (wr == 1) PG8_BAR;
        PG8_WAIT_V(2); PG8_BAR;
        PG8_STAGE(PG8_SB(1, 0), cB + kstep, voffB); PG8_STAGE(PG8_SA(1, 0), cA + kstep, voffA); PG8_STAGE(PG8_SB(1, 1), cB + hstep + kstep, voffB);
        PG8_WAIT_V(6); PG8_BAR;
    } else {
        PG8_STAGE(PG8_SB(0, 0), cB, voffB); PG8_STAGE(PG8_SA(0, 0), cA, voffA); PG8_STAGE(PG8_SB(0, 1), cB + hstep, voffB); PG8_STAGE(PG8_SA(0, 1), cA + hstep, voffA);
        if (wr == 1) PG8_BAR;
        PG8_WAIT_V(4); PG8_BAR;
        PG8_STAGE(PG8_SB(1, 0), cB + kstep, voffB); PG8_STAGE(PG8_SA(1, 0), cA + kstep, voffA); PG8_STAGE(PG8_SB(1, 1), cB + hstep + kstep, voffB);
        PG8_WAIT_V(6); PG8_BAR;
    }
    for (;;) {
        const bool has_next = S.next(ui + 1, nxt);
        const char* nA = has_next ? (const char*)g.A + (size_t)nxt.pm * tstep : cA; const char* nB = has_next ? (const char*)g.Bt + (size_t)nxt.pn * tstep : cB;
        for (int t = 0; t < nt; t += 2) {
            const bool last = (t == nt - 2);
            const char* a1 = cA + (size_t)(t + 1) * kstep;
            const char* a2 = last ? nA : cA + (size_t)(t + 2) * kstep; const char* b2 = last ? nB : cB + (size_t)(t + 2) * kstep;
            const char* a3 = a2 + kstep; const char* b3 = b2 + kstep;
            if (last && has_next) S.a_ready(nxt);
            if constexpr (SP2) {
            PG8_LDB(B0, 0, 0); PG8_LDB(B1, 0, 1); PG8_SCHED; PG8_LDA(At, 0, 0); PG8_STAGE(PG8_SA(1, 1), a1 + hstep, voffA);
            PG8_WAIT_V(8); PG8_WAIT_L(0); PG8_BAR; PG8_MMA(0, 0, At, B0); PG8_MMA(0, 1, At, B1); PG8_BAR; PG8_SCHED;
            PG8_LDA(At, 0, 1); PG8_STAGE(PG8_SB(0, 0), b2, voffB); PG8_STAGE(PG8_SB(0, 1), b2 + hstep, voffB); PG8_STAGE(PG8_SA(0, 0), a2, voffA);
            PG8_WAIT_V(8); PG8_WAIT_L(0); PG8_BAR; PG8_MMA(1, 0, At, B0); PG8_MMA(1, 1, At, B1); PG8_BAR; PG8_SCHED;
            PG8_LDB(B0, 1, 0); PG8_LDB(B1, 1, 1); PG8_SCHED; PG8_LDA(At, 1, 0); PG8_STAGE(PG8_SA(0, 1), a2 + hstep, voffA);
            PG8_WAIT_V(8); PG8_WAIT_L(0); PG8_BAR; PG8_MMA(0, 0, At, B0); PG8_MMA(0, 1, At, B1); PG8_BAR; PG8_SCHED;
            PG8_LDA(At, 1, 1); PG8_STAGE(PG8_SB(1, 0), b3, voffB); PG8_STAGE(PG8_SB(1, 1), b3 + hstep, voffB); PG8_STAGE(PG8_SA(1, 0), a3, voffA);
            PG8_WAIT_V(8); PG8_WAIT_L(0); PG8_BAR; PG8_MMA(1, 0, At, B0); PG8_MMA(1, 1, At, B1); PG8_BAR; PG8_SCHED;
            } else {
            PG8_LDB(B0, 0, 0); PG8_SCHED; PG8_LDA(At, 0, 0); PG8_STAGE(PG8_SA(1, 1), a1 + hstep, voffA);
            PG8_WAIT_L(8); PG8_BAR; PG8_WAIT_L(0); PG8_MMA(0, 0, At, B0); PG8_BAR; PG8_SCHED;
            PG8_LDB(B1, 0, 1); PG8_STAGE(PG8_SB(0, 0), b2, voffB);
            PG8_BAR; PG8_WAIT_L(0); PG8_MMA(0, 1, At, B1); PG8_BAR;
            PG8_LDA(At, 0, 1); PG8_STAGE(PG8_SA(0, 0), a2, voffA);
            PG8_BAR; PG8_WAIT_L(0); PG8_MMA(1, 0, At, B0); PG8_BAR; PG8_SCHED;
            PG8_STAGE(PG8_SB(0, 1), b2 + hstep, voffB);
            PG8_WAIT_V(6); PG8_BAR; PG8_MMA(1, 1, At, B1); PG8_BAR;
            PG8_LDB(B0, 1, 0); PG8_SCHED; PG8_LDA(At, 1, 0); PG8_STAGE(PG8_SA(0, 1), a2 + hstep, voffA);
            PG8_WAIT_L(8); PG8_BAR; PG8_WAIT_L(0); PG8_MMA(0, 0, At, B0); PG8_BAR; PG8_SCHED;
            PG8_LDB(B1, 1, 1); PG8_STAGE(PG8_SB(1, 0), b3, voffB);
            PG8_BAR; PG8_WAIT_L(0); PG8_MMA(0, 1, At, B1); PG8_BAR;
            PG8_LDA(At, 1, 1); PG8_STAGE(PG8_SA(1, 0), a3, voffA);
            PG8_BAR; PG8_WAIT_L(0); PG8_MMA(1, 0, At, B0); PG8_BAR; PG8_SCHED;
            PG8_STAGE(PG8_SB(1, 1), b3 + hstep, voffB);
            PG8_WAIT_V(6); PG8_BAR; PG8_MMA(1, 1, At, B1); PG8_BAR;
            }
        }
        if constexpr (ALIGN_EPI) { if (wr == 0) PG8_BAR; }
        if constexpr (!Epi::AFTER_DRAIN) { E(acc, cur, wr, wc, fr, fq); S.done(cur); }
        if (!has_next) break;
#pragma unroll
        for (int a = 0; a < 2; ++a)
#pragma unroll
            for (int b = 0; b < 2; ++b)
#pragma unroll
                for (int m = 0; m < 4; ++m)
#pragma unroll
                    for (int n = 0; n < 2; ++n) acc[a][b][m][n] = (f32x4){0.f, 0.f, 0.f, 0.f};
        cur = nxt; cA = nA; cB = nB; ++ui;
        if constexpr (ALIGN_EPI) { if (wr == 1) PG8_BAR; }
    }
    PG8_WAIT_V(0);
    if constexpr (!ALIGN_EPI) { if (wr == 0) PG8_BAR; }
    PG8_BAR;
    if constexpr (Epi::AFTER_DRAIN) { E.fused(acc, cur, wr, wc, fr, fq, lds, wid, lane); S.done(cur); }
#undef PG8_SA
#undef PG8_SB
#undef PG8_STAGE
#undef PG8_LDA
#undef PG8_LDB
#undef PG8_MMA
#undef PG8_WAIT_V
#undef PG8_WAIT_L
#undef PG8_BAR
#undef PG8_SCHED
}
}


#define LAS __attribute__((address_space(3)))
typedef unsigned short bf16_t;
typedef short bf16x8 __attribute__((ext_vector_type(8)));
typedef short s16x4 __attribute__((ext_vector_type(4)));
typedef short v4i16_t __attribute__((ext_vector_type(4)));
typedef float f32x4 __attribute__((ext_vector_type(4)));
typedef unsigned u32x4 __attribute__((ext_vector_type(4)));
typedef unsigned u32x2 __attribute__((ext_vector_type(2)));
typedef float f32x2 __attribute__((ext_vector_type(2)));

constexpr int T = 16384, DM = 1024, SEQ = 2048, NP = 3584;
constexpr size_t MiB = 1u << 20;
constexpr size_t WS_CTL = 0, WS_MOD = 4096, WS_GATES = 262144, WS_KEYS = 1 * MiB, WS_WIN = 2 * MiB, WS_WOUT = 9 * MiB, WS_WQ = 11 * MiB,
                 WS_T8 = 16 * MiB, WS_SC = 48 * MiB, WS_ACT = 80 * MiB, WS_P = 112 * MiB, WS_QRY = 112 * MiB, WS_END = 256 * MiB;
constexpr size_t WS_RS = 208 * MiB, WS_SB = 851968, WS_A3 = 176 * MiB;
constexpr int LDS_BYTES = 147456;

__device__ __forceinline__ unsigned f2bf(float f) { unsigned u = __float_as_uint(f); return (u + 0x7fffu + ((u >> 16) & 1u)) >> 16; }
typedef __bf16 bf16x2_t __attribute__((ext_vector_type(2)));
__device__ __forceinline__ unsigned pk2(float lo, float hi) { const f32x2 v = {lo, hi}; const bf16x2_t b = __builtin_convertvector(v, bf16x2_t); return __builtin_bit_cast(unsigned, b); }
__device__ __forceinline__ float bflo(unsigned u) { return __uint_as_float(u << 16); }
__device__ __forceinline__ float bfhi(unsigned u) { return __uint_as_float(u & 0xffff0000u); }
__device__ __forceinline__ float wave_sum(float v) {
    { const auto r = __builtin_amdgcn_permlane32_swap(__float_as_uint(v), __float_as_uint(v), false, false); v = __uint_as_float(r[0]) + __uint_as_float(r[1]); }
    { const auto r = __builtin_amdgcn_permlane16_swap(__float_as_uint(v), __float_as_uint(v), false, false); v = __uint_as_float(r[0]) + __uint_as_float(r[1]); }
    v += __int_as_float(__builtin_amdgcn_mov_dpp(__float_as_int(v), 0xB1, 0xF, 0xF, true));
    v += __int_as_float(__builtin_amdgcn_mov_dpp(__float_as_int(v), 0x4E, 0xF, 0xF, true));
    v += __int_as_float(__builtin_amdgcn_mov_dpp(__float_as_int(v), 0x141, 0xF, 0xF, true));
    v += __int_as_float(__builtin_amdgcn_mov_dpp(__float_as_int(v), 0x140, 0xF, 0xF, true));
    return v;
}
__device__ __forceinline__ float xrow_max(float v) {
    { const auto r = __builtin_amdgcn_permlane16_swap(__float_as_uint(v), __float_as_uint(v), false, false); v = fmaxf(__uint_as_float(r[0]), __uint_as_float(r[1])); }
    { const auto r = __builtin_amdgcn_permlane32_swap(__float_as_uint(v), __float_as_uint(v), false, false); v = fmaxf(__uint_as_float(r[0]), __uint_as_float(r[1])); }
    return v;
}
__device__ __forceinline__ float xrow_sum(float v) {
    { const auto r = __builtin_amdgcn_permlane16_swap(__float_as_uint(v), __float_as_uint(v), false, false); v = __uint_as_float(r[0]) + __uint_as_float(r[1]); }
    { const auto r = __builtin_amdgcn_permlane32_swap(__float_as_uint(v), __float_as_uint(v), false, false); v = __uint_as_float(r[0]) + __uint_as_float(r[1]); }
    return v;
}
#define LDS_WAIT() asm volatile("s_waitcnt lgkmcnt(0)" ::: "memory")
__device__ __forceinline__ s16x4 vtr(LAS unsigned char* p) { return __builtin_bit_cast(s16x4, __builtin_amdgcn_ds_read_tr16_b64_v4i16((LAS v4i16_t*)p)); }
__device__ __forceinline__ bf16x8 cat8(s16x4 a, s16x4 b) { bf16x8 r; r[0] = a[0]; r[1] = a[1]; r[2] = a[2]; r[3] = a[3]; r[4] = b[0]; r[5] = b[1]; r[6] = b[2]; r[7] = b[3]; return r; }
__device__ __forceinline__ bf16x8 pack8(const f32x4 a, const f32x4 b) { u32x4 w; w.x = pk2(a[0], a[1]); w.y = pk2(a[2], a[3]); w.z = pk2(b[0], b[1]); w.w = pk2(b[2], b[3]); return __builtin_bit_cast(bf16x8, w); }
#define MFMA16(a, b, c) __builtin_amdgcn_mfma_f32_16x16x32_bf16((a), (b), (c), 0, 0, 0)

struct Args {
    const float *x, *c, *ada_w, *ada_b, *norm1_g, *w_in, *conv_w, *conv_b, *gate_b, *mnorm_g, *lq1, *lk1, *lq2, *lk2, *dnorm_g, *w_out, *norm2_g, *wq, *keys, *pu, *pv, *final_g;
    float* out; unsigned char* ws;
};

__device__ __forceinline__ void transpose_item(const float* W, int srcN, int soff, bf16_t* WT, LAS float* scr, int kb, int nb, int lane) {
    const int k0 = 64 * kb, n0 = 32 * nb;
    { f32x4 wv[8];
#pragma unroll
      for (int i = 0; i < 8; ++i) wv[i] = *(const f32x4*)(W + (size_t)(k0 + 8 * i + (lane >> 3)) * srcN + n0 + soff + 4 * (lane & 7));
#pragma unroll
      for (int i = 0; i < 8; ++i) { LAS float* d = scr + (8 * i + (lane >> 3)) * 33 + 4 * (lane & 7); d[0] = wv[i][0]; d[1] = wv[i][1]; d[2] = wv[i][2]; d[3] = wv[i][3]; } }
    LDS_WAIT(); asm volatile("" ::: "memory");
    const int c = lane & 7;
#pragma unroll
    for (int j = 0; j < 4; ++j) { const int n = (lane >> 3) + 8 * j; const LAS float* s = scr + (8 * c) * 33 + n;
        u32x4 o; o.x = pk2(s[0 * 33], s[1 * 33]); o.y = pk2(s[2 * 33], s[3 * 33]); o.z = pk2(s[4 * 33], s[5 * 33]); o.w = pk2(s[6 * 33], s[7 * 33]);
        *(u32x4*)(WT + (size_t)(n0 + n) * 1024 + k0 + 8 * c) = o; }
    LDS_WAIT(); asm volatile("" ::: "memory");
}

__device__ __forceinline__ bf16x8 pack8_sw(const f32x4 a, const f32x4 b) {
    u32x4 w; w.x = f2bf(a[0]) | (f2bf(a[1]) << 16); w.y = f2bf(a[2]) | (f2bf(a[3]) << 16); w.z = f2bf(b[0]) | (f2bf(b[1]) << 16); w.w = f2bf(b[2]) | (f2bf(b[3]) << 16); return __builtin_bit_cast(bf16x8, w); }
__device__ __forceinline__ void wprime_item(const Args& A, int hp, int kt, int lane) {
    const int g = lane >> 4, l15 = lane & 15;
    f32x4 acc[8];
#pragma unroll
    for (int nt = 0; nt < 8; ++nt) acc[nt] = (f32x4){0.f, 0.f, 0.f, 0.f};
#pragma unroll
    for (int ks = 0; ks < 4; ++ks) {
        const float* ap = A.wq + (size_t)(16 * kt + l15) * 2048 + hp * 128 + 32 * ks + 8 * g;
        const bf16x8 a = pack8(*(const f32x4*)ap, *(const f32x4*)(ap + 4));
#pragma unroll
        for (int nt = 0; nt < 8; ++nt) { const float* bp = A.keys + (size_t)(hp * 128 + 16 * nt + l15) * 128 + 32 * ks + 8 * g;
            const bf16x8 b = pack8(*(const f32x4*)bp, *(const f32x4*)(bp + 4)); acc[nt] = MFMA16(a, b, acc[nt]); }
    }
    bf16_t* WT = (bf16_t*)(A.ws + WS_WQ);
#pragma unroll
    for (int nt = 0; nt < 8; ++nt) { u32x2 o; o.x = pk2(acc[nt][0], acc[nt][1]); o.y = pk2(acc[nt][2], acc[nt][3]);
        *(u32x2*)(WT + (size_t)(hp * 128 + 16 * nt + l15) * 1024 + 16 * kt + 4 * g) = o; }
}

__device__ __forceinline__ void phase0(const Args& A, LAS unsigned char* lds) {
    int tid_o = threadIdx.x; asm volatile("" : "+v"(tid_o)); const int tid = tid_o, lane = tid & 63, wave = tid >> 6, G = gridDim.x;
    float* MOD = (float*)(A.ws + WS_MOD);
    if ((int)blockIdx.x < 192) {
        LAS float* sc = (LAS float*)lds;
        for (int i = tid; i < 8192; i += 512) { const float v = A.c[i]; sc[i] = v * __builtin_amdgcn_rcpf(1.f + __expf(-v)); }
        __syncthreads();
        for (int item = blockIdx.x; item < 192; item += G) {
            const int j0 = item * 32, kg = tid >> 3, cq = tid & 7;
            f32x4 wv[16];
#pragma unroll
            for (int kk = 0; kk < 16; ++kk) wv[kk] = *(const f32x4*)(A.ada_w + (size_t)(kg * 16 + kk) * 6144 + j0 + 4 * cq);
            f32x4 acc[8];
#pragma unroll
            for (int b = 0; b < 8; ++b) acc[b] = (f32x4){0.f, 0.f, 0.f, 0.f};
#pragma unroll
            for (int b = 0; b < 8; ++b)
#pragma unroll
                for (int k4 = 0; k4 < 4; ++k4) { const f32x4 s4 = *(const LAS f32x4*)(sc + b * 1024 + kg * 16 + 4 * k4);
                    acc[b] += wv[4 * k4] * s4[0]; acc[b] += wv[4 * k4 + 1] * s4[1]; acc[b] += wv[4 * k4 + 2] * s4[2]; acc[b] += wv[4 * k4 + 3] * s4[3]; }
            LAS float* part = (LAS float*)(lds + 32768);
#pragma unroll
            for (int b = 0; b < 8; ++b) *(LAS f32x4*)(part + (kg * 8 + b) * 32 + 4 * cq) = acc[b];
            __syncthreads();
            if (tid < 256) { const int b = tid >> 5, col = tid & 31; float s = A.ada_b[j0 + col];
              for (int k2 = 0; k2 < 64; ++k2) s += part[(k2 * 8 + b) * 32 + col];
              MOD[b * 6144 + j0 + col] = s; }
            __syncthreads();
        }
    }
    if (blockIdx.x == 0 && tid == 0) {
        float s1 = 0.f, s2 = 0.f;
        for (int i = 0; i < 64; ++i) { s1 += A.lq1[i] * A.lk1[i]; s2 += A.lq2[i] * A.lk2[i]; }
        ((float*)(A.ws + WS_CTL))[1] = expf(s1) - expf(s2) + 0.2f;
        ((unsigned*)(A.ws + WS_CTL))[0] = 0u; ((unsigned*)(A.ws + WS_CTL))[2] = 0u;
    }
}

__device__ __forceinline__ void phase0b(const Args& A, LAS unsigned char* lds) {
    int tid_o = threadIdx.x; asm volatile("" : "+v"(tid_o)); const int tid = tid_o, lane = tid & 63, wave = tid >> 6, G = gridDim.x;
    __syncthreads();
    {
        LAS float* scr = (LAS float*)(lds + wave * 16384);
        const int gw = blockIdx.x * 8 + wave, NGW = G * 8;
        for (int it = gw; it < 3328; it += NGW) {
            int r = it;
            if (r < 1792) { const int kb = r / 112, nb = r % 112; transpose_item(A.w_in, 3592, nb >= 64 ? 8 : 0, (bf16_t*)(A.ws + WS_WIN), scr, kb, nb, lane); continue; }
            r -= 1792;
            if (r < 512) { transpose_item(A.w_out, 1024, 0, (bf16_t*)(A.ws + WS_WOUT), scr, r / 32, r % 32, lane); continue; }
            r -= 512;
            wprime_item(A, r >> 6, r & 63, lane);
        }
    }
    {
        for (int i = blockIdx.x * 512 + tid; i < 32768; i += G * 512) {
            const f32x4 a = *(const f32x4*)(A.keys + (size_t)i * 8), b = *(const f32x4*)(A.keys + (size_t)i * 8 + 4);
            u32x4 o; o.x = pk2(a[0], a[1]); o.y = pk2(a[2], a[3]); o.z = pk2(b[0], b[1]); o.w = pk2(b[2], b[3]);
            *(u32x4*)((bf16_t*)(A.ws + WS_KEYS) + (size_t)i * 8) = o;
        }
    }
}

__device__ __forceinline__ void quantise_tables(const Args& A, int gw, int NGW) {
    int tid_o = threadIdx.x; asm volatile("" : "+v"(tid_o)); const int lane = tid_o & 63;
    unsigned char* T8 = A.ws + WS_T8; float* SC = (float*)(A.ws + WS_SC);
#pragma unroll 1
    for (int row = gw; row < 32768; row += 4 * NGW) {
        f32x4 v[4][4]; int rr[4];
#pragma unroll
        for (int q = 0; q < 4; ++q) { const int r = row + q * NGW; rr[q] = r; const int rc = r < 32768 ? r : row;
            const float* s = (rc < 16384 ? A.pu + (size_t)rc * 1024 : A.pv + (size_t)(rc - 16384) * 1024) + 16 * lane;
#pragma unroll
            for (int j = 0; j < 4; ++j) v[q][j] = *(const f32x4*)(s + 4 * j); }
#pragma unroll
        for (int q = 0; q < 4; ++q) {
            float mx = 0.f;
#pragma unroll
            for (int j = 0; j < 4; ++j)
#pragma unroll
                for (int e = 0; e < 4; ++e) mx = fmaxf(mx, fabsf(v[q][j][e]));
#pragma unroll
            for (int o = 1; o < 64; o <<= 1) mx = fmaxf(mx, __shfl_xor(mx, o));
            const float sc = fmaxf(mx, 1e-30f) * (1.f / 256.f), inv = 1.f / sc;
            u32x4 o4;
#pragma unroll
            for (int j = 0; j < 4; ++j) { int w0 = __builtin_amdgcn_cvt_pk_fp8_f32(v[q][j][0] * inv, v[q][j][1] * inv, 0, false); w0 = __builtin_amdgcn_cvt_pk_fp8_f32(v[q][j][2] * inv, v[q][j][3] * inv, w0, true); o4[j] = (unsigned)w0; }
            if (rr[q] < 32768) { *(u32x4*)(T8 + (size_t)rr[q] * 1024 + 16 * lane) = o4; if (lane == 0) SC[rr[q]] = sc; }
        }
    }
}

__device__ __forceinline__ void phase1(const Args& A, LAS unsigned char* lds) {
    int tid_o = threadIdx.x; asm volatile("" : "+v"(tid_o)); const int tid = tid_o, lane = tid & 63, wave = tid >> 6, G = gridDim.x;
    const float* MOD = (const float*)(A.ws + WS_MOD);
    bf16_t* ACT = (bf16_t*)(A.ws + WS_ACT);
    float* GATES = (float*)(A.ws + WS_GATES);
    LAS float* WG = (LAS float*)lds;
    for (int i = tid; i < 8192; i += 512) { const int k = i >> 3, gc = i & 7; WG[gc * 1024 + k] = A.w_in[(size_t)k * 3592 + 2048 + gc]; }
    __syncthreads();
    f32x4 vn[4];
    { const int m0 = blockIdx.x * 8 + wave; if (m0 < T) { const f32x4* xr = (const f32x4*)(A.x + (size_t)m0 * 1024) + lane;
#pragma unroll
        for (int j = 0; j < 4; ++j) vn[j] = xr[64 * j]; } }
    for (int m = blockIdx.x * 8 + wave; m < T; m += G * 8) {
        const int b = m >> 11;
        f32x4 v[4]; float ss = 0.f;
#pragma unroll
        for (int j = 0; j < 4; ++j) { v[j] = vn[j]; ss += (v[j][0] * v[j][0] + v[j][1] * v[j][1]) + (v[j][2] * v[j][2] + v[j][3] * v[j][3]); }
        if (m + G * 8 < T) { const f32x4* xr = (const f32x4*)(A.x + (size_t)(m + G * 8) * 1024) + lane;
#pragma unroll
            for (int j = 0; j < 4; ++j) vn[j] = xr[64 * j]; }
        const float rstd = rsqrtf(wave_sum(ss) * (1.f / 1024.f) + 1e-6f);
        unsigned long long* o8 = (unsigned long long*)(ACT + (size_t)m * 1024) + lane;
#pragma unroll
        for (int j = 0; j < 4; ++j) { const int col = 4 * lane + 256 * j;
            const f32x4 g = *(const f32x4*)(A.norm1_g + col), sc = *(const f32x4*)(MOD + b * 6144 + 1024 + col), sh = *(const f32x4*)(MOD + b * 6144 + col);
            v[j] = v[j] * rstd * g * (sc + 1.0f) + sh;
            o8[64 * j] = (unsigned long long)pk2(v[j][0], v[j][1]) | ((unsigned long long)pk2(v[j][2], v[j][3]) << 32); }
        float gd[8];
#pragma unroll
        for (int gc = 0; gc < 8; ++gc) { float d = 0.f;
#pragma unroll
            for (int j = 0; j < 4; ++j) { const f32x4 w = *(const LAS f32x4*)(WG + gc * 1024 + 256 * j + 4 * lane); d += (v[j][0] * w[0] + v[j][1] * w[1]) + (v[j][2] * w[2] + v[j][3] * w[3]); }
            gd[gc] = wave_sum(d); }
        if (lane == 0) {
            f32x4 ig, lf;
#pragma unroll
            for (int h = 0; h < 4; ++h) { ig[h] = gd[h] + A.gate_b[h]; const float z = gd[4 + h] + A.gate_b[4 + h]; lf[h] = fminf(z, 0.f) - log1pf(expf(-fabsf(z))); }
            *(f32x4*)(GATES + (size_t)m * 8) = ig; *(f32x4*)(GATES + (size_t)m * 8 + 4) = lf;
        }
    }
}

constexpr int AK_STRIDE = 272, AV_STRIDE = 288, AK_BYTES = 64 * AK_STRIDE, AV_BYTES = 64 * AV_STRIDE;
__device__ __forceinline__ void attn_item(const Args& A, LAS unsigned char* lds, int b, int h, int qb, float lam) {
    int tid_o = threadIdx.x; asm volatile("" : "+v"(tid_o)); const int tid = tid_o, lane = tid & 63, w = tid >> 6, g = lane >> 4, l15 = lane & 15;
    const bf16_t* P = (const bf16_t*)(A.ws + WS_P);
    bf16_t* ACT = (bf16_t*)(A.ws + WS_ACT);
    const int t0 = qb * 128, ntiles = 2 * (qb + 1);
    const size_t rowbase = (size_t)b * SEQ;
    bf16x8 qf[2][2];
    { const bf16_t* qp = P + (rowbase + t0 + 16 * w + l15) * NP + 2048 + h * 128 + 8 * g;
#pragma unroll
      for (int p = 0; p < 2; ++p)
#pragma unroll
          for (int ks = 0; ks < 2; ++ks) qf[p][ks] = *(const bf16x8*)(qp + p * 64 + ks * 32); }
    f32x4 o[2][8];
#pragma unroll
    for (int p = 0; p < 2; ++p)
#pragma unroll
        for (int vt = 0; vt < 8; ++vt) o[p][vt] = (f32x4){0.f, 0.f, 0.f, 0.f};
    float mrun[2] = {-1e30f, -1e30f}, lrun[2] = {0.f, 0.f};
    const int srow = tid >> 3, sseg = tid & 7;
    const bf16_t* kg = P + (rowbase + srow) * NP + 2560 + h * 128 + sseg * 16;
    const bf16_t* vg = P + (rowbase + srow) * NP + 3072 + h * 128 + sseg * 16;
    u32x4 kr0, kr1, vr0, vr1;
    kr0 = *(const u32x4*)(kg); kr1 = *(const u32x4*)(kg + 8); vr0 = *(const u32x4*)(vg); vr1 = *(const u32x4*)(vg + 8);
    { LAS unsigned char* kb = lds + srow * AK_STRIDE + sseg * 32; LAS unsigned char* vb = lds + 2 * AK_BYTES + srow * AV_STRIDE + sseg * 32;
      *(LAS u32x4*)kb = kr0; *(LAS u32x4*)(kb + 16) = kr1; *(LAS u32x4*)vb = vr0; *(LAS u32x4*)(vb + 16) = vr1; }
    __syncthreads();
    const float cs = 0.125f * 1.4426950408889634f;
    const int qabs = t0 + 16 * w + l15;
    for (int kt = 0; kt < ntiles; ++kt) {
        const int cur = kt & 1;
        if (kt + 1 < ntiles) { const size_t off = (size_t)(kt + 1) * 64 * NP;
            kr0 = *(const u32x4*)(kg + off); kr1 = *(const u32x4*)(kg + off + 8); vr0 = *(const u32x4*)(vg + off); vr1 = *(const u32x4*)(vg + off + 8); }
        if (64 * kt <= t0 + 16 * w + 15) {
            LAS unsigned char* Kb = lds + cur * AK_BYTES; LAS unsigned char* Vb = lds + 2 * AK_BYTES + cur * AV_BYTES;
            f32x4 s[2][4];
#pragma unroll
            for (int p = 0; p < 2; ++p)
#pragma unroll
                for (int k4 = 0; k4 < 4; ++k4) { f32x4 a = (f32x4){0.f, 0.f, 0.f, 0.f};
#pragma unroll
                    for (int ks = 0; ks < 2; ++ks) { const bf16x8 kf = *(const LAS bf16x8*)(Kb + (16 * k4 + l15) * AK_STRIDE + (p * 64 + ks * 32 + 8 * g) * 2); a = MFMA16(kf, qf[p][ks], a); }
                    s[p][k4] = a; }
            if (64 * kt + 63 > t0 + 16 * w) {
#pragma unroll
                for (int p = 0; p < 2; ++p)
#pragma unroll
                    for (int k4 = 0; k4 < 4; ++k4)
#pragma unroll
                        for (int r = 0; r < 4; ++r) { const int key = 64 * kt + 16 * k4 + 4 * g + r; if (key > qabs) s[p][k4][r] = -1e30f; }
            }
            bf16x8 pf[2][2];
#pragma unroll
            for (int p = 0; p < 2; ++p) {
                float mx = -1e30f;
#pragma unroll
                for (int k4 = 0; k4 < 4; ++k4)
#pragma unroll
                    for (int r = 0; r < 4; ++r) mx = fmaxf(mx, s[p][k4][r]);
                mx = xrow_max(mx);
                const float mnew = fmaxf(mrun[p], mx * cs), alpha = __builtin_amdgcn_exp2f(mrun[p] - mnew);
                mrun[p] = mnew;
                float ls = 0.f;
#pragma unroll
                for (int k4 = 0; k4 < 4; ++k4)
#pragma unroll
                    for (int r = 0; r < 4; ++r) { const float pv = __builtin_amdgcn_exp2f(s[p][k4][r] * cs - mnew); ls += pv; s[p][k4][r] = pv; }
                lrun[p] = lrun[p] * alpha + ls;
                if (__any(alpha != 1.f)) {
#pragma unroll
                    for (int vt = 0; vt < 8; ++vt) o[p][vt] = o[p][vt] * alpha; }
                pf[p][0] = pack8(s[p][0], s[p][1]); pf[p][1] = pack8(s[p][2], s[p][3]);
            }
#pragma unroll
            for (int ks2 = 0; ks2 < 2; ++ks2)
#pragma unroll
                for (int vt = 0; vt < 8; ++vt) {
                    LAS unsigned char* a0 = Vb + (32 * ks2 + 4 * g + (l15 >> 2)) * AV_STRIDE + (16 * vt + 4 * (lane & 3)) * 2;
                    const bf16x8 vf = cat8(vtr(a0), vtr(a0 + 16 * AV_STRIDE));
                    o[0][vt] = MFMA16(vf, pf[0][ks2], o[0][vt]);
                    o[1][vt] = MFMA16(vf, pf[1][ks2], o[1][vt]);
                }
        }
        if (kt + 1 < ntiles) { const int nx = cur ^ 1;
            LAS unsigned char* kb = lds + nx * AK_BYTES + srow * AK_STRIDE + sseg * 32; LAS unsigned char* vb = lds + 2 * AK_BYTES + nx * AV_BYTES + srow * AV_STRIDE + sseg * 32;
            *(LAS u32x4*)kb = kr0; *(LAS u32x4*)(kb + 16) = kr1; *(LAS u32x4*)vb = vr0; *(LAS u32x4*)(vb + 16) = vr1; }
        __syncthreads();
    }
    float inv[2];
#pragma unroll
    for (int p = 0; p < 2; ++p) { const float lt = xrow_sum(lrun[p]); inv[p] = 1.f / lt; }
    float ss = 0.f;
#pragma unroll
    for (int vt = 0; vt < 8; ++vt)
#pragma unroll
        for (int r = 0; r < 4; ++r) { const float ov = o[0][vt][r] * inv[0] - lam * (o[1][vt][r] * inv[1]); o[0][vt][r] = ov; ss += ov * ov; }
    ss = xrow_sum(ss);
    const float rstd = rsqrtf(ss * (1.f / 128.f) + 1e-6f) * 0.8f;
    bf16_t* op = ACT + (rowbase + qabs) * 1024 + 512 + h * 128 + 4 * g;
#pragma unroll
    for (int vt = 0; vt < 8; ++vt) { const f32x4 gn = *(const f32x4*)(A.dnorm_g + 16 * vt + 4 * g);
        u32x2 wv; wv.x = pk2(o[0][vt][0] * rstd * gn[0], o[0][vt][1] * rstd * gn[1]); wv.y = pk2(o[0][vt][2] * rstd * gn[2], o[0][vt][3] * rstd * gn[3]);
        *(u32x2*)(op + 16 * vt) = wv; }
}

constexpr int MQ_STRIDE = 272, MV_STRIDE = 288, MP_STRIDE = 144, MH_STRIDE = 132;
constexpr int ML_Q = 0, ML_K = 17408, ML_V = 34816, ML_P = 53248, ML_H = 62464, ML_CW = 96256, ML_SM = 101376;
constexpr int SM_E = 0, SM_G = 64, SM_B = 128, SM_W = 192, SM_I = 256, SM_R = 320, SM_N = 384, SM_NP = 512, SM_X = 1024;
constexpr size_t WS_CST = 224 * MiB, WS_NST = 15 * MiB, WS_MC = 15 * MiB + 512 * 1024, WS_BAR = 15 * MiB + 768 * 1024;

__device__ __forceinline__ void mlstm_state(const Args& A, LAS unsigned char* lds, int b, int h) {
    int tid_o = threadIdx.x; asm volatile("" : "+v"(tid_o)); const int tid = tid_o, lane = tid & 63, w = tid >> 6, g = lane >> 4, l15 = lane & 15;
    const bf16_t* P = (const bf16_t*)(A.ws + WS_P);
    const float* GATES = (const float*)(A.ws + WS_GATES);
    u32x4* CST = (u32x4*)(A.ws + WS_CST); float* NST = (float*)(A.ws + WS_NST); float* MCg = (float*)(A.ws + WS_MC);
    LAS float* sm = (LAS float*)(lds + ML_SM);
    LAS float* cw = (LAS float*)(lds + ML_CW);
    LAS unsigned char* Ks = lds + ML_K; LAS unsigned char* Vs = lds + ML_V;
    const size_t rowbase = (size_t)b * SEQ; const int bh = b * 4 + h;
    for (int i = tid; i < 640; i += 512) { const int j = i >> 7, ch = i & 127, cch = 512 + h * 128 + ch; cw[i] = (j < 4) ? A.conv_w[j * 1024 + cch] : A.conv_b[cch]; }
    if (tid < 128) sm[SM_N + tid] = 0.f;
    const int rg = tid >> 4, cs = tid & 15;
    const int ccol = 512 + h * 128 + 8 * cs;
    const int srow = tid >> 3, sseg = tid & 7;
    u32x4 cr[5], vr0, vr1; float gi = 0.f, gf = 0.f;
#define MS_PREFETCH(c) do { const int _r0 = (c) * 64 + 2 * rg - 3; \
        _Pragma("unroll") for (int _i = 0; _i < 5; ++_i) { const int _r = _r0 + _i; const u32x4 _v = *(const u32x4*)(P + (rowbase + (_r >= 0 ? _r : 0)) * NP + ccol); cr[_i] = (_r >= 0) ? _v : (u32x4){0u, 0u, 0u, 0u}; } \
        const bf16_t* _vp = P + (rowbase + (c) * 64 + srow) * NP + 1024 + h * 128 + sseg * 16; \
        vr0 = *(const u32x4*)(_vp); vr1 = *(const u32x4*)(_vp + 8); \
        } while (0)
    MS_PREFETCH(0);
    LAS float* Eall = (LAS float*)(lds + ML_Q);
#pragma unroll
    for (int cc = 0; cc < 4; ++cc) { const int c = w + 8 * cc;
        const float* gp = GATES + (rowbase + c * 64 + lane) * 8 + h; gi = gp[0]; gf = gp[4];
        float bc = gf;
#pragma unroll
        for (int o = 1; o < 64; o <<= 1) { const float t = __shfl_up(bc, o); if (lane >= o) bc += t; }
        const float e = gi - bc; float cm = e;
#pragma unroll
        for (int o = 1; o < 64; o <<= 1) { const float t = __shfl_up(cm, o); if (lane >= o) cm = fmaxf(cm, t); }
        Eall[c * 64 + lane] = e;
        if (lane == 63) { Eall[2048 + c] = bc; Eall[2048 + 32 + c] = cm; } }
    f32x4 C[8];
#pragma unroll
    for (int kt = 0; kt < 8; ++kt) C[kt] = (f32x4){0.f, 0.f, 0.f, 0.f};
    float mc = 0.f;
    __syncthreads();
    for (int c = 0; c < 32; ++c) {
        {
            float wt[5][8];
#pragma unroll
            for (int j = 0; j < 5; ++j) { const f32x4 a = *(const LAS f32x4*)(cw + j * 128 + 8 * cs), bb = *(const LAS f32x4*)(cw + j * 128 + 8 * cs + 4);
                wt[j][0] = a[0]; wt[j][1] = a[1]; wt[j][2] = a[2]; wt[j][3] = a[3]; wt[j][4] = bb[0]; wt[j][5] = bb[1]; wt[j][6] = bb[2]; wt[j][7] = bb[3]; }
            LAS unsigned char* dst = Ks + (2 * rg) * MQ_STRIDE + 16 * cs;
#pragma unroll
            for (int r = 0; r < 2; ++r) {
                float ov[8];
#pragma unroll
                for (int e = 0; e < 8; ++e) ov[e] = wt[4][e];
#pragma unroll
                for (int j = 0; j < 4; ++j) { const u32x4 x = cr[r + j];
                    ov[0] += wt[j][0] * bflo(x.x); ov[1] += wt[j][1] * bfhi(x.x); ov[2] += wt[j][2] * bflo(x.y); ov[3] += wt[j][3] * bfhi(x.y);
                    ov[4] += wt[j][4] * bflo(x.z); ov[5] += wt[j][5] * bfhi(x.z); ov[6] += wt[j][6] * bflo(x.w); ov[7] += wt[j][7] * bfhi(x.w); }
#pragma unroll
                for (int e = 0; e < 8; ++e) ov[e] = 0.08838834764831845f * ov[e] * __builtin_amdgcn_rcpf(1.f + __expf(-ov[e]));
                u32x4 o4; o4.x = pk2(ov[0], ov[1]); o4.y = pk2(ov[2], ov[3]); o4.z = pk2(ov[4], ov[5]); o4.w = pk2(ov[6], ov[7]);
                *(LAS u32x4*)(dst + r * MQ_STRIDE) = o4;
            }
            LAS unsigned char* vd = Vs + srow * MV_STRIDE + sseg * 32; *(LAS u32x4*)vd = vr0; *(LAS u32x4*)(vd + 16) = vr1;
            if (w == 0) {
                const float g63 = fmaxf(mc, Eall[2048 + 32 + c]);
                sm[SM_W + lane] = __expf(Eall[c * 64 + lane] - g63);
                if (lane == 63) { sm[SM_X] = __expf(mc - g63); sm[SM_X + 1] = Eall[2048 + c] + g63; }
            }
        }
        __syncthreads();
        { const int cn = (c + 1 < 32) ? c + 1 : 31; MS_PREFETCH(cn); }
        {
            const int item = bh * 32 + c;
#pragma unroll
            for (int k2 = 0; k2 < 4; ++k2) CST[((size_t)(item * 8 + w) * 4 + k2) * 64 + lane] = __builtin_bit_cast(u32x4, pack8(C[2 * k2], C[2 * k2 + 1]));
            if (tid < 128) NST[item * 128 + tid] = sm[SM_N + tid];
            if (tid == 0) MCg[item] = mc;
            LAS float* wS = sm + SM_W;
            const float decay = sm[SM_X];
            bf16x8 vfw[2];
#pragma unroll
            for (int ks = 0; ks < 2; ++ks) {
                LAS unsigned char* a0 = Vs + (32 * ks + 8 * g + (l15 >> 2)) * MV_STRIDE + (16 * w + 4 * (lane & 3)) * 2;
                const bf16x8 vf = cat8(vtr(a0), vtr(a0 + 4 * MV_STRIDE));
                const f32x4 w0 = *(const LAS f32x4*)(wS + 32 * ks + 8 * g), w1 = *(const LAS f32x4*)(wS + 32 * ks + 8 * g + 4);
                const u32x4 vu = __builtin_bit_cast(u32x4, vf);
                u32x4 o4; o4.x = pk2(bflo(vu.x) * w0[0], bfhi(vu.x) * w0[1]); o4.y = pk2(bflo(vu.y) * w0[2], bfhi(vu.y) * w0[3]);
                o4.z = pk2(bflo(vu.z) * w1[0], bfhi(vu.z) * w1[1]); o4.w = pk2(bflo(vu.w) * w1[2], bfhi(vu.w) * w1[3]);
                vfw[ks] = __builtin_bit_cast(bf16x8, o4);
            }
#pragma unroll
            for (int kt = 0; kt < 8; ++kt) C[kt] = C[kt] * decay;
#pragma unroll
            for (int ks = 0; ks < 2; ++ks)
#pragma unroll
                for (int kt = 0; kt < 8; ++kt) { LAS unsigned char* a0 = Ks + (32 * ks + 8 * g + (l15 >> 2)) * MQ_STRIDE + (16 * kt + 4 * (lane & 3)) * 2;
                    const bf16x8 ka = cat8(vtr(a0), vtr(a0 + 4 * MQ_STRIDE)); C[kt] = MFMA16(ka, vfw[ks], C[kt]); }
            { const int kd = tid & 127, sq = tid >> 7; float s = 0.f;
#pragma unroll
              for (int i = 0; i < 16; ++i) { const int s_ = 16 * sq + i; s += wS[s_] * __uint_as_float((unsigned)(*(const LAS bf16_t*)(Ks + s_ * MQ_STRIDE + kd * 2)) << 16); }
              sm[SM_NP + sq * 128 + kd] = s; }
            mc = sm[SM_X + 1];
            __syncthreads();
            if (tid < 128) sm[SM_N + tid] = decay * sm[SM_N + tid] + ((sm[SM_NP + tid] + sm[SM_NP + 128 + tid]) + (sm[SM_NP + 256 + tid] + sm[SM_NP + 384 + tid]));
        }
    }
#undef MS_PREFETCH
    __syncthreads();
}

__device__ __forceinline__ void mlstm_out(const Args& A, LAS unsigned char* lds, int item, int& last_h) {
    int tid_o = threadIdx.x; asm volatile("" : "+v"(tid_o)); const int tid = tid_o, lane = tid & 63, w = tid >> 6, g = lane >> 4, l15 = lane & 15;
    const int bh = item >> 5, c = item & 31, b = bh >> 2, h = bh & 3;
    const bf16_t* P = (const bf16_t*)(A.ws + WS_P);
    bf16_t* ACT = (bf16_t*)(A.ws + WS_ACT);
    const float* GATES = (const float*)(A.ws + WS_GATES);
    const u32x4* CST = (const u32x4*)(A.ws + WS_CST); const float* NST = (const float*)(A.ws + WS_NST); const float* MCg = (const float*)(A.ws + WS_MC);
    LAS float* sm = (LAS float*)(lds + ML_SM);
    LAS float* cw = (LAS float*)(lds + ML_CW);
    LAS unsigned char* Qs = lds + ML_Q; LAS unsigned char* Ks = lds + ML_K; LAS unsigned char* Vs = lds + ML_V; LAS unsigned char* Ps = lds + ML_P;
    LAS float* Hn = (LAS float*)(lds + ML_H);
    LAS float* eS = sm + SM_E; LAS float* gS = sm + SM_G; LAS float* bS = sm + SM_B; LAS float* iS = sm + SM_I; LAS float* nS = sm + SM_N;
    const size_t rowbase = (size_t)b * SEQ;
    const int rg = tid >> 5, cs = tid & 31;
    const int ccol = (cs < 16 ? 0 : 512) + h * 128 + 8 * (cs & 15);
    const int srow = tid >> 3, sseg = tid & 7;
    u32x4 cr[7], vr0, vr1, mc0, mc1, cfr[4]; float gi = 0.f, gf = 0.f, nval = 0.f;
    { const int r0 = c * 64 + 4 * rg - 3;
#pragma unroll
      for (int i = 0; i < 7; ++i) { const int r = r0 + i; const u32x4 v_ = *(const u32x4*)(P + (rowbase + (r >= 0 ? r : 0)) * NP + ccol); cr[i] = (r >= 0) ? v_ : (u32x4){0u, 0u, 0u, 0u}; }
      const bf16_t* vp = P + (rowbase + c * 64 + srow) * NP + h * 128 + sseg * 16;
      vr0 = *(const u32x4*)(vp + 1024); vr1 = *(const u32x4*)(vp + 1032); mc0 = *(const u32x4*)(vp + 1536); mc1 = *(const u32x4*)(vp + 1544);
      if (w == 0) { const float* gp = GATES + (rowbase + c * 64 + lane) * 8 + h; gi = gp[0]; gf = gp[4]; }
#pragma unroll
      for (int k2 = 0; k2 < 4; ++k2) cfr[k2] = CST[((size_t)(item * 8 + w) * 4 + k2) * 64 + lane];
      if (tid < 128) nval = NST[item * 128 + tid]; }
    const float mc = MCg[item];
    if (h != last_h) {
        for (int i = tid; i < 1280; i += 512) { const int j = i >> 8, ch = i & 255, cch = (ch < 128 ? h * 128 + ch : 512 + h * 128 + ch - 128);
            cw[i] = (j < 4) ? A.conv_w[j * 1024 + cch] : A.conv_b[cch]; }
        last_h = h;
        __syncthreads();
    }
    {
        float wt[5][8];
#pragma unroll
        for (int j = 0; j < 5; ++j) { const f32x4 a = *(const LAS f32x4*)(cw + j * 256 + 8 * cs), bb = *(const LAS f32x4*)(cw + j * 256 + 8 * cs + 4);
            wt[j][0] = a[0]; wt[j][1] = a[1]; wt[j][2] = a[2]; wt[j][3] = a[3]; wt[j][4] = bb[0]; wt[j][5] = bb[1]; wt[j][6] = bb[2]; wt[j][7] = bb[3]; }
        const float osc = (cs < 16) ? 1.0f : 0.08838834764831845f;
        LAS unsigned char* dst = (cs < 16 ? Qs : Ks) + (4 * rg) * MQ_STRIDE + 16 * (cs & 15);
#pragma unroll
        for (int r = 0; r < 4; ++r) {
            float ov[8];
#pragma unroll
            for (int e = 0; e < 8; ++e) ov[e] = wt[4][e];
#pragma unroll
            for (int j = 0; j < 4; ++j) { const u32x4 x = cr[r + j];
                ov[0] += wt[j][0] * bflo(x.x); ov[1] += wt[j][1] * bfhi(x.x); ov[2] += wt[j][2] * bflo(x.y); ov[3] += wt[j][3] * bfhi(x.y);
                ov[4] += wt[j][4] * bflo(x.z); ov[5] += wt[j][5] * bfhi(x.z); ov[6] += wt[j][6] * bflo(x.w); ov[7] += wt[j][7] * bfhi(x.w); }
#pragma unroll
            for (int e = 0; e < 8; ++e) ov[e] = osc * ov[e] * __builtin_amdgcn_rcpf(1.f + __expf(-ov[e]));
            u32x4 o4; o4.x = pk2(ov[0], ov[1]); o4.y = pk2(ov[2], ov[3]); o4.z = pk2(ov[4], ov[5]); o4.w = pk2(ov[6], ov[7]);
            *(LAS u32x4*)(dst + r * MQ_STRIDE) = o4;
        }
        LAS unsigned char* vd = Vs + srow * MV_STRIDE + sseg * 32; *(LAS u32x4*)vd = vr0; *(LAS u32x4*)(vd + 16) = vr1;
        if (tid < 128) nS[tid] = nval;
        if (w == 0) {
            float bc = gf;
#pragma unroll
            for (int o = 1; o < 64; o <<= 1) { const float t = __shfl_up(bc, o); if (lane >= o) bc += t; }
            const float e = gi - bc; float cm = e;
#pragma unroll
            for (int o = 1; o < 64; o <<= 1) { const float t = __shfl_up(cm, o); if (lane >= o) cm = fmaxf(cm, t); }
            const float gt = fmaxf(mc, cm);
            eS[lane] = e; gS[lane] = gt; bS[lane] = bc; iS[lane] = __expf(mc - gt);
        }
    }
    __syncthreads();
    {
        const int st = w >> 1;
#pragma unroll
        for (int ti = 0; ti < 2; ++ti) { const int tt = 2 * (w & 1) + ti;
            f32x4 a = (f32x4){0.f, 0.f, 0.f, 0.f};
#pragma unroll
            for (int ks = 0; ks < 4; ++ks) { const bf16x8 kf = *(const LAS bf16x8*)(Ks + (16 * st + l15) * MQ_STRIDE + (32 * ks + 8 * g) * 2);
                const bf16x8 qf = *(const LAS bf16x8*)(Qs + (16 * tt + l15) * MQ_STRIDE + (32 * ks + 8 * g) * 2); a = MFMA16(kf, qf, a); }
            const int t = 16 * tt + l15; const float gt = gS[t];
            float pv[4];
#pragma unroll
            for (int r = 0; r < 4; ++r) { const int s_ = 16 * st + 4 * g + r; pv[r] = (s_ <= t) ? a[r] * __expf(eS[s_] - gt) : 0.f; }
            u32x2 pw; pw.x = pk2(pv[0], pv[1]); pw.y = pk2(pv[2], pv[3]);
            *(LAS u32x2*)(Ps + t * MP_STRIDE + (16 * st + 4 * g) * 2) = pw;
        }
    }
    __syncthreads();
    {
        f32x4 apv[4], aqc[4];
#pragma unroll
        for (int tt = 0; tt < 4; ++tt) { apv[tt] = (f32x4){0.f, 0.f, 0.f, 0.f}; aqc[tt] = (f32x4){0.f, 0.f, 0.f, 0.f}; }
#pragma unroll
        for (int ks = 0; ks < 2; ++ks) {
            LAS unsigned char* a0 = Vs + (32 * ks + 8 * g + (l15 >> 2)) * MV_STRIDE + (16 * w + 4 * (lane & 3)) * 2;
            const bf16x8 vf = cat8(vtr(a0), vtr(a0 + 4 * MV_STRIDE));
#pragma unroll
            for (int tt = 0; tt < 4; ++tt) { const bf16x8 pf = *(const LAS bf16x8*)(Ps + (16 * tt + l15) * MP_STRIDE + (32 * ks + 8 * g) * 2); apv[tt] = MFMA16(pf, vf, apv[tt]); }
        }
#pragma unroll
        for (int k2 = 0; k2 < 4; ++k2) {
            const bf16x8 cf = __builtin_bit_cast(bf16x8, cfr[k2]);
#pragma unroll
            for (int tt = 0; tt < 4; ++tt) { LAS unsigned char* qa = Qs + (16 * tt + l15) * MQ_STRIDE + (32 * k2 + 4 * g) * 2;
                const bf16x8 qf = cat8(*(const LAS s16x4*)qa, *(const LAS s16x4*)(qa + 32)); aqc[tt] = MFMA16(qf, cf, aqc[tt]); }
        }
#pragma unroll
        for (int tt = 0; tt < 4; ++tt)
#pragma unroll
            for (int r = 0; r < 4; ++r) { const int t = 16 * tt + 4 * g + r; Hn[t * MH_STRIDE + 16 * w + l15] = apv[tt][r] + iS[t] * aqc[tt][r]; }
        { const int t = srow, j = sseg;
          const u32x4 pr = *(const LAS u32x4*)(Ps + t * MP_STRIDE + 16 * j);
          float rs = (bflo(pr.x) + bfhi(pr.x)) + (bflo(pr.y) + bfhi(pr.y)) + (bflo(pr.z) + bfhi(pr.z)) + (bflo(pr.w) + bfhi(pr.w));
          const u32x4 q0 = *(const LAS u32x4*)(Qs + t * MQ_STRIDE + 32 * j), q1 = *(const LAS u32x4*)(Qs + t * MQ_STRIDE + 32 * j + 16);
          const f32x4 n0 = *(const LAS f32x4*)(nS + 16 * j), n1 = *(const LAS f32x4*)(nS + 16 * j + 4), n2 = *(const LAS f32x4*)(nS + 16 * j + 8), n3 = *(const LAS f32x4*)(nS + 16 * j + 12);
          float qn = bflo(q0.x) * n0[0] + bfhi(q0.x) * n0[1] + bflo(q0.y) * n0[2] + bfhi(q0.y) * n0[3] + bflo(q0.z) * n1[0] + bfhi(q0.z) * n1[1] + bflo(q0.w) * n1[2] + bfhi(q0.w) * n1[3]
                   + bflo(q1.x) * n2[0] + bfhi(q1.x) * n2[1] + bflo(q1.y) * n2[2] + bfhi(q1.y) * n2[3] + bflo(q1.z) * n3[0] + bfhi(q1.z) * n3[1] + bflo(q1.w) * n3[2] + bfhi(q1.w) * n3[3];
          float d = rs + iS[t] * qn;
          d += __shfl_xor(d, 1); d += __shfl_xor(d, 2); d += __shfl_xor(d, 4);
          if (j == 0) { const float fl = __expf(-(bS[t] + gS[t])); sm[SM_R + t] = 1.f / fmaxf(fabsf(d), fl); } }
    }
    __syncthreads();
    {
        const int t = srow, j = sseg; const float rd = sm[SM_R + t];
        float hv[16]; float ss = 0.f;
#pragma unroll
        for (int q = 0; q < 4; ++q) { const f32x4 x = *(const LAS f32x4*)(Hn + t * MH_STRIDE + 16 * j + 4 * q);
#pragma unroll
            for (int e = 0; e < 4; ++e) { const float v = x[e] * rd; hv[4 * q + e] = v; ss += v * v; } }
        ss += __shfl_xor(ss, 1); ss += __shfl_xor(ss, 2); ss += __shfl_xor(ss, 4);
        const float rstd = rsqrtf(ss * (1.f / 128.f) + 1e-6f);
        const unsigned mo[8] = {mc0.x, mc0.y, mc0.z, mc0.w, mc1.x, mc1.y, mc1.z, mc1.w};
        unsigned ow[8];
#pragma unroll
        for (int q = 0; q < 8; ++q) { const float g0 = A.mnorm_g[h * 128 + 16 * j + 2 * q], g1 = A.mnorm_g[h * 128 + 16 * j + 2 * q + 1];
            const float z0 = bflo(mo[q]), z1 = bfhi(mo[q]);
            ow[q] = pk2(hv[2 * q] * rstd * g0 * __builtin_amdgcn_rcpf(1.f + __expf(-z0)), hv[2 * q + 1] * rstd * g1 * __builtin_amdgcn_rcpf(1.f + __expf(-z1))); }
        bf16_t* op = ACT + (rowbase + c * 64 + t) * 1024 + h * 128 + 16 * j;
        *(u32x4*)op = (u32x4){ow[0], ow[1], ow[2], ow[3]}; *(u32x4*)(op + 8) = (u32x4){ow[4], ow[5], ow[6], ow[7]};
    }
}

__device__ __forceinline__ void phase3(const Args& A, LAS unsigned char* lds, int rep = 0) {
    const int tid = threadIdx.x;
    const float lam = ((const float*)(A.ws + WS_CTL))[1];
    unsigned* ctr = (unsigned*)(A.ws + WS_CTL) + 2 * rep;
    LAS int* slot = (LAS int*)(lds + LDS_BYTES - 64);
    {
        const int lane = tid & 63, wave = tid >> 6;
        const bf16_t* WT = (const bf16_t*)(A.ws + WS_WQ); const float* MOD = (const float*)(A.ws + WS_MOD); float* SB = (float*)(A.ws + WS_SB);
        for (int n = blockIdx.x * 8 + wave; n < 2048; n += gridDim.x * 8) {
            const u32x4 w0 = *(const u32x4*)(WT + (size_t)n * 1024 + 16 * lane), w1 = *(const u32x4*)(WT + (size_t)n * 1024 + 16 * lane + 8);
            const unsigned ww[8] = {w0.x, w0.y, w0.z, w0.w, w1.x, w1.y, w1.z, w1.w};
            float sbv[8];
#pragma unroll
            for (int b = 0; b < 8; ++b) { const float* sp = MOD + b * 6144 + 3072 + 16 * lane; float d = 0.f;
#pragma unroll
                for (int q = 0; q < 4; ++q) { const f32x4 s4 = *(const f32x4*)(sp + 4 * q); d += bflo(ww[2 * q]) * s4[0] + bfhi(ww[2 * q]) * s4[1] + bflo(ww[2 * q + 1]) * s4[2] + bfhi(ww[2 * q + 1]) * s4[3]; }
                sbv[b] = wave_sum(d); }
            if (lane == 0) {
#pragma unroll
                for (int b = 0; b < 8; ++b) SB[b * 2048 + n] = sbv[b]; }
        }
    }
    const int nml = ((int)gridDim.x > 64) ? 32 : 1;
    if ((int)blockIdx.x < nml) for (int bh = blockIdx.x; bh < 32; bh += nml) mlstm_state(A, lds, bh >> 2, bh & 3);
    for (;;) {
        if (tid == 0) slot[0] = (int)atomicAdd(ctr, 1u);
        __syncthreads();
        const int it = slot[0];
        __syncthreads();
        if (it >= 512) break;
        attn_item(A, lds, (it & 31) >> 2, it & 3, 15 - (it >> 5), lam);
    }
}
__device__ __forceinline__ void phase3b(const Args& A, LAS unsigned char* lds) {
    int last_h = -1;
    for (int item = blockIdx.x; item < 1024; item += gridDim.x) mlstm_out(A, lds, item, last_h);
    __syncthreads();
}

__device__ __forceinline__ void phase5(const Args& A) {
    int tid_o = threadIdx.x; asm volatile("" : "+v"(tid_o)); const int tid = tid_o, lane = tid & 63, wave = tid >> 6, G = gridDim.x;
    const float* MOD = (const float*)(A.ws + WS_MOD);
    bf16_t* ACT = (bf16_t*)(A.ws + WS_ACT);
    for (int m = blockIdx.x * 8 + wave; m < T; m += G * 8) {
        const int b = m >> 11;
        const f32x4* xr = (const f32x4*)(A.out + (size_t)m * 1024) + lane;
        f32x4 v[4]; float ss = 0.f;
#pragma unroll
        for (int j = 0; j < 4; ++j) { v[j] = xr[64 * j]; ss += (v[j][0] * v[j][0] + v[j][1] * v[j][1]) + (v[j][2] * v[j][2] + v[j][3] * v[j][3]); }
        const float rstd = rsqrtf(wave_sum(ss) * (1.f / 1024.f) + 1e-6f);
        unsigned long long* o8 = (unsigned long long*)(ACT + (size_t)m * 1024) + lane;
#pragma unroll
        for (int j = 0; j < 4; ++j) { const int col = 4 * lane + 256 * j;
            const f32x4 g = *(const f32x4*)(A.norm2_g + col), sc = *(const f32x4*)(MOD + b * 6144 + 4096 + col), sh = *(const f32x4*)(MOD + b * 6144 + 3072 + col);
            v[j] = v[j] * rstd * g * (sc + 1.0f) + sh;
            o8[64 * j] = (unsigned long long)pk2(v[j][0], v[j][1]) | ((unsigned long long)pk2(v[j][2], v[j][3]) << 32); }
    }
}

__device__ __forceinline__ unsigned f2key(float f) { const unsigned u = __float_as_uint(f); return (u & 0x80000000u) ? ~u : (u | 0x80000000u); }
__device__ __forceinline__ float key2f(unsigned k) { const unsigned u = (k & 0x80000000u) ? (k & 0x7fffffffu) : ~k; return __uint_as_float(u); }
#define CE_DESC(a, b) do { const unsigned _mx = (a) > (b) ? (a) : (b), _mn = (a) > (b) ? (b) : (a); (a) = _mx; (b) = _mn; } while (0)
__device__ __forceinline__ void sort16_desc(unsigned (&k)[16]) {
#pragma unroll
    for (int size = 2; size <= 16; size <<= 1)
#pragma unroll
        for (int stride = size >> 1; stride > 0; stride >>= 1)
#pragma unroll
            for (int i = 0; i < 16; ++i) { const int j = i ^ stride;
                if (j > i) { if ((i & size) == 0) CE_DESC(k[i], k[j]); else CE_DESC(k[j], k[i]); } }
}
__device__ __forceinline__ void merge16(unsigned (&a)[16], const unsigned (&b)[16]) {
#pragma unroll
    for (int i = 0; i < 16; ++i) a[i] = a[i] > b[15 - i] ? a[i] : b[15 - i];
#pragma unroll
    for (int stride = 8; stride > 0; stride >>= 1)
#pragma unroll
        for (int i = 0; i < 16; ++i) { const int j = i ^ stride; if (j > i) CE_DESC(a[i], a[j]); }
}
constexpr int PE_IDX = 0, PE_SEL = 69632;
__device__ __forceinline__ float gelu_erf(float v) { return 0.5f * v * (1.f + erff(v * 0.70710678118654752f)); }
__device__ __forceinline__ float gelu_fast(float v) {
    const float av = fabsf(v), tt = __builtin_amdgcn_rcpf(av * 0.2316418882f + 1.0f);
    float q = tt * 0.5307027145f + (-0.7265760135f); q = q * tt + 0.7107068705f; q = q * tt + (-0.142248368f); q = q * tt + 0.127414796f; q = q * tt;
    const float e = __builtin_amdgcn_exp2f((v * v) * (-0.72134752044f));
    const float m = v * (q * e);
    return v < 0.f ? m : v - m;
}

__device__ __forceinline__ void peer_tile(const Args& A, LAS unsigned char* lds, int tile) {
    int tid_o = threadIdx.x; asm volatile("" : "+v"(tid_o)); const int tid = tid_o, lane = tid & 63, w = tid >> 6, g = lane >> 4, l15 = lane & 15;
    const bf16_t* QRY = (const bf16_t*)(A.ws + WS_QRY);
    const bf16_t* KEYS = (const bf16_t*)(A.ws + WS_KEYS);
    const bf16_t* ACT = (const bf16_t*)(A.ws + WS_ACT);
    const float* MOD = (const float*)(A.ws + WS_MOD);
    LAS unsigned* idx = (LAS unsigned*)(lds + PE_IDX) + (w * 64 + lane) * 33;
    LAS u32x2* SEL = (LAS u32x2*)(lds + PE_SEL);
    {
        const int tg = w & 3, hg = w >> 2, tl = 16 * tg + l15;
        const size_t m = (size_t)tile * 64 + tl;
        unsigned LA[4][2][16];
#pragma unroll
        for (int hh = 0; hh < 4; ++hh) {
            const int h = 4 * hg + hh;
#pragma unroll
            for (int p = 0; p < 2; ++p) {
                const int hp = 2 * h + p;
                unsigned k0[16], k1[16];
                { const bf16_t* sp = QRY + m * 2048 + hp * 128 + 32 * g;
                  const u32x4 s0 = *(const u32x4*)sp, s1 = *(const u32x4*)(sp + 8), s2 = *(const u32x4*)(sp + 16), s3 = *(const u32x4*)(sp + 24);
                  const unsigned sw[16] = {s0.x, s0.y, s0.z, s0.w, s1.x, s1.y, s1.z, s1.w, s2.x, s2.y, s2.z, s2.w, s3.x, s3.y, s3.z, s3.w};
#pragma unroll
                  for (int i = 0; i < 16; ++i) {
                      const float lo = (float)__builtin_bit_cast(_Float16, (unsigned short)(sw[i] & 0xffffu)), hi = (float)__builtin_bit_cast(_Float16, (unsigned short)(sw[i] >> 16));
                      const unsigned klo = (f2key(lo) & ~127u) | (unsigned)(127 - (32 * g + 2 * i)), khi = (f2key(hi) & ~127u) | (unsigned)(127 - (32 * g + 2 * i + 1));
                      if (i < 8) { k0[2 * i] = klo; k0[2 * i + 1] = khi; } else { k1[2 * (i - 8)] = klo; k1[2 * (i - 8) + 1] = khi; } } }
                sort16_desc(k0); sort16_desc(k1); merge16(k0, k1);
#pragma unroll
                for (int msk = 16; msk <= 32; msk <<= 1) {
#pragma unroll
                    for (int i = 0; i < 16; ++i) k1[i] = (unsigned)__shfl_xor((int)k0[i], msk);
                    merge16(k0, k1); }
#pragma unroll
                for (int i = 0; i < 16; ++i) LA[hh][p][i] = k0[i];
            }
        }
        {
            const int h = 4 * hg + g;
            unsigned L2[2][16];
#pragma unroll
            for (int p = 0; p < 2; ++p)
#pragma unroll
                for (int i = 0; i < 16; ++i) L2[p][i] = (g & 2) ? ((g & 1) ? LA[3][p][i] : LA[2][p][i]) : ((g & 1) ? LA[1][p][i] : LA[0][p][i]);
            float va[16], vb[16];
#pragma unroll
            for (int i = 0; i < 16; ++i) { va[i] = key2f(L2[0][i] & ~127u); vb[i] = key2f(L2[1][i] & ~127u); idx[i] = 127u - (L2[0][i] & 127u); idx[16 + i] = 127u - (L2[1][i] & 127u); }
#define CK(i, j) ((f2key(va[i] + vb[j]) & ~255u) | (unsigned)(255 - (16 * (i) + (j))))
            unsigned Lf[16], Bt[16];
#pragma unroll
            for (int j = 0; j < 16; ++j) Lf[j] = CK(0, j);
#pragma unroll
            for (int j = 0; j < 8; ++j) Bt[j] = CK(1, j);
#pragma unroll
            for (int j = 0; j < 5; ++j) Bt[8 + j] = CK(2, j);
#pragma unroll
            for (int j = 0; j < 3; ++j) Bt[13 + j] = CK(4, j);
            sort16_desc(Bt); merge16(Lf, Bt);
#pragma unroll
            for (int j = 0; j < 4; ++j) Bt[j] = CK(3, j);
            Bt[4] = CK(5, 0); Bt[5] = CK(5, 1); Bt[6] = CK(6, 0); Bt[7] = CK(6, 1); Bt[8] = CK(7, 0); Bt[9] = CK(7, 1);
            Bt[10] = CK(8, 0); Bt[11] = CK(9, 0); Bt[12] = CK(10, 0); Bt[13] = CK(11, 0); Bt[14] = CK(12, 0); Bt[15] = CK(13, 0);
            sort16_desc(Bt); merge16(Lf, Bt);
            { unsigned x0 = CK(14, 0), x1 = CK(15, 0);
#pragma unroll
              for (int i = 0; i < 16; ++i) CE_DESC(Lf[i], x0);
#pragma unroll
              for (int i = 0; i < 16; ++i) CE_DESC(Lf[i], x1); }
#undef CK
            float fv[16], den = 0.f; const float f0 = key2f(Lf[0] & ~255u);
#pragma unroll
            for (int k = 0; k < 16; ++k) { fv[k] = __expf(key2f(Lf[k] & ~255u) - f0); den += fv[k]; }
            const float rden = 1.f / den;
            LDS_WAIT();
#pragma unroll
            for (int k = 0; k < 16; ++k) { const unsigned code = 255u - (Lf[k] & 255u); const unsigned e = idx[code >> 4] * 128u + idx[16 + (code & 15u)];
                u32x2 sv; sv.x = e; sv.y = __float_as_uint(fv[k] * rden); SEL[(tl * 8 + h) * 16 + k] = sv; }
        }
    }
    __syncthreads();
    const unsigned char* T8 = A.ws + WS_T8; const float* SC = (const float*)(A.ws + WS_SC);
    LAS u32x2* SORT = (LAS u32x2*)(lds + PE_IDX);
    LAS int* OFFS = (LAS int*)(lds + PE_SEL + 65536);
    for (int ti = 0; ti < 8; ++ti) {
        const int tl = 8 * w + ti;
        const u32x2 e0 = SEL[tl * 128 + lane], e1 = SEL[tl * 128 + 64 + lane];
        const int p0 = (int)(e0.x >> 10), p1 = (int)(e1.x >> 10);
        int off = 0;
        for (int p = 0; p < 16; ++p) {
            const unsigned long long m0 = __ballot(p0 == p), m1 = __ballot(p1 == p);
            const int c0 = __popcll(m0), c1 = __popcll(m1);
            const int r0 = __builtin_amdgcn_mbcnt_hi((unsigned)(m0 >> 32), __builtin_amdgcn_mbcnt_lo((unsigned)m0, 0u));
            const int r1 = __builtin_amdgcn_mbcnt_hi((unsigned)(m1 >> 32), __builtin_amdgcn_mbcnt_lo((unsigned)m1, 0u));
            if (p0 == p) SORT[tl * 128 + off + r0] = e0;
            if (p1 == p) SORT[tl * 128 + off + c0 + r1] = e1;
            if (lane == 0) OFFS[tl * 17 + p] = off;
            off += c0 + c1;
        }
        if (lane == 0) OFFS[tl * 17 + 16] = off;
    }
    LDS_WAIT(); __builtin_amdgcn_wave_barrier();
    const unsigned char* T8v = T8 + (size_t)16384 * 1024;
    const bf16_t* A3 = (const bf16_t*)(A.ws + WS_A3); const float* RSq = (const float*)(A.ws + WS_RS);
    for (int pass = 0; pass < 2; ++pass) {
        const int tb = 8 * w + 4 * pass;
        u32x4 xpa[4], xpb[4]; f32x2 oacc[4][8];
#pragma unroll
        for (int tk = 0; tk < 4; ++tk) { const size_t m = (size_t)tile * 64 + tb + tk;
            { const u32x4 ra = *(const u32x4*)(A3 + m * 1024 + 16 * lane), rb = *(const u32x4*)(A3 + m * 1024 + 16 * lane + 8);
              float xr_; { const f32x4 p0 = *(const f32x4*)(RSq + m * 16), p1 = *(const f32x4*)(RSq + m * 16 + 4), p2 = *(const f32x4*)(RSq + m * 16 + 8), p3 = *(const f32x4*)(RSq + m * 16 + 12);
                const f32x4 ps = (p0 + p1) + (p2 + p3); xr_ = rsqrtf(((ps[0] + ps[1]) + (ps[2] + ps[3])) * (1.f / 1024.f) + 1e-6f); }
              const unsigned rr[8] = {ra.x, ra.y, ra.z, ra.w, rb.x, rb.y, rb.z, rb.w}; unsigned hh[8];
              const float* sp = MOD + (int)(m >> 11) * 6144 + 3072 + 16 * lane;
#pragma unroll
              for (int q = 0; q < 8; ++q) { const f32x2 sh = *(const f32x2*)(sp + 2 * q); hh[q] = pk2(bflo(rr[q]) * xr_ + sh[0], bfhi(rr[q]) * xr_ + sh[1]); }
              xpa[tk] = (u32x4){hh[0], hh[1], hh[2], hh[3]}; xpb[tk] = (u32x4){hh[4], hh[5], hh[6], hh[7]}; }
#pragma unroll
            for (int q = 0; q < 8; ++q) oacc[tk][q] = (f32x2){0.f, 0.f}; }
        int it_p = 0, it_tk = -1, it_j = 0, it_end = 0; bool it_done = false;
#define IT_ADVANCE() do { it_j += 4; while (it_j >= it_end) { if (it_done) break; ++it_tk; if (it_tk == 4) { it_tk = 0; ++it_p; if (it_p == 16) { it_done = true; it_p = 15; it_j = 0; it_end = 1; break; } } \
            it_j = __builtin_amdgcn_readfirstlane(OFFS[(tb + it_tk) * 17 + it_p]); it_end = __builtin_amdgcn_readfirstlane(OFFS[(tb + it_tk) * 17 + it_p + 1]); } } while (0)
#define LOAD_SET(U, V, CG, SU, SV) do { const int _tl = tb + it_tk; \
            _Pragma("unroll") for (int _k = 0; _k < 4; ++_k) { const int _jj = (it_j + _k < it_end) ? it_j + _k : it_end - 1; const unsigned _e = SORT[_tl * 128 + _jj].x; \
                U[_k] = *(const u32x4*)(T8 + (size_t)_e * 1024 + 16 * lane); V[_k] = *(const u32x4*)(T8v + (size_t)_e * 1024 + 16 * lane); } \
            const int _ms = lane >> 4; const bool _valid = it_j + _ms < it_end; const u32x2 _se = SORT[_tl * 128 + (_valid ? it_j + _ms : it_end - 1)]; \
            CG = _valid ? __uint_as_float(_se.y) : 0.f; SU = SC[_se.x]; SV = SC[16384 + _se.x]; } while (0)
        u32x4 uA[4], vA[4], uB[4], vB[4]; float cgA = 0.f, suA = 0.f, svA = 0.f, cgB = 0.f, suB = 0.f, svB = 0.f;
#pragma unroll
        for (int k = 0; k < 4; ++k) { uA[k] = (u32x4){0u, 0u, 0u, 0u}; vA[k] = uA[k]; uB[k] = uA[k]; vB[k] = uA[k]; }
        IT_ADVANCE();
        LOAD_SET(uA, vA, cgA, suA, svA);
        for (int p = 0; p < 16; ++p) {
#pragma unroll
            for (int tk = 0; tk < 4; ++tk) {
                const int tl = tb + tk;
                const int beg = __builtin_amdgcn_readfirstlane(OFFS[tl * 17 + p]), end = __builtin_amdgcn_readfirstlane(OFFS[tl * 17 + p + 1]);
                f32x2 xf[8];
                { const unsigned xx[8] = {xpa[tk].x, xpa[tk].y, xpa[tk].z, xpa[tk].w, xpb[tk].x, xpb[tk].y, xpb[tk].z, xpb[tk].w};
#pragma unroll
                  for (int q = 0; q < 8; ++q) xf[q] = (f32x2){bflo(xx[q]), bfhi(xx[q])}; }
#define COMPUTE_SET(U, V, CG, SU, SV) do { float pd[4]; \
                    _Pragma("unroll") for (int k = 0; k < 4; ++k) { f32x2 d = (f32x2){0.f, 0.f}; \
                        _Pragma("unroll") for (int q = 0; q < 4; ++q) { const int dw = (int)U[k][q]; \
                            d += __builtin_amdgcn_cvt_pk_f32_fp8(dw, false) * xf[2 * q]; d += __builtin_amdgcn_cvt_pk_f32_fp8(dw, true) * xf[2 * q + 1]; } \
                        pd[k] = d[0] + d[1]; } \
                    float s; \
                    { const auto r0 = __builtin_amdgcn_permlane32_swap(__float_as_uint(pd[0]), __float_as_uint(pd[2]), false, false); \
                      const auto r1 = __builtin_amdgcn_permlane32_swap(__float_as_uint(pd[1]), __float_as_uint(pd[3]), false, false); \
                      const float a0 = __uint_as_float(r0[0]) + __uint_as_float(r0[1]), a1 = __uint_as_float(r1[0]) + __uint_as_float(r1[1]); \
                      const auto r2 = __builtin_amdgcn_permlane16_swap(__float_as_uint(a0), __float_as_uint(a1), false, false); \
                      s = __uint_as_float(r2[0]) + __uint_as_float(r2[1]); \
                      s += __int_as_float(__builtin_amdgcn_mov_dpp(__float_as_int(s), 0xB1, 0xF, 0xF, true)); \
                      s += __int_as_float(__builtin_amdgcn_mov_dpp(__float_as_int(s), 0x4E, 0xF, 0xF, true)); \
                      s += __int_as_float(__builtin_amdgcn_mov_dpp(__float_as_int(s), 0x141, 0xF, 0xF, true)); \
                      s += __int_as_float(__builtin_amdgcn_mov_dpp(__float_as_int(s), 0x140, 0xF, 0xF, true)); } \
                    const float coef = CG * gelu_fast(s * SU) * SV; \
                    _Pragma("unroll") for (int k = 0; k < 4; ++k) { const float ck = __int_as_float(__builtin_amdgcn_readlane(__float_as_int(coef), 16 * k)); const f32x2 ck2 = (f32x2){ck, ck}; \
                        _Pragma("unroll") for (int qq = 0; qq < 4; ++qq) { const int dw = (int)V[k][qq]; \
                            oacc[tk][2 * qq] += ck2 * __builtin_amdgcn_cvt_pk_f32_fp8(dw, false); oacc[tk][2 * qq + 1] += ck2 * __builtin_amdgcn_cvt_pk_f32_fp8(dw, true); } } } while (0)
                for (int j0 = beg; j0 < end; j0 += 8) {
                    IT_ADVANCE();
                    LOAD_SET(uB, vB, cgB, suB, svB);
                    COMPUTE_SET(uA, vA, cgA, suA, svA);
                    if (j0 + 4 < end) {
                        IT_ADVANCE();
                        LOAD_SET(uA, vA, cgA, suA, svA);
                        COMPUTE_SET(uB, vB, cgB, suB, svB);
                    } else {
#pragma unroll
                        for (int k = 0; k < 4; ++k) { uA[k] = uB[k]; vA[k] = vB[k]; }
                        cgA = cgB; suA = suB; svA = svB;
                    }
                }
            }
        }
#undef COMPUTE_SET
#undef IT_ADVANCE
#undef LOAD_SET
#pragma unroll
        for (int tk = 0; tk < 4; ++tk) {
            const size_t m = (size_t)tile * 64 + tb + tk; const int b = (int)(m >> 11);
            float* orow = A.out + m * 1024 + 16 * lane;
            const float* g2 = MOD + b * 6144 + 5120 + 16 * lane;
            f32x4 xv[4]; float ss = 0.f;
#pragma unroll
            for (int j = 0; j < 4; ++j) { const f32x4 x1 = *(const f32x4*)(orow + 4 * j), gg = *(const f32x4*)(g2 + 4 * j);
                const f32x4 pe = (f32x4){oacc[tk][2 * j][0], oacc[tk][2 * j][1], oacc[tk][2 * j + 1][0], oacc[tk][2 * j + 1][1]};
                xv[j] = x1 + gg * pe; ss += (xv[j][0] * xv[j][0] + xv[j][1] * xv[j][1]) + (xv[j][2] * xv[j][2] + xv[j][3] * xv[j][3]); }
            const float rstd = rsqrtf(wave_sum(ss) * (1.f / 1024.f) + 1e-6f);
#pragma unroll
            for (int j = 0; j < 4; ++j) { const f32x4 fg = *(const f32x4*)(A.final_g + 16 * lane + 4 * j); *(f32x4*)(orow + 4 * j) = xv[j] * rstd * fg; }
        }
    }
    __syncthreads();
}


#define XB_TMO      128
#define XB_XCNT(j)  (256  + 64 * (j))
#define XB_XSUB(j)  (1280 + 64 * (j))
#define XB_XGEN(j)  (2304 + 64 * (j))
#define XB_TOP      3328
#define XB_TOPGEN   3392
#define XCD_BAR_WORDS 3456
#define XB_SPIN_CAP (1u << 18)

__device__ __forceinline__ unsigned xb_ld(unsigned* p)              { return __hip_atomic_load(p, __ATOMIC_RELAXED, __HIP_MEMORY_SCOPE_AGENT); }
__device__ __forceinline__ unsigned xb_add(unsigned* p, unsigned v) { return __hip_atomic_fetch_add(p, v, __ATOMIC_RELAXED, __HIP_MEMORY_SCOPE_AGENT); }
__device__ __forceinline__ unsigned xb_xcc_id() { return (unsigned)__builtin_amdgcn_s_getreg((3 << 11) | 20) & 0xFu; }
#define XB_SPIN(cond, bar) do { unsigned _sp = 0; while (cond) { __builtin_amdgcn_s_sleep(1); \
    if ((++_sp & 255u) == 0u) { if (xb_ld(&(bar)[XB_TMO])) break; if (_sp > XB_SPIN_CAP) { atomicAdd(&(bar)[XB_TMO], 1u); break; } } } } while (0)

struct XcdBarrier {
    unsigned* bar; unsigned x;
    volatile LAS unsigned* st;
};

__device__ __forceinline__ XcdBarrier xcd_barrier_post(unsigned* bar, volatile LAS unsigned* st) {
    XcdBarrier b; b.bar = bar; b.x = xb_xcc_id(); b.st = st;
    if (threadIdx.x == 0) (void)xb_add(&bar[XB_XCNT(b.x)], 1u);
    return b;
}
__device__ __forceinline__ void xcd_barrier_complete(unsigned* bar, unsigned x, unsigned& nloc, unsigned& nx) {
    const unsigned G = gridDim.x * gridDim.y * gridDim.z;
    unsigned sum, cnt, mine, sp = 0u;
    for (;;) {
        sum = 0u; cnt = 0u; mine = 0u;
#pragma unroll
        for (unsigned j = 0; j < 16; ++j) { const unsigned c = xb_ld(&bar[XB_XCNT(j)]); sum += c; cnt += (c > 0u) ? 1u : 0u; mine = (j == x) ? c : mine; }
        if (sum == G) break;
        __builtin_amdgcn_s_sleep(1);
        if ((++sp & 255u) == 0u) { if (xb_ld(&bar[XB_TMO])) break; if (sp > XB_SPIN_CAP) { atomicAdd(&bar[XB_TMO], 1u); break; } }
    }
    nloc = mine > 0u ? mine : 1u; nx = cnt > 0u ? cnt : 1u;
}

__device__ __forceinline__ void xcd_barrier(const XcdBarrier& b) {
    asm volatile("s_waitcnt vmcnt(0)" ::: "memory");
    __syncthreads();
    if (threadIdx.x == 0) {
        unsigned* bar = b.bar;
        __builtin_amdgcn_s_waitcnt(0);
        unsigned nloc = b.st[0], nx = b.st[1];
        if (nloc == 0u) { xcd_barrier_complete(bar, b.x, nloc, nx); b.st[0] = nloc; b.st[1] = nx; }
        const unsigned old = xb_add(&bar[XB_XSUB(b.x)], 1u);
        const unsigned gen = old / nloc;
        if (old + 1u == (gen + 1u) * nloc) {
            __builtin_amdgcn_fence(__ATOMIC_RELEASE, "agent");
            asm volatile("s_waitcnt vmcnt(0)" ::: "memory");
            const unsigned og = xb_add(&bar[XB_TOP], 1u);
            const unsigned tg = og / nx;
            if (og + 1u == (tg + 1u) * nx) xb_add(&bar[XB_TOPGEN], 1u);
            else XB_SPIN(xb_ld(&bar[XB_TOPGEN]) == tg, bar);
            __builtin_amdgcn_fence(__ATOMIC_ACQUIRE, "agent");
            xb_add(&bar[XB_XGEN(b.x)], 1u);
            asm volatile("s_waitcnt vmcnt(0)" ::: "memory");
        } else {
            XB_SPIN(xb_ld(&bar[XB_XGEN(b.x)]) == gen, bar);
            __builtin_amdgcn_fence(__ATOMIC_ACQUIRE, "agent");
            asm volatile("s_waitcnt vmcnt(0)" ::: "memory");
        }
    }
    __syncthreads();
}

__global__ void __launch_bounds__(512, 2) mega_fwd(Args A) {
    extern __shared__ __attribute__((aligned(16))) unsigned char lds_raw[];
    LAS unsigned char* lds = (LAS unsigned char*)lds_raw;
    cg::grid_group grid = cg::this_grid();
    const int G = gridDim.x;
    if (threadIdx.x < 4) ((LAS unsigned*)(lds + LDS_BYTES - 32))[threadIdx.x] = 0u;
    __syncthreads();
    if (A.ws == nullptr) grid.sync();
    const XcdBarrier xb = xcd_barrier_post((unsigned*)(A.ws + WS_BAR), (volatile LAS unsigned*)(lds + LDS_BYTES - 32));
    phase0(A, lds);
    xcd_barrier(xb);
    phase1(A, lds);
    phase0b(A, lds);
    xcd_barrier(xb);
    { pg8::Gemm gm{(const pg8::bf16_t*)(A.ws + WS_ACT), (const pg8::bf16_t*)(A.ws + WS_WIN), T, NP, DM}; pg8::StaticOrder S; S.init(T, NP, G, (int)blockIdx.x);
      pg8::EpiStoreBf16 E{(pg8::bf16_t*)(A.ws + WS_P), NP};
      pg8::gemm_phase<pg8::EpiStoreBf16, pg8::StaticOrder, true, true>((PG8_LAS unsigned char*)lds, gm, S, E); }
    { const int nshort = G - (896 % G == 0 ? 0 : 896 % G);
      const int first = G - nshort;
      if ((int)blockIdx.x >= first) quantise_tables(A, ((int)blockIdx.x - first) * 8 + (int)(threadIdx.x >> 6), nshort * 8); }
    xcd_barrier(xb);
    phase3(A, lds);
    xcd_barrier(xb);
    phase3b(A, lds);
    xcd_barrier(xb);
    { pg8::Gemm gm{(const pg8::bf16_t*)(A.ws + WS_ACT), (const pg8::bf16_t*)(A.ws + WS_WOUT), T, DM, DM}; pg8::StaticOrder S; S.init(T, DM, G, (int)blockIdx.x);
      pg8::EpiResidNorm E{A.x, (const float*)(A.ws + WS_MOD), A.norm2_g, A.out, (pg8::bf16_t*)(A.ws + WS_A3), (float*)(A.ws + WS_RS)};
      pg8::gemm_phase<pg8::EpiResidNorm, pg8::StaticOrder, true, true>((PG8_LAS unsigned char*)lds, gm, S, E); }
    xcd_barrier(xb);
    { pg8::Gemm gm{(const pg8::bf16_t*)(A.ws + WS_A3), (const pg8::bf16_t*)(A.ws + WS_WQ), T, 2048, DM}; pg8::StaticOrder S; S.init(T, 2048, G, (int)blockIdx.x);
      pg8::EpiScoreF16 E{(pg8::bf16_t*)(A.ws + WS_QRY), 2048, (const float*)(A.ws + WS_RS), (const float*)(A.ws + WS_SB)};
      pg8::gemm_phase<pg8::EpiScoreF16, pg8::StaticOrder, true, true>((PG8_LAS unsigned char*)lds, gm, S, E); }
    xcd_barrier(xb);
    for (int tile = blockIdx.x; tile < T / 64; tile += G) peer_tile(A, lds, tile);
}

extern "C" void kernel_launch(void* const* d_in, const int* in_sizes, int n_in, void* d_out, int out_size, void* d_ws, size_t ws_size, hipStream_t stream) {
    static int grid = 0;
    if (grid == 0) {
        if (n_in != 22 || out_size != T * DM || ws_size < WS_END) { fprintf(stderr, "kernel_launch: unexpected shapes (n_in %d out %d ws %zu)\n", n_in, out_size, ws_size); grid = -1; return; }
        int dev = 0, cus = 0, per_cu = 0;
        if (hipGetDevice(&dev) != hipSuccess || hipDeviceGetAttribute(&cus, hipDeviceAttributeMultiprocessorCount, dev) != hipSuccess) { grid = -1; return; }
        if (hipFuncSetAttribute((const void*)mega_fwd, hipFuncAttributeMaxDynamicSharedMemorySize, LDS_BYTES) != hipSuccess) { fprintf(stderr, "kernel_launch: hipFuncSetAttribute failed\n"); grid = -1; return; }
        if (hipOccupancyMaxActiveBlocksPerMultiprocessor(&per_cu, (const void*)mega_fwd, 512, LDS_BYTES) != hipSuccess || per_cu < 1) { fprintf(stderr, "kernel_launch: occupancy query gave %d\n", per_cu); per_cu = 1; }
        (void)hipGetLastError();
        grid = cus * per_cu;
    }
    if (grid < 0) return;
    Args a{};
    const float** ap = (const float**)&a;
    for (int i = 0; i < 22; ++i) ap[i] = (const float*)d_in[i];
    a.out = (float*)d_out; a.ws = (unsigned char*)d_ws;
    if (hipMemsetAsync((unsigned char*)d_ws + WS_BAR, 0, XCD_BAR_WORDS * sizeof(unsigned), stream) != hipSuccess) { fprintf(stderr, "kernel_launch: memset of the barrier words failed\n"); return; }
    void* args[] = {&a};
    hipError_t e = hipLaunchCooperativeKernel((const void*)mega_fwd, dim3(grid), dim3(512), args, LDS_BYTES, stream);
    if (e != hipSuccess) fprintf(stderr, "kernel_launch: cooperative launch failed: %s (grid %d)\n", hipGetErrorString(e), grid);
}
```

```cpp
#include <hip/hip_runtime.h>
#include <hip/hip_cooperative_groups.h>
#include <cstdio>
#include <cstdint>
namespace cg = cooperative_groups;

namespace pg8 {
#define PG8_LAS __attribute__((address_space(3)))
typedef unsigned short bf16_t;
typedef short bf16x8 __attribute__((ext_vector_type(8)));
typedef float f32x4 __attribute__((ext_vector_type(4)));
typedef unsigned u32x4 __attribute__((ext_vector_type(4)));
constexpr int BM = 256, BK = 64, HALF = 128, HTB = HALF * BK * 2  , STAGE_BYTES = 8 * HTB, NXCD = 8, WGM = 8;

__host__ __device__ __forceinline__ int lds_byte(int r, int c) { const int st = (r >> 4) * 2 + (c >> 5), rr = r & 15, cc = c & 31, ob = rr * 64 + cc * 2; return st * 1024 + (ob ^ (((ob >> 9) & 1) << 5)); }
__host__ __device__ __forceinline__ void stage_rc(int b, int& R, int& C) { const int st = b / 1024, sb = b % 1024, swz = sb ^ (((sb >> 9) & 1) << 5); R = (st >> 1) * 16 + swz / 64; C = (st & 1) * 32 + (swz % 64) / 2; }
__host__ __device__ __forceinline__ int perm32(int rho) { const int n = rho >> 4, i = rho & 15; return 8 * (i >> 2) + 4 * n + (i & 3); }

struct Unit { int pm, pn; };
struct Gemm { const bf16_t* A; const bf16_t* Bt; int M, N, K; };

struct StaticOrder {
    int nM, nN, nwg, G, c;
    __host__ __device__ void init(int M, int N, int G_, int c_) { nM = M / BM; nN = N / BM; nwg = nM * nN; G = G_; c = c_; }
    __host__ __device__ bool next(int i, Unit& u) const {
        const long L = (long)i * G + c; if (L >= nwg) return false;
        int wgid = (int)L; { const int q = nwg / NXCD, r = nwg % NXCD, xcd = wgid % NXCD, off = wgid / NXCD; wgid = (xcd < r ? xcd * (q + 1) : r * (q + 1) + (xcd - r) * q) + off; }
        const int nig = WGM * nN, gid = wgid / nig, fm = gid * WGM, gsz = (nM - fm) < WGM ? (nM - fm) : WGM;
        u.pm = fm + ((wgid % nig) % gsz); u.pn = (wgid % nig) / gsz; return true;
    }
    __device__ __forceinline__ void a_ready(const Unit&) const {}
    __device__ __forceinline__ void done(const Unit&) const {}
};

__device__ __forceinline__ unsigned cvt_pk_bf16(float lo, float hi) { unsigned r; asm volatile("v_cvt_pk_bf16_f32 %0, %1, %2" : "=v"(r) : "v"(lo), "v"(hi)); return r; }

struct EpiStoreBf16 {
    static constexpr bool PERM = true, AFTER_DRAIN = false;
    bf16_t* O; int ldc;
    __device__ __forceinline__ void operator()(const f32x4 (&acc)[2][2][4][2], const Unit& u, int wr, int wc, int fr, int fq) const {
        const int row0 = u.pm * BM + wr * 64 + fr, col0 = u.pn * BM + wc * 32 + 8 * fq;
#pragma unroll
        for (int ai = 0; ai < 2; ++ai)
#pragma unroll
            for (int m = 0; m < 4; ++m) { bf16_t* rowp = O + (size_t)(row0 + ai * HALF + m * 16) * ldc + col0;
#pragma unroll
                for (int bj = 0; bj < 2; ++bj) { const f32x4 v0 = acc[ai][bj][m][0], v1 = acc[ai][bj][m][1];
                    u32x4 w; w.x = cvt_pk_bf16(v0[0], v0[1]); w.y = cvt_pk_bf16(v0[2], v0[3]); w.z = cvt_pk_bf16(v1[0], v1[1]); w.w = cvt_pk_bf16(v1[2], v1[3]);
                    *(u32x4*)(rowp + bj * HALF) = w; } }
    }
};
struct EpiStoreF16 {
    static constexpr bool PERM = true, AFTER_DRAIN = false;
    bf16_t* O; int ldc;
    static __device__ __forceinline__ unsigned pkh(float a, float b) { return (unsigned)__builtin_bit_cast(unsigned short, (_Float16)a) | ((unsigned)__builtin_bit_cast(unsigned short, (_Float16)b) << 16); }
    __device__ __forceinline__ void operator()(const f32x4 (&acc)[2][2][4][2], const Unit& u, int wr, int wc, int fr, int fq) const {
        const int row0 = u.pm * BM + wr * 64 + fr, col0 = u.pn * BM + wc * 32 + 8 * fq;
#pragma unroll
        for (int ai = 0; ai < 2; ++ai)
#pragma unroll
            for (int m = 0; m < 4; ++m) { bf16_t* rowp = O + (size_t)(row0 + ai * HALF + m * 16) * ldc + col0;
#pragma unroll
                for (int bj = 0; bj < 2; ++bj) { const f32x4 v0 = acc[ai][bj][m][0], v1 = acc[ai][bj][m][1];
                    u32x4 w; w.x = pkh(v0[0], v0[1]); w.y = pkh(v0[2], v0[3]); w.z = pkh(v1[0], v1[1]); w.w = pkh(v1[2], v1[3]);
                    *(u32x4*)(rowp + bj * HALF) = w; } }
    }
};
struct EpiResid {
    static constexpr bool PERM = true, AFTER_DRAIN = false;
    const float* x; const float* gate; float* out;
    __device__ __forceinline__ void operator()(const f32x4 (&acc)[2][2][4][2], const Unit& u, int wr, int wc, int fr, int fq) const {
        const int row0 = u.pm * BM + wr * 64 + fr, col0 = u.pn * BM + wc * 32 + 8 * fq;
#pragma unroll
        for (int ai = 0; ai < 2; ++ai)
#pragma unroll
            for (int m = 0; m < 4; ++m) { const int r = row0 + ai * HALF + m * 16; const float* gp = gate + (size_t)(r >> 11) * 6144;
#pragma unroll
                for (int bj = 0; bj < 2; ++bj) { const int c = col0 + bj * HALF;
                    const f32x4 xa = *(const f32x4*)(x + (size_t)r * 1024 + c), xb = *(const f32x4*)(x + (size_t)r * 1024 + c + 4);
                    const f32x4 ga = *(const f32x4*)(gp + c), gb = *(const f32x4*)(gp + c + 4);
                    *(f32x4*)(out + (size_t)r * 1024 + c) = xa + ga * acc[ai][bj][m][0];
                    *(f32x4*)(out + (size_t)r * 1024 + c + 4) = xb + gb * acc[ai][bj][m][1]; } }
    }
};
struct EpiResidNorm {
    static constexpr bool PERM = true, AFTER_DRAIN = false;
    const float* x; const float* mod; const float* ng; float* out; bf16_t* a3; float* rs;
    __device__ __forceinline__ void operator()(const f32x4 (&acc)[2][2][4][2], const Unit& u, int wr, int wc, int fr, int fq) const {
        const int row0 = u.pm * BM + wr * 64 + fr, col0 = u.pn * BM + wc * 32 + 8 * fq;
        const float* mp = mod + (size_t)((u.pm * BM) >> 11) * 6144;
        f32x4 g1v[2][2], csv[2][2];
#pragma unroll
        for (int bj = 0; bj < 2; ++bj)
#pragma unroll
            for (int n = 0; n < 2; ++n) { const int c = col0 + bj * HALF + 4 * n; g1v[bj][n] = *(const f32x4*)(mp + 2048 + c); csv[bj][n] = *(const f32x4*)(ng + c) * (*(const f32x4*)(mp + 4096 + c) + 1.0f); }
#pragma unroll
        for (int ai = 0; ai < 2; ++ai)
#pragma unroll
            for (int m = 0; m < 4; ++m) { const int r = row0 + ai * HALF + m * 16; float ss = 0.f;
#pragma unroll
                for (int bj = 0; bj < 2; ++bj) { const int c = col0 + bj * HALF;
                    const f32x4 xa = *(const f32x4*)(x + (size_t)r * 1024 + c), xb = *(const f32x4*)(x + (size_t)r * 1024 + c + 4);
                    const f32x4 v0 = xa + g1v[bj][0] * acc[ai][bj][m][0], v1 = xb + g1v[bj][1] * acc[ai][bj][m][1];
                    *(f32x4*)(out + (size_t)r * 1024 + c) = v0; *(f32x4*)(out + (size_t)r * 1024 + c + 4) = v1;
                    ss += (v0[0] * v0[0] + v0[1] * v0[1]) + (v0[2] * v0[2] + v0[3] * v0[3]) + (v1[0] * v1[0] + v1[1] * v1[1]) + (v1[2] * v1[2] + v1[3] * v1[3]);
                    const f32x4 a0 = v0 * csv[bj][0], a1 = v1 * csv[bj][1];
                    u32x4 w; w.x = cvt_pk_bf16(a0[0], a0[1]); w.y = cvt_pk_bf16(a0[2], a0[3]); w.z = cvt_pk_bf16(a1[0], a1[1]); w.w = cvt_pk_bf16(a1[2], a1[3]);
                    *(u32x4*)(a3 + (size_t)r * 1024 + c) = w; }
                ss += __shfl_xor(ss, 16); ss += __shfl_xor(ss, 32);
                if (fq == 0) rs[(size_t)r * 16 + (u.pn & 3) * 4 + wc] = ss; }
    }
};
struct EpiScoreF16 {
    static constexpr bool PERM = true, AFTER_DRAIN = false;
    bf16_t* O; int ldc; const float* rs; const float* sb;
    static __device__ __forceinline__ unsigned pkh(float a, float b) { return (unsigned)__builtin_bit_cast(unsigned short, (_Float16)a) | ((unsigned)__builtin_bit_cast(unsigned short, (_Float16)b) << 16); }
    __device__ __forceinline__ void operator()(const f32x4 (&acc)[2][2][4][2], const Unit& u, int wr, int wc, int fr, int fq) const {
        const int row0 = u.pm * BM + wr * 64 + fr, col0 = u.pn * BM + wc * 32 + 8 * fq;
        const float* sbp = sb + (size_t)((u.pm * BM) >> 11) * 2048;
        f32x4 bv[2][2];
#pragma unroll
        for (int bj = 0; bj < 2; ++bj)
#pragma unroll
            for (int n = 0; n < 2; ++n) bv[bj][n] = *(const f32x4*)(sbp + col0 + bj * HALF + 4 * n);
#pragma unroll
        for (int ai = 0; ai < 2; ++ai)
#pragma unroll
            for (int m = 0; m < 4; ++m) { const int r = row0 + ai * HALF + m * 16;
                float rstd; { const f32x4 p0 = *(const f32x4*)(rs + (size_t)r * 16), p1 = *(const f32x4*)(rs + (size_t)r * 16 + 4), p2 = *(const f32x4*)(rs + (size_t)r * 16 + 8), p3 = *(const f32x4*)(rs + (size_t)r * 16 + 12);
                  const f32x4 ps = (p0 + p1) + (p2 + p3); rstd = rsqrtf(((ps[0] + ps[1]) + (ps[2] + ps[3])) * (1.f / 1024.f) + 1e-6f); }
                bf16_t* rowp = O + (size_t)r * ldc + col0;
#pragma unroll
                for (int bj = 0; bj < 2; ++bj) { const f32x4 v0 = acc[ai][bj][m][0] * rstd + bv[bj][0], v1 = acc[ai][bj][m][1] * rstd + bv[bj][1];
                    u32x4 w; w.x = pkh(v0[0], v0[1]); w.y = pkh(v0[2], v0[3]); w.z = pkh(v1[0], v1[1]); w.w = pkh(v1[2], v1[3]);
                    *(u32x4*)(rowp + bj * HALF) = w; } }
    }
};
template <class Epi, class Sched, bool ALIGN_EPI = false, bool SP2 = false>
__device__ __forceinline__ void gemm_phase(PG8_LAS unsigned char* lds, const Gemm g, const Sched& S, const Epi& E) {
    int tid_o = threadIdx.x; asm volatile("" : "+v"(tid_o)); const int tid = tid_o, wid = __builtin_amdgcn_readfirstlane(tid >> 6), lane = tid & 63, wr = wid >> 2, wc = wid & 3, fr = lane & 15, fq = lane >> 4;
    const int K = g.K, nt = K / BK;
    unsigned voffA[2], voffB[2];
#pragma unroll
    for (int i = 0; i < 2; ++i) { int R, C; stage_rc(tid * 16 + i * 8192, R, C); const int Rb = Epi::PERM ? ((R & ~31) + perm32(R & 31)) : R;
        voffA[i] = (unsigned)(R * K + C) * 2u; voffB[i] = (unsigned)(Rb * K + C) * 2u; }
    const size_t kstep = (size_t)(BK * 2);
    const size_t hstep = (size_t)HALF * K * 2;
    const size_t tstep = 2 * hstep;
    const unsigned ldsw = (unsigned)wid * 1024u;
    const int aoff = lds_byte(wr * 64 + fr, fq * 8), boff = lds_byte(wc * 32 + fr, fq * 8);
#define PG8_SA(b, h) (((b) * 2 + (h)) * HTB)
#define PG8_SB(b, h) ((4 + (b) * 2 + (h)) * HTB)
#define PG8_STAGE(bufoff, gbase, voff) do { _Pragma("unroll") for (int _i = 0; _i < 2; ++_i) \
        __builtin_amdgcn_global_load_lds((const unsigned*)((const char*)(gbase) + (voff)[_i]), (PG8_LAS unsigned*)(lds + (bufoff) + ldsw + _i * 8192), 16, 0, 0); } while (0)
#define PG8_LDA(dst, b, h) do { _Pragma("unroll") for (int m = 0; m < 4; ++m) _Pragma("unroll") for (int k = 0; k < 2; ++k) dst[m][k] = *(const PG8_LAS bf16x8*)(lds + PG8_SA(b, h) + aoff + m * 2048 + k * 1024); } while (0)
#define PG8_LDB(dst, b, h) do { _Pragma("unroll") for (int n = 0; n < 2; ++n) _Pragma("unroll") for (int k = 0; k < 2; ++k) dst[n][k] = *(const PG8_LAS bf16x8*)(lds + PG8_SB(b, h) + boff + n * 2048 + k * 1024); } while (0)
#define PG8_MMA(ai, bj, At, Bt) do { __builtin_amdgcn_s_setprio(1); _Pragma("unroll") for (int m = 0; m < 4; ++m) _Pragma("unroll") for (int n = 0; n < 2; ++n) _Pragma("unroll") for (int k = 0; k < 2; ++k) \
        acc[ai][bj][m][n] = __builtin_amdgcn_mfma_f32_16x16x32_bf16(Bt[n][k], At[m][k], acc[ai][bj][m][n], 0, 0, 0); __builtin_amdgcn_s_setprio(0); } while (0)
#define PG8_WAIT_V(n) asm volatile("s_waitcnt vmcnt(" #n ")" ::: "memory")
#define PG8_WAIT_L(n) asm volatile("s_waitcnt lgkmcnt(" #n ")" ::: "memory")
#define PG8_BAR __builtin_amdgcn_s_barrier()
#define PG8_SCHED __builtin_amdgcn_sched_barrier(0)
    Unit cur, nxt; int ui = 0;
    if (!S.next(0, cur)) return;
    f32x4 acc[2][2][4][2];
#pragma unroll
    for (int a = 0; a < 2; ++a)
#pragma unroll
        for (int b = 0; b < 2; ++b)
#pragma unroll
            for (int m = 0; m < 4; ++m)
#pragma unroll
                for (int n = 0; n < 2; ++n) acc[a][b][m][n] = (f32x4){0.f, 0.f, 0.f, 0.f};
    bf16x8 At[4][2], B0[2][2], B1[2][2];
    const char* cA = (const char*)g.A + (size_t)cur.pm * tstep; const char* cB = (const char*)g.Bt + (size_t)cur.pn * tstep;
    S.a_ready(cur);
    if constexpr (SP2) {
        PG8_STAGE(PG8_SB(0, 0), cB, voffB); PG8_STAGE(PG8_SB(0, 1), cB + hstep, voffB); PG8_STAGE(PG8_SA(0, 0), cA, voffA); PG8_STAGE(PG8_SA(0, 1), cA + hstep, voffA);
        if (wr == 1) PG8_BAR;
        PG8_WAIT_V(2); PG8_BAR;
        PG8_STAGE(PG8_SB(1, 0), cB + kstep, voffB); PG8_STAGE(PG8_SA(1, 0), cA + kstep, voffA); PG8_STAGE(PG8_SB(1, 1), cB + hstep + kstep, voffB);
        PG8_WAIT_V(6); PG8_BAR;
    } else {
        PG8_STAGE(PG8_SB(0, 0), cB, voffB); PG8_STAGE(PG8_SA(0, 0), cA, voffA); PG8_STAGE(PG8_SB(0, 1), cB + hstep, voffB); PG8_STAGE(PG8_SA(0, 1), cA + hstep, voffA);
        if (wr == 1) PG8_BAR;
        PG8_WAIT_V(4); PG8_BAR;
        PG8_STAGE(PG8_SB(1, 0), cB + kstep, voffB); PG8_STAGE(PG8_SA(1, 0), cA + kstep, voffA); PG8_STAGE(PG8_SB(1, 1), cB + hstep + kstep, voffB);
        PG8_WAIT_V(6); PG8_BAR;
    }
    for (;;) {
        const bool has_next = S.next(ui + 1, nxt);
        const char* nA = has_next ? (const char*)g.A + (size_t)nxt.pm * tstep : cA; const char* nB = has_next ? (const char*)g.Bt + (size_t)nxt.pn * tstep : cB;
        for (int t = 0; t < nt; t += 2) {
            const bool last = (t == nt - 2);
            const char* a1 = cA + (size_t)(t + 1) * kstep;
            const char* a2 = last ? nA : cA + (size_t)(t + 2) * kstep; const char* b2 = last ? nB : cB + (size_t)(t + 2) * kstep;
            const char* a3 = a2 + kstep; const char* b3 = b2 + kstep;
            if (last && has_next) S.a_ready(nxt);
            if constexpr (SP2) {
            PG8_LDB(B0, 0, 0); PG8_LDB(B1, 0, 1); PG8_SCHED; PG8_LDA(At, 0, 0); PG8_STAGE(PG8_SA(1, 1), a1 + hstep, voffA);
            PG8_WAIT_V(8); PG8_WAIT_L(0); PG8_BAR; PG8_MMA(0, 0, At, B0); PG8_MMA(0, 1, At, B1); PG8_BAR; PG8_SCHED;
            PG8_LDA(At, 0, 1); PG8_STAGE(PG8_SB(0, 0), b2, voffB); PG8_STAGE(PG8_SB(0, 1), b2 + hstep, voffB); PG8_STAGE(PG8_SA(0, 0), a2, voffA);
            PG8_WAIT_V(8); PG8_WAIT_L(0); PG8_BAR; PG8_MMA(1, 0, At, B0); PG8_MMA(1, 1, At, B1); PG8_BAR; PG8_SCHED;
            PG8_LDB(B0, 1, 0); PG8_LDB(B1, 1, 1); PG8_SCHED; PG8_LDA(At, 1, 0); PG8_STAGE(PG8_SA(0, 1), a2 + hstep, voffA);
            PG8_WAIT_V(8); PG8_WAIT_L(0); PG8_BAR; PG8_MMA(0, 0, At, B0); PG8_MMA(0, 1, At, B1); PG8_BAR; PG8_SCHED;
            PG8_LDA(At, 1, 1); PG8_STAGE(PG8_SB(1, 0), b3, voffB); PG8_STAGE(PG8_SB(1, 1), b3 + hstep, voffB); PG8_STAGE(PG8_SA(1, 0), a3, voffA);
            PG8_WAIT_V(8); PG8_WAIT_L(0); PG8_BAR; PG8_MMA(1, 0, At, B0); PG8_MMA(1, 1, At, B1); PG8_BAR; PG8_SCHED;
            } else {
            PG8_LDB(B0, 0, 0); PG8_SCHED; PG8_LDA(At, 0, 0); PG8_STAGE(PG8_SA(1, 1), a1 + hstep, voffA);
            PG8_WAIT_L(8); PG8_BAR; PG8_WAIT_L(0); PG8_MMA(0, 0, At, B0); PG8_BAR; PG8_SCHED;
            PG8_LDB(B1, 0, 1); PG8_STAGE(PG8_SB(0, 0), b2, voffB);
            PG8_BAR; PG8_WAIT_L(0); PG8_MMA(0, 1, At, B1); PG8_BAR;
            PG8_LDA(At, 0, 1); PG8_STAGE(PG8_SA(0, 0), a2, voffA);
            PG8_BAR; PG8_WAIT_L(0); PG8_MMA(1, 0, At, B0); PG8_BAR; PG8_SCHED;
            PG8_STAGE(PG8_SB(0, 1), b2 + hstep, voffB);
            PG8_WAIT_V(6); PG8_BAR; PG8_MMA(1, 1, At, B1); PG8_BAR;
            PG8_LDB(B0, 1, 0); PG8_SCHED; PG8_LDA(At, 1, 0); PG8_STAGE(PG8_SA(0, 1), a2 + hstep, voffA);
            PG8_WAIT_L(8); PG8_BAR; PG8_WAIT_L(0); PG8_MMA(0, 0, At, B0); PG8_BAR; PG8_SCHED;
            PG8_LDB(B1, 1, 1); PG8_STAGE(PG8_SB(1, 0), b3, voffB);
            PG8_BAR; PG8_WAIT_L(0); PG8_MMA(0, 1, At, B1); PG8_BAR;
            PG8_LDA(At, 1, 1); PG8_STAGE(PG8_SA(1, 0), a3, voffA);
            PG8_BAR; PG8_WAIT_L(0); PG8_MMA(1, 0, At, B0); PG8_BAR; PG8_SCHED;
            PG8_STAGE(PG8_SB(1, 1), b3 + hstep, voffB);
            PG8_WAIT_V(6); PG8_BAR; PG8_MMA(1, 1, At, B1); PG8_BAR;
            }
        }
        if constexpr (ALIGN_EPI) { if (wr == 0) PG8_BAR; }
        if constexpr (!Epi::AFTER_DRAIN) { E(acc, cur, wr, wc, fr, fq); S.done(cur); }
        if (!has_next) break;
#pragma unroll
        for (int a = 0; a < 2; ++a)
#pragma unroll
            for (int b = 0; b < 2; ++b)
#pragma unroll
                for (int m = 0; m < 4; ++m)
#pragma unroll
                    for (int n = 0; n < 2; ++n) acc[a][b][m][n] = (f32x4){0.f, 0.f, 0.f, 0.f};
        cur = nxt; cA = nA; cB = nB; ++ui;
        if constexpr (ALIGN_EPI) { if (wr == 1) PG8_BAR; }
    }
    PG8_WAIT_V(0);
    if constexpr (!ALIGN_EPI) { if (wr == 0) PG8_BAR; }
    PG8_BAR;
    if constexpr (Epi::AFTER_DRAIN) { E.fused(acc, cur, wr, wc, fr, fq, lds, wid, lane); S.done(cur); }
#undef PG8_SA
#undef PG8_SB
#undef PG8_STAGE
#undef PG8_LDA
#undef PG8_LDB
#undef PG8_MMA
#undef PG8_WAIT_V
#undef PG8_WAIT_L
#undef PG8_BAR
#undef PG8_SCHED
}
}


#define LAS __attribute__((address_space(3)))
typedef unsigned short bf16_t;
typedef short bf16x8 __attribute__((ext_vector_type(8)));
typedef short s16x4 __attribute__((ext_vector_type(4)));
typedef short v4i16_t __attribute__((ext_vector_type(4)));
typedef float f32x4 __attribute__((ext_vector_type(4)));
typedef unsigned u32x4 __attribute__((ext_vector_type(4)));
typedef unsigned u32x2 __attribute__((ext_vector_type(2)));
typedef float f32x2 __attribute__((ext_vector_type(2)));

constexpr int T = 16384, DM = 1024, SEQ = 2048, NP = 3584;
constexpr size_t MiB = 1u << 20;
constexpr size_t WS_CTL = 0, WS_MOD = 4096, WS_GATES = 262144, WS_KEYS = 1 * MiB, WS_WIN = 2 * MiB, WS_WOUT = 9 * MiB, WS_WQ = 11 * MiB,
                 WS_T8 = 16 * MiB, WS_SC = 48 * MiB, WS_ACT = 80 * MiB, WS_P = 112 * MiB, WS_QRY = 112 * MiB, WS_END = 256 * MiB;
constexpr size_t WS_RS = 208 * MiB, WS_SB = 851968, WS_WGT = 917504, WS_A3 = 176 * MiB;
constexpr int LDS_BYTES = 147456;

__device__ __forceinline__ unsigned f2bf(float f) { unsigned u = __float_as_uint(f); return (u + 0x7fffu + ((u >> 16) & 1u)) >> 16; }
typedef __bf16 bf16x2_t __attribute__((ext_vector_type(2)));
__device__ __forceinline__ unsigned pk2(float lo, float hi) { const f32x2 v = {lo, hi}; const bf16x2_t b = __builtin_convertvector(v, bf16x2_t); return __builtin_bit_cast(unsigned, b); }
__device__ __forceinline__ float bflo(unsigned u) { return __uint_as_float(u << 16); }
__device__ __forceinline__ float bfhi(unsigned u) { return __uint_as_float(u & 0xffff0000u); }
__device__ __forceinline__ float wave_sum(float v) {
    { const auto r = __builtin_amdgcn_permlane32_swap(__float_as_uint(v), __float_as_uint(v), false, false); v = __uint_as_float(r[0]) + __uint_as_float(r[1]); }
    { const auto r = __builtin_amdgcn_permlane16_swap(__float_as_uint(v), __float_as_uint(v), false, false); v = __uint_as_float(r[0]) + __uint_as_float(r[1]); }
    v += __int_as_float(__builtin_amdgcn_mov_dpp(__float_as_int(v), 0xB1, 0xF, 0xF, true));
    v += __int_as_float(__builtin_amdgcn_mov_dpp(__float_as_int(v), 0x4E, 0xF, 0xF, true));
    v += __int_as_float(__builtin_amdgcn_mov_dpp(__float_as_int(v), 0x141, 0xF, 0xF, true));
    v += __int_as_float(__builtin_amdgcn_mov_dpp(__float_as_int(v), 0x140, 0xF, 0xF, true));
    return v;
}
__device__ __forceinline__ float xrow_max(float v) {
    { const auto r = __builtin_amdgcn_permlane16_swap(__float_as_uint(v), __float_as_uint(v), false, false); v = fmaxf(__uint_as_float(r[0]), __uint_as_float(r[1])); }
    { const auto r = __builtin_amdgcn_permlane32_swap(__float_as_uint(v), __float_as_uint(v), false, false); v = fmaxf(__uint_as_float(r[0]), __uint_as_float(r[1])); }
    return v;
}
__device__ __forceinline__ float xrow_sum(float v) {
    { const auto r = __builtin_amdgcn_permlane16_swap(__float_as_uint(v), __float_as_uint(v), false, false); v = __uint_as_float(r[0]) + __uint_as_float(r[1]); }
    { const auto r = __builtin_amdgcn_permlane32_swap(__float_as_uint(v), __float_as_uint(v), false, false); v = __uint_as_float(r[0]) + __uint_as_float(r[1]); }
    return v;
}
#define LDS_WAIT() asm volatile("s_waitcnt lgkmcnt(0)" ::: "memory")
__device__ __forceinline__ s16x4 vtr(LAS unsigned char* p) { return __builtin_bit_cast(s16x4, __builtin_amdgcn_ds_read_tr16_b64_v4i16((LAS v4i16_t*)p)); }
__device__ __forceinline__ bf16x8 cat8(s16x4 a, s16x4 b) { bf16x8 r; r[0] = a[0]; r[1] = a[1]; r[2] = a[2]; r[3] = a[3]; r[4] = b[0]; r[5] = b[1]; r[6] = b[2]; r[7] = b[3]; return r; }
__device__ __forceinline__ bf16x8 pack8(const f32x4 a, const f32x4 b) { u32x4 w; w.x = pk2(a[0], a[1]); w.y = pk2(a[2], a[3]); w.z = pk2(b[0], b[1]); w.w = pk2(b[2], b[3]); return __builtin_bit_cast(bf16x8, w); }
#define MFMA16(a, b, c) __builtin_amdgcn_mfma_f32_16x16x32_bf16((a), (b), (c), 0, 0, 0)

struct Args {
    const float *x, *c, *ada_w, *ada_b, *norm1_g, *w_in, *conv_w, *conv_b, *gate_b, *mnorm_g, *lq1, *lk1, *lq2, *lk2, *dnorm_g, *w_out, *norm2_g, *wq, *keys, *pu, *pv, *final_g;
    float* out; unsigned char* ws;
};

__device__ __forceinline__ void transpose_item(const float* W, int srcN, int soff, bf16_t* WT, LAS float* scr, int kb, int nb, int lane) {
    const int k0 = 64 * kb, n0 = 32 * nb;
    { f32x4 wv[8];
#pragma unroll
      for (int i = 0; i < 8; ++i) wv[i] = *(const f32x4*)(W + (size_t)(k0 + 8 * i + (lane >> 3)) * srcN + n0 + soff + 4 * (lane & 7));
#pragma unroll
      for (int i = 0; i < 8; ++i) { LAS float* d = scr + (8 * i + (lane >> 3)) * 33 + 4 * (lane & 7); d[0] = wv[i][0]; d[1] = wv[i][1]; d[2] = wv[i][2]; d[3] = wv[i][3]; } }
    LDS_WAIT(); asm volatile("" ::: "memory");
    const int c = lane & 7;
#pragma unroll
    for (int j = 0; j < 4; ++j) { const int n = (lane >> 3) + 8 * j; const LAS float* s = scr + (8 * c) * 33 + n;
        u32x4 o; o.x = pk2(s[0 * 33], s[1 * 33]); o.y = pk2(s[2 * 33], s[3 * 33]); o.z = pk2(s[4 * 33], s[5 * 33]); o.w = pk2(s[6 * 33], s[7 * 33]);
        *(u32x4*)(WT + (size_t)(n0 + n) * 1024 + k0 + 8 * c) = o; }
    LDS_WAIT(); asm volatile("" ::: "memory");
}

__device__ __forceinline__ bf16x8 pack8_sw(const f32x4 a, const f32x4 b) {
    u32x4 w; w.x = f2bf(a[0]) | (f2bf(a[1]) << 16); w.y = f2bf(a[2]) | (f2bf(a[3]) << 16); w.z = f2bf(b[0]) | (f2bf(b[1]) << 16); w.w = f2bf(b[2]) | (f2bf(b[3]) << 16); return __builtin_bit_cast(bf16x8, w); }
__device__ __forceinline__ void wprime_item(const Args& A, int hp, int kt, int lane) {
    const int g = lane >> 4, l15 = lane & 15;
    f32x4 acc[8];
#pragma unroll
    for (int nt = 0; nt < 8; ++nt) acc[nt] = (f32x4){0.f, 0.f, 0.f, 0.f};
#pragma unroll
    for (int ks = 0; ks < 4; ++ks) {
        const float* ap = A.wq + (size_t)(16 * kt + l15) * 2048 + hp * 128 + 32 * ks + 8 * g;
        const bf16x8 a = pack8(*(const f32x4*)ap, *(const f32x4*)(ap + 4));
#pragma unroll
        for (int nt = 0; nt < 8; ++nt) { const float* bp = A.keys + (size_t)(hp * 128 + 16 * nt + l15) * 128 + 32 * ks + 8 * g;
            const bf16x8 b = pack8(*(const f32x4*)bp, *(const f32x4*)(bp + 4)); acc[nt] = MFMA16(a, b, acc[nt]); }
    }
    bf16_t* WT = (bf16_t*)(A.ws + WS_WQ);
#pragma unroll
    for (int nt = 0; nt < 8; ++nt) { u32x2 o; o.x = pk2(acc[nt][0], acc[nt][1]); o.y = pk2(acc[nt][2], acc[nt][3]);
        *(u32x2*)(WT + (size_t)(hp * 128 + 16 * nt + l15) * 1024 + 16 * kt + 4 * g) = o; }
}

__device__ __forceinline__ void phase0(const Args& A, LAS unsigned char* lds) {
    int tid_o = threadIdx.x; asm volatile("" : "+v"(tid_o)); const int tid = tid_o, lane = tid & 63, wave = tid >> 6, G = gridDim.x;
    float* MOD = (float*)(A.ws + WS_MOD);
    if ((int)blockIdx.x < 192) {
        LAS float* sc = (LAS float*)lds;
        for (int i = tid; i < 8192; i += 512) { const float v = A.c[i]; sc[i] = v * __builtin_amdgcn_rcpf(1.f + __expf(-v)); }
        __syncthreads();
        for (int item = blockIdx.x; item < 192; item += G) {
            const int j0 = item * 32, kg = tid >> 3, cq = tid & 7;
            f32x4 wv[16];
#pragma unroll
            for (int kk = 0; kk < 16; ++kk) wv[kk] = *(const f32x4*)(A.ada_w + (size_t)(kg * 16 + kk) * 6144 + j0 + 4 * cq);
            f32x4 acc[8];
#pragma unroll
            for (int b = 0; b < 8; ++b) acc[b] = (f32x4){0.f, 0.f, 0.f, 0.f};
#pragma unroll
            for (int b = 0; b < 8; ++b)
#pragma unroll
                for (int k4 = 0; k4 < 4; ++k4) { const f32x4 s4 = *(const LAS f32x4*)(sc + b * 1024 + kg * 16 + 4 * k4);
                    acc[b] += wv[4 * k4] * s4[0]; acc[b] += wv[4 * k4 + 1] * s4[1]; acc[b] += wv[4 * k4 + 2] * s4[2]; acc[b] += wv[4 * k4 + 3] * s4[3]; }
            LAS float* part = (LAS float*)(lds + 32768);
#pragma unroll
            for (int b = 0; b < 8; ++b) *(LAS f32x4*)(part + (kg * 8 + b) * 32 + 4 * cq) = acc[b];
            __syncthreads();
            if (tid < 256) { const int b = tid >> 5, col = tid & 31; float s = A.ada_b[j0 + col];
              for (int k2 = 0; k2 < 64; ++k2) s += part[(k2 * 8 + b) * 32 + col];
              MOD[b * 6144 + j0 + col] = s; }
            __syncthreads();
        }
    }
    for (int i = (G - 1 - (int)blockIdx.x) * 512 + tid; i < 8192; i += G * 512) { const int gc = i >> 10, k = i & 1023; ((float*)(A.ws + WS_WGT))[i] = A.w_in[(size_t)k * 3592 + 2048 + gc]; }
    if (blockIdx.x == 0 && tid == 0) {
        float s1 = 0.f, s2 = 0.f;
        for (int i = 0; i < 64; ++i) { s1 += A.lq1[i] * A.lk1[i]; s2 += A.lq2[i] * A.lk2[i]; }
        ((float*)(A.ws + WS_CTL))[1] = expf(s1) - expf(s2) + 0.2f;
        ((unsigned*)(A.ws + WS_CTL))[0] = 0u; ((unsigned*)(A.ws + WS_CTL))[2] = 0u;
    }
}

__device__ __forceinline__ void phase0b(const Args& A, LAS unsigned char* lds) {
    int tid_o = threadIdx.x; asm volatile("" : "+v"(tid_o)); const int tid = tid_o, lane = tid & 63, wave = tid >> 6, G = gridDim.x;
    __syncthreads();
    {
        LAS float* scr = (LAS float*)(lds + wave * 16384);
        const int gw = blockIdx.x * 8 + wave, NGW = G * 8;
        for (int it = gw; it < 3328; it += NGW) {
            int r = it;
            if (r < 1792) { const int kb = r / 112, nb = r % 112; transpose_item(A.w_in, 3592, nb >= 64 ? 8 : 0, (bf16_t*)(A.ws + WS_WIN), scr, kb, nb, lane); continue; }
            r -= 1792;
            if (r < 512) { transpose_item(A.w_out, 1024, 0, (bf16_t*)(A.ws + WS_WOUT), scr, r / 32, r % 32, lane); continue; }
            r -= 512;
            wprime_item(A, r >> 6, r & 63, lane);
        }
    }
    {
        for (int i = blockIdx.x * 512 + tid; i < 32768; i += G * 512) {
            const f32x4 a = *(const f32x4*)(A.keys + (size_t)i * 8), b = *(const f32x4*)(A.keys + (size_t)i * 8 + 4);
            u32x4 o; o.x = pk2(a[0], a[1]); o.y = pk2(a[2], a[3]); o.z = pk2(b[0], b[1]); o.w = pk2(b[2], b[3]);
            *(u32x4*)((bf16_t*)(A.ws + WS_KEYS) + (size_t)i * 8) = o;
        }
    }
}

__device__ __forceinline__ void quantise_tables(const Args& A, int gw, int NGW) {
    int tid_o = threadIdx.x; asm volatile("" : "+v"(tid_o)); const int lane = tid_o & 63;
    unsigned char* T8 = A.ws + WS_T8; float* SC = (float*)(A.ws + WS_SC);
#pragma unroll 1
    for (int row = gw; row < 32768; row += 4 * NGW) {
        f32x4 v[4][4]; int rr[4];
#pragma unroll
        for (int q = 0; q < 4; ++q) { const int r = row + q * NGW; rr[q] = r; const int rc = r < 32768 ? r : row;
            const float* s = (rc < 16384 ? A.pu + (size_t)rc * 1024 : A.pv + (size_t)(rc - 16384) * 1024) + 16 * lane;
#pragma unroll
            for (int j = 0; j < 4; ++j) v[q][j] = *(const f32x4*)(s + 4 * j); }
#pragma unroll
        for (int q = 0; q < 4; ++q) {
            float mx = 0.f;
#pragma unroll
            for (int j = 0; j < 4; ++j)
#pragma unroll
                for (int e = 0; e < 4; ++e) mx = fmaxf(mx, fabsf(v[q][j][e]));
#pragma unroll
            for (int o = 1; o < 64; o <<= 1) mx = fmaxf(mx, __shfl_xor(mx, o));
            const float sc = fmaxf(mx, 1e-30f) * (1.f / 256.f), inv = 1.f / sc;
            u32x4 o4;
#pragma unroll
            for (int j = 0; j < 4; ++j) { int w0 = __builtin_amdgcn_cvt_pk_fp8_f32(v[q][j][0] * inv, v[q][j][1] * inv, 0, false); w0 = __builtin_amdgcn_cvt_pk_fp8_f32(v[q][j][2] * inv, v[q][j][3] * inv, w0, true); o4[j] = (unsigned)w0; }
            if (rr[q] < 32768) { *(u32x4*)(T8 + (size_t)rr[q] * 1024 + 16 * lane) = o4; if (lane == 0) SC[rr[q]] = sc; }
        }
    }
}

__device__ __forceinline__ void phase1(const Args& A, LAS unsigned char* lds) {
    int tid_o = threadIdx.x; asm volatile("" : "+v"(tid_o)); const int tid = tid_o, lane = tid & 63, wave = tid >> 6, G = gridDim.x;
    const float* MOD = (const float*)(A.ws + WS_MOD);
    bf16_t* ACT = (bf16_t*)(A.ws + WS_ACT);
    float* GATES = (float*)(A.ws + WS_GATES);
    LAS float* WG = (LAS float*)lds;
    for (int i = tid; i < 8192; i += 512) WG[i] = ((const float*)(A.ws + WS_WGT))[i];
    __syncthreads();
    f32x4 vn[4];
    { const int m0 = blockIdx.x * 8 + wave; if (m0 < T) { const f32x4* xr = (const f32x4*)(A.x + (size_t)m0 * 1024) + lane;
#pragma unroll
        for (int j = 0; j < 4; ++j) vn[j] = xr[64 * j]; } }
    for (int m = blockIdx.x * 8 + wave; m < T; m += G * 8) {
        const int b = m >> 11;
        f32x4 v[4]; float ss = 0.f;
#pragma unroll
        for (int j = 0; j < 4; ++j) { v[j] = vn[j]; ss += (v[j][0] * v[j][0] + v[j][1] * v[j][1]) + (v[j][2] * v[j][2] + v[j][3] * v[j][3]); }
        if (m + G * 8 < T) { const f32x4* xr = (const f32x4*)(A.x + (size_t)(m + G * 8) * 1024) + lane;
#pragma unroll
            for (int j = 0; j < 4; ++j) vn[j] = xr[64 * j]; }
        const float rstd = rsqrtf(wave_sum(ss) * (1.f / 1024.f) + 1e-6f);
        unsigned long long* o8 = (unsigned long long*)(ACT + (size_t)m * 1024) + lane;
#pragma unroll
        for (int j = 0; j < 4; ++j) { const int col = 4 * lane + 256 * j;
            const f32x4 g = *(const f32x4*)(A.norm1_g + col), sc = *(const f32x4*)(MOD + b * 6144 + 1024 + col), sh = *(const f32x4*)(MOD + b * 6144 + col);
            v[j] = v[j] * rstd * g * (sc + 1.0f) + sh;
            o8[64 * j] = (unsigned long long)pk2(v[j][0], v[j][1]) | ((unsigned long long)pk2(v[j][2], v[j][3]) << 32); }
        float gd[8];
#pragma unroll
        for (int gc = 0; gc < 8; ++gc) { float d = 0.f;
#pragma unroll
            for (int j = 0; j < 4; ++j) { const f32x4 w = *(const LAS f32x4*)(WG + gc * 1024 + 256 * j + 4 * lane); d += (v[j][0] * w[0] + v[j][1] * w[1]) + (v[j][2] * w[2] + v[j][3] * w[3]); }
            gd[gc] = wave_sum(d); }
        if (lane == 0) {
            f32x4 ig, lf;
#pragma unroll
            for (int h = 0; h < 4; ++h) { ig[h] = gd[h] + A.gate_b[h]; const float z = gd[4 + h] + A.gate_b[4 + h]; lf[h] = fminf(z, 0.f) - log1pf(expf(-fabsf(z))); }
            *(f32x4*)(GATES + (size_t)m * 8) = ig; *(f32x4*)(GATES + (size_t)m * 8 + 4) = lf;
        }
    }
}

constexpr int AK_STRIDE = 272, AV_STRIDE = 288, AK_BYTES = 64 * AK_STRIDE, AV_BYTES = 64 * AV_STRIDE;
__device__ __forceinline__ void attn_item(const Args& A, LAS unsigned char* lds, int b, int h, int qb, float lam) {
    int tid_o = threadIdx.x; asm volatile("" : "+v"(tid_o)); const int tid = tid_o, lane = tid & 63, w = tid >> 6, g = lane >> 4, l15 = lane & 15;
    const bf16_t* P = (const bf16_t*)(A.ws + WS_P);
    bf16_t* ACT = (bf16_t*)(A.ws + WS_ACT);
    const int t0 = qb * 128, ntiles = 2 * (qb + 1);
    const size_t rowbase = (size_t)b * SEQ;
    bf16x8 qf[2][2];
    { const bf16_t* qp = P + (rowbase + t0 + 16 * w + l15) * NP + 2048 + h * 128 + 8 * g;
#pragma unroll
      for (int p = 0; p < 2; ++p)
#pragma unroll
          for (int ks = 0; ks < 2; ++ks) qf[p][ks] = *(const bf16x8*)(qp + p * 64 + ks * 32); }
    f32x4 o[2][8];
#pragma unroll
    for (int p = 0; p < 2; ++p)
#pragma unroll
        for (int vt = 0; vt < 8; ++vt) o[p][vt] = (f32x4){0.f, 0.f, 0.f, 0.f};
    float mrun[2] = {-1e30f, -1e30f}, lrun[2] = {0.f, 0.f};
    const int srow = tid >> 3, sseg = tid & 7;
    const bf16_t* kg = P + (rowbase + srow) * NP + 2560 + h * 128 + sseg * 16;
    const bf16_t* vg = P + (rowbase + srow) * NP + 3072 + h * 128 + sseg * 16;
    u32x4 kr0, kr1, vr0, vr1;
    kr0 = *(const u32x4*)(kg); kr1 = *(const u32x4*)(kg + 8); vr0 = *(const u32x4*)(vg); vr1 = *(const u32x4*)(vg + 8);
    { LAS unsigned char* kb = lds + srow * AK_STRIDE + sseg * 32; LAS unsigned char* vb = lds + 2 * AK_BYTES + srow * AV_STRIDE + sseg * 32;
      *(LAS u32x4*)kb = kr0; *(LAS u32x4*)(kb + 16) = kr1; *(LAS u32x4*)vb = vr0; *(LAS u32x4*)(vb + 16) = vr1; }
    __syncthreads();
    const float cs = 0.125f * 1.4426950408889634f;
    const int qabs = t0 + 16 * w + l15;
    for (int kt = 0; kt < ntiles; ++kt) {
        const int cur = kt & 1;
        if (kt + 1 < ntiles) { const size_t off = (size_t)(kt + 1) * 64 * NP;
            kr0 = *(const u32x4*)(kg + off); kr1 = *(const u32x4*)(kg + off + 8); vr0 = *(const u32x4*)(vg + off); vr1 = *(const u32x4*)(vg + off + 8); }
        if (64 * kt <= t0 + 16 * w + 15) {
            LAS unsigned char* Kb = lds + cur * AK_BYTES; LAS unsigned char* Vb = lds + 2 * AK_BYTES + cur * AV_BYTES;
            f32x4 s[2][4];
#pragma unroll
            for (int p = 0; p < 2; ++p)
#pragma unroll
                for (int k4 = 0; k4 < 4; ++k4) { f32x4 a = (f32x4){0.f, 0.f, 0.f, 0.f};
#pragma unroll
                    for (int ks = 0; ks < 2; ++ks) { const bf16x8 kf = *(const LAS bf16x8*)(Kb + (16 * k4 + l15) * AK_STRIDE + (p * 64 + ks * 32 + 8 * g) * 2); a = MFMA16(kf, qf[p][ks], a); }
                    s[p][k4] = a; }
            if (64 * kt + 63 > t0 + 16 * w) {
#pragma unroll
                for (int p = 0; p < 2; ++p)
#pragma unroll
                    for (int k4 = 0; k4 < 4; ++k4)
#pragma unroll
                        for (int r = 0; r < 4; ++r) { const int key = 64 * kt + 16 * k4 + 4 * g + r; if (key > qabs) s[p][k4][r] = -1e30f; }
            }
            bf16x8 pf[2][2];
#pragma unroll
            for (int p = 0; p < 2; ++p) {
                float mx = -1e30f;
#pragma unroll
                for (int k4 = 0; k4 < 4; ++k4)
#pragma unroll
                    for (int r = 0; r < 4; ++r) mx = fmaxf(mx, s[p][k4][r]);
                mx = xrow_max(mx);
                const float mnew = fmaxf(mrun[p], mx * cs), alpha = __builtin_amdgcn_exp2f(mrun[p] - mnew);
                mrun[p] = mnew;
                float ls = 0.f;
#pragma unroll
                for (int k4 = 0; k4 < 4; ++k4)
#pragma unroll
                    for (int r = 0; r < 4; ++r) { const float pv = __builtin_amdgcn_exp2f(s[p][k4][r] * cs - mnew); ls += pv; s[p][k4][r] = pv; }
                lrun[p] = lrun[p] * alpha + ls;
                if (__any(alpha != 1.f)) {
#pragma unroll
                    for (int vt = 0; vt < 8; ++vt) o[p][vt] = o[p][vt] * alpha; }
                pf[p][0] = pack8(s[p][0], s[p][1]); pf[p][1] = pack8(s[p][2], s[p][3]);
            }
#pragma unroll
            for (int ks2 = 0; ks2 < 2; ++ks2)
#pragma unroll
                for (int vt = 0; vt < 8; ++vt) {
                    LAS unsigned char* a0 = Vb + (32 * ks2 + 4 * g + (l15 >> 2)) * AV_STRIDE + (16 * vt + 4 * (lane & 3)) * 2;
                    const bf16x8 vf = cat8(vtr(a0), vtr(a0 + 16 * AV_STRIDE));
                    o[0][vt] = MFMA16(vf, pf[0][ks2], o[0][vt]);
                    o[1][vt] = MFMA16(vf, pf[1][ks2], o[1][vt]);
                }
        }
        if (kt + 1 < ntiles) { const int nx = cur ^ 1;
            LAS unsigned char* kb = lds + nx * AK_BYTES + srow * AK_STRIDE + sseg * 32; LAS unsigned char* vb = lds + 2 * AK_BYTES + nx * AV_BYTES + srow * AV_STRIDE + sseg * 32;
            *(LAS u32x4*)kb = kr0; *(LAS u32x4*)(kb + 16) = kr1; *(LAS u32x4*)vb = vr0; *(LAS u32x4*)(vb + 16) = vr1; }
        __syncthreads();
    }
    float inv[2];
#pragma unroll
    for (int p = 0; p < 2; ++p) { const float lt = xrow_sum(lrun[p]); inv[p] = 1.f / lt; }
    float ss = 0.f;
#pragma unroll
    for (int vt = 0; vt < 8; ++vt)
#pragma unroll
        for (int r = 0; r < 4; ++r) { const float ov = o[0][vt][r] * inv[0] - lam * (o[1][vt][r] * inv[1]); o[0][vt][r] = ov; ss += ov * ov; }
    ss = xrow_sum(ss);
    const float rstd = rsqrtf(ss * (1.f / 128.f) + 1e-6f) * 0.8f;
    bf16_t* op = ACT + (rowbase + qabs) * 1024 + 512 + h * 128 + 4 * g;
#pragma unroll
    for (int vt = 0; vt < 8; ++vt) { const f32x4 gn = *(const f32x4*)(A.dnorm_g + 16 * vt + 4 * g);
        u32x2 wv; wv.x = pk2(o[0][vt][0] * rstd * gn[0], o[0][vt][1] * rstd * gn[1]); wv.y = pk2(o[0][vt][2] * rstd * gn[2], o[0][vt][3] * rstd * gn[3]);
        *(u32x2*)(op + 16 * vt) = wv; }
}

constexpr int MQ_STRIDE = 272, MV_STRIDE = 288, MP_STRIDE = 144, MH_STRIDE = 132;
constexpr int ML_Q = 0, ML_K = 17408, ML_V = 34816, ML_P = 53248, ML_H = 62464, ML_CW = 96256, ML_SM = 101376;
constexpr int SM_E = 0, SM_G = 64, SM_B = 128, SM_W = 192, SM_I = 256, SM_R = 320, SM_N = 384, SM_NP = 512, SM_X = 1024;
constexpr size_t WS_CST = 224 * MiB, WS_NST = 15 * MiB, WS_MC = 15 * MiB + 512 * 1024, WS_BAR = 15 * MiB + 768 * 1024;

__device__ __forceinline__ void mlstm_state(const Args& A, LAS unsigned char* lds, int b, int h) {
    int tid_o = threadIdx.x; asm volatile("" : "+v"(tid_o)); const int tid = tid_o, lane = tid & 63, w = tid >> 6, g = lane >> 4, l15 = lane & 15;
    const bf16_t* P = (const bf16_t*)(A.ws + WS_P);
    const float* GATES = (const float*)(A.ws + WS_GATES);
    u32x4* CST = (u32x4*)(A.ws + WS_CST); float* NST = (float*)(A.ws + WS_NST); float* MCg = (float*)(A.ws + WS_MC);
    LAS float* sm = (LAS float*)(lds + ML_SM);
    LAS float* cw = (LAS float*)(lds + ML_CW);
    LAS unsigned char* Ks = lds + ML_K; LAS unsigned char* Vs = lds + ML_V;
    const size_t rowbase = (size_t)b * SEQ; const int bh = b * 4 + h;
    for (int i = tid; i < 640; i += 512) { const int j = i >> 7, ch = i & 127, cch = 512 + h * 128 + ch; cw[i] = (j < 4) ? A.conv_w[j * 1024 + cch] : A.conv_b[cch]; }
    if (tid < 128) sm[SM_N + tid] = 0.f;
    const int rg = tid >> 4, cs = tid & 15;
    const int ccol = 512 + h * 128 + 8 * cs;
    const int srow = tid >> 3, sseg = tid & 7;
    u32x4 cr[5], vr0, vr1; float gi = 0.f, gf = 0.f;
#define MS_PREFETCH(c) do { const int _r0 = (c) * 64 + 2 * rg - 3; \
        _Pragma("unroll") for (int _i = 0; _i < 5; ++_i) { const int _r = _r0 + _i; const u32x4 _v = *(const u32x4*)(P + (rowbase + (_r >= 0 ? _r : 0)) * NP + ccol); cr[_i] = (_r >= 0) ? _v : (u32x4){0u, 0u, 0u, 0u}; } \
        const bf16_t* _vp = P + (rowbase + (c) * 64 + srow) * NP + 1024 + h * 128 + sseg * 16; \
        vr0 = *(const u32x4*)(_vp); vr1 = *(const u32x4*)(_vp + 8); \
        } while (0)
    MS_PREFETCH(0);
    LAS float* Eall = (LAS float*)(lds + ML_Q);
#pragma unroll
    for (int cc = 0; cc < 4; ++cc) { const int c = w + 8 * cc;
        const float* gp = GATES + (rowbase + c * 64 + lane) * 8 + h; gi = gp[0]; gf = gp[4];
        float bc = gf;
#pragma unroll
        for (int o = 1; o < 64; o <<= 1) { const float t = __shfl_up(bc, o); if (lane >= o) bc += t; }
        const float e = gi - bc; float cm = e;
#pragma unroll
        for (int o = 1; o < 64; o <<= 1) { const float t = __shfl_up(cm, o); if (lane >= o) cm = fmaxf(cm, t); }
        Eall[c * 64 + lane] = e;
        if (lane == 63) { Eall[2048 + c] = bc; Eall[2048 + 32 + c] = cm; } }
    f32x4 C[8];
#pragma unroll
    for (int kt = 0; kt < 8; ++kt) C[kt] = (f32x4){0.f, 0.f, 0.f, 0.f};
    float mc = 0.f;
    __syncthreads();
    for (int c = 0; c < 32; ++c) {
        {
            float wt[5][8];
#pragma unroll
            for (int j = 0; j < 5; ++j) { const f32x4 a = *(const LAS f32x4*)(cw + j * 128 + 8 * cs), bb = *(const LAS f32x4*)(cw + j * 128 + 8 * cs + 4);
                wt[j][0] = a[0]; wt[j][1] = a[1]; wt[j][2] = a[2]; wt[j][3] = a[3]; wt[j][4] = bb[0]; wt[j][5] = bb[1]; wt[j][6] = bb[2]; wt[j][7] = bb[3]; }
            LAS unsigned char* dst = Ks + (2 * rg) * MQ_STRIDE + 16 * cs;
#pragma unroll
            for (int r = 0; r < 2; ++r) {
                float ov[8];
#pragma unroll
                for (int e = 0; e < 8; ++e) ov[e] = wt[4][e];
#pragma unroll
                for (int j = 0; j < 4; ++j) { const u32x4 x = cr[r + j];
                    ov[0] += wt[j][0] * bflo(x.x); ov[1] += wt[j][1] * bfhi(x.x); ov[2] += wt[j][2] * bflo(x.y); ov[3] += wt[j][3] * bfhi(x.y);
                    ov[4] += wt[j][4] * bflo(x.z); ov[5] += wt[j][5] * bfhi(x.z); ov[6] += wt[j][6] * bflo(x.w); ov[7] += wt[j][7] * bfhi(x.w); }
#pragma unroll
                for (int e = 0; e < 8; ++e) ov[e] = 0.08838834764831845f * ov[e] * __builtin_amdgcn_rcpf(1.f + __expf(-ov[e]));
                u32x4 o4; o4.x = pk2(ov[0], ov[1]); o4.y = pk2(ov[2], ov[3]); o4.z = pk2(ov[4], ov[5]); o4.w = pk2(ov[6], ov[7]);
                *(LAS u32x4*)(dst + r * MQ_STRIDE) = o4;
            }
            LAS unsigned char* vd = Vs + srow * MV_STRIDE + sseg * 32; *(LAS u32x4*)vd = vr0; *(LAS u32x4*)(vd + 16) = vr1;
            if (w == 0) {
                const float g63 = fmaxf(mc, Eall[2048 + 32 + c]);
                sm[SM_W + lane] = __expf(Eall[c * 64 + lane] - g63);
                if (lane == 63) { sm[SM_X] = __expf(mc - g63); sm[SM_X + 1] = Eall[2048 + c] + g63; }
            }
        }
        __syncthreads();
        { const int cn = (c + 1 < 32) ? c + 1 : 31; MS_PREFETCH(cn); }
        {
            const int item = bh * 32 + c;
#pragma unroll
            for (int k2 = 0; k2 < 4; ++k2) CST[((size_t)(item * 8 + w) * 4 + k2) * 64 + lane] = __builtin_bit_cast(u32x4, pack8(C[2 * k2], C[2 * k2 + 1]));
            if (tid < 128) NST[item * 128 + tid] = sm[SM_N + tid];
            if (tid == 0) MCg[item] = mc;
            LAS float* wS = sm + SM_W;
            const float decay = sm[SM_X];
            bf16x8 vfw[2];
#pragma unroll
            for (int ks = 0; ks < 2; ++ks) {
                LAS unsigned char* a0 = Vs + (32 * ks + 8 * g + (l15 >> 2)) * MV_STRIDE + (16 * w + 4 * (lane & 3)) * 2;
                const bf16x8 vf = cat8(vtr(a0), vtr(a0 + 4 * MV_STRIDE));
                const f32x4 w0 = *(const LAS f32x4*)(wS + 32 * ks + 8 * g), w1 = *(const LAS f32x4*)(wS + 32 * ks + 8 * g + 4);
                const u32x4 vu = __builtin_bit_cast(u32x4, vf);
                u32x4 o4; o4.x = pk2(bflo(vu.x) * w0[0], bfhi(vu.x) * w0[1]); o4.y = pk2(bflo(vu.y) * w0[2], bfhi(vu.y) * w0[3]);
                o4.z = pk2(bflo(vu.z) * w1[0], bfhi(vu.z) * w1[1]); o4.w = pk2(bflo(vu.w) * w1[2], bfhi(vu.w) * w1[3]);
                vfw[ks] = __builtin_bit_cast(bf16x8, o4);
            }
#pragma unroll
            for (int kt = 0; kt < 8; ++kt) C[kt] = C[kt] * decay;
#pragma unroll
            for (int ks = 0; ks < 2; ++ks)
#pragma unroll
                for (int kt = 0; kt < 8; ++kt) { LAS unsigned char* a0 = Ks + (32 * ks + 8 * g + (l15 >> 2)) * MQ_STRIDE + (16 * kt + 4 * (lane & 3)) * 2;
                    const bf16x8 ka = cat8(vtr(a0), vtr(a0 + 4 * MQ_STRIDE)); C[kt] = MFMA16(ka, vfw[ks], C[kt]); }
            { const int kd = tid & 127, sq = tid >> 7; float s = 0.f;
#pragma unroll
              for (int i = 0; i < 16; ++i) { const int s_ = 16 * sq + i; s += wS[s_] * __uint_as_float((unsigned)(*(const LAS bf16_t*)(Ks + s_ * MQ_STRIDE + kd * 2)) << 16); }
              sm[SM_NP + sq * 128 + kd] = s; }
            mc = sm[SM_X + 1];
            __syncthreads();
            if (tid < 128) sm[SM_N + tid] = decay * sm[SM_N + tid] + ((sm[SM_NP + tid] + sm[SM_NP + 128 + tid]) + (sm[SM_NP + 256 + tid] + sm[SM_NP + 384 + tid]));
        }
    }
#undef MS_PREFETCH
    __syncthreads();
}

__device__ __forceinline__ void mlstm_out(const Args& A, LAS unsigned char* lds, int item, int& last_h) {
    int tid_o = threadIdx.x; asm volatile("" : "+v"(tid_o)); const int tid = tid_o, lane = tid & 63, w = tid >> 6, g = lane >> 4, l15 = lane & 15;
    const int bh = item >> 5, c = item & 31, b = bh >> 2, h = bh & 3;
    const bf16_t* P = (const bf16_t*)(A.ws + WS_P);
    bf16_t* ACT = (bf16_t*)(A.ws + WS_ACT);
    const float* GATES = (const float*)(A.ws + WS_GATES);
    const u32x4* CST = (const u32x4*)(A.ws + WS_CST); const float* NST = (const float*)(A.ws + WS_NST); const float* MCg = (const float*)(A.ws + WS_MC);
    LAS float* sm = (LAS float*)(lds + ML_SM);
    LAS float* cw = (LAS float*)(lds + ML_CW);
    LAS unsigned char* Qs = lds + ML_Q; LAS unsigned char* Ks = lds + ML_K; LAS unsigned char* Vs = lds + ML_V; LAS unsigned char* Ps = lds + ML_P;
    LAS float* Hn = (LAS float*)(lds + ML_H);
    LAS float* eS = sm + SM_E; LAS float* gS = sm + SM_G; LAS float* bS = sm + SM_B; LAS float* iS = sm + SM_I; LAS float* nS = sm + SM_N;
    const size_t rowbase = (size_t)b * SEQ;
    const int rg = tid >> 5, cs = tid & 31;
    const int ccol = (cs < 16 ? 0 : 512) + h * 128 + 8 * (cs & 15);
    const int srow = tid >> 3, sseg = tid & 7;
    u32x4 cr[7], vr0, vr1, mc0, mc1, cfr[4]; float gi = 0.f, gf = 0.f, nval = 0.f;
    { const int r0 = c * 64 + 4 * rg - 3;
#pragma unroll
      for (int i = 0; i < 7; ++i) { const int r = r0 + i; const u32x4 v_ = *(const u32x4*)(P + (rowbase + (r >= 0 ? r : 0)) * NP + ccol); cr[i] = (r >= 0) ? v_ : (u32x4){0u, 0u, 0u, 0u}; }
      const bf16_t* vp = P + (rowbase + c * 64 + srow) * NP + h * 128 + sseg * 16;
      vr0 = *(const u32x4*)(vp + 1024); vr1 = *(const u32x4*)(vp + 1032); mc0 = *(const u32x4*)(vp + 1536); mc1 = *(const u32x4*)(vp + 1544);
      if (w == 0) { const float* gp = GATES + (rowbase + c * 64 + lane) * 8 + h; gi = gp[0]; gf = gp[4]; }
#pragma unroll
      for (int k2 = 0; k2 < 4; ++k2) cfr[k2] = CST[((size_t)(item * 8 + w) * 4 + k2) * 64 + lane];
      if (tid < 128) nval = NST[item * 128 + tid]; }
    const float mc = MCg[item];
    if (h != last_h) {
        for (int i = tid; i < 1280; i += 512) { const int j = i >> 8, ch = i & 255, cch = (ch < 128 ? h * 128 + ch : 512 + h * 128 + ch - 128);
            cw[i] = (j < 4) ? A.conv_w[j * 1024 + cch] : A.conv_b[cch]; }
        last_h = h;
        __syncthreads();
    }
    {
        float wt[5][8];
#pragma unroll
        for (int j = 0; j < 5; ++j) { const f32x4 a = *(const LAS f32x4*)(cw + j * 256 + 8 * cs), bb = *(const LAS f32x4*)(cw + j * 256 + 8 * cs + 4);
            wt[j][0] = a[0]; wt[j][1] = a[1]; wt[j][2] = a[2]; wt[j][3] = a[3]; wt[j][4] = bb[0]; wt[j][5] = bb[1]; wt[j][6] = bb[2]; wt[j][7] = bb[3]; }
        const float osc = (cs < 16) ? 1.0f : 0.08838834764831845f;
        LAS unsigned char* dst = (cs < 16 ? Qs : Ks) + (4 * rg) * MQ_STRIDE + 16 * (cs & 15);
#pragma unroll
        for (int r = 0; r < 4; ++r) {
            float ov[8];
#pragma unroll
            for (int e = 0; e < 8; ++e) ov[e] = wt[4][e];
#pragma unroll
            for (int j = 0; j < 4; ++j) { const u32x4 x = cr[r + j];
                ov[0] += wt[j][0] * bflo(x.x); ov[1] += wt[j][1] * bfhi(x.x); ov[2] += wt[j][2] * bflo(x.y); ov[3] += wt[j][3] * bfhi(x.y);
                ov[4] += wt[j][4] * bflo(x.z); ov[5] += wt[j][5] * bfhi(x.z); ov[6] += wt[j][6] * bflo(x.w); ov[7] += wt[j][7] * bfhi(x.w); }
#pragma unroll
            for (int e = 0; e < 8; ++e) ov[e] = osc * ov[e] * __builtin_amdgcn_rcpf(1.f + __expf(-ov[e]));
            u32x4 o4; o4.x = pk2(ov[0], ov[1]); o4.y = pk2(ov[2], ov[3]); o4.z = pk2(ov[4], ov[5]); o4.w = pk2(ov[6], ov[7]);
            *(LAS u32x4*)(dst + r * MQ_STRIDE) = o4;
        }
        LAS unsigned char* vd = Vs + srow * MV_STRIDE + sseg * 32; *(LAS u32x4*)vd = vr0; *(LAS u32x4*)(vd + 16) = vr1;
        if (tid < 128) nS[tid] = nval;
        if (w == 0) {
            float bc = gf;
#pragma unroll
            for (int o = 1; o < 64; o <<= 1) { const float t = __shfl_up(bc, o); if (lane >= o) bc += t; }
            const float e = gi - bc; float cm = e;
#pragma unroll
            for (int o = 1; o < 64; o <<= 1) { const float t = __shfl_up(cm, o); if (lane >= o) cm = fmaxf(cm, t); }
            const float gt = fmaxf(mc, cm);
            eS[lane] = e; gS[lane] = gt; bS[lane] = bc; iS[lane] = __expf(mc - gt);
        }
    }
    __syncthreads();
    {
        const int st = w >> 1;
#pragma unroll
        for (int ti = 0; ti < 2; ++ti) { const int tt = 2 * (w & 1) + ti;
            f32x4 a = (f32x4){0.f, 0.f, 0.f, 0.f};
#pragma unroll
            for (int ks = 0; ks < 4; ++ks) { const bf16x8 kf = *(const LAS bf16x8*)(Ks + (16 * st + l15) * MQ_STRIDE + (32 * ks + 8 * g) * 2);
                const bf16x8 qf = *(const LAS bf16x8*)(Qs + (16 * tt + l15) * MQ_STRIDE + (32 * ks + 8 * g) * 2); a = MFMA16(kf, qf, a); }
            const int t = 16 * tt + l15; const float gt = gS[t];
            float pv[4];
#pragma unroll
            for (int r = 0; r < 4; ++r) { const int s_ = 16 * st + 4 * g + r; pv[r] = (s_ <= t) ? a[r] * __expf(eS[s_] - gt) : 0.f; }
            u32x2 pw; pw.x = pk2(pv[0], pv[1]); pw.y = pk2(pv[2], pv[3]);
            *(LAS u32x2*)(Ps + t * MP_STRIDE + (16 * st + 4 * g) * 2) = pw;
        }
    }
    __syncthreads();
    {
        f32x4 apv[4], aqc[4];
#pragma unroll
        for (int tt = 0; tt < 4; ++tt) { apv[tt] = (f32x4){0.f, 0.f, 0.f, 0.f}; aqc[tt] = (f32x4){0.f, 0.f, 0.f, 0.f}; }
#pragma unroll
        for (int ks = 0; ks < 2; ++ks) {
            LAS unsigned char* a0 = Vs + (32 * ks + 8 * g + (l15 >> 2)) * MV_STRIDE + (16 * w + 4 * (lane & 3)) * 2;
            const bf16x8 vf = cat8(vtr(a0), vtr(a0 + 4 * MV_STRIDE));
#pragma unroll
            for (int tt = 0; tt < 4; ++tt) { const bf16x8 pf = *(const LAS bf16x8*)(Ps + (16 * tt + l15) * MP_STRIDE + (32 * ks + 8 * g) * 2); apv[tt] = MFMA16(pf, vf, apv[tt]); }
        }
#pragma unroll
        for (int k2 = 0; k2 < 4; ++k2) {
            const bf16x8 cf = __builtin_bit_cast(bf16x8, cfr[k2]);
#pragma unroll
            for (int tt = 0; tt < 4; ++tt) { LAS unsigned char* qa = Qs + (16 * tt + l15) * MQ_STRIDE + (32 * k2 + 4 * g) * 2;
                const bf16x8 qf = cat8(*(const LAS s16x4*)qa, *(const LAS s16x4*)(qa + 32)); aqc[tt] = MFMA16(qf, cf, aqc[tt]); }
        }
#pragma unroll
        for (int tt = 0; tt < 4; ++tt)
#pragma unroll
            for (int r = 0; r < 4; ++r) { const int t = 16 * tt + 4 * g + r; Hn[t * MH_STRIDE + 16 * w + l15] = apv[tt][r] + iS[t] * aqc[tt][r]; }
        { const int t = srow, j = sseg;
          const u32x4 pr = *(const LAS u32x4*)(Ps + t * MP_STRIDE + 16 * j);
          float rs = (bflo(pr.x) + bfhi(pr.x)) + (bflo(pr.y) + bfhi(pr.y)) + (bflo(pr.z) + bfhi(pr.z)) + (bflo(pr.w) + bfhi(pr.w));
          const u32x4 q0 = *(const LAS u32x4*)(Qs + t * MQ_STRIDE + 32 * j), q1 = *(const LAS u32x4*)(Qs + t * MQ_STRIDE + 32 * j + 16);
          const f32x4 n0 = *(const LAS f32x4*)(nS + 16 * j), n1 = *(const LAS f32x4*)(nS + 16 * j + 4), n2 = *(const LAS f32x4*)(nS + 16 * j + 8), n3 = *(const LAS f32x4*)(nS + 16 * j + 12);
          float qn = bflo(q0.x) * n0[0] + bfhi(q0.x) * n0[1] + bflo(q0.y) * n0[2] + bfhi(q0.y) * n0[3] + bflo(q0.z) * n1[0] + bfhi(q0.z) * n1[1] + bflo(q0.w) * n1[2] + bfhi(q0.w) * n1[3]
                   + bflo(q1.x) * n2[0] + bfhi(q1.x) * n2[1] + bflo(q1.y) * n2[2] + bfhi(q1.y) * n2[3] + bflo(q1.z) * n3[0] + bfhi(q1.z) * n3[1] + bflo(q1.w) * n3[2] + bfhi(q1.w) * n3[3];
          float d = rs + iS[t] * qn;
          d += __shfl_xor(d, 1); d += __shfl_xor(d, 2); d += __shfl_xor(d, 4);
          if (j == 0) { const float fl = __expf(-(bS[t] + gS[t])); sm[SM_R + t] = 1.f / fmaxf(fabsf(d), fl); } }
    }
    __syncthreads();
    {
        const int t = srow, j = sseg; const float rd = sm[SM_R + t];
        float hv[16]; float ss = 0.f;
#pragma unroll
        for (int q = 0; q < 4; ++q) { const f32x4 x = *(const LAS f32x4*)(Hn + t * MH_STRIDE + 16 * j + 4 * q);
#pragma unroll
            for (int e = 0; e < 4; ++e) { const float v = x[e] * rd; hv[4 * q + e] = v; ss += v * v; } }
        ss += __shfl_xor(ss, 1); ss += __shfl_xor(ss, 2); ss += __shfl_xor(ss, 4);
        const float rstd = rsqrtf(ss * (1.f / 128.f) + 1e-6f);
        const unsigned mo[8] = {mc0.x, mc0.y, mc0.z, mc0.w, mc1.x, mc1.y, mc1.z, mc1.w};
        unsigned ow[8];
#pragma unroll
        for (int q = 0; q < 8; ++q) { const float g0 = A.mnorm_g[h * 128 + 16 * j + 2 * q], g1 = A.mnorm_g[h * 128 + 16 * j + 2 * q + 1];
            const float z0 = bflo(mo[q]), z1 = bfhi(mo[q]);
            ow[q] = pk2(hv[2 * q] * rstd * g0 * __builtin_amdgcn_rcpf(1.f + __expf(-z0)), hv[2 * q + 1] * rstd * g1 * __builtin_amdgcn_rcpf(1.f + __expf(-z1))); }
        bf16_t* op = ACT + (rowbase + c * 64 + t) * 1024 + h * 128 + 16 * j;
        *(u32x4*)op = (u32x4){ow[0], ow[1], ow[2], ow[3]}; *(u32x4*)(op + 8) = (u32x4){ow[4], ow[5], ow[6], ow[7]};
    }
}

__device__ __forceinline__ void phase3(const Args& A, LAS unsigned char* lds, int rep = 0) {
    const int tid = threadIdx.x;
    const float lam = ((const float*)(A.ws + WS_CTL))[1];
    unsigned* ctr = (unsigned*)(A.ws + WS_CTL) + 2 * rep;
    LAS int* slot = (LAS int*)(lds + LDS_BYTES - 64);
    {
        const int lane = tid & 63, wave = tid >> 6;
        const bf16_t* WT = (const bf16_t*)(A.ws + WS_WQ); const float* MOD = (const float*)(A.ws + WS_MOD); float* SB = (float*)(A.ws + WS_SB);
        for (int n = blockIdx.x * 8 + wave; n < 2048; n += gridDim.x * 8) {
            const u32x4 w0 = *(const u32x4*)(WT + (size_t)n * 1024 + 16 * lane), w1 = *(const u32x4*)(WT + (size_t)n * 1024 + 16 * lane + 8);
            const unsigned ww[8] = {w0.x, w0.y, w0.z, w0.w, w1.x, w1.y, w1.z, w1.w};
            float sbv[8];
#pragma unroll
            for (int b = 0; b < 8; ++b) { const float* sp = MOD + b * 6144 + 3072 + 16 * lane; float d = 0.f;
#pragma unroll
                for (int q = 0; q < 4; ++q) { const f32x4 s4 = *(const f32x4*)(sp + 4 * q); d += bflo(ww[2 * q]) * s4[0] + bfhi(ww[2 * q]) * s4[1] + bflo(ww[2 * q + 1]) * s4[2] + bfhi(ww[2 * q + 1]) * s4[3]; }
                sbv[b] = wave_sum(d); }
            if (lane == 0) {
#pragma unroll
                for (int b = 0; b < 8; ++b) SB[b * 2048 + n] = sbv[b]; }
        }
    }
    const int nml = ((int)gridDim.x > 64) ? 32 : 1;
    if ((int)blockIdx.x < nml) for (int bh = blockIdx.x; bh < 32; bh += nml) mlstm_state(A, lds, bh >> 2, bh & 3);
    for (;;) {
        if (tid == 0) slot[0] = (int)atomicAdd(ctr, 1u);
        __syncthreads();
        const int it = slot[0];
        __syncthreads();
        if (it >= 512) break;
        attn_item(A, lds, (it & 31) >> 2, it & 3, 15 - (it >> 5), lam);
    }
}
__device__ __forceinline__ void phase3b(const Args& A, LAS unsigned char* lds) {
    int last_h = -1;
    for (int item = blockIdx.x; item < 1024; item += gridDim.x) mlstm_out(A, lds, item, last_h);
    __syncthreads();
}

__device__ __forceinline__ void phase5(const Args& A) {
    int tid_o = threadIdx.x; asm volatile("" : "+v"(tid_o)); const int tid = tid_o, lane = tid & 63, wave = tid >> 6, G = gridDim.x;
    const float* MOD = (const float*)(A.ws + WS_MOD);
    bf16_t* ACT = (bf16_t*)(A.ws + WS_ACT);
    for (int m = blockIdx.x * 8 + wave; m < T; m += G * 8) {
        const int b = m >> 11;
        const f32x4* xr = (const f32x4*)(A.out + (size_t)m * 1024) + lane;
        f32x4 v[4]; float ss = 0.f;
#pragma unroll
        for (int j = 0; j < 4; ++j) { v[j] = xr[64 * j]; ss += (v[j][0] * v[j][0] + v[j][1] * v[j][1]) + (v[j][2] * v[j][2] + v[j][3] * v[j][3]); }
        const float rstd = rsqrtf(wave_sum(ss) * (1.f / 1024.f) + 1e-6f);
        unsigned long long* o8 = (unsigned long long*)(ACT + (size_t)m * 1024) + lane;
#pragma unroll
        for (int j = 0; j < 4; ++j) { const int col = 4 * lane + 256 * j;
            const f32x4 g = *(const f32x4*)(A.norm2_g + col), sc = *(const f32x4*)(MOD + b * 6144 + 4096 + col), sh = *(const f32x4*)(MOD + b * 6144 + 3072 + col);
            v[j] = v[j] * rstd * g * (sc + 1.0f) + sh;
            o8[64 * j] = (unsigned long long)pk2(v[j][0], v[j][1]) | ((unsigned long long)pk2(v[j][2], v[j][3]) << 32); }
    }
}

__device__ __forceinline__ unsigned f2key(float f) { const unsigned u = __float_as_uint(f); return (u & 0x80000000u) ? ~u : (u | 0x80000000u); }
__device__ __forceinline__ float key2f(unsigned k) { const unsigned u = (k & 0x80000000u) ? (k & 0x7fffffffu) : ~k; return __uint_as_float(u); }
#define CE_DESC(a, b) do { const unsigned _mx = (a) > (b) ? (a) : (b), _mn = (a) > (b) ? (b) : (a); (a) = _mx; (b) = _mn; } while (0)
__device__ __forceinline__ void sort16_desc(unsigned (&k)[16]) {
#pragma unroll
    for (int size = 2; size <= 16; size <<= 1)
#pragma unroll
        for (int stride = size >> 1; stride > 0; stride >>= 1)
#pragma unroll
            for (int i = 0; i < 16; ++i) { const int j = i ^ stride;
                if (j > i) { if ((i & size) == 0) CE_DESC(k[i], k[j]); else CE_DESC(k[j], k[i]); } }
}
__device__ __forceinline__ void merge16(unsigned (&a)[16], const unsigned (&b)[16]) {
#pragma unroll
    for (int i = 0; i < 16; ++i) a[i] = a[i] > b[15 - i] ? a[i] : b[15 - i];
#pragma unroll
    for (int stride = 8; stride > 0; stride >>= 1)
#pragma unroll
        for (int i = 0; i < 16; ++i) { const int j = i ^ stride; if (j > i) CE_DESC(a[i], a[j]); }
}
constexpr int PE_IDX = 0, PE_SEL = 69632;
__device__ __forceinline__ float gelu_erf(float v) { return 0.5f * v * (1.f + erff(v * 0.70710678118654752f)); }
__device__ __forceinline__ float gelu_fast(float v) {
    const float av = fabsf(v), tt = __builtin_amdgcn_rcpf(av * 0.2316418882f + 1.0f);
    float q = tt * 0.5307027145f + (-0.7265760135f); q = q * tt + 0.7107068705f; q = q * tt + (-0.142248368f); q = q * tt + 0.127414796f; q = q * tt;
    const float e = __builtin_amdgcn_exp2f((v * v) * (-0.72134752044f));
    const float m = v * (q * e);
    return v < 0.f ? m : v - m;
}

__device__ __forceinline__ void peer_tile(const Args& A, LAS unsigned char* lds, int tile) {
    int tid_o = threadIdx.x; asm volatile("" : "+v"(tid_o)); const int tid = tid_o, lane = tid & 63, w = tid >> 6, g = lane >> 4, l15 = lane & 15;
    const bf16_t* QRY = (const bf16_t*)(A.ws + WS_QRY);
    const bf16_t* KEYS = (const bf16_t*)(A.ws + WS_KEYS);
    const bf16_t* ACT = (const bf16_t*)(A.ws + WS_ACT);
    const float* MOD = (const float*)(A.ws + WS_MOD);
    LAS unsigned* idx = (LAS unsigned*)(lds + PE_IDX) + (w * 64 + lane) * 33;
    LAS u32x2* SEL = (LAS u32x2*)(lds + PE_SEL);
    {
        const int tg = w & 3, hg = w >> 2, tl = 16 * tg + l15;
        const size_t m = (size_t)tile * 64 + tl;
        unsigned LA[4][2][16];
#pragma unroll
        for (int hh = 0; hh < 4; ++hh) {
            const int h = 4 * hg + hh;
#pragma unroll
            for (int p = 0; p < 2; ++p) {
                const int hp = 2 * h + p;
                unsigned k0[16], k1[16];
                { const bf16_t* sp = QRY + m * 2048 + hp * 128 + 32 * g;
                  const u32x4 s0 = *(const u32x4*)sp, s1 = *(const u32x4*)(sp + 8), s2 = *(const u32x4*)(sp + 16), s3 = *(const u32x4*)(sp + 24);
                  const unsigned sw[16] = {s0.x, s0.y, s0.z, s0.w, s1.x, s1.y, s1.z, s1.w, s2.x, s2.y, s2.z, s2.w, s3.x, s3.y, s3.z, s3.w};
#pragma unroll
                  for (int i = 0; i < 16; ++i) {
                      const float lo = (float)__builtin_bit_cast(_Float16, (unsigned short)(sw[i] & 0xffffu)), hi = (float)__builtin_bit_cast(_Float16, (unsigned short)(sw[i] >> 16));
                      const unsigned klo = (f2key(lo) & ~127u) | (unsigned)(127 - (32 * g + 2 * i)), khi = (f2key(hi) & ~127u) | (unsigned)(127 - (32 * g + 2 * i + 1));
                      if (i < 8) { k0[2 * i] = klo; k0[2 * i + 1] = khi; } else { k1[2 * (i - 8)] = klo; k1[2 * (i - 8) + 1] = khi; } } }
                sort16_desc(k0); sort16_desc(k1); merge16(k0, k1);
#pragma unroll
                for (int msk = 16; msk <= 32; msk <<= 1) {
#pragma unroll
                    for (int i = 0; i < 16; ++i) k1[i] = (unsigned)__shfl_xor((int)k0[i], msk);
                    merge16(k0, k1); }
#pragma unroll
                for (int i = 0; i < 16; ++i) LA[hh][p][i] = k0[i];
            }
        }
        {
            const int h = 4 * hg + g;
            unsigned L2[2][16];
#pragma unroll
            for (int p = 0; p < 2; ++p)
#pragma unroll
                for (int i = 0; i < 16; ++i) L2[p][i] = (g & 2) ? ((g & 1) ? LA[3][p][i] : LA[2][p][i]) : ((g & 1) ? LA[1][p][i] : LA[0][p][i]);
            float va[16], vb[16];
#pragma unroll
            for (int i = 0; i < 16; ++i) { va[i] = key2f(L2[0][i] & ~127u); vb[i] = key2f(L2[1][i] & ~127u); idx[i] = 127u - (L2[0][i] & 127u); idx[16 + i] = 127u - (L2[1][i] & 127u); }
#define CK(i, j) ((f2key(va[i] + vb[j]) & ~255u) | (unsigned)(255 - (16 * (i) + (j))))
            unsigned Lf[16], Bt[16];
#pragma unroll
            for (int j = 0; j < 16; ++j) Lf[j] = CK(0, j);
#pragma unroll
            for (int j = 0; j < 8; ++j) Bt[j] = CK(1, j);
#pragma unroll
            for (int j = 0; j < 5; ++j) Bt[8 + j] = CK(2, j);
#pragma unroll
            for (int j = 0; j < 3; ++j) Bt[13 + j] = CK(4, j);
            sort16_desc(Bt); merge16(Lf, Bt);
#pragma unroll
            for (int j = 0; j < 4; ++j) Bt[j] = CK(3, j);
            Bt[4] = CK(5, 0); Bt[5] = CK(5, 1); Bt[6] = CK(6, 0); Bt[7] = CK(6, 1); Bt[8] = CK(7, 0); Bt[9] = CK(7, 1);
            Bt[10] = CK(8, 0); Bt[11] = CK(9, 0); Bt[12] = CK(10, 0); Bt[13] = CK(11, 0); Bt[14] = CK(12, 0); Bt[15] = CK(13, 0);
            sort16_desc(Bt); merge16(Lf, Bt);
            { unsigned x0 = CK(14, 0), x1 = CK(15, 0);
#pragma unroll
              for (int i = 0; i < 16; ++i) CE_DESC(Lf[i], x0);
#pragma unroll
              for (int i = 0; i < 16; ++i) CE_DESC(Lf[i], x1); }
#undef CK
            float fv[16], den = 0.f; const float f0 = key2f(Lf[0] & ~255u);
#pragma unroll
            for (int k = 0; k < 16; ++k) { fv[k] = __expf(key2f(Lf[k] & ~255u) - f0); den += fv[k]; }
            const float rden = 1.f / den;
            LDS_WAIT();
#pragma unroll
            for (int k = 0; k < 16; ++k) { const unsigned code = 255u - (Lf[k] & 255u); const unsigned e = idx[code >> 4] * 128u + idx[16 + (code & 15u)];
                u32x2 sv; sv.x = e; sv.y = __float_as_uint(fv[k] * rden); SEL[(tl * 8 + h) * 16 + k] = sv; }
        }
    }
    __syncthreads();
    const unsigned char* T8 = A.ws + WS_T8; const float* SC = (const float*)(A.ws + WS_SC);
    LAS u32x2* SORT = (LAS u32x2*)(lds + PE_IDX);
    LAS int* OFFS = (LAS int*)(lds + PE_SEL + 65536);
    for (int ti = 0; ti < 8; ++ti) {
        const int tl = 8 * w + ti;
        const u32x2 e0 = SEL[tl * 128 + lane], e1 = SEL[tl * 128 + 64 + lane];
        const int p0 = (int)(e0.x >> 10), p1 = (int)(e1.x >> 10);
        int off = 0;
        for (int p = 0; p < 16; ++p) {
            const unsigned long long m0 = __ballot(p0 == p), m1 = __ballot(p1 == p);
            const int c0 = __popcll(m0), c1 = __popcll(m1);
            const int r0 = __builtin_amdgcn_mbcnt_hi((unsigned)(m0 >> 32), __builtin_amdgcn_mbcnt_lo((unsigned)m0, 0u));
            const int r1 = __builtin_amdgcn_mbcnt_hi((unsigned)(m1 >> 32), __builtin_amdgcn_mbcnt_lo((unsigned)m1, 0u));
            if (p0 == p) SORT[tl * 128 + off + r0] = e0;
            if (p1 == p) SORT[tl * 128 + off + c0 + r1] = e1;
            if (lane == 0) OFFS[tl * 17 + p] = off;
            off += c0 + c1;
        }
        if (lane == 0) OFFS[tl * 17 + 16] = off;
    }
    LDS_WAIT(); __builtin_amdgcn_wave_barrier();
    const unsigned char* T8v = T8 + (size_t)16384 * 1024;
    const bf16_t* A3 = (const bf16_t*)(A.ws + WS_A3); const float* RSq = (const float*)(A.ws + WS_RS);
    for (int pass = 0; pass < 2; ++pass) {
        const int tb = 8 * w + 4 * pass;
        u32x4 xpa[4], xpb[4]; f32x2 oacc[4][8];
#pragma unroll
        for (int tk = 0; tk < 4; ++tk) { const size_t m = (size_t)tile * 64 + tb + tk;
            { const u32x4 ra = *(const u32x4*)(A3 + m * 1024 + 16 * lane), rb = *(const u32x4*)(A3 + m * 1024 + 16 * lane + 8);
              float xr_; { const f32x4 p0 = *(const f32x4*)(RSq + m * 16), p1 = *(const f32x4*)(RSq + m * 16 + 4), p2 = *(const f32x4*)(RSq + m * 16 + 8), p3 = *(const f32x4*)(RSq + m * 16 + 12);
                const f32x4 ps = (p0 + p1) + (p2 + p3); xr_ = rsqrtf(((ps[0] + ps[1]) + (ps[2] + ps[3])) * (1.f / 1024.f) + 1e-6f); }
              const unsigned rr[8] = {ra.x, ra.y, ra.z, ra.w, rb.x, rb.y, rb.z, rb.w}; unsigned hh[8];
              const float* sp = MOD + (int)(m >> 11) * 6144 + 3072 + 16 * lane;
#pragma unroll
              for (int q = 0; q < 8; ++q) { const f32x2 sh = *(const f32x2*)(sp + 2 * q); hh[q] = pk2(bflo(rr[q]) * xr_ + sh[0], bfhi(rr[q]) * xr_ + sh[1]); }
              xpa[tk] = (u32x4){hh[0], hh[1], hh[2], hh[3]}; xpb[tk] = (u32x4){hh[4], hh[5], hh[6], hh[7]}; }
#pragma unroll
            for (int q = 0; q < 8; ++q) oacc[tk][q] = (f32x2){0.f, 0.f}; }
        int it_p = 0, it_tk = -1, it_j = 0, it_end = 0; bool it_done = false;
#define IT_ADVANCE() do { it_j += 4; while (it_j >= it_end) { if (it_done) break; ++it_tk; if (it_tk == 4) { it_tk = 0; ++it_p; if (it_p == 16) { it_done = true; it_p = 15; it_j = 0; it_end = 1; break; } } \
            it_j = __builtin_amdgcn_readfirstlane(OFFS[(tb + it_tk) * 17 + it_p]); it_end = __builtin_amdgcn_readfirstlane(OFFS[(tb + it_tk) * 17 + it_p + 1]); } } while (0)
#define LOAD_SET(U, V, CG, SU, SV) do { const int _tl = tb + it_tk; \
            _Pragma("unroll") for (int _k = 0; _k < 4; ++_k) { const int _jj = (it_j + _k < it_end) ? it_j + _k : it_end - 1; const unsigned _e = SORT[_tl * 128 + _jj].x; \
                U[_k] = *(const u32x4*)(T8 + (size_t)_e * 1024 + 16 * lane); V[_k] = *(const u32x4*)(T8v + (size_t)_e * 1024 + 16 * lane); } \
            const int _ms = lane >> 4; const bool _valid = it_j + _ms < it_end; const u32x2 _se = SORT[_tl * 128 + (_valid ? it_j + _ms : it_end - 1)]; \
            CG = _valid ? __uint_as_float(_se.y) : 0.f; SU = SC[_se.x]; SV = SC[16384 + _se.x]; } while (0)
        u32x4 uA[4], vA[4], uB[4], vB[4]; float cgA = 0.f, suA = 0.f, svA = 0.f, cgB = 0.f, suB = 0.f, svB = 0.f;
#pragma unroll
        for (int k = 0; k < 4; ++k) { uA[k] = (u32x4){0u, 0u, 0u, 0u}; vA[k] = uA[k]; uB[k] = uA[k]; vB[k] = uA[k]; }
        IT_ADVANCE();
        LOAD_SET(uA, vA, cgA, suA, svA);
        for (int p = 0; p < 16; ++p) {
#pragma unroll
            for (int tk = 0; tk < 4; ++tk) {
                const int tl = tb + tk;
                const int beg = __builtin_amdgcn_readfirstlane(OFFS[tl * 17 + p]), end = __builtin_amdgcn_readfirstlane(OFFS[tl * 17 + p + 1]);
                f32x2 xf[8];
                { const unsigned xx[8] = {xpa[tk].x, xpa[tk].y, xpa[tk].z, xpa[tk].w, xpb[tk].x, xpb[tk].y, xpb[tk].z, xpb[tk].w};
#pragma unroll
                  for (int q = 0; q < 8; ++q) xf[q] = (f32x2){bflo(xx[q]), bfhi(xx[q])}; }
#define COMPUTE_SET(U, V, CG, SU, SV) do { float pd[4]; \
                    _Pragma("unroll") for (int k = 0; k < 4; ++k) { f32x2 d = (f32x2){0.f, 0.f}; \
                        _Pragma("unroll") for (int q = 0; q < 4; ++q) { const int dw = (int)U[k][q]; \
                            d += __builtin_amdgcn_cvt_pk_f32_fp8(dw, false) * xf[2 * q]; d += __builtin_amdgcn_cvt_pk_f32_fp8(dw, true) * xf[2 * q + 1]; } \
                        pd[k] = d[0] + d[1]; } \
                    float s; \
                    { const auto r0 = __builtin_amdgcn_permlane32_swap(__float_as_uint(pd[0]), __float_as_uint(pd[2]), false, false); \
                      const auto r1 = __builtin_amdgcn_permlane32_swap(__float_as_uint(pd[1]), __float_as_uint(pd[3]), false, false); \
                      const float a0 = __uint_as_float(r0[0]) + __uint_as_float(r0[1]), a1 = __uint_as_float(r1[0]) + __uint_as_float(r1[1]); \
                      const auto r2 = __builtin_amdgcn_permlane16_swap(__float_as_uint(a0), __float_as_uint(a1), false, false); \
                      s = __uint_as_float(r2[0]) + __uint_as_float(r2[1]); \
                      s += __int_as_float(__builtin_amdgcn_mov_dpp(__float_as_int(s), 0xB1, 0xF, 0xF, true)); \
                      s += __int_as_float(__builtin_amdgcn_mov_dpp(__float_as_int(s), 0x4E, 0xF, 0xF, true)); \
                      s += __int_as_float(__builtin_amdgcn_mov_dpp(__float_as_int(s), 0x141, 0xF, 0xF, true)); \
                      s += __int_as_float(__builtin_amdgcn_mov_dpp(__float_as_int(s), 0x140, 0xF, 0xF, true)); } \
                    const float coef = CG * gelu_fast(s * SU) * SV; \
                    _Pragma("unroll") for (int k = 0; k < 4; ++k) { const float ck = __int_as_float(__builtin_amdgcn_readlane(__float_as_int(coef), 16 * k)); const f32x2 ck2 = (f32x2){ck, ck}; \
                        _Pragma("unroll") for (int qq = 0; qq < 4; ++qq) { const int dw = (int)V[k][qq]; \
                            oacc[tk][2 * qq] += ck2 * __builtin_amdgcn_cvt_pk_f32_fp8(dw, false); oacc[tk][2 * qq + 1] += ck2 * __builtin_amdgcn_cvt_pk_f32_fp8(dw, true); } } } while (0)
                for (int j0 = beg; j0 < end; j0 += 8) {
                    IT_ADVANCE();
                    LOAD_SET(uB, vB, cgB, suB, svB);
                    COMPUTE_SET(uA, vA, cgA, suA, svA);
                    if (j0 + 4 < end) {
                        IT_ADVANCE();
                        LOAD_SET(uA, vA, cgA, suA, svA);
                        COMPUTE_SET(uB, vB, cgB, suB, svB);
                    } else {
#pragma unroll
                        for (int k = 0; k < 4; ++k) { uA[k] = uB[k]; vA[k] = vB[k]; }
                        cgA = cgB; suA = suB; svA = svB;
                    }
                }
            }
        }
#undef COMPUTE_SET
#undef IT_ADVANCE
#undef LOAD_SET
#pragma unroll
        for (int tk = 0; tk < 4; ++tk) {
            const size_t m = (size_t)tile * 64 + tb + tk; const int b = (int)(m >> 11);
            float* orow = A.out + m * 1024 + 16 * lane;
            const float* g2 = MOD + b * 6144 + 5120 + 16 * lane;
            f32x4 xv[4]; float ss = 0.f;
#pragma unroll
            for (int j = 0; j < 4; ++j) { const f32x4 x1 = *(const f32x4*)(orow + 4 * j), gg = *(const f32x4*)(g2 + 4 * j);
                const f32x4 pe = (f32x4){oacc[tk][2 * j][0], oacc[tk][2 * j][1], oacc[tk][2 * j + 1][0], oacc[tk][2 * j + 1][1]};
                xv[j] = x1 + gg * pe; ss += (xv[j][0] * xv[j][0] + xv[j][1] * xv[j][1]) + (xv[j][2] * xv[j][2] + xv[j][3] * xv[j][3]); }
            const float rstd = rsqrtf(wave_sum(ss) * (1.f / 1024.f) + 1e-6f);
#pragma unroll
            for (int j = 0; j < 4; ++j) { const f32x4 fg = *(const f32x4*)(A.final_g + 16 * lane + 4 * j); *(f32x4*)(orow + 4 * j) = xv[j] * rstd * fg; }
        }
    }
    __syncthreads();
}


#define XB_TMO      128
#define XB_XCNT(j)  (256  + 64 * (j))
#define XB_XSUB(j)  (1280 + 64 * (j))
#define XB_XGEN(j)  (2304 + 64 * (j))
#define XB_TOP      3328
#define XB_TOPGEN   3392
#define XCD_BAR_WORDS 3456
#define XB_SPIN_CAP (1u << 18)

__device__ __forceinline__ unsigned xb_ld(unsigned* p)              { return __hip_atomic_load(p, __ATOMIC_RELAXED, __HIP_MEMORY_SCOPE_AGENT); }
__device__ __forceinline__ unsigned xb_add(unsigned* p, unsigned v) { return __hip_atomic_fetch_add(p, v, __ATOMIC_RELAXED, __HIP_MEMORY_SCOPE_AGENT); }
__device__ __forceinline__ unsigned xb_xcc_id() { return (unsigned)__builtin_amdgcn_s_getreg((3 << 11) | 20) & 0xFu; }
#define XB_SPIN(cond, bar) do { unsigned _sp = 0; while (cond) { __builtin_amdgcn_s_sleep(1); \
    if ((++_sp & 255u) == 0u) { if (xb_ld(&(bar)[XB_TMO])) break; if (_sp > XB_SPIN_CAP) { atomicAdd(&(bar)[XB_TMO], 1u); break; } } } } while (0)

struct XcdBarrier {
    unsigned* bar; unsigned x;
    volatile LAS unsigned* st;
};

__device__ __forceinline__ XcdBarrier xcd_barrier_post(unsigned* bar, volatile LAS unsigned* st) {
    XcdBarrier b; b.bar = bar; b.x = xb_xcc_id(); b.st = st;
    if (threadIdx.x == 0) (void)xb_add(&bar[XB_XCNT(b.x)], 1u);
    return b;
}
__device__ __forceinline__ void xcd_barrier_complete(unsigned* bar, unsigned x, unsigned& nloc, unsigned& nx) {
    const unsigned G = gridDim.x * gridDim.y * gridDim.z;
    unsigned sum, cnt, mine, sp = 0u;
    for (;;) {
        sum = 0u; cnt = 0u; mine = 0u;
#pragma unroll
        for (unsigned j = 0; j < 16; ++j) { const unsigned c = xb_ld(&bar[XB_XCNT(j)]); sum += c; cnt += (c > 0u) ? 1u : 0u; mine = (j == x) ? c : mine; }
        if (sum == G) break;
        __builtin_amdgcn_s_sleep(1);
        if ((++sp & 255u) == 0u) { if (xb_ld(&bar[XB_TMO])) break; if (sp > XB_SPIN_CAP) { atomicAdd(&bar[XB_TMO], 1u); break; } }
    }
    nloc = mine > 0u ? mine : 1u; nx = cnt > 0u ? cnt : 1u;
}

__device__ __forceinline__ void xcd_barrier(const XcdBarrier& b) {
    asm volatile("s_waitcnt vmcnt(0)" ::: "memory");
    __syncthreads();
    if (threadIdx.x == 0) {
        unsigned* bar = b.bar;
        __builtin_amdgcn_s_waitcnt(0);
        unsigned nloc = b.st[0], nx = b.st[1];
        if (nloc == 0u) { xcd_barrier_complete(bar, b.x, nloc, nx); b.st[0] = nloc; b.st[1] = nx; }
        const unsigned old = xb_add(&bar[XB_XSUB(b.x)], 1u);
        const unsigned gen = old / nloc;
        if (old + 1u == (gen + 1u) * nloc) {
            __builtin_amdgcn_fence(__ATOMIC_RELEASE, "agent");
            asm volatile("s_waitcnt vmcnt(0)" ::: "memory");
            const unsigned og = xb_add(&bar[XB_TOP], 1u);
            const unsigned tg = og / nx;
            if (og + 1u == (tg + 1u) * nx) xb_add(&bar[XB_TOPGEN], 1u);
            else XB_SPIN(xb_ld(&bar[XB_TOPGEN]) == tg, bar);
            __builtin_amdgcn_fence(__ATOMIC_ACQUIRE, "agent");
            xb_add(&bar[XB_XGEN(b.x)], 1u);
            asm volatile("s_waitcnt vmcnt(0)" ::: "memory");
        } else {
            XB_SPIN(xb_ld(&bar[XB_XGEN(b.x)]) == gen, bar);
            __builtin_amdgcn_fence(__ATOMIC_ACQUIRE, "agent");
            asm volatile("s_waitcnt vmcnt(0)" ::: "memory");
        }
    }
    __syncthreads();
}

__global__ void __launch_bounds__(512, 2) mega_fwd(Args A) {
    extern __shared__ __attribute__((aligned(16))) unsigned char lds_raw[];
    LAS unsigned char* lds = (LAS unsigned char*)lds_raw;
    cg::grid_group grid = cg::this_grid();
    const int G = gridDim.x;
    if (threadIdx.x < 4) ((LAS unsigned*)(lds + LDS_BYTES - 32))[threadIdx.x] = 0u;
    __syncthreads();
    if (A.ws == nullptr) grid.sync();
    const XcdBarrier xb = xcd_barrier_post((unsigned*)(A.ws + WS_BAR), (volatile LAS unsigned*)(lds + LDS_BYTES - 32));
    phase0(A, lds);
    xcd_barrier(xb);
    phase1(A, lds);
    phase0b(A, lds);
    xcd_barrier(xb);
    { pg8::Gemm gm{(const pg8::bf16_t*)(A.ws + WS_ACT), (const pg8::bf16_t*)(A.ws + WS_WIN), T, NP, DM}; pg8::StaticOrder S; S.init(T, NP, G, (int)blockIdx.x);
      pg8::EpiStoreBf16 E{(pg8::bf16_t*)(A.ws + WS_P), NP};
      pg8::gemm_phase<pg8::EpiStoreBf16, pg8::StaticOrder, true, true>((PG8_LAS unsigned char*)lds, gm, S, E); }
    { const int nshort = G - (896 % G == 0 ? 0 : 896 % G);
      const int first = G - nshort;
      if ((int)blockIdx.x >= first) quantise_tables(A, ((int)blockIdx.x - first) * 8 + (int)(threadIdx.x >> 6), nshort * 8); }
    xcd_barrier(xb);
    phase3(A, lds);
    xcd_barrier(xb);
    phase3b(A, lds);
    xcd_barrier(xb);
    { pg8::Gemm gm{(const pg8::bf16_t*)(A.ws + WS_ACT), (const pg8::bf16_t*)(A.ws + WS_WOUT), T, DM, DM}; pg8::StaticOrder S; S.init(T, DM, G, (int)blockIdx.x);
      pg8::EpiResidNorm E{A.x, (const float*)(A.ws + WS_MOD), A.norm2_g, A.out, (pg8::bf16_t*)(A.ws + WS_A3), (float*)(A.ws + WS_RS)};
      pg8::gemm_phase<pg8::EpiResidNorm, pg8::StaticOrder, true, true>((PG8_LAS unsigned char*)lds, gm, S, E); }
    xcd_barrier(xb);
    { pg8::Gemm gm{(const pg8::bf16_t*)(A.ws + WS_A3), (const pg8::bf16_t*)(A.ws + WS_WQ), T, 2048, DM}; pg8::StaticOrder S; S.init(T, 2048, G, (int)blockIdx.x);
      pg8::EpiScoreF16 E{(pg8::bf16_t*)(A.ws + WS_QRY), 2048, (const float*)(A.ws + WS_RS), (const float*)(A.ws + WS_SB)};
      pg8::gemm_phase<pg8::EpiScoreF16, pg8::StaticOrder, true, true>((PG8_LAS unsigned char*)lds, gm, S, E); }
    xcd_barrier(xb);
    for (int tile = blockIdx.x; tile < T / 64; tile += G) peer_tile(A, lds, tile);
}

extern "C" void kernel_launch(void* const* d_in, const int* in_sizes, int n_in, void* d_out, int out_size, void* d_ws, size_t ws_size, hipStream_t stream) {
    static int grid = 0;
    if (grid == 0) {
        if (n_in != 22 || out_size != T * DM || ws_size < WS_END) { fprintf(stderr, "kernel_launch: unexpected shapes (n_in %d out %d ws %zu)\n", n_in, out_size, ws_size); grid = -1; return; }
        int dev = 0, cus = 0, per_cu = 0;
        if (hipGetDevice(&dev) != hipSuccess || hipDeviceGetAttribute(&cus, hipDeviceAttributeMultiprocessorCount, dev) != hipSuccess) { grid = -1; return; }
        if (hipFuncSetAttribute((const void*)mega_fwd, hipFuncAttributeMaxDynamicSharedMemorySize, LDS_BYTES) != hipSuccess) { fprintf(stderr, "kernel_launch: hipFuncSetAttribute failed\n"); grid = -1; return; }
        if (hipOccupancyMaxActiveBlocksPerMultiprocessor(&per_cu, (const void*)mega_fwd, 512, LDS_BYTES) != hipSuccess || per_cu < 1) { fprintf(stderr, "kernel_launch: occupancy query gave %d\n", per_cu); per_cu = 1; }
        (void)hipGetLastError();
        grid = cus * per_cu;
    }
    if (grid < 0) return;
    Args a{};
    const float** ap = (const float**)&a;
    for (int i = 0; i < 22; ++i) ap[i] = (const float*)d_in[i];
    a.out = (float*)d_out; a.ws = (unsigned char*)d_ws;
    if (hipMemsetAsync((unsigned char*)d_ws + WS_BAR, 0, XCD_BAR_WORDS * sizeof(unsigned), stream) != hipSuccess) { fprintf(stderr, "kernel_launch: memset of the barrier words failed\n"); return; }
    void* args[] = {&a};
    hipError_t e = hipLaunchCooperativeKernel((const void*)mega_fwd, dim3(grid), dim3(512), args, LDS_BYTES, stream);
    if (e != hipSuccess) fprintf(stderr, "kernel_launch: cooperative launch failed: %s (grid %d)\n", hipGetErrorString(e), grid);
}
```

```cpp
#include <hip/hip_runtime.h>
#include <hip/hip_cooperative_groups.h>
#include <cstdio>
#include <cstdint>
namespace cg = cooperative_groups;

namespace pg8 {
#define PG8_LAS __attribute__((address_space(3)))
typedef unsigned short bf16_t;
typedef short bf16x8 __attribute__((ext_vector_type(8)));
typedef float f32x4 __attribute__((ext_vector_type(4)));
typedef unsigned u32x4 __attribute__((ext_vector_type(4)));
constexpr int BM = 256, BK = 64, HALF = 128, HTB = HALF * BK * 2  , STAGE_BYTES = 8 * HTB, NXCD = 8, WGM = 8;

__host__ __device__ __forceinline__ int lds_byte(int r, int c) { const int st = (r >> 4) * 2 + (c >> 5), rr = r & 15, cc = c & 31, ob = rr * 64 + cc * 2; return st * 1024 + (ob ^ (((ob >> 9) & 1) << 5)); }
__host__ __device__ __forceinline__ void stage_rc(int b, int& R, int& C) { const int st = b / 1024, sb = b % 1024, swz = sb ^ (((sb >> 9) & 1) << 5); R = (st >> 1) * 16 + swz / 64; C = (st & 1) * 32 + (swz % 64) / 2; }
__host__ __device__ __forceinline__ int perm32(int rho) { const int n = rho >> 4, i = rho & 15; return 8 * (i >> 2) + 4 * n + (i & 3); }

struct Unit { int pm, pn; };
struct Gemm { const bf16_t* A; const bf16_t* Bt; int M, N, K; };

struct StaticOrder {
    int nM, nN, nwg, G, c;
    __host__ __device__ void init(int M, int N, int G_, int c_) { nM = M / BM; nN = N / BM; nwg = nM * nN; G = G_; c = c_; }
    __host__ __device__ bool next(int i, Unit& u) const {
        const long L = (long)i * G + c; if (L >= nwg) return false;
        int wgid = (int)L; { const int q = nwg / NXCD, r = nwg % NXCD, xcd = wgid % NXCD, off = wgid / NXCD; wgid = (xcd < r ? xcd * (q + 1) : r * (q + 1) + (xcd - r) * q) + off; }
        const int nig = WGM * nN, gid = wgid / nig, fm = gid * WGM, gsz = (nM - fm) < WGM ? (nM - fm) : WGM;
        u.pm = fm + ((wgid % nig) % gsz); u.pn = (wgid % nig) / gsz; return true;
    }
    __device__ __forceinline__ void a_ready(const Unit&) const {}
    __device__ __forceinline__ void done(const Unit&) const {}
};

__device__ __forceinline__ unsigned cvt_pk_bf16(float lo, float hi) { unsigned r; asm volatile("v_cvt_pk_bf16_f32 %0, %1, %2" : "=v"(r) : "v"(lo), "v"(hi)); return r; }

struct EpiStoreBf16 {
    static constexpr bool PERM = true, AFTER_DRAIN = false;
    bf16_t* O; int ldc;
    __device__ __forceinline__ void operator()(const f32x4 (&acc)[2][2][4][2], const Unit& u, int wr, int wc, int fr, int fq) const {
        const int row0 = u.pm * BM + wr * 64 + fr, col0 = u.pn * BM + wc * 32 + 8 * fq;
#pragma unroll
        for (int ai = 0; ai < 2; ++ai)
#pragma unroll
            for (int m = 0; m < 4; ++m) { bf16_t* rowp = O + (size_t)(row0 + ai * HALF + m * 16) * ldc + col0;
#pragma unroll
                for (int bj = 0; bj < 2; ++bj) { const f32x4 v0 = acc[ai][bj][m][0], v1 = acc[ai][bj][m][1];
                    u32x4 w; w.x = cvt_pk_bf16(v0[0], v0[1]); w.y = cvt_pk_bf16(v0[2], v0[3]); w.z = cvt_pk_bf16(v1[0], v1[1]); w.w = cvt_pk_bf16(v1[2], v1[3]);
                    *(u32x4*)(rowp + bj * HALF) = w; } }
    }
};
struct EpiStoreF16 {
    static constexpr bool PERM = true, AFTER_DRAIN = false;
    bf16_t* O; int ldc;
    static __device__ __forceinline__ unsigned pkh(float a, float b) { return (unsigned)__builtin_bit_cast(unsigned short, (_Float16)a) | ((unsigned)__builtin_bit_cast(unsigned short, (_Float16)b) << 16); }
    __device__ __forceinline__ void operator()(const f32x4 (&acc)[2][2][4][2], const Unit& u, int wr, int wc, int fr, int fq) const {
        const int row0 = u.pm * BM + wr * 64 + fr, col0 = u.pn * BM + wc * 32 + 8 * fq;
#pragma unroll
        for (int ai = 0; ai < 2; ++ai)
#pragma unroll
            for (int m = 0; m < 4; ++m) { bf16_t* rowp = O + (size_t)(row0 + ai * HALF + m * 16) * ldc + col0;
#pragma unroll
                for (int bj = 0; bj < 2; ++bj) { const f32x4 v0 = acc[ai][bj][m][0], v1 = acc[ai][bj][m][1];
                    u32x4 w; w.x = pkh(v0[0], v0[1]); w.y = pkh(v0[2], v0[3]); w.z = pkh(v1[0], v1[1]); w.w = pkh(v1[2], v1[3]);
                    *(u32x4*)(rowp + bj * HALF) = w; } }
    }
};
struct EpiResid {
    static constexpr bool PERM = true, AFTER_DRAIN = false;
    const float* x; const float* gate; float* out;
    __device__ __forceinline__ void operator()(const f32x4 (&acc)[2][2][4][2], const Unit& u, int wr, int wc, int fr, int fq) const {
        const int row0 = u.pm * BM + wr * 64 + fr, col0 = u.pn * BM + wc * 32 + 8 * fq;
#pragma unroll
        for (int ai = 0; ai < 2; ++ai)
#pragma unroll
            for (int m = 0; m < 4; ++m) { const int r = row0 + ai * HALF + m * 16; const float* gp = gate + (size_t)(r >> 11) * 6144;
#pragma unroll
                for (int bj = 0; bj < 2; ++bj) { const int c = col0 + bj * HALF;
                    const f32x4 xa = *(const f32x4*)(x + (size_t)r * 1024 + c), xb = *(const f32x4*)(x + (size_t)r * 1024 + c + 4);
                    const f32x4 ga = *(const f32x4*)(gp + c), gb = *(const f32x4*)(gp + c + 4);
                    *(f32x4*)(out + (size_t)r * 1024 + c) = xa + ga * acc[ai][bj][m][0];
                    *(f32x4*)(out + (size_t)r * 1024 + c + 4) = xb + gb * acc[ai][bj][m][1]; } }
    }
};
struct EpiResidNorm {
    static constexpr bool PERM = true, AFTER_DRAIN = false;
    const float* x; const float* mod; const float* ng; float* out; bf16_t* a3; float* rs;
    __device__ __forceinline__ void operator()(const f32x4 (&acc)[2][2][4][2], const Unit& u, int wr, int wc, int fr, int fq) const {
        const int row0 = u.pm * BM + wr * 64 + fr, col0 = u.pn * BM + wc * 32 + 8 * fq;
        const float* mp = mod + (size_t)((u.pm * BM) >> 11) * 6144;
        f32x4 g1v[2][2], csv[2][2];
#pragma unroll
        for (int bj = 0; bj < 2; ++bj)
#pragma unroll
            for (int n = 0; n < 2; ++n) { const int c = col0 + bj * HALF + 4 * n; g1v[bj][n] = *(const f32x4*)(mp + 2048 + c); csv[bj][n] = *(const f32x4*)(ng + c) * (*(const f32x4*)(mp + 4096 + c) + 1.0f); }
#pragma unroll
        for (int ai = 0; ai < 2; ++ai)
#pragma unroll
            for (int m = 0; m < 4; ++m) { const int r = row0 + ai * HALF + m * 16; float ss = 0.f;
#pragma unroll
                for (int bj = 0; bj < 2; ++bj) { const int c = col0 + bj * HALF;
                    const f32x4 xa = *(const f32x4*)(x + (size_t)r * 1024 + c), xb = *(const f32x4*)(x + (size_t)r * 1024 + c + 4);
                    const f32x4 v0 = xa + g1v[bj][0] * acc[ai][bj][m][0], v1 = xb + g1v[bj][1] * acc[ai][bj][m][1];
                    *(f32x4*)(out + (size_t)r * 1024 + c) = v0; *(f32x4*)(out + (size_t)r * 1024 + c + 4) = v1;
                    ss += (v0[0] * v0[0] + v0[1] * v0[1]) + (v0[2] * v0[2] + v0[3] * v0[3]) + (v1[0] * v1[0] + v1[1] * v1[1]) + (v1[2] * v1[2] + v1[3] * v1[3]);
                    const f32x4 a0 = v0 * csv[bj][0], a1 = v1 * csv[bj][1];
                    u32x4 w; w.x = cvt_pk_bf16(a0[0], a0[1]); w.y = cvt_pk_bf16(a0[2], a0[3]); w.z = cvt_pk_bf16(a1[0], a1[1]); w.w = cvt_pk_bf16(a1[2], a1[3]);
                    *(u32x4*)(a3 + (size_t)r * 1024 + c) = w; }
                ss += __shfl_xor(ss, 16); ss += __shfl_xor(ss, 32);
                if (fq == 0) rs[(size_t)r * 16 + (u.pn & 3) * 4 + wc] = ss; }
    }
};
struct EpiScoreF16 {
    static constexpr bool PERM = true, AFTER_DRAIN = false;
    bf16_t* O; int ldc; const float* rs; const float* sb;
    static __device__ __forceinline__ unsigned pkh(float a, float b) { return (unsigned)__builtin_bit_cast(unsigned short, (_Float16)a) | ((unsigned)__builtin_bit_cast(unsigned short, (_Float16)b) << 16); }
    __device__ __forceinline__ void operator()(const f32x4 (&acc)[2][2][4][2], const Unit& u, int wr, int wc, int fr, int fq) const {
        const int row0 = u.pm * BM + wr * 64 + fr, col0 = u.pn * BM + wc * 32 + 8 * fq;
        const float* sbp = sb + (size_t)((u.pm * BM) >> 11) * 2048;
        f32x4 bv[2][2];
#pragma unroll
        for (int bj = 0; bj < 2; ++bj)
#pragma unroll
            for (int n = 0; n < 2; ++n) bv[bj][n] = *(const f32x4*)(sbp + col0 + bj * HALF + 4 * n);
#pragma unroll
        for (int ai = 0; ai < 2; ++ai)
#pragma unroll
            for (int m = 0; m < 4; ++m) { const int r = row0 + ai * HALF + m * 16;
                float rstd; { const f32x4 p0 = *(const f32x4*)(rs + (size_t)r * 16), p1 = *(const f32x4*)(rs + (size_t)r * 16 + 4), p2 = *(const f32x4*)(rs + (size_t)r * 16 + 8), p3 = *(const f32x4*)(rs + (size_t)r * 16 + 12);
                  const f32x4 ps = (p0 + p1) + (p2 + p3); rstd = rsqrtf(((ps[0] + ps[1]) + (ps[2] + ps[3])) * (1.f / 1024.f) + 1e-6f); }
                bf16_t* rowp = O + (size_t)r * ldc + col0;
#pragma unroll
                for (int bj = 0; bj < 2; ++bj) { const f32x4 v0 = acc[ai][bj][m][0] * rstd + bv[bj][0], v1 = acc[ai][bj][m][1] * rstd + bv[bj][1];
                    u32x4 w; w.x = pkh(v0[0], v0[1]); w.y = pkh(v0[2], v0[3]); w.z = pkh(v1[0], v1[1]); w.w = pkh(v1[2], v1[3]);
                    *(u32x4*)(rowp + bj * HALF) = w; } }
    }
};
template <class Epi, class Sched, bool ALIGN_EPI = false, bool SP2 = false>
__device__ __forceinline__ void gemm_phase(PG8_LAS unsigned char* lds, const Gemm g, const Sched& S, const Epi& E) {
    int tid_o = threadIdx.x; asm volatile("" : "+v"(tid_o)); const int tid = tid_o, wid = __builtin_amdgcn_readfirstlane(tid >> 6), lane = tid & 63, wr = wid >> 2, wc = wid & 3, fr = lane & 15, fq = lane >> 4;
    const int K = g.K, nt = K / BK;
    unsigned voffA[2], voffB[2];
#pragma unroll
    for (int i = 0; i < 2; ++i) { int R, C; stage_rc(tid * 16 + i * 8192, R, C); const int Rb = Epi::PERM ? ((R & ~31) + perm32(R & 31)) : R;
        voffA[i] = (unsigned)(R * K + C) * 2u; voffB[i] = (unsigned)(Rb * K + C) * 2u; }
    const size_t kstep = (size_t)(BK * 2);
    const size_t hstep = (size_t)HALF * K * 2;
    const size_t tstep = 2 * hstep;
    const unsigned ldsw = (unsigned)wid * 1024u;
    const int aoff = lds_byte(wr * 64 + fr, fq * 8), boff = lds_byte(wc * 32 + fr, fq * 8);
#define PG8_SA(b, h) (((b) * 2 + (h)) * HTB)
#define PG8_SB(b, h) ((4 + (b) * 2 + (h)) * HTB)
#define PG8_STAGE(bufoff, gbase, voff) do { _Pragma("unroll") for (int _i = 0; _i < 2; ++_i) \
        __builtin_amdgcn_global_load_lds((const unsigned*)((const char*)(gbase) + (voff)[_i]), (PG8_LAS unsigned*)(lds + (bufoff) + ldsw + _i * 8192), 16, 0, 0); } while (0)
#define PG8_LDA(dst, b, h) do { _Pragma("unroll") for (int m = 0; m < 4; ++m) _Pragma("unroll") for (int k = 0; k < 2; ++k) dst[m][k] = *(const PG8_LAS bf16x8*)(lds + PG8_SA(b, h) + aoff + m * 2048 + k * 1024); } while (0)
#define PG8_LDB(dst, b, h) do { _Pragma("unroll") for (int n = 0; n < 2; ++n) _Pragma("unroll") for (int k = 0; k < 2; ++k) dst[n][k] = *(const PG8_LAS bf16x8*)(lds + PG8_SB(b, h) + boff + n * 2048 + k * 1024); } while (0)
#define PG8_MMA(ai, bj, At, Bt) do { __builtin_amdgcn_s_setprio(1); _Pragma("unroll") for (int m = 0; m < 4; ++m) _Pragma("unroll") for (int n = 0; n < 2; ++n) _Pragma("unroll") for (int k = 0; k < 2; ++k) \
        acc[ai][bj][m][n] = __builtin_amdgcn_mfma_f32_16x16x32_bf16(Bt[n][k], At[m][k], acc[ai][bj][m][n], 0, 0, 0); __builtin_amdgcn_s_setprio(0); } while (0)
#define PG8_WAIT_V(n) asm volatile("s_waitcnt vmcnt(" #n ")" ::: "memory")
#define PG8_WAIT_L(n) asm volatile("s_waitcnt lgkmcnt(" #n ")" ::: "memory")
#define PG8_BAR __builtin_amdgcn_s_barrier()
#define PG8_SCHED __builtin_amdgcn_sched_barrier(0)
    Unit cur, nxt; int ui = 0;
    if (!S.next(0, cur)) return;
    f32x4 acc[2][2][4][2];
#pragma unroll
    for (int a = 0; a < 2; ++a)
#pragma unroll
        for (int b = 0; b < 2; ++b)
#pragma unroll
            for (int m = 0; m < 4; ++m)
#pragma unroll
                for (int n = 0; n < 2; ++n) acc[a][b][m][n] = (f32x4){0.f, 0.f, 0.f, 0.f};
    bf16x8 At[4][2], B0[2][2], B1[2][2];
    const char* cA = (const char*)g.A + (size_t)cur.pm * tstep; const char* cB = (const char*)g.Bt + (size_t)cur.pn * tstep;
    S.a_ready(cur);
    if constexpr (SP2) {
        PG8_STAGE(PG8_SB(0, 0), cB, voffB); PG8_STAGE(PG8_SB(0, 1), cB + hstep, voffB); PG8_STAGE(PG8_SA(0, 0), cA, voffA); PG8_STAGE(PG8_SA(0, 1), cA + hstep, voffA);
        if (wr == 1) PG8_BAR;
        PG8_WAIT_V(2); PG8_BAR;
        PG8_STAGE(PG8_SB(1, 0), cB + kstep, voffB); PG8_STAGE(PG8_SA(1, 0), cA + kstep, voffA); PG8_STAGE(PG8_SB(1, 1), cB + hstep + kstep, voffB);
        PG8_WAIT_V(6); PG8_BAR;
    } else {
        PG8_STAGE(PG8_SB(0, 0), cB, voffB); PG8_STAGE(PG8_SA(0, 0), cA, voffA); PG8_STAGE(PG8_SB(0, 1), cB + hstep, voffB); PG8_STAGE(PG8_SA(0, 1), cA + hstep, voffA);
        if (wr == 1) PG8_BAR;
        PG8_WAIT_V(4); PG8_BAR;
        PG8_STAGE(PG8_SB(1, 0), cB + kstep, voffB); PG8_STAGE(PG8_SA(1, 0), cA + kstep, voffA); PG8_STAGE(PG8_SB(1, 1), cB + hstep + kstep, voffB);
        PG8_WAIT_V(6); PG8_BAR;
    }
    for (;;) {
        const bool has_next = S.next(ui + 1, nxt);
        const char* nA = has_next ? (const char*)g.A + (size_t)nxt.pm * tstep : cA; const char* nB = has_next ? (const char*)g.Bt + (size_t)nxt.pn * tstep : cB;
        for (int t = 0; t < nt; t += 2) {
            const bool last = (t == nt - 2);
            const char* a1 = cA + (size_t)(t + 1) * kstep;
            const char* a2 = last ? nA : cA + (size_t)(t + 2) * kstep; const char* b2 = last ? nB : cB + (size_t)(t + 2) * kstep;
            const char* a3 = a2 + kstep; const char* b3 = b2 + kstep;
            if (last && has_next) S.a_ready(nxt);
            if constexpr (SP2) {
            PG8_LDB(B0, 0, 0); PG8_LDB(B1, 0, 1); PG8_SCHED; PG8_LDA(At, 0, 0); PG8_STAGE(PG8_SA(1, 1), a1 + hstep, voffA);
            PG8_WAIT_V(8); PG8_WAIT_L(0); PG8_BAR; PG8_MMA(0, 0, At, B0); PG8_MMA(0, 1, At, B1); PG8_BAR; PG8_SCHED;
            PG8_LDA(At, 0, 1); PG8_STAGE(PG8_SB(0, 0), b2, voffB); PG8_STAGE(PG8_SB(0, 1), b2 + hstep, voffB); PG8_STAGE(PG8_SA(0, 0), a2, voffA);
            PG8_WAIT_V(8); PG8_WAIT_L(0); PG8_BAR; PG8_MMA(1, 0, At, B0); PG8_MMA(1, 1, At, B1); PG8_BAR; PG8_SCHED;
            PG8_LDB(B0, 1, 0); PG8_LDB(B1, 1, 1); PG8_SCHED; PG8_LDA(At, 1, 0); PG8_STAGE(PG8_SA(0, 1), a2 + hstep, voffA);
            PG8_WAIT_V(8); PG8_WAIT_L(0); PG8_BAR; PG8_MMA(0, 0, At, B0); PG8_MMA(0, 1, At, B1); PG8_BAR; PG8_SCHED;
            PG8_LDA(At, 1, 1); PG8_STAGE(PG8_SB(1, 0), b3, voffB); PG8_STAGE(PG8_SB(1, 1), b3 + hstep, voffB); PG8_STAGE(PG8_SA(1, 0), a3, voffA);
            PG8_WAIT_V(8); PG8_WAIT_L(0); PG8_BAR; PG8_MMA(1, 0, At, B0); PG8_MMA(1, 1, At, B1); PG8_BAR; PG8_SCHED;
            } else {
            PG8_LDB(B0, 0, 0); PG8_SCHED; PG8_LDA(At, 0, 0); PG8_STAGE(PG8_SA(1, 1), a1 + hstep, voffA);
            PG8_WAIT_L(8); PG8_BAR; PG8_WAIT_L(0); PG8_MMA(0, 0, At, B0); PG8_BAR; PG8_SCHED;
            PG8_LDB(B1, 0, 1); PG8_STAGE(PG8_SB(0, 0), b2, voffB);
            PG8_BAR; PG8_WAIT_L(0); PG8_MMA(0, 1, At, B1); PG8_BAR;
            PG8_LDA(At, 0, 1); PG8_STAGE(PG8_SA(0, 0), a2, voffA);
            PG8_BAR; PG8_WAIT_L(0); PG8_MMA(1, 0, At, B0); PG8_BAR; PG8_SCHED;
            PG8_STAGE(PG8_SB(0, 1), b2 + hstep, voffB);
            PG8_WAIT_V(6); PG8_BAR; PG8_MMA(1, 1, At, B1); PG8_BAR;
            PG8_LDB(B0, 1, 0); PG8_SCHED; PG8_LDA(At, 1, 0); PG8_STAGE(PG8_SA(0, 1), a2 + hstep, voffA);
            PG8_WAIT_L(8); PG8_BAR; PG8_WAIT_L(0); PG8_MMA(0, 0, At, B0); PG8_BAR; PG8_SCHED;
            PG8_LDB(B1, 1, 1); PG8_STAGE(PG8_SB(1, 0), b3, voffB);
            PG8_BAR; PG8_WAIT_L(0); PG8_MMA(0, 1, At, B1); PG8_BAR;
            PG8_LDA(At, 1, 1); PG8_STAGE(PG8_SA(1, 0), a3, voffA);
            PG8_BAR; PG8_WAIT_L(0); PG8_MMA(1, 0, At, B0); PG8_BAR; PG8_SCHED;
            PG8_STAGE(PG8_SB(1, 1), b3 + hstep, voffB);
            PG8_WAIT_V(6); PG8_BAR; PG8_MMA(1, 1, At, B1); PG8_BAR;
            }
        }
        if constexpr (ALIGN_EPI) { if (wr == 0) PG8_BAR; }
        if constexpr (!Epi::AFTER_DRAIN) { E(acc, cur, wr, wc, fr, fq); S.done(cur); }
        if (!has_next) break;
#pragma unroll
        for (int a = 0; a < 2; ++a)
#pragma unroll
            for (int b = 0; b < 2; ++b)
#pragma unroll
                for (int m = 0; m < 4; ++m)
#pragma unroll
                    for (int n = 0; n < 2; ++n) acc[a][b][m][n] = (f32x4){0.f, 0.f, 0.f, 0.f};
        cur = nxt; cA = nA; cB = nB; ++ui;
        if constexpr (ALIGN_EPI) { if (wr == 1) PG8_BAR; }
    }
    PG8_WAIT_V(0);
    if constexpr (!ALIGN_EPI) { if (wr == 0) PG8_BAR; }
    PG8_BAR;
    if constexpr (Epi::AFTER_DRAIN) { E.fused(acc, cur, wr, wc, fr, fq, lds, wid, lane); S.done(cur); }
#undef PG8_SA
#undef PG8_SB
#undef PG8_STAGE
#undef PG8_LDA
#undef PG8_LDB
#undef PG8_MMA
#undef PG8_WAIT_V
#undef PG8_WAIT_L
#undef PG8_BAR
#undef PG8_SCHED
}
}


#define LAS __attribute__((address_space(3)))
typedef unsigned short bf16_t;
typedef short bf16x8 __attribute__((ext_vector_type(8)));
typedef short s16x4 __attribute__((ext_vector_type(4)));
typedef short v4i16_t __attribute__((ext_vector_type(4)));
typedef float f32x4 __attribute__((ext_vector_type(4)));
typedef unsigned u32x4 __attribute__((ext_vector_type(4)));
typedef unsigned u32x2 __attribute__((ext_vector_type(2)));
typedef float f32x2 __attribute__((ext_vector_type(2)));

constexpr int T = 16384, DM = 1024, SEQ = 2048, NP = 3584;
constexpr size_t MiB = 1u << 20;
constexpr size_t WS_CTL = 0, WS_MOD = 4096, WS_GATES = 262144, WS_KEYS = 1 * MiB, WS_WIN = 2 * MiB, WS_WOUT = 9 * MiB, WS_WQ = 11 * MiB,
                 WS_T8 = 16 * MiB, WS_SC = 48 * MiB, WS_ACT = 80 * MiB, WS_P = 112 * MiB, WS_QRY = 112 * MiB, WS_END = 256 * MiB;
constexpr size_t WS_RS = 208 * MiB, WS_SB = 851968, WS_WGT = 917504, WS_A3 = 176 * MiB;
constexpr int LDS_BYTES = 147456;

__device__ __forceinline__ unsigned f2bf(float f) { unsigned u = __float_as_uint(f); return (u + 0x7fffu + ((u >> 16) & 1u)) >> 16; }
typedef __bf16 bf16x2_t __attribute__((ext_vector_type(2)));
__device__ __forceinline__ unsigned pk2(float lo, float hi) { const f32x2 v = {lo, hi}; const bf16x2_t b = __builtin_convertvector(v, bf16x2_t); return __builtin_bit_cast(unsigned, b); }
__device__ __forceinline__ float bflo(unsigned u) { return __uint_as_float(u << 16); }
__device__ __forceinline__ float bfhi(unsigned u) { return __uint_as_float(u & 0xffff0000u); }
__device__ __forceinline__ float wave_sum(float v) {
    { const auto r = __builtin_amdgcn_permlane32_swap(__float_as_uint(v), __float_as_uint(v), false, false); v = __uint_as_float(r[0]) + __uint_as_float(r[1]); }
    { const auto r = __builtin_amdgcn_permlane16_swap(__float_as_uint(v), __float_as_uint(v), false, false); v = __uint_as_float(r[0]) + __uint_as_float(r[1]); }
    v += __int_as_float(__builtin_amdgcn_mov_dpp(__float_as_int(v), 0xB1, 0xF, 0xF, true));
    v += __int_as_float(__builtin_amdgcn_mov_dpp(__float_as_int(v), 0x4E, 0xF, 0xF, true));
    v += __int_as_float(__builtin_amdgcn_mov_dpp(__float_as_int(v), 0x141, 0xF, 0xF, true));
    v += __int_as_float(__builtin_amdgcn_mov_dpp(__float_as_int(v), 0x140, 0xF, 0xF, true));
    return v;
}
__device__ __forceinline__ float xrow_max(float v) {
    { const auto r = __builtin_amdgcn_permlane16_swap(__float_as_uint(v), __float_as_uint(v), false, false); v = fmaxf(__uint_as_float(r[0]), __uint_as_float(r[1])); }
    { const auto r = __builtin_amdgcn_permlane32_swap(__float_as_uint(v), __float_as_uint(v), false, false); v = fmaxf(__uint_as_float(r[0]), __uint_as_float(r[1])); }
    return v;
}
__device__ __forceinline__ float xrow_sum(float v) {
    { const auto r = __builtin_amdgcn_permlane16_swap(__float_as_uint(v), __float_as_uint(v), false, false); v = __uint_as_float(r[0]) + __uint_as_float(r[1]); }
    { const auto r = __builtin_amdgcn_permlane32_swap(__float_as_uint(v), __float_as_uint(v), false, false); v = __uint_as_float(r[0]) + __uint_as_float(r[1]); }
    return v;
}
#define LDS_WAIT() asm volatile("s_waitcnt lgkmcnt(0)" ::: "memory")
__device__ __forceinline__ s16x4 vtr(LAS unsigned char* p) { return __builtin_bit_cast(s16x4, __builtin_amdgcn_ds_read_tr16_b64_v4i16((LAS v4i16_t*)p)); }
__device__ __forceinline__ bf16x8 cat8(s16x4 a, s16x4 b) { bf16x8 r; r[0] = a[0]; r[1] = a[1]; r[2] = a[2]; r[3] = a[3]; r[4] = b[0]; r[5] = b[1]; r[6] = b[2]; r[7] = b[3]; return r; }
__device__ __forceinline__ bf16x8 pack8(const f32x4 a, const f32x4 b) { u32x4 w; w.x = pk2(a[0], a[1]); w.y = pk2(a[2], a[3]); w.z = pk2(b[0], b[1]); w.w = pk2(b[2], b[3]); return __builtin_bit_cast(bf16x8, w); }
#define MFMA16(a, b, c) __builtin_amdgcn_mfma_f32_16x16x32_bf16((a), (b), (c), 0, 0, 0)

struct Args {
    const float *x, *c, *ada_w, *ada_b, *norm1_g, *w_in, *conv_w, *conv_b, *gate_b, *mnorm_g, *lq1, *lk1, *lq2, *lk2, *dnorm_g, *w_out, *norm2_g, *wq, *keys, *pu, *pv, *final_g;
    float* out; unsigned char* ws;
};

__device__ __forceinline__ void transpose_item(const float* W, int srcN, int soff, bf16_t* WT, LAS float* scr, int kb, int nb, int lane) {
    const int k0 = 64 * kb, n0 = 32 * nb;
    { f32x4 wv[8];
#pragma unroll
      for (int i = 0; i < 8; ++i) wv[i] = *(const f32x4*)(W + (size_t)(k0 + 8 * i + (lane >> 3)) * srcN + n0 + soff + 4 * (lane & 7));
#pragma unroll
      for (int i = 0; i < 8; ++i) { LAS float* d = scr + (8 * i + (lane >> 3)) * 33 + 4 * (lane & 7); d[0] = wv[i][0]; d[1] = wv[i][1]; d[2] = wv[i][2]; d[3] = wv[i][3]; } }
    LDS_WAIT(); asm volatile("" ::: "memory");
    const int c = lane & 7;
#pragma unroll
    for (int j = 0; j < 4; ++j) { const int n = (lane >> 3) + 8 * j; const LAS float* s = scr + (8 * c) * 33 + n;
        u32x4 o; o.x = pk2(s[0 * 33], s[1 * 33]); o.y = pk2(s[2 * 33], s[3 * 33]); o.z = pk2(s[4 * 33], s[5 * 33]); o.w = pk2(s[6 * 33], s[7 * 33]);
        *(u32x4*)(WT + (size_t)(n0 + n) * 1024 + k0 + 8 * c) = o; }
    LDS_WAIT(); asm volatile("" ::: "memory");
}

__device__ __forceinline__ bf16x8 pack8_sw(const f32x4 a, const f32x4 b) {
    u32x4 w; w.x = f2bf(a[0]) | (f2bf(a[1]) << 16); w.y = f2bf(a[2]) | (f2bf(a[3]) << 16); w.z = f2bf(b[0]) | (f2bf(b[1]) << 16); w.w = f2bf(b[2]) | (f2bf(b[3]) << 16); return __builtin_bit_cast(bf16x8, w); }
__device__ __forceinline__ void wprime_item(const Args& A, int hp, int kt, int lane) {
    const int g = lane >> 4, l15 = lane & 15;
    f32x4 acc[8];
#pragma unroll
    for (int nt = 0; nt < 8; ++nt) acc[nt] = (f32x4){0.f, 0.f, 0.f, 0.f};
#pragma unroll
    for (int ks = 0; ks < 4; ++ks) {
        const float* ap = A.wq + (size_t)(16 * kt + l15) * 2048 + hp * 128 + 32 * ks + 8 * g;
        const bf16x8 a = pack8(*(const f32x4*)ap, *(const f32x4*)(ap + 4));
#pragma unroll
        for (int nt = 0; nt < 8; ++nt) { const float* bp = A.keys + (size_t)(hp * 128 + 16 * nt + l15) * 128 + 32 * ks + 8 * g;
            const bf16x8 b = pack8(*(const f32x4*)bp, *(const f32x4*)(bp + 4)); acc[nt] = MFMA16(a, b, acc[nt]); }
    }
    bf16_t* WT = (bf16_t*)(A.ws + WS_WQ);
#pragma unroll
    for (int nt = 0; nt < 8; ++nt) { u32x2 o; o.x = pk2(acc[nt][0], acc[nt][1]); o.y = pk2(acc[nt][2], acc[nt][3]);
        *(u32x2*)(WT + (size_t)(hp * 128 + 16 * nt + l15) * 1024 + 16 * kt + 4 * g) = o; }
}

__device__ __forceinline__ void phase0(const Args& A, LAS unsigned char* lds) {
    int tid_o = threadIdx.x; asm volatile("" : "+v"(tid_o)); const int tid = tid_o, lane = tid & 63, wave = tid >> 6, G = gridDim.x;
    float* MOD = (float*)(A.ws + WS_MOD);
    if ((int)blockIdx.x < 192) {
        LAS float* sc = (LAS float*)lds;
        for (int i = tid; i < 8192; i += 512) { const float v = A.c[i]; sc[i] = v * __builtin_amdgcn_rcpf(1.f + __expf(-v)); }
        __syncthreads();
        for (int item = blockIdx.x; item < 192; item += G) {
            const int j0 = item * 32, kg = tid >> 3, cq = tid & 7;
            f32x4 wv[16];
#pragma unroll
            for (int kk = 0; kk < 16; ++kk) wv[kk] = *(const f32x4*)(A.ada_w + (size_t)(kg * 16 + kk) * 6144 + j0 + 4 * cq);
            f32x4 acc[8];
#pragma unroll
            for (int b = 0; b < 8; ++b) acc[b] = (f32x4){0.f, 0.f, 0.f, 0.f};
#pragma unroll
            for (int b = 0; b < 8; ++b)
#pragma unroll
                for (int k4 = 0; k4 < 4; ++k4) { const f32x4 s4 = *(const LAS f32x4*)(sc + b * 1024 + kg * 16 + 4 * k4);
                    acc[b] += wv[4 * k4] * s4[0]; acc[b] += wv[4 * k4 + 1] * s4[1]; acc[b] += wv[4 * k4 + 2] * s4[2]; acc[b] += wv[4 * k4 + 3] * s4[3]; }
            LAS float* part = (LAS float*)(lds + 32768);
#pragma unroll
            for (int b = 0; b < 8; ++b) *(LAS f32x4*)(part + (kg * 8 + b) * 32 + 4 * cq) = acc[b];
            __syncthreads();
            if (tid < 256) { const int b = tid >> 5, col = tid & 31; float s = A.ada_b[j0 + col];
              for (int k2 = 0; k2 < 64; ++k2) s += part[(k2 * 8 + b) * 32 + col];
              MOD[b * 6144 + j0 + col] = s; }
            __syncthreads();
        }
    }
    for (int i = (G - 1 - (int)blockIdx.x) * 512 + tid; i < 8192; i += G * 512) { const int gc = i >> 10, k = i & 1023; ((float*)(A.ws + WS_WGT))[i] = A.w_in[(size_t)k * 3592 + 2048 + gc]; }
    if (blockIdx.x == 0 && tid == 0) {
        float s1 = 0.f, s2 = 0.f;
        for (int i = 0; i < 64; ++i) { s1 += A.lq1[i] * A.lk1[i]; s2 += A.lq2[i] * A.lk2[i]; }
        ((float*)(A.ws + WS_CTL))[1] = expf(s1) - expf(s2) + 0.2f;
        ((unsigned*)(A.ws + WS_CTL))[0] = 0u; ((unsigned*)(A.ws + WS_CTL))[2] = 0u;
    }
}

__device__ __forceinline__ void phase0b(const Args& A, LAS unsigned char* lds) {
    int tid_o = threadIdx.x; asm volatile("" : "+v"(tid_o)); const int tid = tid_o, lane = tid & 63, wave = tid >> 6, G = gridDim.x;
    __syncthreads();
    {
        LAS float* scr = (LAS float*)(lds + wave * 16384);
        const int gw = blockIdx.x * 8 + wave, NGW = G * 8;
        for (int it = gw; it < 1792; it += NGW) { const int kb = it / 112, nb = it % 112; transpose_item(A.w_in, 3592, nb >= 64 ? 8 : 0, (bf16_t*)(A.ws + WS_WIN), scr, kb, nb, lane); }
    }
}

__device__ __forceinline__ void quantise_tables(const Args& A, int gw, int NGW) {
    int tid_o = threadIdx.x; asm volatile("" : "+v"(tid_o)); const int lane = tid_o & 63;
    unsigned char* T8 = A.ws + WS_T8; float* SC = (float*)(A.ws + WS_SC);
#pragma unroll 1
    for (int row = gw; row < 32768; row += 4 * NGW) {
        f32x4 v[4][4]; int rr[4];
#pragma unroll
        for (int q = 0; q < 4; ++q) { const int r = row + q * NGW; rr[q] = r; const int rc = r < 32768 ? r : row;
            const float* s = (rc < 16384 ? A.pu + (size_t)rc * 1024 : A.pv + (size_t)(rc - 16384) * 1024) + 16 * lane;
#pragma unroll
            for (int j = 0; j < 4; ++j) v[q][j] = *(const f32x4*)(s + 4 * j); }
#pragma unroll
        for (int q = 0; q < 4; ++q) {
            float mx = 0.f;
#pragma unroll
            for (int j = 0; j < 4; ++j)
#pragma unroll
                for (int e = 0; e < 4; ++e) mx = fmaxf(mx, fabsf(v[q][j][e]));
#pragma unroll
            for (int o = 1; o < 64; o <<= 1) mx = fmaxf(mx, __shfl_xor(mx, o));
            const float sc = fmaxf(mx, 1e-30f) * (1.f / 256.f), inv = 1.f / sc;
            u32x4 o4;
#pragma unroll
            for (int j = 0; j < 4; ++j) { int w0 = __builtin_amdgcn_cvt_pk_fp8_f32(v[q][j][0] * inv, v[q][j][1] * inv, 0, false); w0 = __builtin_amdgcn_cvt_pk_fp8_f32(v[q][j][2] * inv, v[q][j][3] * inv, w0, true); o4[j] = (unsigned)w0; }
            if (rr[q] < 32768) { *(u32x4*)(T8 + (size_t)rr[q] * 1024 + 16 * lane) = o4; if (lane == 0) SC[rr[q]] = sc; }
        }
    }
}

__device__ __forceinline__ void phase1(const Args& A, LAS unsigned char* lds) {
    int tid_o = threadIdx.x; asm volatile("" : "+v"(tid_o)); const int tid = tid_o, lane = tid & 63, wave = tid >> 6, G = gridDim.x;
    const float* MOD = (const float*)(A.ws + WS_MOD);
    bf16_t* ACT = (bf16_t*)(A.ws + WS_ACT);
    float* GATES = (float*)(A.ws + WS_GATES);
    LAS float* WG = (LAS float*)lds;
    for (int i = tid; i < 8192; i += 512) WG[i] = ((const float*)(A.ws + WS_WGT))[i];
    __syncthreads();
    f32x4 vn[4];
    { const int m0 = blockIdx.x * 8 + wave; if (m0 < T) { const f32x4* xr = (const f32x4*)(A.x + (size_t)m0 * 1024) + lane;
#pragma unroll
        for (int j = 0; j < 4; ++j) vn[j] = xr[64 * j]; } }
    for (int m = blockIdx.x * 8 + wave; m < T; m += G * 8) {
        const int b = m >> 11;
        f32x4 v[4]; float ss = 0.f;
#pragma unroll
        for (int j = 0; j < 4; ++j) { v[j] = vn[j]; ss += (v[j][0] * v[j][0] + v[j][1] * v[j][1]) + (v[j][2] * v[j][2] + v[j][3] * v[j][3]); }
        if (m + G * 8 < T) { const f32x4* xr = (const f32x4*)(A.x + (size_t)(m + G * 8) * 1024) + lane;
#pragma unroll
            for (int j = 0; j < 4; ++j) vn[j] = xr[64 * j]; }
        const float rstd = rsqrtf(wave_sum(ss) * (1.f / 1024.f) + 1e-6f);
        unsigned long long* o8 = (unsigned long long*)(ACT + (size_t)m * 1024) + lane;
#pragma unroll
        for (int j = 0; j < 4; ++j) { const int col = 4 * lane + 256 * j;
            const f32x4 g = *(const f32x4*)(A.norm1_g + col), sc = *(const f32x4*)(MOD + b * 6144 + 1024 + col), sh = *(const f32x4*)(MOD + b * 6144 + col);
            v[j] = v[j] * rstd * g * (sc + 1.0f) + sh;
            o8[64 * j] = (unsigned long long)pk2(v[j][0], v[j][1]) | ((unsigned long long)pk2(v[j][2], v[j][3]) << 32); }
        float gd[8];
#pragma unroll
        for (int gc = 0; gc < 8; ++gc) { float d = 0.f;
#pragma unroll
            for (int j = 0; j < 4; ++j) { const f32x4 w = *(const LAS f32x4*)(WG + gc * 1024 + 256 * j + 4 * lane); d += (v[j][0] * w[0] + v[j][1] * w[1]) + (v[j][2] * w[2] + v[j][3] * w[3]); }
            gd[gc] = wave_sum(d); }
        if (lane == 0) {
            f32x4 ig, lf;
#pragma unroll
            for (int h = 0; h < 4; ++h) { ig[h] = gd[h] + A.gate_b[h]; const float z = gd[4 + h] + A.gate_b[4 + h]; lf[h] = fminf(z, 0.f) - log1pf(expf(-fabsf(z))); }
            *(f32x4*)(GATES + (size_t)m * 8) = ig; *(f32x4*)(GATES + (size_t)m * 8 + 4) = lf;
        }
    }
}

constexpr int AK_STRIDE = 272, AV_STRIDE = 288, AK_BYTES = 64 * AK_STRIDE, AV_BYTES = 64 * AV_STRIDE;
__device__ __forceinline__ void attn_item(const Args& A, LAS unsigned char* lds, int b, int h, int qb, float lam) {
    int tid_o = threadIdx.x; asm volatile("" : "+v"(tid_o)); const int tid = tid_o, lane = tid & 63, w = tid >> 6, g = lane >> 4, l15 = lane & 15;
    const bf16_t* P = (const bf16_t*)(A.ws + WS_P);
    bf16_t* ACT = (bf16_t*)(A.ws + WS_ACT);
    const int t0 = qb * 128, ntiles = 2 * (qb + 1);
    const size_t rowbase = (size_t)b * SEQ;
    bf16x8 qf[2][2];
    { const bf16_t* qp = P + (rowbase + t0 + 16 * w + l15) * NP + 2048 + h * 128 + 8 * g;
#pragma unroll
      for (int p = 0; p < 2; ++p)
#pragma unroll
          for (int ks = 0; ks < 2; ++ks) qf[p][ks] = *(const bf16x8*)(qp + p * 64 + ks * 32); }
    f32x4 o[2][8];
#pragma unroll
    for (int p = 0; p < 2; ++p)
#pragma unroll
        for (int vt = 0; vt < 8; ++vt) o[p][vt] = (f32x4){0.f, 0.f, 0.f, 0.f};
    float mrun[2] = {-1e30f, -1e30f}, lrun[2] = {0.f, 0.f};
    const int srow = tid >> 3, sseg = tid & 7;
    const bf16_t* kg = P + (rowbase + srow) * NP + 2560 + h * 128 + sseg * 16;
    const bf16_t* vg = P + (rowbase + srow) * NP + 3072 + h * 128 + sseg * 16;
    u32x4 kr0, kr1, vr0, vr1;
    kr0 = *(const u32x4*)(kg); kr1 = *(const u32x4*)(kg + 8); vr0 = *(const u32x4*)(vg); vr1 = *(const u32x4*)(vg + 8);
    { LAS unsigned char* kb = lds + srow * AK_STRIDE + sseg * 32; LAS unsigned char* vb = lds + 2 * AK_BYTES + srow * AV_STRIDE + sseg * 32;
      *(LAS u32x4*)kb = kr0; *(LAS u32x4*)(kb + 16) = kr1; *(LAS u32x4*)vb = vr0; *(LAS u32x4*)(vb + 16) = vr1; }
    __syncthreads();
    const float cs = 0.125f * 1.4426950408889634f;
    const int qabs = t0 + 16 * w + l15;
    for (int kt = 0; kt < ntiles; ++kt) {
        const int cur = kt & 1;
        if (kt + 1 < ntiles) { const size_t off = (size_t)(kt + 1) * 64 * NP;
            kr0 = *(const u32x4*)(kg + off); kr1 = *(const u32x4*)(kg + off + 8); vr0 = *(const u32x4*)(vg + off); vr1 = *(const u32x4*)(vg + off + 8); }
        if (64 * kt <= t0 + 16 * w + 15) {
            LAS unsigned char* Kb = lds + cur * AK_BYTES; LAS unsigned char* Vb = lds + 2 * AK_BYTES + cur * AV_BYTES;
            f32x4 s[2][4];
#pragma unroll
            for (int p = 0; p < 2; ++p)
#pragma unroll
                for (int k4 = 0; k4 < 4; ++k4) { f32x4 a = (f32x4){0.f, 0.f, 0.f, 0.f};
#pragma unroll
                    for (int ks = 0; ks < 2; ++ks) { const bf16x8 kf = *(const LAS bf16x8*)(Kb + (16 * k4 + l15) * AK_STRIDE + (p * 64 + ks * 32 + 8 * g) * 2); a = MFMA16(kf, qf[p][ks], a); }
                    s[p][k4] = a; }
            if (64 * kt + 63 > t0 + 16 * w) {
#pragma unroll
                for (int p = 0; p < 2; ++p)
#pragma unroll
                    for (int k4 = 0; k4 < 4; ++k4)
#pragma unroll
                        for (int r = 0; r < 4; ++r) { const int key = 64 * kt + 16 * k4 + 4 * g + r; if (key > qabs) s[p][k4][r] = -1e30f; }
            }
            bf16x8 pf[2][2];
#pragma unroll
            for (int p = 0; p < 2; ++p) {
                float mx = -1e30f;
#pragma unroll
                for (int k4 = 0; k4 < 4; ++k4)
#pragma unroll
                    for (int r = 0; r < 4; ++r) mx = fmaxf(mx, s[p][k4][r]);
                mx = xrow_max(mx);
                const float mnew = fmaxf(mrun[p], mx * cs), alpha = __builtin_amdgcn_exp2f(mrun[p] - mnew);
                mrun[p] = mnew;
                float ls = 0.f;
#pragma unroll
                for (int k4 = 0; k4 < 4; ++k4)
#pragma unroll
                    for (int r = 0; r < 4; ++r) { const float pv = __builtin_amdgcn_exp2f(s[p][k4][r] * cs - mnew); ls += pv; s[p][k4][r] = pv; }
                lrun[p] = lrun[p] * alpha + ls;
                if (__any(alpha != 1.f)) {
#pragma unroll
                    for (int vt = 0; vt < 8; ++vt) o[p][vt] = o[p][vt] * alpha; }
                pf[p][0] = pack8(s[p][0], s[p][1]); pf[p][1] = pack8(s[p][2], s[p][3]);
            }
#pragma unroll
            for (int ks2 = 0; ks2 < 2; ++ks2)
#pragma unroll
                for (int vt = 0; vt < 8; ++vt) {
                    LAS unsigned char* a0 = Vb + (32 * ks2 + 4 * g + (l15 >> 2)) * AV_STRIDE + (16 * vt + 4 * (lane & 3)) * 2;
                    const bf16x8 vf = cat8(vtr(a0), vtr(a0 + 16 * AV_STRIDE));
                    o[0][vt] = MFMA16(vf, pf[0][ks2], o[0][vt]);
                    o[1][vt] = MFMA16(vf, pf[1][ks2], o[1][vt]);
                }
        }
        if (kt + 1 < ntiles) { const int nx = cur ^ 1;
            LAS unsigned char* kb = lds + nx * AK_BYTES + srow * AK_STRIDE + sseg * 32; LAS unsigned char* vb = lds + 2 * AK_BYTES + nx * AV_BYTES + srow * AV_STRIDE + sseg * 32;
            *(LAS u32x4*)kb = kr0; *(LAS u32x4*)(kb + 16) = kr1; *(LAS u32x4*)vb = vr0; *(LAS u32x4*)(vb + 16) = vr1; }
        __syncthreads();
    }
    float inv[2];
#pragma unroll
    for (int p = 0; p < 2; ++p) { const float lt = xrow_sum(lrun[p]); inv[p] = 1.f / lt; }
    float ss = 0.f;
#pragma unroll
    for (int vt = 0; vt < 8; ++vt)
#pragma unroll
        for (int r = 0; r < 4; ++r) { const float ov = o[0][vt][r] * inv[0] - lam * (o[1][vt][r] * inv[1]); o[0][vt][r] = ov; ss += ov * ov; }
    ss = xrow_sum(ss);
    const float rstd = rsqrtf(ss * (1.f / 128.f) + 1e-6f) * 0.8f;
    bf16_t* op = ACT + (rowbase + qabs) * 1024 + 512 + h * 128 + 4 * g;
#pragma unroll
    for (int vt = 0; vt < 8; ++vt) { const f32x4 gn = *(const f32x4*)(A.dnorm_g + 16 * vt + 4 * g);
        u32x2 wv; wv.x = pk2(o[0][vt][0] * rstd * gn[0], o[0][vt][1] * rstd * gn[1]); wv.y = pk2(o[0][vt][2] * rstd * gn[2], o[0][vt][3] * rstd * gn[3]);
        *(u32x2*)(op + 16 * vt) = wv; }
}

constexpr int MQ_STRIDE = 272, MV_STRIDE = 288, MP_STRIDE = 144, MH_STRIDE = 132;
constexpr int ML_Q = 0, ML_K = 17408, ML_V = 34816, ML_P = 53248, ML_H = 62464, ML_CW = 96256, ML_SM = 101376;
constexpr int SM_E = 0, SM_G = 64, SM_B = 128, SM_W = 192, SM_I = 256, SM_R = 320, SM_N = 384, SM_NP = 512, SM_X = 1024;
constexpr size_t WS_CST = 224 * MiB, WS_NST = 15 * MiB, WS_MC = 15 * MiB + 512 * 1024, WS_BAR = 15 * MiB + 768 * 1024;

__device__ __forceinline__ void mlstm_state(const Args& A, LAS unsigned char* lds, int b, int h) {
    int tid_o = threadIdx.x; asm volatile("" : "+v"(tid_o)); const int tid = tid_o, lane = tid & 63, w = tid >> 6, g = lane >> 4, l15 = lane & 15;
    const bf16_t* P = (const bf16_t*)(A.ws + WS_P);
    const float* GATES = (const float*)(A.ws + WS_GATES);
    u32x4* CST = (u32x4*)(A.ws + WS_CST); float* NST = (float*)(A.ws + WS_NST); float* MCg = (float*)(A.ws + WS_MC);
    LAS float* sm = (LAS float*)(lds + ML_SM);
    LAS float* cw = (LAS float*)(lds + ML_CW);
    LAS unsigned char* Ks = lds + ML_K; LAS unsigned char* Vs = lds + ML_V;
    const size_t rowbase = (size_t)b * SEQ; const int bh = b * 4 + h;
    for (int i = tid; i < 640; i += 512) { const int j = i >> 7, ch = i & 127, cch = 512 + h * 128 + ch; cw[i] = (j < 4) ? A.conv_w[j * 1024 + cch] : A.conv_b[cch]; }
    if (tid < 128) sm[SM_N + tid] = 0.f;
    const int rg = tid >> 4, cs = tid & 15;
    const int ccol = 512 + h * 128 + 8 * cs;
    const int srow = tid >> 3, sseg = tid & 7;
    u32x4 cr[5], vr0, vr1; float gi = 0.f, gf = 0.f;
#define MS_PREFETCH(c) do { const int _r0 = (c) * 64 + 2 * rg - 3; \
        _Pragma("unroll") for (int _i = 0; _i < 5; ++_i) { const int _r = _r0 + _i; const u32x4 _v = *(const u32x4*)(P + (rowbase + (_r >= 0 ? _r : 0)) * NP + ccol); cr[_i] = (_r >= 0) ? _v : (u32x4){0u, 0u, 0u, 0u}; } \
        const bf16_t* _vp = P + (rowbase + (c) * 64 + srow) * NP + 1024 + h * 128 + sseg * 16; \
        vr0 = *(const u32x4*)(_vp); vr1 = *(const u32x4*)(_vp + 8); \
        } while (0)
    MS_PREFETCH(0);
    LAS float* Eall = (LAS float*)(lds + ML_Q);
#pragma unroll
    for (int cc = 0; cc < 4; ++cc) { const int c = w + 8 * cc;
        const float* gp = GATES + (rowbase + c * 64 + lane) * 8 + h; gi = gp[0]; gf = gp[4];
        float bc = gf;
#pragma unroll
        for (int o = 1; o < 64; o <<= 1) { const float t = __shfl_up(bc, o); if (lane >= o) bc += t; }
        const float e = gi - bc; float cm = e;
#pragma unroll
        for (int o = 1; o < 64; o <<= 1) { const float t = __shfl_up(cm, o); if (lane >= o) cm = fmaxf(cm, t); }
        Eall[c * 64 + lane] = e;
        if (lane == 63) { Eall[2048 + c] = bc; Eall[2048 + 32 + c] = cm; } }
    f32x4 C[8];
#pragma unroll
    for (int kt = 0; kt < 8; ++kt) C[kt] = (f32x4){0.f, 0.f, 0.f, 0.f};
    float mc = 0.f;
    __syncthreads();
    for (int c = 0; c < 32; ++c) {
        {
            float wt[5][8];
#pragma unroll
            for (int j = 0; j < 5; ++j) { const f32x4 a = *(const LAS f32x4*)(cw + j * 128 + 8 * cs), bb = *(const LAS f32x4*)(cw + j * 128 + 8 * cs + 4);
                wt[j][0] = a[0]; wt[j][1] = a[1]; wt[j][2] = a[2]; wt[j][3] = a[3]; wt[j][4] = bb[0]; wt[j][5] = bb[1]; wt[j][6] = bb[2]; wt[j][7] = bb[3]; }
            LAS unsigned char* dst = Ks + (2 * rg) * MQ_STRIDE + 16 * cs;
#pragma unroll
            for (int r = 0; r < 2; ++r) {
                float ov[8];
#pragma unroll
                for (int e = 0; e < 8; ++e) ov[e] = wt[4][e];
#pragma unroll
                for (int j = 0; j < 4; ++j) { const u32x4 x = cr[r + j];
                    ov[0] += wt[j][0] * bflo(x.x); ov[1] += wt[j][1] * bfhi(x.x); ov[2] += wt[j][2] * bflo(x.y); ov[3] += wt[j][3] * bfhi(x.y);
                    ov[4] += wt[j][4] * bflo(x.z); ov[5] += wt[j][5] * bfhi(x.z); ov[6] += wt[j][6] * bflo(x.w); ov[7] += wt[j][7] * bfhi(x.w); }
#pragma unroll
                for (int e = 0; e < 8; ++e) ov[e] = 0.08838834764831845f * ov[e] * __builtin_amdgcn_rcpf(1.f + __expf(-ov[e]));
                u32x4 o4; o4.x = pk2(ov[0], ov[1]); o4.y = pk2(ov[2], ov[3]); o4.z = pk2(ov[4], ov[5]); o4.w = pk2(ov[6], ov[7]);
                *(LAS u32x4*)(dst + r * MQ_STRIDE) = o4;
            }
            LAS unsigned char* vd = Vs + srow * MV_STRIDE + sseg * 32; *(LAS u32x4*)vd = vr0; *(LAS u32x4*)(vd + 16) = vr1;
            if (w == 0) {
                const float g63 = fmaxf(mc, Eall[2048 + 32 + c]);
                sm[SM_W + lane] = __expf(Eall[c * 64 + lane] - g63);
                if (lane == 63) { sm[SM_X] = __expf(mc - g63); sm[SM_X + 1] = Eall[2048 + c] + g63; }
            }
        }
        __syncthreads();
        { const int cn = (c + 1 < 32) ? c + 1 : 31; MS_PREFETCH(cn); }
        {
            const int item = bh * 32 + c;
#pragma unroll
            for (int k2 = 0; k2 < 4; ++k2) CST[((size_t)(item * 8 + w) * 4 + k2) * 64 + lane] = __builtin_bit_cast(u32x4, pack8(C[2 * k2], C[2 * k2 + 1]));
            if (tid < 128) NST[item * 128 + tid] = sm[SM_N + tid];
            if (tid == 0) MCg[item] = mc;
            LAS float* wS = sm + SM_W;
            const float decay = sm[SM_X];
            bf16x8 vfw[2];
#pragma unroll
            for (int ks = 0; ks < 2; ++ks) {
                LAS unsigned char* a0 = Vs + (32 * ks + 8 * g + (l15 >> 2)) * MV_STRIDE + (16 * w + 4 * (lane & 3)) * 2;
                const bf16x8 vf = cat8(vtr(a0), vtr(a0 + 4 * MV_STRIDE));
                const f32x4 w0 = *(const LAS f32x4*)(wS + 32 * ks + 8 * g), w1 = *(const LAS f32x4*)(wS + 32 * ks + 8 * g + 4);
                const u32x4 vu = __builtin_bit_cast(u32x4, vf);
                u32x4 o4; o4.x = pk2(bflo(vu.x) * w0[0], bfhi(vu.x) * w0[1]); o4.y = pk2(bflo(vu.y) * w0[2], bfhi(vu.y) * w0[3]);
                o4.z = pk2(bflo(vu.z) * w1[0], bfhi(vu.z) * w1[1]); o4.w = pk2(bflo(vu.w) * w1[2], bfhi(vu.w) * w1[3]);
                vfw[ks] = __builtin_bit_cast(bf16x8, o4);
            }
#pragma unroll
            for (int kt = 0; kt < 8; ++kt) C[kt] = C[kt] * decay;
#pragma unroll
            for (int ks = 0; ks < 2; ++ks)
#pragma unroll
                for (int kt = 0; kt < 8; ++kt) { LAS unsigned char* a0 = Ks + (32 * ks + 8 * g + (l15 >> 2)) * MQ_STRIDE + (16 * kt + 4 * (lane & 3)) * 2;
                    const bf16x8 ka = cat8(vtr(a0), vtr(a0 + 4 * MQ_STRIDE)); C[kt] = MFMA16(ka, vfw[ks], C[kt]); }
            { const int kd = tid & 127, sq = tid >> 7; float s = 0.f;
#pragma unroll
              for (int i = 0; i < 16; ++i) { const int s_ = 16 * sq + i; s += wS[s_] * __uint_as_float((unsigned)(*(const LAS bf16_t*)(Ks + s_ * MQ_STRIDE + kd * 2)) << 16); }
              sm[SM_NP + sq * 128 + kd] = s; }
            mc = sm[SM_X + 1];
            __syncthreads();
            if (tid < 128) sm[SM_N + tid] = decay * sm[SM_N + tid] + ((sm[SM_NP + tid] + sm[SM_NP + 128 + tid]) + (sm[SM_NP + 256 + tid] + sm[SM_NP + 384 + tid]));
        }
    }
#undef MS_PREFETCH
    __syncthreads();
}

__device__ __forceinline__ void mlstm_out(const Args& A, LAS unsigned char* lds, int item, int& last_h) {
    int tid_o = threadIdx.x; asm volatile("" : "+v"(tid_o)); const int tid = tid_o, lane = tid & 63, w = tid >> 6, g = lane >> 4, l15 = lane & 15;
    const int bh = item >> 5, c = item & 31, b = bh >> 2, h = bh & 3;
    const bf16_t* P = (const bf16_t*)(A.ws + WS_P);
    bf16_t* ACT = (bf16_t*)(A.ws + WS_ACT);
    const float* GATES = (const float*)(A.ws + WS_GATES);
    const u32x4* CST = (const u32x4*)(A.ws + WS_CST); const float* NST = (const float*)(A.ws + WS_NST); const float* MCg = (const float*)(A.ws + WS_MC);
    LAS float* sm = (LAS float*)(lds + ML_SM);
    LAS float* cw = (LAS float*)(lds + ML_CW);
    LAS unsigned char* Qs = lds + ML_Q; LAS unsigned char* Ks = lds + ML_K; LAS unsigned char* Vs = lds + ML_V; LAS unsigned char* Ps = lds + ML_P;
    LAS float* Hn = (LAS float*)(lds + ML_H);
    LAS float* eS = sm + SM_E; LAS float* gS = sm + SM_G; LAS float* bS = sm + SM_B; LAS float* iS = sm + SM_I; LAS float* nS = sm + SM_N;
    const size_t rowbase = (size_t)b * SEQ;
    const int rg = tid >> 5, cs = tid & 31;
    const int ccol = (cs < 16 ? 0 : 512) + h * 128 + 8 * (cs & 15);
    const int srow = tid >> 3, sseg = tid & 7;
    u32x4 cr[7], vr0, vr1, mc0, mc1, cfr[4]; float gi = 0.f, gf = 0.f, nval = 0.f;
    { const int r0 = c * 64 + 4 * rg - 3;
#pragma unroll
      for (int i = 0; i < 7; ++i) { const int r = r0 + i; const u32x4 v_ = *(const u32x4*)(P + (rowbase + (r >= 0 ? r : 0)) * NP + ccol); cr[i] = (r >= 0) ? v_ : (u32x4){0u, 0u, 0u, 0u}; }
      const bf16_t* vp = P + (rowbase + c * 64 + srow) * NP + h * 128 + sseg * 16;
      vr0 = *(const u32x4*)(vp + 1024); vr1 = *(const u32x4*)(vp + 1032); mc0 = *(const u32x4*)(vp + 1536); mc1 = *(const u32x4*)(vp + 1544);
      if (w == 0) { const float* gp = GATES + (rowbase + c * 64 + lane) * 8 + h; gi = gp[0]; gf = gp[4]; }
#pragma unroll
      for (int k2 = 0; k2 < 4; ++k2) cfr[k2] = CST[((size_t)(item * 8 + w) * 4 + k2) * 64 + lane];
      if (tid < 128) nval = NST[item * 128 + tid]; }
    const float mc = MCg[item];
    if (h != last_h) {
        for (int i = tid; i < 1280; i += 512) { const int j = i >> 8, ch = i & 255, cch = (ch < 128 ? h * 128 + ch : 512 + h * 128 + ch - 128);
            cw[i] = (j < 4) ? A.conv_w[j * 1024 + cch] : A.conv_b[cch]; }
        last_h = h;
        __syncthreads();
    }
    {
        float wt[5][8];
#pragma unroll
        for (int j = 0; j < 5; ++j) { const f32x4 a = *(const LAS f32x4*)(cw + j * 256 + 8 * cs), bb = *(const LAS f32x4*)(cw + j * 256 + 8 * cs + 4);
            wt[j][0] = a[0]; wt[j][1] = a[1]; wt[j][2] = a[2]; wt[j][3] = a[3]; wt[j][4] = bb[0]; wt[j][5] = bb[1]; wt[j][6] = bb[2]; wt[j][7] = bb[3]; }
        const float osc = (cs < 16) ? 1.0f : 0.08838834764831845f;
        LAS unsigned char* dst = (cs < 16 ? Qs : Ks) + (4 * rg) * MQ_STRIDE + 16 * (cs & 15);
#pragma unroll
        for (int r = 0; r < 4; ++r) {
            float ov[8];
#pragma unroll
            for (int e = 0; e < 8; ++e) ov[e] = wt[4][e];
#pragma unroll
            for (int j = 0; j < 4; ++j) { const u32x4 x = cr[r + j];
                ov[0] += wt[j][0] * bflo(x.x); ov[1] += wt[j][1] * bfhi(x.x); ov[2] += wt[j][2] * bflo(x.y); ov[3] += wt[j][3] * bfhi(x.y);
                ov[4] += wt[j][4] * bflo(x.z); ov[5] += wt[j][5] * bfhi(x.z); ov[6] += wt[j][6] * bflo(x.w); ov[7] += wt[j][7] * bfhi(x.w); }
#pragma unroll
            for (int e = 0; e < 8; ++e) ov[e] = osc * ov[e] * __builtin_amdgcn_rcpf(1.f + __expf(-ov[e]));
            u32x4 o4; o4.x = pk2(ov[0], ov[1]); o4.y = pk2(ov[2], ov[3]); o4.z = pk2(ov[4], ov[5]); o4.w = pk2(ov[6], ov[7]);
            *(LAS u32x4*)(dst + r * MQ_STRIDE) = o4;
        }
        LAS unsigned char* vd = Vs + srow * MV_STRIDE + sseg * 32; *(LAS u32x4*)vd = vr0; *(LAS u32x4*)(vd + 16) = vr1;
        if (tid < 128) nS[tid] = nval;
        if (w == 0) {
            float bc = gf;
#pragma unroll
            for (int o = 1; o < 64; o <<= 1) { const float t = __shfl_up(bc, o); if (lane >= o) bc += t; }
            const float e = gi - bc; float cm = e;
#pragma unroll
            for (int o = 1; o < 64; o <<= 1) { const float t = __shfl_up(cm, o); if (lane >= o) cm = fmaxf(cm, t); }
            const float gt = fmaxf(mc, cm);
            eS[lane] = e; gS[lane] = gt; bS[lane] = bc; iS[lane] = __expf(mc - gt);
        }
    }
    __syncthreads();
    {
        const int st = w >> 1;
#pragma unroll
        for (int ti = 0; ti < 2; ++ti) { const int tt = 2 * (w & 1) + ti;
            f32x4 a = (f32x4){0.f, 0.f, 0.f, 0.f};
#pragma unroll
            for (int ks = 0; ks < 4; ++ks) { const bf16x8 kf = *(const LAS bf16x8*)(Ks + (16 * st + l15) * MQ_STRIDE + (32 * ks + 8 * g) * 2);
                const bf16x8 qf = *(const LAS bf16x8*)(Qs + (16 * tt + l15) * MQ_STRIDE + (32 * ks + 8 * g) * 2); a = MFMA16(kf, qf, a); }
            const int t = 16 * tt + l15; const float gt = gS[t];
            float pv[4];
#pragma unroll
            for (int r = 0; r < 4; ++r) { const int s_ = 16 * st + 4 * g + r; pv[r] = (s_ <= t) ? a[r] * __expf(eS[s_] - gt) : 0.f; }
            u32x2 pw; pw.x = pk2(pv[0], pv[1]); pw.y = pk2(pv[2], pv[3]);
            *(LAS u32x2*)(Ps + t * MP_STRIDE + (16 * st + 4 * g) * 2) = pw;
        }
    }
    __syncthreads();
    {
        f32x4 apv[4], aqc[4];
#pragma unroll
        for (int tt = 0; tt < 4; ++tt) { apv[tt] = (f32x4){0.f, 0.f, 0.f, 0.f}; aqc[tt] = (f32x4){0.f, 0.f, 0.f, 0.f}; }
#pragma unroll
        for (int ks = 0; ks < 2; ++ks) {
            LAS unsigned char* a0 = Vs + (32 * ks + 8 * g + (l15 >> 2)) * MV_STRIDE + (16 * w + 4 * (lane & 3)) * 2;
            const bf16x8 vf = cat8(vtr(a0), vtr(a0 + 4 * MV_STRIDE));
#pragma unroll
            for (int tt = 0; tt < 4; ++tt) { const bf16x8 pf = *(const LAS bf16x8*)(Ps + (16 * tt + l15) * MP_STRIDE + (32 * ks + 8 * g) * 2); apv[tt] = MFMA16(pf, vf, apv[tt]); }
        }
#pragma unroll
        for (int k2 = 0; k2 < 4; ++k2) {
            const bf16x8 cf = __builtin_bit_cast(bf16x8, cfr[k2]);
#pragma unroll
            for (int tt = 0; tt < 4; ++tt) { LAS unsigned char* qa = Qs + (16 * tt + l15) * MQ_STRIDE + (32 * k2 + 4 * g) * 2;
                const bf16x8 qf = cat8(*(const LAS s16x4*)qa, *(const LAS s16x4*)(qa + 32)); aqc[tt] = MFMA16(qf, cf, aqc[tt]); }
        }
#pragma unroll
        for (int tt = 0; tt < 4; ++tt)
#pragma unroll
            for (int r = 0; r < 4; ++r) { const int t = 16 * tt + 4 * g + r; Hn[t * MH_STRIDE + 16 * w + l15] = apv[tt][r] + iS[t] * aqc[tt][r]; }
        { const int t = srow, j = sseg;
          const u32x4 pr = *(const LAS u32x4*)(Ps + t * MP_STRIDE + 16 * j);
          float rs = (bflo(pr.x) + bfhi(pr.x)) + (bflo(pr.y) + bfhi(pr.y)) + (bflo(pr.z) + bfhi(pr.z)) + (bflo(pr.w) + bfhi(pr.w));
          const u32x4 q0 = *(const LAS u32x4*)(Qs + t * MQ_STRIDE + 32 * j), q1 = *(const LAS u32x4*)(Qs + t * MQ_STRIDE + 32 * j + 16);
          const f32x4 n0 = *(const LAS f32x4*)(nS + 16 * j), n1 = *(const LAS f32x4*)(nS + 16 * j + 4), n2 = *(const LAS f32x4*)(nS + 16 * j + 8), n3 = *(const LAS f32x4*)(nS + 16 * j + 12);
          float qn = bflo(q0.x) * n0[0] + bfhi(q0.x) * n0[1] + bflo(q0.y) * n0[2] + bfhi(q0.y) * n0[3] + bflo(q0.z) * n1[0] + bfhi(q0.z) * n1[1] + bflo(q0.w) * n1[2] + bfhi(q0.w) * n1[3]
                   + bflo(q1.x) * n2[0] + bfhi(q1.x) * n2[1] + bflo(q1.y) * n2[2] + bfhi(q1.y) * n2[3] + bflo(q1.z) * n3[0] + bfhi(q1.z) * n3[1] + bflo(q1.w) * n3[2] + bfhi(q1.w) * n3[3];
          float d = rs + iS[t] * qn;
          d += __shfl_xor(d, 1); d += __shfl_xor(d, 2); d += __shfl_xor(d, 4);
          if (j == 0) { const float fl = __expf(-(bS[t] + gS[t])); sm[SM_R + t] = 1.f / fmaxf(fabsf(d), fl); } }
    }
    __syncthreads();
    {
        const int t = srow, j = sseg; const float rd = sm[SM_R + t];
        float hv[16]; float ss = 0.f;
#pragma unroll
        for (int q = 0; q < 4; ++q) { const f32x4 x = *(const LAS f32x4*)(Hn + t * MH_STRIDE + 16 * j + 4 * q);
#pragma unroll
            for (int e = 0; e < 4; ++e) { const float v = x[e] * rd; hv[4 * q + e] = v; ss += v * v; } }
        ss += __shfl_xor(ss, 1); ss += __shfl_xor(ss, 2); ss += __shfl_xor(ss, 4);
        const float rstd = rsqrtf(ss * (1.f / 128.f) + 1e-6f);
        const unsigned mo[8] = {mc0.x, mc0.y, mc0.z, mc0.w, mc1.x, mc1.y, mc1.z, mc1.w};
        unsigned ow[8];
#pragma unroll
        for (int q = 0; q < 8; ++q) { const float g0 = A.mnorm_g[h * 128 + 16 * j + 2 * q], g1 = A.mnorm_g[h * 128 + 16 * j + 2 * q + 1];
            const float z0 = bflo(mo[q]), z1 = bfhi(mo[q]);
            ow[q] = pk2(hv[2 * q] * rstd * g0 * __builtin_amdgcn_rcpf(1.f + __expf(-z0)), hv[2 * q + 1] * rstd * g1 * __builtin_amdgcn_rcpf(1.f + __expf(-z1))); }
        bf16_t* op = ACT + (rowbase + c * 64 + t) * 1024 + h * 128 + 16 * j;
        *(u32x4*)op = (u32x4){ow[0], ow[1], ow[2], ow[3]}; *(u32x4*)(op + 8) = (u32x4){ow[4], ow[5], ow[6], ow[7]};
    }
}

__device__ __forceinline__ void phase3(const Args& A, LAS unsigned char* lds, int rep = 0) {
    const int tid = threadIdx.x;
    const float lam = ((const float*)(A.ws + WS_CTL))[1];
    unsigned* ctr = (unsigned*)(A.ws + WS_CTL) + 2 * rep;
    LAS int* slot = (LAS int*)(lds + LDS_BYTES - 64);
    const int nml = ((int)gridDim.x > 64) ? 32 : 1;
    if ((int)blockIdx.x < nml) for (int bh = blockIdx.x; bh < 32; bh += nml) mlstm_state(A, lds, bh >> 2, bh & 3);
    for (;;) {
        if (tid == 0) slot[0] = (int)atomicAdd(ctr, 1u);
        __syncthreads();
        const int it = slot[0];
        __syncthreads();
        if (it >= 512) break;
        attn_item(A, lds, (it & 31) >> 2, it & 3, 15 - (it >> 5), lam);
    }
    {
        const int lane = tid & 63, wave = tid >> 6;
        LAS float* scr = (LAS float*)(lds + wave * 16384);
        for (int r = blockIdx.x * 8 + wave; r < 1536; r += gridDim.x * 8) {
            if (r < 512) transpose_item(A.w_out, 1024, 0, (bf16_t*)(A.ws + WS_WOUT), scr, r / 32, r % 32, lane);
            else wprime_item(A, (r - 512) >> 6, (r - 512) & 63, lane);
        }
    }
}
__device__ __forceinline__ void phase3b(const Args& A, LAS unsigned char* lds) {
    const int tid = threadIdx.x;
    {
        const int lane = tid & 63, wave = tid >> 6;
        const bf16_t* WT = (const bf16_t*)(A.ws + WS_WQ); const float* MOD = (const float*)(A.ws + WS_MOD); float* SB = (float*)(A.ws + WS_SB);
        for (int n = blockIdx.x * 8 + wave; n < 2048; n += gridDim.x * 8) {
            const u32x4 w0 = *(const u32x4*)(WT + (size_t)n * 1024 + 16 * lane), w1 = *(const u32x4*)(WT + (size_t)n * 1024 + 16 * lane + 8);
            const unsigned ww[8] = {w0.x, w0.y, w0.z, w0.w, w1.x, w1.y, w1.z, w1.w};
            float sbv[8];
#pragma unroll
            for (int b = 0; b < 8; ++b) { const float* sp = MOD + b * 6144 + 3072 + 16 * lane; float d = 0.f;
#pragma unroll
                for (int q = 0; q < 4; ++q) { const f32x4 s4 = *(const f32x4*)(sp + 4 * q); d += bflo(ww[2 * q]) * s4[0] + bfhi(ww[2 * q]) * s4[1] + bflo(ww[2 * q + 1]) * s4[2] + bfhi(ww[2 * q + 1]) * s4[3]; }
                sbv[b] = wave_sum(d); }
            if (lane == 0) {
#pragma unroll
                for (int b = 0; b < 8; ++b) SB[b * 2048 + n] = sbv[b]; }
        }
    }
    int last_h = -1;
    for (int item = blockIdx.x; item < 1024; item += gridDim.x) mlstm_out(A, lds, item, last_h);
    __syncthreads();
}

__device__ __forceinline__ void phase5(const Args& A) {
    int tid_o = threadIdx.x; asm volatile("" : "+v"(tid_o)); const int tid = tid_o, lane = tid & 63, wave = tid >> 6, G = gridDim.x;
    const float* MOD = (const float*)(A.ws + WS_MOD);
    bf16_t* ACT = (bf16_t*)(A.ws + WS_ACT);
    for (int m = blockIdx.x * 8 + wave; m < T; m += G * 8) {
        const int b = m >> 11;
        const f32x4* xr = (const f32x4*)(A.out + (size_t)m * 1024) + lane;
        f32x4 v[4]; float ss = 0.f;
#pragma unroll
        for (int j = 0; j < 4; ++j) { v[j] = xr[64 * j]; ss += (v[j][0] * v[j][0] + v[j][1] * v[j][1]) + (v[j][2] * v[j][2] + v[j][3] * v[j][3]); }
        const float rstd = rsqrtf(wave_sum(ss) * (1.f / 1024.f) + 1e-6f);
        unsigned long long* o8 = (unsigned long long*)(ACT + (size_t)m * 1024) + lane;
#pragma unroll
        for (int j = 0; j < 4; ++j) { const int col = 4 * lane + 256 * j;
            const f32x4 g = *(const f32x4*)(A.norm2_g + col), sc = *(const f32x4*)(MOD + b * 6144 + 4096 + col), sh = *(const f32x4*)(MOD + b * 6144 + 3072 + col);
            v[j] = v[j] * rstd * g * (sc + 1.0f) + sh;
            o8[64 * j] = (unsigned long long)pk2(v[j][0], v[j][1]) | ((unsigned long long)pk2(v[j][2], v[j][3]) << 32); }
    }
}

__device__ __forceinline__ unsigned f2key(float f) { const unsigned u = __float_as_uint(f); return (u & 0x80000000u) ? ~u : (u | 0x80000000u); }
__device__ __forceinline__ float key2f(unsigned k) { const unsigned u = (k & 0x80000000u) ? (k & 0x7fffffffu) : ~k; return __uint_as_float(u); }
#define CE_DESC(a, b) do { const unsigned _mx = (a) > (b) ? (a) : (b), _mn = (a) > (b) ? (b) : (a); (a) = _mx; (b) = _mn; } while (0)
__device__ __forceinline__ void sort16_desc(unsigned (&k)[16]) {
#pragma unroll
    for (int size = 2; size <= 16; size <<= 1)
#pragma unroll
        for (int stride = size >> 1; stride > 0; stride >>= 1)
#pragma unroll
            for (int i = 0; i < 16; ++i) { const int j = i ^ stride;
                if (j > i) { if ((i & size) == 0) CE_DESC(k[i], k[j]); else CE_DESC(k[j], k[i]); } }
}
__device__ __forceinline__ void merge16(unsigned (&a)[16], const unsigned (&b)[16]) {
#pragma unroll
    for (int i = 0; i < 16; ++i) a[i] = a[i] > b[15 - i] ? a[i] : b[15 - i];
#pragma unroll
    for (int stride = 8; stride > 0; stride >>= 1)
#pragma unroll
        for (int i = 0; i < 16; ++i) { const int j = i ^ stride; if (j > i) CE_DESC(a[i], a[j]); }
}
constexpr int PE_IDX = 0, PE_SEL = 69632;
__device__ __forceinline__ float gelu_erf(float v) { return 0.5f * v * (1.f + erff(v * 0.70710678118654752f)); }
__device__ __forceinline__ float gelu_fast(float v) {
    const float av = fabsf(v), tt = __builtin_amdgcn_rcpf(av * 0.2316418882f + 1.0f);
    float q = tt * 0.5307027145f + (-0.7265760135f); q = q * tt + 0.7107068705f; q = q * tt + (-0.142248368f); q = q * tt + 0.127414796f; q = q * tt;
    const float e = __builtin_amdgcn_exp2f((v * v) * (-0.72134752044f));
    const float m = v * (q * e);
    return v < 0.f ? m : v - m;
}

__device__ __forceinline__ void peer_tile(const Args& A, LAS unsigned char* lds, int tile) {
    int tid_o = threadIdx.x; asm volatile("" : "+v"(tid_o)); const int tid = tid_o, lane = tid & 63, w = tid >> 6, g = lane >> 4, l15 = lane & 15;
    const bf16_t* QRY = (const bf16_t*)(A.ws + WS_QRY);
    const bf16_t* KEYS = (const bf16_t*)(A.ws + WS_KEYS);
    const bf16_t* ACT = (const bf16_t*)(A.ws + WS_ACT);
    const float* MOD = (const float*)(A.ws + WS_MOD);
    LAS unsigned* idx = (LAS unsigned*)(lds + PE_IDX) + (w * 64 + lane) * 33;
    LAS u32x2* SEL = (LAS u32x2*)(lds + PE_SEL);
    {
        const int tg = w & 3, hg = w >> 2, tl = 16 * tg + l15;
        const size_t m = (size_t)tile * 64 + tl;
        unsigned LA[4][2][16];
#pragma unroll
        for (int hh = 0; hh < 4; ++hh) {
            const int h = 4 * hg + hh;
#pragma unroll
            for (int p = 0; p < 2; ++p) {
                const int hp = 2 * h + p;
                unsigned k0[16], k1[16];
                { const bf16_t* sp = QRY + m * 2048 + hp * 128 + 32 * g;
                  const u32x4 s0 = *(const u32x4*)sp, s1 = *(const u32x4*)(sp + 8), s2 = *(const u32x4*)(sp + 16), s3 = *(const u32x4*)(sp + 24);
                  const unsigned sw[16] = {s0.x, s0.y, s0.z, s0.w, s1.x, s1.y, s1.z, s1.w, s2.x, s2.y, s2.z, s2.w, s3.x, s3.y, s3.z, s3.w};
#pragma unroll
                  for (int i = 0; i < 16; ++i) {
                      const float lo = (float)__builtin_bit_cast(_Float16, (unsigned short)(sw[i] & 0xffffu)), hi = (float)__builtin_bit_cast(_Float16, (unsigned short)(sw[i] >> 16));
                      const unsigned klo = (f2key(lo) & ~127u) | (unsigned)(127 - (32 * g + 2 * i)), khi = (f2key(hi) & ~127u) | (unsigned)(127 - (32 * g + 2 * i + 1));
                      if (i < 8) { k0[2 * i] = klo; k0[2 * i + 1] = khi; } else { k1[2 * (i - 8)] = klo; k1[2 * (i - 8) + 1] = khi; } } }
                sort16_desc(k0); sort16_desc(k1); merge16(k0, k1);
#pragma unroll
                for (int msk = 16; msk <= 32; msk <<= 1) {
#pragma unroll
                    for (int i = 0; i < 16; ++i) k1[i] = (unsigned)__shfl_xor((int)k0[i], msk);
                    merge16(k0, k1); }
#pragma unroll
                for (int i = 0; i < 16; ++i) LA[hh][p][i] = k0[i];
            }
        }
        {
            const int h = 4 * hg + g;
            unsigned L2[2][16];
#pragma unroll
            for (int p = 0; p < 2; ++p)
#pragma unroll
                for (int i = 0; i < 16; ++i) L2[p][i] = (g & 2) ? ((g & 1) ? LA[3][p][i] : LA[2][p][i]) : ((g & 1) ? LA[1][p][i] : LA[0][p][i]);
            float va[16], vb[16];
#pragma unroll
            for (int i = 0; i < 16; ++i) { va[i] = key2f(L2[0][i] & ~127u); vb[i] = key2f(L2[1][i] & ~127u); idx[i] = 127u - (L2[0][i] & 127u); idx[16 + i] = 127u - (L2[1][i] & 127u); }
#define CK(i, j) ((f2key(va[i] + vb[j]) & ~255u) | (unsigned)(255 - (16 * (i) + (j))))
            unsigned Lf[16], Bt[16];
#pragma unroll
            for (int j = 0; j < 16; ++j) Lf[j] = CK(0, j);
#pragma unroll
            for (int j = 0; j < 8; ++j) Bt[j] = CK(1, j);
#pragma unroll
            for (int j = 0; j < 5; ++j) Bt[8 + j] = CK(2, j);
#pragma unroll
            for (int j = 0; j < 3; ++j) Bt[13 + j] = CK(4, j);
            sort16_desc(Bt); merge16(Lf, Bt);
#pragma unroll
            for (int j = 0; j < 4; ++j) Bt[j] = CK(3, j);
            Bt[4] = CK(5, 0); Bt[5] = CK(5, 1); Bt[6] = CK(6, 0); Bt[7] = CK(6, 1); Bt[8] = CK(7, 0); Bt[9] = CK(7, 1);
            Bt[10] = CK(8, 0); Bt[11] = CK(9, 0); Bt[12] = CK(10, 0); Bt[13] = CK(11, 0); Bt[14] = CK(12, 0); Bt[15] = CK(13, 0);
            sort16_desc(Bt); merge16(Lf, Bt);
            { unsigned x0 = CK(14, 0), x1 = CK(15, 0);
#pragma unroll
              for (int i = 0; i < 16; ++i) CE_DESC(Lf[i], x0);
#pragma unroll
              for (int i = 0; i < 16; ++i) CE_DESC(Lf[i], x1); }
#undef CK
            float fv[16], den = 0.f; const float f0 = key2f(Lf[0] & ~255u);
#pragma unroll
            for (int k = 0; k < 16; ++k) { fv[k] = __expf(key2f(Lf[k] & ~255u) - f0); den += fv[k]; }
            const float rden = 1.f / den;
            LDS_WAIT();
#pragma unroll
            for (int k = 0; k < 16; ++k) { const unsigned code = 255u - (Lf[k] & 255u); const unsigned e = idx[code >> 4] * 128u + idx[16 + (code & 15u)];
                u32x2 sv; sv.x = e; sv.y = __float_as_uint(fv[k] * rden); SEL[(tl * 8 + h) * 16 + k] = sv; }
        }
    }
    __syncthreads();
    const unsigned char* T8 = A.ws + WS_T8; const float* SC = (const float*)(A.ws + WS_SC);
    LAS u32x2* SORT = (LAS u32x2*)(lds + PE_IDX);
    LAS int* OFFS = (LAS int*)(lds + PE_SEL + 65536);
    for (int ti = 0; ti < 8; ++ti) {
        const int tl = 8 * w + ti;
        const u32x2 e0 = SEL[tl * 128 + lane], e1 = SEL[tl * 128 + 64 + lane];
        const int p0 = (int)(e0.x >> 10), p1 = (int)(e1.x >> 10);
        int off = 0;
        for (int p = 0; p < 16; ++p) {
            const unsigned long long m0 = __ballot(p0 == p), m1 = __ballot(p1 == p);
            const int c0 = __popcll(m0), c1 = __popcll(m1);
            const int r0 = __builtin_amdgcn_mbcnt_hi((unsigned)(m0 >> 32), __builtin_amdgcn_mbcnt_lo((unsigned)m0, 0u));
            const int r1 = __builtin_amdgcn_mbcnt_hi((unsigned)(m1 >> 32), __builtin_amdgcn_mbcnt_lo((unsigned)m1, 0u));
            if (p0 == p) SORT[tl * 128 + off + r0] = e0;
            if (p1 == p) SORT[tl * 128 + off + c0 + r1] = e1;
            if (lane == 0) OFFS[tl * 17 + p] = off;
            off += c0 + c1;
        }
        if (lane == 0) OFFS[tl * 17 + 16] = off;
    }
    LDS_WAIT(); __builtin_amdgcn_wave_barrier();
    const unsigned char* T8v = T8 + (size_t)16384 * 1024;
    const bf16_t* A3 = (const bf16_t*)(A.ws + WS_A3); const float* RSq = (const float*)(A.ws + WS_RS);
    for (int pass = 0; pass < 2; ++pass) {
        const int tb = 8 * w + 4 * pass;
        u32x4 xpa[4], xpb[4]; f32x2 oacc[4][8];
#pragma unroll
        for (int tk = 0; tk < 4; ++tk) { const size_t m = (size_t)tile * 64 + tb + tk;
            { const u32x4 ra = *(const u32x4*)(A3 + m * 1024 + 16 * lane), rb = *(const u32x4*)(A3 + m * 1024 + 16 * lane + 8);
              float xr_; { const f32x4 p0 = *(const f32x4*)(RSq + m * 16), p1 = *(const f32x4*)(RSq + m * 16 + 4), p2 = *(const f32x4*)(RSq + m * 16 + 8), p3 = *(const f32x4*)(RSq + m * 16 + 12);
                const f32x4 ps = (p0 + p1) + (p2 + p3); xr_ = rsqrtf(((ps[0] + ps[1]) + (ps[2] + ps[3])) * (1.f / 1024.f) + 1e-6f); }
              const unsigned rr[8] = {ra.x, ra.y, ra.z, ra.w, rb.x, rb.y, rb.z, rb.w}; unsigned hh[8];
              const float* sp = MOD + (int)(m >> 11) * 6144 + 3072 + 16 * lane;
#pragma unroll
              for (int q = 0; q < 8; ++q) { const f32x2 sh = *(const f32x2*)(sp + 2 * q); hh[q] = pk2(bflo(rr[q]) * xr_ + sh[0], bfhi(rr[q]) * xr_ + sh[1]); }
              xpa[tk] = (u32x4){hh[0], hh[1], hh[2], hh[3]}; xpb[tk] = (u32x4){hh[4], hh[5], hh[6], hh[7]}; }
#pragma unroll
            for (int q = 0; q < 8; ++q) oacc[tk][q] = (f32x2){0.f, 0.f}; }
        int it_p = 0, it_tk = -1, it_j = 0, it_end = 0; bool it_done = false;
#define IT_ADVANCE() do { it_j += 4; while (it_j >= it_end) { if (it_done) break; ++it_tk; if (it_tk == 4) { it_tk = 0; ++it_p; if (it_p == 16) { it_done = true; it_p = 15; it_j = 0; it_end = 1; break; } } \
            it_j = __builtin_amdgcn_readfirstlane(OFFS[(tb + it_tk) * 17 + it_p]); it_end = __builtin_amdgcn_readfirstlane(OFFS[(tb + it_tk) * 17 + it_p + 1]); } } while (0)
#define LOAD_SET(U, V, CG, SU, SV) do { const int _tl = tb + it_tk; \
            _Pragma("unroll") for (int _k = 0; _k < 4; ++_k) { const int _jj = (it_j + _k < it_end) ? it_j + _k : it_end - 1; const unsigned _e = SORT[_tl * 128 + _jj].x; \
                U[_k] = *(const u32x4*)(T8 + (size_t)_e * 1024 + 16 * lane); V[_k] = *(const u32x4*)(T8v + (size_t)_e * 1024 + 16 * lane); } \
            const int _ms = lane >> 4; const bool _valid = it_j + _ms < it_end; const u32x2 _se = SORT[_tl * 128 + (_valid ? it_j + _ms : it_end - 1)]; \
            CG = _valid ? __uint_as_float(_se.y) : 0.f; SU = SC[_se.x]; SV = SC[16384 + _se.x]; } while (0)
        u32x4 uA[4], vA[4], uB[4], vB[4]; float cgA = 0.f, suA = 0.f, svA = 0.f, cgB = 0.f, suB = 0.f, svB = 0.f;
#pragma unroll
        for (int k = 0; k < 4; ++k) { uA[k] = (u32x4){0u, 0u, 0u, 0u}; vA[k] = uA[k]; uB[k] = uA[k]; vB[k] = uA[k]; }
        IT_ADVANCE();
        LOAD_SET(uA, vA, cgA, suA, svA);
        for (int p = 0; p < 16; ++p) {
#pragma unroll
            for (int tk = 0; tk < 4; ++tk) {
                const int tl = tb + tk;
                const int beg = __builtin_amdgcn_readfirstlane(OFFS[tl * 17 + p]), end = __builtin_amdgcn_readfirstlane(OFFS[tl * 17 + p + 1]);
                f32x2 xf[8];
                { const unsigned xx[8] = {xpa[tk].x, xpa[tk].y, xpa[tk].z, xpa[tk].w, xpb[tk].x, xpb[tk].y, xpb[tk].z, xpb[tk].w};
#pragma unroll
                  for (int q = 0; q < 8; ++q) xf[q] = (f32x2){bflo(xx[q]), bfhi(xx[q])}; }
#define COMPUTE_SET(U, V, CG, SU, SV) do { float pd[4]; \
                    _Pragma("unroll") for (int k = 0; k < 4; ++k) { f32x2 d = (f32x2){0.f, 0.f}; \
                        _Pragma("unroll") for (int q = 0; q < 4; ++q) { const int dw = (int)U[k][q]; \
                            d += __builtin_amdgcn_cvt_pk_f32_fp8(dw, false) * xf[2 * q]; d += __builtin_amdgcn_cvt_pk_f32_fp8(dw, true) * xf[2 * q + 1]; } \
                        pd[k] = d[0] + d[1]; } \
                    float s; \
                    { const auto r0 = __builtin_amdgcn_permlane32_swap(__float_as_uint(pd[0]), __float_as_uint(pd[2]), false, false); \
                      const auto r1 = __builtin_amdgcn_permlane32_swap(__float_as_uint(pd[1]), __float_as_uint(pd[3]), false, false); \
                      const float a0 = __uint_as_float(r0[0]) + __uint_as_float(r0[1]), a1 = __uint_as_float(r1[0]) + __uint_as_float(r1[1]); \
                      const auto r2 = __builtin_amdgcn_permlane16_swap(__float_as_uint(a0), __float_as_uint(a1), false, false); \
                      s = __uint_as_float(r2[0]) + __uint_as_float(r2[1]); \
                      s += __int_as_float(__builtin_amdgcn_mov_dpp(__float_as_int(s), 0xB1, 0xF, 0xF, true)); \
                      s += __int_as_float(__builtin_amdgcn_mov_dpp(__float_as_int(s), 0x4E, 0xF, 0xF, true)); \
                      s += __int_as_float(__builtin_amdgcn_mov_dpp(__float_as_int(s), 0x141, 0xF, 0xF, true)); \
                      s += __int_as_float(__builtin_amdgcn_mov_dpp(__float_as_int(s), 0x140, 0xF, 0xF, true)); } \
                    const float coef = CG * gelu_fast(s * SU) * SV; \
                    _Pragma("unroll") for (int k = 0; k < 4; ++k) { const float ck = __int_as_float(__builtin_amdgcn_readlane(__float_as_int(coef), 16 * k)); const f32x2 ck2 = (f32x2){ck, ck}; \
                        _Pragma("unroll") for (int qq = 0; qq < 4; ++qq) { const int dw = (int)V[k][qq]; \
                            oacc[tk][2 * qq] += ck2 * __builtin_amdgcn_cvt_pk_f32_fp8(dw, false); oacc[tk][2 * qq + 1] += ck2 * __builtin_amdgcn_cvt_pk_f32_fp8(dw, true); } } } while (0)
                for (int j0 = beg; j0 < end; j0 += 8) {
                    IT_ADVANCE();
                    LOAD_SET(uB, vB, cgB, suB, svB);
                    COMPUTE_SET(uA, vA, cgA, suA, svA);
                    if (j0 + 4 < end) {
                        IT_ADVANCE();
                        LOAD_SET(uA, vA, cgA, suA, svA);
                        COMPUTE_SET(uB, vB, cgB, suB, svB);
                    } else {
#pragma unroll
                        for (int k = 0; k < 4; ++k) { uA[k] = uB[k]; vA[k] = vB[k]; }
                        cgA = cgB; suA = suB; svA = svB;
                    }
                }
            }
        }
#undef COMPUTE_SET
#undef IT_ADVANCE
#undef LOAD_SET
#pragma unroll
        for (int tk = 0; tk < 4; ++tk) {
            const size_t m = (size_t)tile * 64 + tb + tk; const int b = (int)(m >> 11);
            float* orow = A.out + m * 1024 + 16 * lane;
            const float* g2 = MOD + b * 6144 + 5120 + 16 * lane;
            f32x4 xv[4]; float ss = 0.f;
#pragma unroll
            for (int j = 0; j < 4; ++j) { const f32x4 x1 = *(const f32x4*)(orow + 4 * j), gg = *(const f32x4*)(g2 + 4 * j);
                const f32x4 pe = (f32x4){oacc[tk][2 * j][0], oacc[tk][2 * j][1], oacc[tk][2 * j + 1][0], oacc[tk][2 * j + 1][1]};
                xv[j] = x1 + gg * pe; ss += (xv[j][0] * xv[j][0] + xv[j][1] * xv[j][1]) + (xv[j][2] * xv[j][2] + xv[j][3] * xv[j][3]); }
            const float rstd = rsqrtf(wave_sum(ss) * (1.f / 1024.f) + 1e-6f);
#pragma unroll
            for (int j = 0; j < 4; ++j) { const f32x4 fg = *(const f32x4*)(A.final_g + 16 * lane + 4 * j); *(f32x4*)(orow + 4 * j) = xv[j] * rstd * fg; }
        }
    }
    __syncthreads();
}


#define XB_TMO      128
#define XB_XCNT(j)  (256  + 64 * (j))
#define XB_XSUB(j)  (1280 + 64 * (j))
#define XB_XGEN(j)  (2304 + 64 * (j))
#define XB_TOP      3328
#define XB_TOPGEN   3392
#define XCD_BAR_WORDS 3456
#define XB_SPIN_CAP (1u << 18)

__device__ __forceinline__ unsigned xb_ld(unsigned* p)              { return __hip_atomic_load(p, __ATOMIC_RELAXED, __HIP_MEMORY_SCOPE_AGENT); }
__device__ __forceinline__ unsigned xb_add(unsigned* p, unsigned v) { return __hip_atomic_fetch_add(p, v, __ATOMIC_RELAXED, __HIP_MEMORY_SCOPE_AGENT); }
__device__ __forceinline__ unsigned xb_xcc_id() { return (unsigned)__builtin_amdgcn_s_getreg((3 << 11) | 20) & 0xFu; }
#define XB_SPIN(cond, bar) do { unsigned _sp = 0; while (cond) { __builtin_amdgcn_s_sleep(1); \
    if ((++_sp & 255u) == 0u) { if (xb_ld(&(bar)[XB_TMO])) break; if (_sp > XB_SPIN_CAP) { atomicAdd(&(bar)[XB_TMO], 1u); break; } } } } while (0)

struct XcdBarrier {
    unsigned* bar; unsigned x;
    volatile LAS unsigned* st;
};

__device__ __forceinline__ XcdBarrier xcd_barrier_post(unsigned* bar, volatile LAS unsigned* st) {
    XcdBarrier b; b.bar = bar; b.x = xb_xcc_id(); b.st = st;
    if (threadIdx.x == 0) (void)xb_add(&bar[XB_XCNT(b.x)], 1u);
    return b;
}
__device__ __forceinline__ void xcd_barrier_complete(unsigned* bar, unsigned x, unsigned& nloc, unsigned& nx) {
    const unsigned G = gridDim.x * gridDim.y * gridDim.z;
    unsigned sum, cnt, mine, sp = 0u;
    for (;;) {
        sum = 0u; cnt = 0u; mine = 0u;
#pragma unroll
        for (unsigned j = 0; j < 16; ++j) { const unsigned c = xb_ld(&bar[XB_XCNT(j)]); sum += c; cnt += (c > 0u) ? 1u : 0u; mine = (j == x) ? c : mine; }
        if (sum == G) break;
        __builtin_amdgcn_s_sleep(1);
        if ((++sp & 255u) == 0u) { if (xb_ld(&bar[XB_TMO])) break; if (sp > XB_SPIN_CAP) { atomicAdd(&bar[XB_TMO], 1u); break; } }
    }
    nloc = mine > 0u ? mine : 1u; nx = cnt > 0u ? cnt : 1u;
}

__device__ __forceinline__ void xcd_barrier(const XcdBarrier& b) {
    asm volatile("s_waitcnt vmcnt(0)" ::: "memory");
    __syncthreads();
    if (threadIdx.x == 0) {
        unsigned* bar = b.bar;
        __builtin_amdgcn_s_waitcnt(0);
        unsigned nloc = b.st[0], nx = b.st[1];
        if (nloc == 0u) { xcd_barrier_complete(bar, b.x, nloc, nx); b.st[0] = nloc; b.st[1] = nx; }
        const unsigned old = xb_add(&bar[XB_XSUB(b.x)], 1u);
        const unsigned gen = old / nloc;
        if (old + 1u == (gen + 1u) * nloc) {
            __builtin_amdgcn_fence(__ATOMIC_RELEASE, "agent");
            asm volatile("s_waitcnt vmcnt(0)" ::: "memory");
            const unsigned og = xb_add(&bar[XB_TOP], 1u);
            const unsigned tg = og / nx;
            if (og + 1u == (tg + 1u) * nx) xb_add(&bar[XB_TOPGEN], 1u);
            else XB_SPIN(xb_ld(&bar[XB_TOPGEN]) == tg, bar);
            __builtin_amdgcn_fence(__ATOMIC_ACQUIRE, "agent");
            xb_add(&bar[XB_XGEN(b.x)], 1u);
            asm volatile("s_waitcnt vmcnt(0)" ::: "memory");
        } else {
            XB_SPIN(xb_ld(&bar[XB_XGEN(b.x)]) == gen, bar);
            __builtin_amdgcn_fence(__ATOMIC_ACQUIRE, "agent");
            asm volatile("s_waitcnt vmcnt(0)" ::: "memory");
        }
    }
    __syncthreads();
}

__global__ void __launch_bounds__(512, 2) mega_fwd(Args A) {
    extern __shared__ __attribute__((aligned(16))) unsigned char lds_raw[];
    LAS unsigned char* lds = (LAS unsigned char*)lds_raw;
    cg::grid_group grid = cg::this_grid();
    const int G = gridDim.x;
    if (threadIdx.x < 4) ((LAS unsigned*)(lds + LDS_BYTES - 32))[threadIdx.x] = 0u;
    __syncthreads();
    if (A.ws == nullptr) grid.sync();
    const XcdBarrier xb = xcd_barrier_post((unsigned*)(A.ws + WS_BAR), (volatile LAS unsigned*)(lds + LDS_BYTES - 32));
    phase0(A, lds);
    xcd_barrier(xb);
    phase1(A, lds);
    phase0b(A, lds);
    xcd_barrier(xb);
    { pg8::Gemm gm{(const pg8::bf16_t*)(A.ws + WS_ACT), (const pg8::bf16_t*)(A.ws + WS_WIN), T, NP, DM}; pg8::StaticOrder S; S.init(T, NP, G, (int)blockIdx.x);
      pg8::EpiStoreBf16 E{(pg8::bf16_t*)(A.ws + WS_P), NP};
      pg8::gemm_phase<pg8::EpiStoreBf16, pg8::StaticOrder, true, true>((PG8_LAS unsigned char*)lds, gm, S, E); }
    { const int nshort = G - (896 % G == 0 ? 0 : 896 % G);
      const int first = G - nshort;
      if ((int)blockIdx.x >= first) quantise_tables(A, ((int)blockIdx.x - first) * 8 + (int)(threadIdx.x >> 6), nshort * 8); }
    xcd_barrier(xb);
    phase3(A, lds);
    xcd_barrier(xb);
    phase3b(A, lds);
    xcd_barrier(xb);
    { pg8::Gemm gm{(const pg8::bf16_t*)(A.ws + WS_ACT), (const pg8::bf16_t*)(A.ws + WS_WOUT), T, DM, DM}; pg8::StaticOrder S; S.init(T, DM, G, (int)blockIdx.x);
      pg8::EpiResidNorm E{A.x, (const float*)(A.ws + WS_MOD), A.norm2_g, A.out, (pg8::bf16_t*)(A.ws + WS_A3), (float*)(A.ws + WS_RS)};
      pg8::gemm_phase<pg8::EpiResidNorm, pg8::StaticOrder, true, true>((PG8_LAS unsigned char*)lds, gm, S, E); }
    xcd_barrier(xb);
    { pg8::Gemm gm{(const pg8::bf16_t*)(A.ws + WS_A3), (const pg8::bf16_t*)(A.ws + WS_WQ), T, 2048, DM}; pg8::StaticOrder S; S.init(T, 2048, G, (int)blockIdx.x);
      pg8::EpiScoreF16 E{(pg8::bf16_t*)(A.ws + WS_QRY), 2048, (const float*)(A.ws + WS_RS), (const float*)(A.ws + WS_SB)};
      pg8::gemm_phase<pg8::EpiScoreF16, pg8::StaticOrder, true, true>((PG8_LAS unsigned char*)lds, gm, S, E); }
    xcd_barrier(xb);
    for (int tile = blockIdx.x; tile < T / 64; tile += G) peer_tile(A, lds, tile);
}

extern "C" void kernel_launch(void* const* d_in, const int* in_sizes, int n_in, void* d_out, int out_size, void* d_ws, size_t ws_size, hipStream_t stream) {
    static int grid = 0;
    if (grid == 0) {
        if (n_in != 22 || out_size != T * DM || ws_size < WS_END) { fprintf(stderr, "kernel_launch: unexpected shapes (n_in %d out %d ws %zu)\n", n_in, out_size, ws_size); grid = -1; return; }
        int dev = 0, cus = 0, per_cu = 0;
        if (hipGetDevice(&dev) != hipSuccess || hipDeviceGetAttribute(&cus, hipDeviceAttributeMultiprocessorCount, dev) != hipSuccess) { grid = -1; return; }
        if (hipFuncSetAttribute((const void*)mega_fwd, hipFuncAttributeMaxDynamicSharedMemorySize, LDS_BYTES) != hipSuccess) { fprintf(stderr, "kernel_launch: hipFuncSetAttribute failed\n"); grid = -1; return; }
        if (hipOccupancyMaxActiveBlocksPerMultiprocessor(&per_cu, (const void*)mega_fwd, 512, LDS_BYTES) != hipSuccess || per_cu < 1) { fprintf(stderr, "kernel_launch: occupancy query gave %d\n", per_cu); per_cu = 1; }
        (void)hipGetLastError();
        grid = cus * per_cu;
    }
    if (grid < 0) return;
    Args a{};
    const float** ap = (const float**)&a;
    for (int i = 0; i < 22; ++i) ap[i] = (const float*)d_in[i];
    a.out = (float*)d_out; a.ws = (unsigned char*)d_ws;
    if (hipMemsetAsync((unsigned char*)d_ws + WS_BAR, 0, XCD_BAR_WORDS * sizeof(unsigned), stream) != hipSuccess) { fprintf(stderr, "kernel_launch: memset of the barrier words failed\n"); return; }
    void* args[] = {&a};
    hipError_t e = hipLaunchCooperativeKernel((const void*)mega_fwd, dim3(grid), dim3(512), args, LDS_BYTES, stream);
    if (e != hipSuccess) fprintf(stderr, "kernel_launch: cooperative launch failed: %s (grid %d)\n", hipGetErrorString(e), grid);
}
```

```cpp
#include <hip/hip_runtime.h>
#include <hip/hip_cooperative_groups.h>
#include <cstdio>
#include <cstdint>
namespace cg = cooperative_groups;

namespace pg8 {
#define PG8_LAS __attribute__((address_space(3)))
typedef unsigned short bf16_t;
typedef short bf16x8 __attribute__((ext_vector_type(8)));
typedef float f32x4 __attribute__((ext_vector_type(4)));
typedef unsigned u32x4 __attribute__((ext_vector_type(4)));
constexpr int BM = 256, BK = 64, HALF = 128, HTB = HALF * BK * 2  , STAGE_BYTES = 8 * HTB, NXCD = 8, WGM = 8;

__host__ __device__ __forceinline__ int lds_byte(int r, int c) { const int st = (r >> 4) * 2 + (c >> 5), rr = r & 15, cc = c & 31, ob = rr * 64 + cc * 2; return st * 1024 + (ob ^ (((ob >> 9) & 1) << 5)); }
__host__ __device__ __forceinline__ void stage_rc(int b, int& R, int& C) { const int st = b / 1024, sb = b % 1024, swz = sb ^ (((sb >> 9) & 1) << 5); R = (st >> 1) * 16 + swz / 64; C = (st & 1) * 32 + (swz % 64) / 2; }
__host__ __device__ __forceinline__ int perm32(int rho) { const int n = rho >> 4, i = rho & 15; return 8 * (i >> 2) + 4 * n + (i & 3); }

struct Unit { int pm, pn; };
struct Gemm { const bf16_t* A; const bf16_t* Bt; int M, N, K; };

struct StaticOrder {
    int nM, nN, nwg, G, c;
    __host__ __device__ void init(int M, int N, int G_, int c_) { nM = M / BM; nN = N / BM; nwg = nM * nN; G = G_; c = c_; }
    __host__ __device__ bool next(int i, Unit& u) const {
        const long L = (long)i * G + c; if (L >= nwg) return false;
        int wgid = (int)L; { const int q = nwg / NXCD, r = nwg % NXCD, xcd = wgid % NXCD, off = wgid / NXCD; wgid = (xcd < r ? xcd * (q + 1) : r * (q + 1) + (xcd - r) * q) + off; }
        const int nig = WGM * nN, gid = wgid / nig, fm = gid * WGM, gsz = (nM - fm) < WGM ? (nM - fm) : WGM;
        u.pm = fm + ((wgid % nig) % gsz); u.pn = (wgid % nig) / gsz; return true;
    }
    __device__ __forceinline__ void a_ready(const Unit&) const {}
    __device__ __forceinline__ void done(const Unit&) const {}
};

__device__ __forceinline__ unsigned cvt_pk_bf16(float lo, float hi) { unsigned r; asm volatile("v_cvt_pk_bf16_f32 %0, %1, %2" : "=v"(r) : "v"(lo), "v"(hi)); return r; }

struct EpiStoreBf16 {
    static constexpr bool PERM = true, AFTER_DRAIN = false;
    bf16_t* O; int ldc;
    __device__ __forceinline__ void operator()(const f32x4 (&acc)[2][2][4][2], const Unit& u, int wr, int wc, int fr, int fq) const {
        const int row0 = u.pm * BM + wr * 64 + fr, col0 = u.pn * BM + wc * 32 + 8 * fq;
#pragma unroll
        for (int ai = 0; ai < 2; ++ai)
#pragma unroll
            for (int m = 0; m < 4; ++m) { bf16_t* rowp = O + (size_t)(row0 + ai * HALF + m * 16) * ldc + col0;
#pragma unroll
                for (int bj = 0; bj < 2; ++bj) { const f32x4 v0 = acc[ai][bj][m][0], v1 = acc[ai][bj][m][1];
                    u32x4 w; w.x = cvt_pk_bf16(v0[0], v0[1]); w.y = cvt_pk_bf16(v0[2], v0[3]); w.z = cvt_pk_bf16(v1[0], v1[1]); w.w = cvt_pk_bf16(v1[2], v1[3]);
                    *(u32x4*)(rowp + bj * HALF) = w; } }
    }
};
struct EpiStoreF16 {
    static constexpr bool PERM = true, AFTER_DRAIN = false;
    bf16_t* O; int ldc;
    static __device__ __forceinline__ unsigned pkh(float a, float b) { return (unsigned)__builtin_bit_cast(unsigned short, (_Float16)a) | ((unsigned)__builtin_bit_cast(unsigned short, (_Float16)b) << 16); }
    __device__ __forceinline__ void operator()(const f32x4 (&acc)[2][2][4][2], const Unit& u, int wr, int wc, int fr, int fq) const {
        const int row0 = u.pm * BM + wr * 64 + fr, col0 = u.pn * BM + wc * 32 + 8 * fq;
#pragma unroll
        for (int ai = 0; ai < 2; ++ai)
#pragma unroll
            for (int m = 0; m < 4; ++m) { bf16_t* rowp = O + (size_t)(row0 + ai * HALF + m * 16) * ldc + col0;
#pragma unroll
                for (int bj = 0; bj < 2; ++bj) { const f32x4 v0 = acc[ai][bj][m][0], v1 = acc[ai][bj][m][1];
                    u32x4 w; w.x = pkh(v0[0], v0[1]); w.y = pkh(v0[2], v0[3]); w.z = pkh(v1[0], v1[1]); w.w = pkh(v1[2], v1[3]);
                    *(u32x4*)(rowp + bj * HALF) = w; } }
    }
};
struct EpiResid {
    static constexpr bool PERM = true, AFTER_DRAIN = false;
    const float* x; const float* gate; float* out;
    __device__ __forceinline__ void operator()(const f32x4 (&acc)[2][2][4][2], const Unit& u, int wr, int wc, int fr, int fq) const {
        const int row0 = u.pm * BM + wr * 64 + fr, col0 = u.pn * BM + wc * 32 + 8 * fq;
#pragma unroll
        for (int ai = 0; ai < 2; ++ai)
#pragma unroll
            for (int m = 0; m < 4; ++m) { const int r = row0 + ai * HALF + m * 16; const float* gp = gate + (size_t)(r >> 11) * 6144;
#pragma unroll
                for (int bj = 0; bj < 2; ++bj) { const int c = col0 + bj * HALF;
                    const f32x4 xa = *(const f32x4*)(x + (size_t)r * 1024 + c), xb = *(const f32x4*)(x + (size_t)r * 1024 + c + 4);
                    const f32x4 ga = *(const f32x4*)(gp + c), gb = *(const f32x4*)(gp + c + 4);
                    *(f32x4*)(out + (size_t)r * 1024 + c) = xa + ga * acc[ai][bj][m][0];
                    *(f32x4*)(out + (size_t)r * 1024 + c + 4) = xb + gb * acc[ai][bj][m][1]; } }
    }
};
struct EpiResidNorm {
    static constexpr bool PERM = true, AFTER_DRAIN = false;
    const float* x; const float* mod; const float* ng; float* out; bf16_t* a3; float* rs;
    __device__ __forceinline__ void operator()(const f32x4 (&acc)[2][2][4][2], const Unit& u, int wr, int wc, int fr, int fq) const {
        const int row0 = u.pm * BM + wr * 64 + fr, col0 = u.pn * BM + wc * 32 + 8 * fq;
        const float* mp = mod + (size_t)((u.pm * BM) >> 11) * 6144;
        f32x4 g1v[2][2], csv[2][2];
#pragma unroll
        for (int bj = 0; bj < 2; ++bj)
#pragma unroll
            for (int n = 0; n < 2; ++n) { const int c = col0 + bj * HALF + 4 * n; g1v[bj][n] = *(const f32x4*)(mp + 2048 + c); csv[bj][n] = *(const f32x4*)(ng + c) * (*(const f32x4*)(mp + 4096 + c) + 1.0f); }
#pragma unroll
        for (int ai = 0; ai < 2; ++ai)
#pragma unroll
            for (int m = 0; m < 4; ++m) { const int r = row0 + ai * HALF + m * 16; float ss = 0.f;
#pragma unroll
                for (int bj = 0; bj < 2; ++bj) { const int c = col0 + bj * HALF;
                    const f32x4 xa = *(const f32x4*)(x + (size_t)r * 1024 + c), xb = *(const f32x4*)(x + (size_t)r * 1024 + c + 4);
                    const f32x4 v0 = xa + g1v[bj][0] * acc[ai][bj][m][0], v1 = xb + g1v[bj][1] * acc[ai][bj][m][1];
                    *(f32x4*)(out + (size_t)r * 1024 + c) = v0; *(f32x4*)(out + (size_t)r * 1024 + c + 4) = v1;
                    ss += (v0[0] * v0[0] + v0[1] * v0[1]) + (v0[2] * v0[2] + v0[3] * v0[3]) + (v1[0] * v1[0] + v1[1] * v1[1]) + (v1[2] * v1[2] + v1[3] * v1[3]);
                    const f32x4 a0 = v0 * csv[bj][0], a1 = v1 * csv[bj][1];
                    u32x4 w; w.x = cvt_pk_bf16(a0[0], a0[1]); w.y = cvt_pk_bf16(a0[2], a0[3]); w.z = cvt_pk_bf16(a1[0], a1[1]); w.w = cvt_pk_bf16(a1[2], a1[3]);
                    *(u32x4*)(a3 + (size_t)r * 1024 + c) = w; }
                ss += __shfl_xor(ss, 16); ss += __shfl_xor(ss, 32);
                if (fq == 0) rs[(size_t)r * 16 + (u.pn & 3) * 4 + wc] = ss; }
    }
};
struct EpiScoreF16 {
    static constexpr bool PERM = true, AFTER_DRAIN = false;
    bf16_t* O; int ldc; const float* rs; const float* sb;
    static __device__ __forceinline__ unsigned pkh(float a, float b) { return (unsigned)__builtin_bit_cast(unsigned short, (_Float16)a) | ((unsigned)__builtin_bit_cast(unsigned short, (_Float16)b) << 16); }
    __device__ __forceinline__ void operator()(const f32x4 (&acc)[2][2][4][2], const Unit& u, int wr, int wc, int fr, int fq) const {
        const int row0 = u.pm * BM + wr * 64 + fr, col0 = u.pn * BM + wc * 32 + 8 * fq;
        const float* sbp = sb + (size_t)((u.pm * BM) >> 11) * 2048;
        f32x4 bv[2][2];
#pragma unroll
        for (int bj = 0; bj < 2; ++bj)
#pragma unroll
            for (int n = 0; n < 2; ++n) bv[bj][n] = *(const f32x4*)(sbp + col0 + bj * HALF + 4 * n);
#pragma unroll
        for (int ai = 0; ai < 2; ++ai)
#pragma unroll
            for (int m = 0; m < 4; ++m) { const int r = row0 + ai * HALF + m * 16;
                float rstd; { const f32x4 p0 = *(const f32x4*)(rs + (size_t)r * 16), p1 = *(const f32x4*)(rs + (size_t)r * 16 + 4), p2 = *(const f32x4*)(rs + (size_t)r * 16 + 8), p3 = *(const f32x4*)(rs + (size_t)r * 16 + 12);
                  const f32x4 ps = (p0 + p1) + (p2 + p3); rstd = rsqrtf(((ps[0] + ps[1]) + (ps[2] + ps[3])) * (1.f / 1024.f) + 1e-6f); }
                bf16_t* rowp = O + (size_t)r * ldc + col0;
#pragma unroll
                for (int bj = 0; bj < 2; ++bj) { const f32x4 v0 = acc[ai][bj][m][0] * rstd + bv[bj][0], v1 = acc[ai][bj][m][1] * rstd + bv[bj][1];
                    u32x4 w; w.x = pkh(v0[0], v0[1]); w.y = pkh(v0[2], v0[3]); w.z = pkh(v1[0], v1[1]); w.w = pkh(v1[2], v1[3]);
                    *(u32x4*)(rowp + bj * HALF) = w; } }
    }
};
template <class Epi, class Sched, bool ALIGN_EPI = false, bool SP2 = false>
__device__ __forceinline__ void gemm_phase(PG8_LAS unsigned char* lds, const Gemm g, const Sched& S, const Epi& E) {
    int tid_o = threadIdx.x; asm volatile("" : "+v"(tid_o)); const int tid = tid_o, wid = __builtin_amdgcn_readfirstlane(tid >> 6), lane = tid & 63, wr = wid >> 2, wc = wid & 3, fr = lane & 15, fq = lane >> 4;
    const int K = g.K, nt = K / BK;
    unsigned voffA[2], voffB[2];
#pragma unroll
    for (int i = 0; i < 2; ++i) { int R, C; stage_rc(tid * 16 + i * 8192, R, C); const int Rb = Epi::PERM ? ((R & ~31) + perm32(R & 31)) : R;
        voffA[i] = (unsigned)(R * K + C) * 2u; voffB[i] = (unsigned)(Rb * K + C) * 2u; }
    const size_t kstep = (size_t)(BK * 2);
    const size_t hstep = (size_t)HALF * K * 2;
    const size_t tstep = 2 * hstep;
    const unsigned ldsw = (unsigned)wid * 1024u;
    const int aoff = lds_byte(wr * 64 + fr, fq * 8), boff = lds_byte(wc * 32 + fr, fq * 8);
#define PG8_SA(b, h) (((b) * 2 + (h)) * HTB)
#define PG8_SB(b, h) ((4 + (b) * 2 + (h)) * HTB)
#define PG8_STAGE(bufoff, gbase, voff) do { _Pragma("unroll") for (int _i = 0; _i < 2; ++_i) \
        __builtin_amdgcn_global_load_lds((const unsigned*)((const char*)(gbase) + (voff)[_i]), (PG8_LAS unsigned*)(lds + (bufoff) + ldsw + _i * 8192), 16, 0, 0); } while (0)
#define PG8_LDA(dst, b, h) do { _Pragma("unroll") for (int m = 0; m < 4; ++m) _Pragma("unroll") for (int k = 0; k < 2; ++k) dst[m][k] = *(const PG8_LAS bf16x8*)(lds + PG8_SA(b, h) + aoff + m * 2048 + k * 1024); } while (0)
#define PG8_LDB(dst, b, h) do { _Pragma("unroll") for (int n = 0; n < 2; ++n) _Pragma("unroll") for (int k = 0; k < 2; ++k) dst[n][k] = *(const PG8_LAS bf16x8*)(lds + PG8_SB(b, h) + boff + n * 2048 + k * 1024); } while (0)
#define PG8_MMA(ai, bj, At, Bt) do { __builtin_amdgcn_s_setprio(1); _Pragma("unroll") for (int m = 0; m < 4; ++m) _Pragma("unroll") for (int n = 0; n < 2; ++n) _Pragma("unroll") for (int k = 0; k < 2; ++k) \
        acc[ai][bj][m][n] = __builtin_amdgcn_mfma_f32_16x16x32_bf16(Bt[n][k], At[m][k], acc[ai][bj][m][n], 0, 0, 0); __builtin_amdgcn_s_setprio(0); } while (0)
#define PG8_WAIT_V(n) asm volatile("s_waitcnt vmcnt(" #n ")" ::: "memory")
#define PG8_WAIT_L(n) asm volatile("s_waitcnt lgkmcnt(" #n ")" ::: "memory")
#define PG8_BAR __builtin_amdgcn_s_barrier()
#define PG8_SCHED __builtin_amdgcn_sched_barrier(0)
    Unit cur, nxt; int ui = 0;
    if (!S.next(0, cur)) return;
    f32x4 acc[2][2][4][2];
#pragma unroll
    for (int a = 0; a < 2; ++a)
#pragma unroll
        for (int b = 0; b < 2; ++b)
#pragma unroll
            for (int m = 0; m < 4; ++m)
#pragma unroll
                for (int n = 0; n < 2; ++n) acc[a][b][m][n] = (f32x4){0.f, 0.f, 0.f, 0.f};
    bf16x8 At[4][2], B0[2][2], B1[2][2];
    const char* cA = (const char*)g.A + (size_t)cur.pm * tstep; const char* cB = (const char*)g.Bt + (size_t)cur.pn * tstep;
    S.a_ready(cur);
    if constexpr (SP2) {
        PG8_STAGE(PG8_SB(0, 0), cB, voffB); PG8_STAGE(PG8_SB(0, 1), cB + hstep, voffB); PG8_STAGE(PG8_SA(0, 0), cA, voffA); PG8_STAGE(PG8_SA(0, 1), cA + hstep, voffA);
        if (wr == 1) PG8_BAR;
        PG8_WAIT_V(2); PG8_BAR;
        PG8_STAGE(PG8_SB(1, 0), cB + kstep, voffB); PG8_STAGE(PG8_SA(1, 0), cA + kstep, voffA); PG8_STAGE(PG8_SB(1, 1), cB + hstep + kstep, voffB);
        PG8_WAIT_V(6); PG8_BAR;
    } else {
        PG8_STAGE(PG8_SB(0, 0), cB, voffB); PG8_STAGE(PG8_SA(0, 0), cA, voffA); PG8_STAGE(PG8_SB(0, 1), cB + hstep, voffB); PG8_STAGE(PG8_SA(0, 1), cA + hstep, voffA);
        if (wr == 1) PG8_BAR;
        PG8_WAIT_V(4); PG8_BAR;
        PG8_STAGE(PG8_SB(1, 0), cB + kstep, voffB); PG8_STAGE(PG8_SA(1, 0), cA + kstep, voffA); PG8_STAGE(PG8_SB(1, 1), cB + hstep + kstep, voffB);
        PG8_WAIT_V(6); PG8_BAR;
    }
    for (;;) {
        const bool has_next = S.next(ui + 1, nxt);
        const char* nA = has_next ? (const char*)g.A + (size_t)nxt.pm * tstep : cA; const char* nB = has_next ? (const char*)g.Bt + (size_t)nxt.pn * tstep : cB;
        for (int t = 0; t < nt; t += 2) {
            const bool last = (t == nt - 2);
            const char* a1 = cA + (size_t)(t + 1) * kstep;
            const char* a2 = last ? nA : cA + (size_t)(t + 2) * kstep; const char* b2 = last ? nB : cB + (size_t)(t + 2) * kstep;
            const char* a3 = a2 + kstep; const char* b3 = b2 + kstep;
            if (last && has_next) S.a_ready(nxt);
            if constexpr (SP2) {
            PG8_LDB(B0, 0, 0); PG8_LDB(B1, 0, 1); PG8_SCHED; PG8_LDA(At, 0, 0); PG8_STAGE(PG8_SA(1, 1), a1 + hstep, voffA);
            PG8_WAIT_V(8); PG8_WAIT_L(0); PG8_BAR; PG8_MMA(0, 0, At, B0); PG8_MMA(0, 1, At, B1); PG8_BAR; PG8_SCHED;
            PG8_LDA(At, 0, 1); PG8_STAGE(PG8_SB(0, 0), b2, voffB); PG8_STAGE(PG8_SB(0, 1), b2 + hstep, voffB); PG8_STAGE(PG8_SA(0, 0), a2, voffA);
            PG8_WAIT_V(8); PG8_WAIT_L(0); PG8_BAR; PG8_MMA(1, 0, At, B0); PG8_MMA(1, 1, At, B1); PG8_BAR; PG8_SCHED;
            PG8_LDB(B0, 1, 0); PG8_LDB(B1, 1, 1); PG8_SCHED; PG8_LDA(At, 1, 0); PG8_STAGE(PG8_SA(0, 1), a2 + hstep, voffA);
            PG8_WAIT_V(8); PG8_WAIT_L(0); PG8_BAR; PG8_MMA(0, 0, At, B0); PG8_MMA(0, 1, At, B1); PG8_BAR; PG8_SCHED;
            PG8_LDA(At, 1, 1); PG8_STAGE(PG8_SB(1, 0), b3, voffB); PG8_STAGE(PG8_SB(1, 1), b3 + hstep, voffB); PG8_STAGE(PG8_SA(1, 0), a3, voffA);
            PG8_WAIT_V(8); PG8_WAIT_L(0); PG8_BAR; PG8_MMA(1, 0, At, B0); PG8_MMA(1, 1, At, B1); PG8_BAR; PG8_SCHED;
            } else {
            PG8_LDB(B0, 0, 0); PG8_SCHED; PG8_LDA(At, 0, 0); PG8_STAGE(PG8_SA(1, 1), a1 + hstep, voffA);
            PG8_WAIT_L(8); PG8_BAR; PG8_WAIT_L(0); PG8_MMA(0, 0, At, B0); PG8_BAR; PG8_SCHED;
            PG8_LDB(B1, 0, 1); PG8_STAGE(PG8_SB(0, 0), b2, voffB);
            PG8_BAR; PG8_WAIT_L(0); PG8_MMA(0, 1, At, B1); PG8_BAR;
            PG8_LDA(At, 0, 1); PG8_STAGE(PG8_SA(0, 0), a2, voffA);
            PG8_BAR; PG8_WAIT_L(0); PG8_MMA(1, 0, At, B0); PG8_BAR; PG8_SCHED;
            PG8_STAGE(PG8_SB(0, 1), b2 + hstep, voffB);
            PG8_WAIT_V(6); PG8_BAR; PG8_MMA(1, 1, At, B1); PG8_BAR;
            PG8_LDB(B0, 1, 0); PG8_SCHED; PG8_LDA(At, 1, 0); PG8_STAGE(PG8_SA(0, 1), a2 + hstep, voffA);
            PG8_WAIT_L(8); PG8_BAR; PG8_WAIT_L(0); PG8_MMA(0, 0, At, B0); PG8_BAR; PG8_SCHED;
            PG8_LDB(B1, 1, 1); PG8_STAGE(PG8_SB(1, 0), b3, voffB);
            PG8_BAR; PG8_WAIT_L(0); PG8_MMA(0, 1, At, B1); PG8_BAR;
            PG8_LDA(At, 1, 1); PG8_STAGE(PG8_SA(1, 0), a3, voffA);
            PG8_BAR; PG8_WAIT_L(0); PG8_MMA(1, 0, At, B0); PG8_BAR; PG8_SCHED;
            PG8_STAGE(PG8_SB(1, 1), b3 + hstep, voffB);
            PG8_WAIT_V(6); PG8_BAR; PG8_MMA(1, 1, At, B1); PG8_BAR;
            }
        }
        if constexpr (ALIGN_EPI) { if (wr == 0) PG8_BAR; }
        if constexpr (!Epi::AFTER_DRAIN) { E(acc, cur, wr, wc, fr, fq); S.done(cur); }
        if (!has_next) break;
#pragma unroll
        for (int a = 0; a < 2; ++a)
#pragma unroll
            for (int b = 0; b < 2; ++b)
#pragma unroll
                for (int m = 0; m < 4; ++m)
#pragma unroll
                    for (int n = 0; n < 2; ++n) acc[a][b][m][n] = (f32x4){0.f, 0.f, 0.f, 0.f};
        cur = nxt; cA = nA; cB = nB; ++ui;
        if constexpr (ALIGN_EPI) { if (wr == 1) PG8_BAR; }
    }
    PG8_WAIT_V(0);
    if constexpr (!ALIGN_EPI) { if (wr == 0) PG8_BAR; }
    PG8_BAR;
    if constexpr (Epi::AFTER_DRAIN) { E.fused(acc, cur, wr, wc, fr, fq, lds, wid, lane); S.done(cur); }
#undef PG8_SA
#undef PG8_SB
#undef PG8_STAGE
#undef PG8_LDA
#undef PG8_LDB
#undef PG8_MMA
#undef PG8_WAIT_V
#undef PG8_WAIT_L
#undef PG8_BAR
#undef PG8_SCHED
}
}


#define LAS __attribute__((address_space(3)))
typedef unsigned short bf16_t;
typedef short bf16x8 __attribute__((ext_vector_type(8)));
typedef short s16x4 __attribute__((ext_vector_type(4)));
typedef short v4i16_t __attribute__((ext_vector_type(4)));
typedef float f32x4 __attribute__((ext_vector_type(4)));
typedef unsigned u32x4 __attribute__((ext_vector_type(4)));
typedef unsigned u32x2 __attribute__((ext_vector_type(2)));
typedef float f32x2 __attribute__((ext_vector_type(2)));

constexpr int T = 16384, DM = 1024, SEQ = 2048, NP = 3584;
constexpr size_t MiB = 1u << 20;
constexpr size_t WS_CTL = 0, WS_MOD = 4096, WS_GATES = 262144, WS_KEYS = 1 * MiB, WS_WIN = 2 * MiB, WS_WOUT = 9 * MiB, WS_WQ = 11 * MiB,
                 WS_T8 = 16 * MiB, WS_SC = 48 * MiB, WS_ACT = 80 * MiB, WS_P = 112 * MiB, WS_QRY = 112 * MiB, WS_END = 256 * MiB;
constexpr size_t WS_RS = 208 * MiB, WS_SB = 851968, WS_WGT = 917504, WS_A3 = 176 * MiB;
constexpr int LDS_BYTES = 147456;

__device__ __forceinline__ unsigned f2bf(float f) { unsigned u = __float_as_uint(f); return (u + 0x7fffu + ((u >> 16) & 1u)) >> 16; }
typedef __bf16 bf16x2_t __attribute__((ext_vector_type(2)));
__device__ __forceinline__ unsigned pk2(float lo, float hi) { const f32x2 v = {lo, hi}; const bf16x2_t b = __builtin_convertvector(v, bf16x2_t); return __builtin_bit_cast(unsigned, b); }
__device__ __forceinline__ float bflo(unsigned u) { return __uint_as_float(u << 16); }
__device__ __forceinline__ float bfhi(unsigned u) { return __uint_as_float(u & 0xffff0000u); }
__device__ __forceinline__ float wave_sum(float v) {
    { const auto r = __builtin_amdgcn_permlane32_swap(__float_as_uint(v), __float_as_uint(v), false, false); v = __uint_as_float(r[0]) + __uint_as_float(r[1]); }
    { const auto r = __builtin_amdgcn_permlane16_swap(__float_as_uint(v), __float_as_uint(v), false, false); v = __uint_as_float(r[0]) + __uint_as_float(r[1]); }
    v += __int_as_float(__builtin_amdgcn_mov_dpp(__float_as_int(v), 0xB1, 0xF, 0xF, true));
    v += __int_as_float(__builtin_amdgcn_mov_dpp(__float_as_int(v), 0x4E, 0xF, 0xF, true));
    v += __int_as_float(__builtin_amdgcn_mov_dpp(__float_as_int(v), 0x141, 0xF, 0xF, true));
    v += __int_as_float(__builtin_amdgcn_mov_dpp(__float_as_int(v), 0x140, 0xF, 0xF, true));
    return v;
}
__device__ __forceinline__ float xrow_max(float v) {
    { const auto r = __builtin_amdgcn_permlane16_swap(__float_as_uint(v), __float_as_uint(v), false, false); v = fmaxf(__uint_as_float(r[0]), __uint_as_float(r[1])); }
    { const auto r = __builtin_amdgcn_permlane32_swap(__float_as_uint(v), __float_as_uint(v), false, false); v = fmaxf(__uint_as_float(r[0]), __uint_as_float(r[1])); }
    return v;
}
__device__ __forceinline__ float xrow_sum(float v) {
    { const auto r = __builtin_amdgcn_permlane16_swap(__float_as_uint(v), __float_as_uint(v), false, false); v = __uint_as_float(r[0]) + __uint_as_float(r[1]); }
    { const auto r = __builtin_amdgcn_permlane32_swap(__float_as_uint(v), __float_as_uint(v), false, false); v = __uint_as_float(r[0]) + __uint_as_float(r[1]); }
    return v;
}
#define LDS_WAIT() asm volatile("s_waitcnt lgkmcnt(0)" ::: "memory")
__device__ __forceinline__ s16x4 vtr(LAS unsigned char* p) { return __builtin_bit_cast(s16x4, __builtin_amdgcn_ds_read_tr16_b64_v4i16((LAS v4i16_t*)p)); }
__device__ __forceinline__ bf16x8 cat8(s16x4 a, s16x4 b) { bf16x8 r; r[0] = a[0]; r[1] = a[1]; r[2] = a[2]; r[3] = a[3]; r[4] = b[0]; r[5] = b[1]; r[6] = b[2]; r[7] = b[3]; return r; }
__device__ __forceinline__ bf16x8 pack8(const f32x4 a, const f32x4 b) { u32x4 w; w.x = pk2(a[0], a[1]); w.y = pk2(a[2], a[3]); w.z = pk2(b[0], b[1]); w.w = pk2(b[2], b[3]); return __builtin_bit_cast(bf16x8, w); }
#define MFMA16(a, b, c) __builtin_amdgcn_mfma_f32_16x16x32_bf16((a), (b), (c), 0, 0, 0)

struct Args {
    const float *x, *c, *ada_w, *ada_b, *norm1_g, *w_in, *conv_w, *conv_b, *gate_b, *mnorm_g, *lq1, *lk1, *lq2, *lk2, *dnorm_g, *w_out, *norm2_g, *wq, *keys, *pu, *pv, *final_g;
    float* out; unsigned char* ws;
};

__device__ __forceinline__ void transpose_item(const float* W, int srcN, int soff, bf16_t* WT, LAS float* scr, int kb, int nb, int lane) {
    const int k0 = 64 * kb, n0 = 32 * nb;
    { f32x4 wv[8];
#pragma unroll
      for (int i = 0; i < 8; ++i) wv[i] = *(const f32x4*)(W + (size_t)(k0 + 8 * i + (lane >> 3)) * srcN + n0 + soff + 4 * (lane & 7));
#pragma unroll
      for (int i = 0; i < 8; ++i) { LAS float* d = scr + (8 * i + (lane >> 3)) * 33 + 4 * (lane & 7); d[0] = wv[i][0]; d[1] = wv[i][1]; d[2] = wv[i][2]; d[3] = wv[i][3]; } }
    LDS_WAIT(); asm volatile("" ::: "memory");
    const int c = lane & 7;
#pragma unroll
    for (int j = 0; j < 4; ++j) { const int n = (lane >> 3) + 8 * j; const LAS float* s = scr + (8 * c) * 33 + n;
        u32x4 o; o.x = pk2(s[0 * 33], s[1 * 33]); o.y = pk2(s[2 * 33], s[3 * 33]); o.z = pk2(s[4 * 33], s[5 * 33]); o.w = pk2(s[6 * 33], s[7 * 33]);
        *(u32x4*)(WT + (size_t)(n0 + n) * 1024 + k0 + 8 * c) = o; }
    LDS_WAIT(); asm volatile("" ::: "memory");
}

__device__ __forceinline__ bf16x8 pack8_sw(const f32x4 a, const f32x4 b) {
    u32x4 w; w.x = f2bf(a[0]) | (f2bf(a[1]) << 16); w.y = f2bf(a[2]) | (f2bf(a[3]) << 16); w.z = f2bf(b[0]) | (f2bf(b[1]) << 16); w.w = f2bf(b[2]) | (f2bf(b[3]) << 16); return __builtin_bit_cast(bf16x8, w); }
__device__ __forceinline__ void wprime_item(const Args& A, int hp, int kt, int lane) {
    const int g = lane >> 4, l15 = lane & 15;
    f32x4 acc[8];
#pragma unroll
    for (int nt = 0; nt < 8; ++nt) acc[nt] = (f32x4){0.f, 0.f, 0.f, 0.f};
#pragma unroll
    for (int ks = 0; ks < 4; ++ks) {
        const float* ap = A.wq + (size_t)(16 * kt + l15) * 2048 + hp * 128 + 32 * ks + 8 * g;
        const bf16x8 a = pack8(*(const f32x4*)ap, *(const f32x4*)(ap + 4));
#pragma unroll
        for (int nt = 0; nt < 8; ++nt) { const float* bp = A.keys + (size_t)(hp * 128 + 16 * nt + l15) * 128 + 32 * ks + 8 * g;
            const bf16x8 b = pack8(*(const f32x4*)bp, *(const f32x4*)(bp + 4)); acc[nt] = MFMA16(a, b, acc[nt]); }
    }
    bf16_t* WT = (bf16_t*)(A.ws + WS_WQ);
#pragma unroll
    for (int nt = 0; nt < 8; ++nt) { u32x2 o; o.x = pk2(acc[nt][0], acc[nt][1]); o.y = pk2(acc[nt][2], acc[nt][3]);
        *(u32x2*)(WT + (size_t)(hp * 128 + 16 * nt + l15) * 1024 + 16 * kt + 4 * g) = o; }
}

__device__ __forceinline__ void phase0(const Args& A, LAS unsigned char* lds) {
    int tid_o = threadIdx.x; asm volatile("" : "+v"(tid_o)); const int tid = tid_o, lane = tid & 63, wave = tid >> 6, G = gridDim.x;
    float* MOD = (float*)(A.ws + WS_MOD);
    if ((int)blockIdx.x < 192) {
        LAS float* sc = (LAS float*)lds;
        for (int i = tid; i < 8192; i += 512) { const float v = A.c[i]; sc[i] = v * __builtin_amdgcn_rcpf(1.f + __expf(-v)); }
        __syncthreads();
        for (int item = blockIdx.x; item < 192; item += G) {
            const int j0 = item * 32, kg = tid >> 3, cq = tid & 7;
            f32x4 wv[16];
#pragma unroll
            for (int kk = 0; kk < 16; ++kk) wv[kk] = *(const f32x4*)(A.ada_w + (size_t)(kg * 16 + kk) * 6144 + j0 + 4 * cq);
            f32x4 acc[8];
#pragma unroll
            for (int b = 0; b < 8; ++b) acc[b] = (f32x4){0.f, 0.f, 0.f, 0.f};
#pragma unroll
            for (int b = 0; b < 8; ++b)
#pragma unroll
                for (int k4 = 0; k4 < 4; ++k4) { const f32x4 s4 = *(const LAS f32x4*)(sc + b * 1024 + kg * 16 + 4 * k4);
                    acc[b] += wv[4 * k4] * s4[0]; acc[b] += wv[4 * k4 + 1] * s4[1]; acc[b] += wv[4 * k4 + 2] * s4[2]; acc[b] += wv[4 * k4 + 3] * s4[3]; }
            LAS float* part = (LAS float*)(lds + 32768);
#pragma unroll
            for (int b = 0; b < 8; ++b) *(LAS f32x4*)(part + (kg * 8 + b) * 32 + 4 * cq) = acc[b];
            __syncthreads();
            if (tid < 256) { const int b = tid >> 5, col = tid & 31; float s = A.ada_b[j0 + col];
              for (int k2 = 0; k2 < 64; ++k2) s += part[(k2 * 8 + b) * 32 + col];
              MOD[b * 6144 + j0 + col] = s; }
            __syncthreads();
        }
    }
    for (int i = (G - 1 - (int)blockIdx.x) * 512 + tid; i < 8192; i += G * 512) { const int gc = i >> 10, k = i & 1023; ((float*)(A.ws + WS_WGT))[i] = A.w_in[(size_t)k * 3592 + 2048 + gc]; }
    if (blockIdx.x == 0 && tid == 0) {
        float s1 = 0.f, s2 = 0.f;
        for (int i = 0; i < 64; ++i) { s1 += A.lq1[i] * A.lk1[i]; s2 += A.lq2[i] * A.lk2[i]; }
        ((float*)(A.ws + WS_CTL))[1] = expf(s1) - expf(s2) + 0.2f;
        ((unsigned*)(A.ws + WS_CTL))[0] = 0u; ((unsigned*)(A.ws + WS_CTL))[2] = 0u;
    }
}

__device__ __forceinline__ void phase0b(const Args& A, LAS unsigned char* lds) {
    int tid_o = threadIdx.x; asm volatile("" : "+v"(tid_o)); const int tid = tid_o, lane = tid & 63, wave = tid >> 6, G = gridDim.x;
    __syncthreads();
    {
        LAS float* scr = (LAS float*)(lds + wave * 16384);
        const int gw = blockIdx.x * 8 + wave, NGW = G * 8;
        for (int it = gw; it < 1792; it += NGW) { const int kb = it / 112, nb = it % 112; transpose_item(A.w_in, 3592, nb >= 64 ? 8 : 0, (bf16_t*)(A.ws + WS_WIN), scr, kb, nb, lane); }
    }
}

__device__ __forceinline__ void quantise_tables(const Args& A, int gw, int NGW, int row_lo, int row_hi) {
    int tid_o = threadIdx.x; asm volatile("" : "+v"(tid_o)); const int lane = tid_o & 63;
    unsigned char* T8 = A.ws + WS_T8; float* SC = (float*)(A.ws + WS_SC);
#pragma unroll 1
    for (int row = row_lo + gw; row < row_hi; row += 4 * NGW) {
        f32x4 v[4][4]; int rr[4];
#pragma unroll
        for (int q = 0; q < 4; ++q) { const int r = row + q * NGW; rr[q] = r; const int rc = r < row_hi ? r : row;
            const float* s = (rc < 16384 ? A.pu + (size_t)rc * 1024 : A.pv + (size_t)(rc - 16384) * 1024) + 16 * lane;
#pragma unroll
            for (int j = 0; j < 4; ++j) v[q][j] = *(const f32x4*)(s + 4 * j); }
#pragma unroll
        for (int q = 0; q < 4; ++q) {
            float mx = 0.f;
#pragma unroll
            for (int j = 0; j < 4; ++j)
#pragma unroll
                for (int e = 0; e < 4; ++e) mx = fmaxf(mx, fabsf(v[q][j][e]));
#pragma unroll
            for (int o = 1; o < 64; o <<= 1) mx = fmaxf(mx, __shfl_xor(mx, o));
            const float sc = fmaxf(mx, 1e-30f) * (1.f / 256.f), inv = 1.f / sc;
            u32x4 o4;
#pragma unroll
            for (int j = 0; j < 4; ++j) { int w0 = __builtin_amdgcn_cvt_pk_fp8_f32(v[q][j][0] * inv, v[q][j][1] * inv, 0, false); w0 = __builtin_amdgcn_cvt_pk_fp8_f32(v[q][j][2] * inv, v[q][j][3] * inv, w0, true); o4[j] = (unsigned)w0; }
            if (rr[q] < row_hi) { *(u32x4*)(T8 + (size_t)rr[q] * 1024 + 16 * lane) = o4; if (lane == 0) SC[rr[q]] = sc; }
        }
    }
}

__device__ __forceinline__ void phase1(const Args& A, LAS unsigned char* lds) {
    int tid_o = threadIdx.x; asm volatile("" : "+v"(tid_o)); const int tid = tid_o, lane = tid & 63, wave = tid >> 6, G = gridDim.x;
    const float* MOD = (const float*)(A.ws + WS_MOD);
    bf16_t* ACT = (bf16_t*)(A.ws + WS_ACT);
    float* GATES = (float*)(A.ws + WS_GATES);
    LAS float* WG = (LAS float*)lds;
    for (int i = tid; i < 8192; i += 512) WG[i] = ((const float*)(A.ws + WS_WGT))[i];
    __syncthreads();
    f32x4 vn[4];
    { const int m0 = blockIdx.x * 8 + wave; if (m0 < T) { const f32x4* xr = (const f32x4*)(A.x + (size_t)m0 * 1024) + lane;
#pragma unroll
        for (int j = 0; j < 4; ++j) vn[j] = xr[64 * j]; } }
    for (int m = blockIdx.x * 8 + wave; m < T; m += G * 8) {
        const int b = m >> 11;
        f32x4 v[4]; float ss = 0.f;
#pragma unroll
        for (int j = 0; j < 4; ++j) { v[j] = vn[j]; ss += (v[j][0] * v[j][0] + v[j][1] * v[j][1]) + (v[j][2] * v[j][2] + v[j][3] * v[j][3]); }
        if (m + G * 8 < T) { const f32x4* xr = (const f32x4*)(A.x + (size_t)(m + G * 8) * 1024) + lane;
#pragma unroll
            for (int j = 0; j < 4; ++j) vn[j] = xr[64 * j]; }
        const float rstd = rsqrtf(wave_sum(ss) * (1.f / 1024.f) + 1e-6f);
        unsigned long long* o8 = (unsigned long long*)(ACT + (size_t)m * 1024) + lane;
#pragma unroll
        for (int j = 0; j < 4; ++j) { const int col = 4 * lane + 256 * j;
            const f32x4 g = *(const f32x4*)(A.norm1_g + col), sc = *(const f32x4*)(MOD + b * 6144 + 1024 + col), sh = *(const f32x4*)(MOD + b * 6144 + col);
            v[j] = v[j] * rstd * g * (sc + 1.0f) + sh;
            o8[64 * j] = (unsigned long long)pk2(v[j][0], v[j][1]) | ((unsigned long long)pk2(v[j][2], v[j][3]) << 32); }
        float gd[8];
#pragma unroll
        for (int gc = 0; gc < 8; ++gc) { float d = 0.f;
#pragma unroll
            for (int j = 0; j < 4; ++j) { const f32x4 w = *(const LAS f32x4*)(WG + gc * 1024 + 256 * j + 4 * lane); d += (v[j][0] * w[0] + v[j][1] * w[1]) + (v[j][2] * w[2] + v[j][3] * w[3]); }
            gd[gc] = wave_sum(d); }
        if (lane == 0) {
            f32x4 ig, lf;
#pragma unroll
            for (int h = 0; h < 4; ++h) { ig[h] = gd[h] + A.gate_b[h]; const float z = gd[4 + h] + A.gate_b[4 + h]; lf[h] = fminf(z, 0.f) - log1pf(expf(-fabsf(z))); }
            *(f32x4*)(GATES + (size_t)m * 8) = ig; *(f32x4*)(GATES + (size_t)m * 8 + 4) = lf;
        }
    }
}

constexpr int AK_STRIDE = 272, AV_STRIDE = 288, AK_BYTES = 64 * AK_STRIDE, AV_BYTES = 64 * AV_STRIDE;
__device__ __forceinline__ void attn_item(const Args& A, LAS unsigned char* lds, int b, int h, int qb, float lam) {
    int tid_o = threadIdx.x; asm volatile("" : "+v"(tid_o)); const int tid = tid_o, lane = tid & 63, w = tid >> 6, g = lane >> 4, l15 = lane & 15;
    const bf16_t* P = (const bf16_t*)(A.ws + WS_P);
    bf16_t* ACT = (bf16_t*)(A.ws + WS_ACT);
    const int t0 = qb * 128, ntiles = 2 * (qb + 1);
    const size_t rowbase = (size_t)b * SEQ;
    bf16x8 qf[2][2];
    { const bf16_t* qp = P + (rowbase + t0 + 16 * w + l15) * NP + 2048 + h * 128 + 8 * g;
#pragma unroll
      for (int p = 0; p < 2; ++p)
#pragma unroll
          for (int ks = 0; ks < 2; ++ks) qf[p][ks] = *(const bf16x8*)(qp + p * 64 + ks * 32); }
    f32x4 o[2][8];
#pragma unroll
    for (int p = 0; p < 2; ++p)
#pragma unroll
        for (int vt = 0; vt < 8; ++vt) o[p][vt] = (f32x4){0.f, 0.f, 0.f, 0.f};
    float mrun[2] = {-1e30f, -1e30f}, lrun[2] = {0.f, 0.f};
    const int srow = tid >> 3, sseg = tid & 7;
    const bf16_t* kg = P + (rowbase + srow) * NP + 2560 + h * 128 + sseg * 16;
    const bf16_t* vg = P + (rowbase + srow) * NP + 3072 + h * 128 + sseg * 16;
    u32x4 kr0, kr1, vr0, vr1;
    kr0 = *(const u32x4*)(kg); kr1 = *(const u32x4*)(kg + 8); vr0 = *(const u32x4*)(vg); vr1 = *(const u32x4*)(vg + 8);
    { LAS unsigned char* kb = lds + srow * AK_STRIDE + sseg * 32; LAS unsigned char* vb = lds + 2 * AK_BYTES + srow * AV_STRIDE + sseg * 32;
      *(LAS u32x4*)kb = kr0; *(LAS u32x4*)(kb + 16) = kr1; *(LAS u32x4*)vb = vr0; *(LAS u32x4*)(vb + 16) = vr1; }
    __syncthreads();
    const float cs = 0.125f * 1.4426950408889634f;
    const int qabs = t0 + 16 * w + l15;
    for (int kt = 0; kt < ntiles; ++kt) {
        const int cur = kt & 1;
        if (kt + 1 < ntiles) { const size_t off = (size_t)(kt + 1) * 64 * NP;
            kr0 = *(const u32x4*)(kg + off); kr1 = *(const u32x4*)(kg + off + 8); vr0 = *(const u32x4*)(vg + off); vr1 = *(const u32x4*)(vg + off + 8); }
        if (64 * kt <= t0 + 16 * w + 15) {
            LAS unsigned char* Kb = lds + cur * AK_BYTES; LAS unsigned char* Vb = lds + 2 * AK_BYTES + cur * AV_BYTES;
            f32x4 s[2][4];
#pragma unroll
            for (int p = 0; p < 2; ++p)
#pragma unroll
                for (int k4 = 0; k4 < 4; ++k4) { f32x4 a = (f32x4){0.f, 0.f, 0.f, 0.f};
#pragma unroll
                    for (int ks = 0; ks < 2; ++ks) { const bf16x8 kf = *(const LAS bf16x8*)(Kb + (16 * k4 + l15) * AK_STRIDE + (p * 64 + ks * 32 + 8 * g) * 2); a = MFMA16(kf, qf[p][ks], a); }
                    s[p][k4] = a; }
            if (64 * kt + 63 > t0 + 16 * w) {
#pragma unroll
                for (int p = 0; p < 2; ++p)
#pragma unroll
                    for (int k4 = 0; k4 < 4; ++k4)
#pragma unroll
                        for (int r = 0; r < 4; ++r) { const int key = 64 * kt + 16 * k4 + 4 * g + r; if (key > qabs) s[p][k4][r] = -1e30f; }
            }
            bf16x8 pf[2][2];
#pragma unroll
            for (int p = 0; p < 2; ++p) {
                float mx = -1e30f;
#pragma unroll
                for (int k4 = 0; k4 < 4; ++k4)
#pragma unroll
                    for (int r = 0; r < 4; ++r) mx = fmaxf(mx, s[p][k4][r]);
                mx = xrow_max(mx);
                const float mnew = fmaxf(mrun[p], mx * cs), alpha = __builtin_amdgcn_exp2f(mrun[p] - mnew);
                mrun[p] = mnew;
                float ls = 0.f;
#pragma unroll
                for (int k4 = 0; k4 < 4; ++k4)
#pragma unroll
                    for (int r = 0; r < 4; ++r) { const float pv = __builtin_amdgcn_exp2f(s[p][k4][r] * cs - mnew); ls += pv; s[p][k4][r] = pv; }
                lrun[p] = lrun[p] * alpha + ls;
                if (__any(alpha != 1.f)) {
#pragma unroll
                    for (int vt = 0; vt < 8; ++vt) o[p][vt] = o[p][vt] * alpha; }
                pf[p][0] = pack8(s[p][0], s[p][1]); pf[p][1] = pack8(s[p][2], s[p][3]);
            }
#pragma unroll
            for (int ks2 = 0; ks2 < 2; ++ks2)
#pragma unroll
                for (int vt = 0; vt < 8; ++vt) {
                    LAS unsigned char* a0 = Vb + (32 * ks2 + 4 * g + (l15 >> 2)) * AV_STRIDE + (16 * vt + 4 * (lane & 3)) * 2;
                    const bf16x8 vf = cat8(vtr(a0), vtr(a0 + 16 * AV_STRIDE));
                    o[0][vt] = MFMA16(vf, pf[0][ks2], o[0][vt]);
                    o[1][vt] = MFMA16(vf, pf[1][ks2], o[1][vt]);
                }
        }
        if (kt + 1 < ntiles) { const int nx = cur ^ 1;
            LAS unsigned char* kb = lds + nx * AK_BYTES + srow * AK_STRIDE + sseg * 32; LAS unsigned char* vb = lds + 2 * AK_BYTES + nx * AV_BYTES + srow * AV_STRIDE + sseg * 32;
            *(LAS u32x4*)kb = kr0; *(LAS u32x4*)(kb + 16) = kr1; *(LAS u32x4*)vb = vr0; *(LAS u32x4*)(vb + 16) = vr1; }
        __syncthreads();
    }
    float inv[2];
#pragma unroll
    for (int p = 0; p < 2; ++p) { const float lt = xrow_sum(lrun[p]); inv[p] = 1.f / lt; }
    float ss = 0.f;
#pragma unroll
    for (int vt = 0; vt < 8; ++vt)
#pragma unroll
        for (int r = 0; r < 4; ++r) { const float ov = o[0][vt][r] * inv[0] - lam * (o[1][vt][r] * inv[1]); o[0][vt][r] = ov; ss += ov * ov; }
    ss = xrow_sum(ss);
    const float rstd = rsqrtf(ss * (1.f / 128.f) + 1e-6f) * 0.8f;
    bf16_t* op = ACT + (rowbase + qabs) * 1024 + 512 + h * 128 + 4 * g;
#pragma unroll
    for (int vt = 0; vt < 8; ++vt) { const f32x4 gn = *(const f32x4*)(A.dnorm_g + 16 * vt + 4 * g);
        u32x2 wv; wv.x = pk2(o[0][vt][0] * rstd * gn[0], o[0][vt][1] * rstd * gn[1]); wv.y = pk2(o[0][vt][2] * rstd * gn[2], o[0][vt][3] * rstd * gn[3]);
        *(u32x2*)(op + 16 * vt) = wv; }
}

constexpr int MQ_STRIDE = 272, MV_STRIDE = 288, MP_STRIDE = 144, MH_STRIDE = 132;
constexpr int ML_Q = 0, ML_K = 17408, ML_V = 34816, ML_P = 53248, ML_H = 62464, ML_CW = 96256, ML_SM = 101376;
constexpr int SM_E = 0, SM_G = 64, SM_B = 128, SM_W = 192, SM_I = 256, SM_R = 320, SM_N = 384, SM_NP = 512, SM_X = 1024;
constexpr size_t WS_CST = 224 * MiB, WS_NST = 15 * MiB, WS_MC = 15 * MiB + 512 * 1024, WS_BAR = 15 * MiB + 768 * 1024;

__device__ __forceinline__ void mlstm_state(const Args& A, LAS unsigned char* lds, int b, int h) {
    int tid_o = threadIdx.x; asm volatile("" : "+v"(tid_o)); const int tid = tid_o, lane = tid & 63, w = tid >> 6, g = lane >> 4, l15 = lane & 15;
    const bf16_t* P = (const bf16_t*)(A.ws + WS_P);
    const float* GATES = (const float*)(A.ws + WS_GATES);
    u32x4* CST = (u32x4*)(A.ws + WS_CST); float* NST = (float*)(A.ws + WS_NST); float* MCg = (float*)(A.ws + WS_MC);
    LAS float* sm = (LAS float*)(lds + ML_SM);
    LAS float* cw = (LAS float*)(lds + ML_CW);
    LAS unsigned char* Ks = lds + ML_K; LAS unsigned char* Vs = lds + ML_V;
    const size_t rowbase = (size_t)b * SEQ; const int bh = b * 4 + h;
    for (int i = tid; i < 640; i += 512) { const int j = i >> 7, ch = i & 127, cch = 512 + h * 128 + ch; cw[i] = (j < 4) ? A.conv_w[j * 1024 + cch] : A.conv_b[cch]; }
    if (tid < 128) sm[SM_N + tid] = 0.f;
    const int rg = tid >> 4, cs = tid & 15;
    const int ccol = 512 + h * 128 + 8 * cs;
    const int srow = tid >> 3, sseg = tid & 7;
    u32x4 cr[5], vr0, vr1; float gi = 0.f, gf = 0.f;
#define MS_PREFETCH(c) do { const int _r0 = (c) * 64 + 2 * rg - 3; \
        _Pragma("unroll") for (int _i = 0; _i < 5; ++_i) { const int _r = _r0 + _i; const u32x4 _v = *(const u32x4*)(P + (rowbase + (_r >= 0 ? _r : 0)) * NP + ccol); cr[_i] = (_r >= 0) ? _v : (u32x4){0u, 0u, 0u, 0u}; } \
        const bf16_t* _vp = P + (rowbase + (c) * 64 + srow) * NP + 1024 + h * 128 + sseg * 16; \
        vr0 = *(const u32x4*)(_vp); vr1 = *(const u32x4*)(_vp + 8); \
        } while (0)
    MS_PREFETCH(0);
    LAS float* Eall = (LAS float*)(lds + ML_Q);
#pragma unroll
    for (int cc = 0; cc < 4; ++cc) { const int c = w + 8 * cc;
        const float* gp = GATES + (rowbase + c * 64 + lane) * 8 + h; gi = gp[0]; gf = gp[4];
        float bc = gf;
#pragma unroll
        for (int o = 1; o < 64; o <<= 1) { const float t = __shfl_up(bc, o); if (lane >= o) bc += t; }
        const float e = gi - bc; float cm = e;
#pragma unroll
        for (int o = 1; o < 64; o <<= 1) { const float t = __shfl_up(cm, o); if (lane >= o) cm = fmaxf(cm, t); }
        Eall[c * 64 + lane] = e;
        if (lane == 63) { Eall[2048 + c] = bc; Eall[2048 + 32 + c] = cm; } }
    f32x4 C[8];
#pragma unroll
    for (int kt = 0; kt < 8; ++kt) C[kt] = (f32x4){0.f, 0.f, 0.f, 0.f};
    float mc = 0.f;
    __syncthreads();
    for (int c = 0; c < 32; ++c) {
        {
            float wt[5][8];
#pragma unroll
            for (int j = 0; j < 5; ++j) { const f32x4 a = *(const LAS f32x4*)(cw + j * 128 + 8 * cs), bb = *(const LAS f32x4*)(cw + j * 128 + 8 * cs + 4);
                wt[j][0] = a[0]; wt[j][1] = a[1]; wt[j][2] = a[2]; wt[j][3] = a[3]; wt[j][4] = bb[0]; wt[j][5] = bb[1]; wt[j][6] = bb[2]; wt[j][7] = bb[3]; }
            LAS unsigned char* dst = Ks + (2 * rg) * MQ_STRIDE + 16 * cs;
#pragma unroll
            for (int r = 0; r < 2; ++r) {
                float ov[8];
#pragma unroll
                for (int e = 0; e < 8; ++e) ov[e] = wt[4][e];
#pragma unroll
                for (int j = 0; j < 4; ++j) { const u32x4 x = cr[r + j];
                    ov[0] += wt[j][0] * bflo(x.x); ov[1] += wt[j][1] * bfhi(x.x); ov[2] += wt[j][2] * bflo(x.y); ov[3] += wt[j][3] * bfhi(x.y);
                    ov[4] += wt[j][4] * bflo(x.z); ov[5] += wt[j][5] * bfhi(x.z); ov[6] += wt[j][6] * bflo(x.w); ov[7] += wt[j][7] * bfhi(x.w); }
#pragma unroll
                for (int e = 0; e < 8; ++e) ov[e] = 0.08838834764831845f * ov[e] * __builtin_amdgcn_rcpf(1.f + __expf(-ov[e]));
                u32x4 o4; o4.x = pk2(ov[0], ov[1]); o4.y = pk2(ov[2], ov[3]); o4.z = pk2(ov[4], ov[5]); o4.w = pk2(ov[6], ov[7]);
                *(LAS u32x4*)(dst + r * MQ_STRIDE) = o4;
            }
            LAS unsigned char* vd = Vs + srow * MV_STRIDE + sseg * 32; *(LAS u32x4*)vd = vr0; *(LAS u32x4*)(vd + 16) = vr1;
            if (w == 0) {
                const float g63 = fmaxf(mc, Eall[2048 + 32 + c]);
                sm[SM_W + lane] = __expf(Eall[c * 64 + lane] - g63);
                if (lane == 63) { sm[SM_X] = __expf(mc - g63); sm[SM_X + 1] = Eall[2048 + c] + g63; }
            }
        }
        __syncthreads();
        { const int cn = (c + 1 < 32) ? c + 1 : 31; MS_PREFETCH(cn); }
        {
            const int item = bh * 32 + c;
#pragma unroll
            for (int k2 = 0; k2 < 4; ++k2) CST[((size_t)(item * 8 + w) * 4 + k2) * 64 + lane] = __builtin_bit_cast(u32x4, pack8(C[2 * k2], C[2 * k2 + 1]));
            if (tid < 128) NST[item * 128 + tid] = sm[SM_N + tid];
            if (tid == 0) MCg[item] = mc;
            LAS float* wS = sm + SM_W;
            const float decay = sm[SM_X];
            bf16x8 vfw[2];
#pragma unroll
            for (int ks = 0; ks < 2; ++ks) {
                LAS unsigned char* a0 = Vs + (32 * ks + 8 * g + (l15 >> 2)) * MV_STRIDE + (16 * w + 4 * (lane & 3)) * 2;
                const bf16x8 vf = cat8(vtr(a0), vtr(a0 + 4 * MV_STRIDE));
                const f32x4 w0 = *(const LAS f32x4*)(wS + 32 * ks + 8 * g), w1 = *(const LAS f32x4*)(wS + 32 * ks + 8 * g + 4);
                const u32x4 vu = __builtin_bit_cast(u32x4, vf);
                u32x4 o4; o4.x = pk2(bflo(vu.x) * w0[0], bfhi(vu.x) * w0[1]); o4.y = pk2(bflo(vu.y) * w0[2], bfhi(vu.y) * w0[3]);
                o4.z = pk2(bflo(vu.z) * w1[0], bfhi(vu.z) * w1[1]); o4.w = pk2(bflo(vu.w) * w1[2], bfhi(vu.w) * w1[3]);
                vfw[ks] = __builtin_bit_cast(bf16x8, o4);
            }
#pragma unroll
            for (int kt = 0; kt < 8; ++kt) C[kt] = C[kt] * decay;
#pragma unroll
            for (int ks = 0; ks < 2; ++ks)
#pragma unroll
                for (int kt = 0; kt < 8; ++kt) { LAS unsigned char* a0 = Ks + (32 * ks + 8 * g + (l15 >> 2)) * MQ_STRIDE + (16 * kt + 4 * (lane & 3)) * 2;
                    const bf16x8 ka = cat8(vtr(a0), vtr(a0 + 4 * MQ_STRIDE)); C[kt] = MFMA16(ka, vfw[ks], C[kt]); }
            { const int kd = tid & 127, sq = tid >> 7; float s = 0.f;
#pragma unroll
              for (int i = 0; i < 16; ++i) { const int s_ = 16 * sq + i; s += wS[s_] * __uint_as_float((unsigned)(*(const LAS bf16_t*)(Ks + s_ * MQ_STRIDE + kd * 2)) << 16); }
              sm[SM_NP + sq * 128 + kd] = s; }
            mc = sm[SM_X + 1];
            __syncthreads();
            if (tid < 128) sm[SM_N + tid] = decay * sm[SM_N + tid] + ((sm[SM_NP + tid] + sm[SM_NP + 128 + tid]) + (sm[SM_NP + 256 + tid] + sm[SM_NP + 384 + tid]));
        }
    }
#undef MS_PREFETCH
    __syncthreads();
}

__device__ __forceinline__ void mlstm_out(const Args& A, LAS unsigned char* lds, int item, int& last_h) {
    int tid_o = threadIdx.x; asm volatile("" : "+v"(tid_o)); const int tid = tid_o, lane = tid & 63, w = tid >> 6, g = lane >> 4, l15 = lane & 15;
    const int bh = item >> 5, c = item & 31, b = bh >> 2, h = bh & 3;
    const bf16_t* P = (const bf16_t*)(A.ws + WS_P);
    bf16_t* ACT = (bf16_t*)(A.ws + WS_ACT);
    const float* GATES = (const float*)(A.ws + WS_GATES);
    const u32x4* CST = (const u32x4*)(A.ws + WS_CST); const float* NST = (const float*)(A.ws + WS_NST); const float* MCg = (const float*)(A.ws + WS_MC);
    LAS float* sm = (LAS float*)(lds + ML_SM);
    LAS float* cw = (LAS float*)(lds + ML_CW);
    LAS unsigned char* Qs = lds + ML_Q; LAS unsigned char* Ks = lds + ML_K; LAS unsigned char* Vs = lds + ML_V; LAS unsigned char* Ps = lds + ML_P;
    LAS float* Hn = (LAS float*)(lds + ML_H);
    LAS float* eS = sm + SM_E; LAS float* gS = sm + SM_G; LAS float* bS = sm + SM_B; LAS float* iS = sm + SM_I; LAS float* nS = sm + SM_N;
    const size_t rowbase = (size_t)b * SEQ;
    const int rg = tid >> 5, cs = tid & 31;
    const int ccol = (cs < 16 ? 0 : 512) + h * 128 + 8 * (cs & 15);
    const int srow = tid >> 3, sseg = tid & 7;
    u32x4 cr[7], vr0, vr1, mc0, mc1, cfr[4]; float gi = 0.f, gf = 0.f, nval = 0.f;
    { const int r0 = c * 64 + 4 * rg - 3;
#pragma unroll
      for (int i = 0; i < 7; ++i) { const int r = r0 + i; const u32x4 v_ = *(const u32x4*)(P + (rowbase + (r >= 0 ? r : 0)) * NP + ccol); cr[i] = (r >= 0) ? v_ : (u32x4){0u, 0u, 0u, 0u}; }
      const bf16_t* vp = P + (rowbase + c * 64 + srow) * NP + h * 128 + sseg * 16;
      vr0 = *(const u32x4*)(vp + 1024); vr1 = *(const u32x4*)(vp + 1032); mc0 = *(const u32x4*)(vp + 1536); mc1 = *(const u32x4*)(vp + 1544);
      if (w == 0) { const float* gp = GATES + (rowbase + c * 64 + lane) * 8 + h; gi = gp[0]; gf = gp[4]; }
#pragma unroll
      for (int k2 = 0; k2 < 4; ++k2) cfr[k2] = CST[((size_t)(item * 8 + w) * 4 + k2) * 64 + lane];
      if (tid < 128) nval = NST[item * 128 + tid]; }
    const float mc = MCg[item];
    if (h != last_h) {
        for (int i = tid; i < 1280; i += 512) { const int j = i >> 8, ch = i & 255, cch = (ch < 128 ? h * 128 + ch : 512 + h * 128 + ch - 128);
            cw[i] = (j < 4) ? A.conv_w[j * 1024 + cch] : A.conv_b[cch]; }
        last_h = h;
        __syncthreads();
    }
    {
        float wt[5][8];
#pragma unroll
        for (int j = 0; j < 5; ++j) { const f32x4 a = *(const LAS f32x4*)(cw + j * 256 + 8 * cs), bb = *(const LAS f32x4*)(cw + j * 256 + 8 * cs + 4);
            wt[j][0] = a[0]; wt[j][1] = a[1]; wt[j][2] = a[2]; wt[j][3] = a[3]; wt[j][4] = bb[0]; wt[j][5] = bb[1]; wt[j][6] = bb[2]; wt[j][7] = bb[3]; }
        const float osc = (cs < 16) ? 1.0f : 0.08838834764831845f;
        LAS unsigned char* dst = (cs < 16 ? Qs : Ks) + (4 * rg) * MQ_STRIDE + 16 * (cs & 15);
#pragma unroll
        for (int r = 0; r < 4; ++r) {
            float ov[8];
#pragma unroll
            for (int e = 0; e < 8; ++e) ov[e] = wt[4][e];
#pragma unroll
            for (int j = 0; j < 4; ++j) { const u32x4 x = cr[r + j];
                ov[0] += wt[j][0] * bflo(x.x); ov[1] += wt[j][1] * bfhi(x.x); ov[2] += wt[j][2] * bflo(x.y); ov[3] += wt[j][3] * bfhi(x.y);
                ov[4] += wt[j][4] * bflo(x.z); ov[5] += wt[j][5] * bfhi(x.z); ov[6] += wt[j][6] * bflo(x.w); ov[7] += wt[j][7] * bfhi(x.w); }
#pragma unroll
            for (int e = 0; e < 8; ++e) ov[e] = osc * ov[e] * __builtin_amdgcn_rcpf(1.f + __expf(-ov[e]));
            u32x4 o4; o4.x = pk2(ov[0], ov[1]); o4.y = pk2(ov[2], ov[3]); o4.z = pk2(ov[4], ov[5]); o4.w = pk2(ov[6], ov[7]);
            *(LAS u32x4*)(dst + r * MQ_STRIDE) = o4;
        }
        LAS unsigned char* vd = Vs + srow * MV_STRIDE + sseg * 32; *(LAS u32x4*)vd = vr0; *(LAS u32x4*)(vd + 16) = vr1;
        if (tid < 128) nS[tid] = nval;
        if (w == 0) {
            float bc = gf;
#pragma unroll
            for (int o = 1; o < 64; o <<= 1) { const float t = __shfl_up(bc, o); if (lane >= o) bc += t; }
            const float e = gi - bc; float cm = e;
#pragma unroll
            for (int o = 1; o < 64; o <<= 1) { const float t = __shfl_up(cm, o); if (lane >= o) cm = fmaxf(cm, t); }
            const float gt = fmaxf(mc, cm);
            eS[lane] = e; gS[lane] = gt; bS[lane] = bc; iS[lane] = __expf(mc - gt);
        }
    }
    __syncthreads();
    {
        const int st = w >> 1;
#pragma unroll
        for (int ti = 0; ti < 2; ++ti) { const int tt = 2 * (w & 1) + ti;
            f32x4 a = (f32x4){0.f, 0.f, 0.f, 0.f};
#pragma unroll
            for (int ks = 0; ks < 4; ++ks) { const bf16x8 kf = *(const LAS bf16x8*)(Ks + (16 * st + l15) * MQ_STRIDE + (32 * ks + 8 * g) * 2);
                const bf16x8 qf = *(const LAS bf16x8*)(Qs + (16 * tt + l15) * MQ_STRIDE + (32 * ks + 8 * g) * 2); a = MFMA16(kf, qf, a); }
            const int t = 16 * tt + l15; const float gt = gS[t];
            float pv[4];
#pragma unroll
            for (int r = 0; r < 4; ++r) { const int s_ = 16 * st + 4 * g + r; pv[r] = (s_ <= t) ? a[r] * __expf(eS[s_] - gt) : 0.f; }
            u32x2 pw; pw.x = pk2(pv[0], pv[1]); pw.y = pk2(pv[2], pv[3]);
            *(LAS u32x2*)(Ps + t * MP_STRIDE + (16 * st + 4 * g) * 2) = pw;
        }
    }
    __syncthreads();
    {
        f32x4 apv[4], aqc[4];
#pragma unroll
        for (int tt = 0; tt < 4; ++tt) { apv[tt] = (f32x4){0.f, 0.f, 0.f, 0.f}; aqc[tt] = (f32x4){0.f, 0.f, 0.f, 0.f}; }
#pragma unroll
        for (int ks = 0; ks < 2; ++ks) {
            LAS unsigned char* a0 = Vs + (32 * ks + 8 * g + (l15 >> 2)) * MV_STRIDE + (16 * w + 4 * (lane & 3)) * 2;
            const bf16x8 vf = cat8(vtr(a0), vtr(a0 + 4 * MV_STRIDE));
#pragma unroll
            for (int tt = 0; tt < 4; ++tt) { const bf16x8 pf = *(const LAS bf16x8*)(Ps + (16 * tt + l15) * MP_STRIDE + (32 * ks + 8 * g) * 2); apv[tt] = MFMA16(pf, vf, apv[tt]); }
        }
#pragma unroll
        for (int k2 = 0; k2 < 4; ++k2) {
            const bf16x8 cf = __builtin_bit_cast(bf16x8, cfr[k2]);
#pragma unroll
            for (int tt = 0; tt < 4; ++tt) { LAS unsigned char* qa = Qs + (16 * tt + l15) * MQ_STRIDE + (32 * k2 + 4 * g) * 2;
                const bf16x8 qf = cat8(*(const LAS s16x4*)qa, *(const LAS s16x4*)(qa + 32)); aqc[tt] = MFMA16(qf, cf, aqc[tt]); }
        }
#pragma unroll
        for (int tt = 0; tt < 4; ++tt)
#pragma unroll
            for (int r = 0; r < 4; ++r) { const int t = 16 * tt + 4 * g + r; Hn[t * MH_STRIDE + 16 * w + l15] = apv[tt][r] + iS[t] * aqc[tt][r]; }
        { const int t = srow, j = sseg;
          const u32x4 pr = *(const LAS u32x4*)(Ps + t * MP_STRIDE + 16 * j);
          float rs = (bflo(pr.x) + bfhi(pr.x)) + (bflo(pr.y) + bfhi(pr.y)) + (bflo(pr.z) + bfhi(pr.z)) + (bflo(pr.w) + bfhi(pr.w));
          const u32x4 q0 = *(const LAS u32x4*)(Qs + t * MQ_STRIDE + 32 * j), q1 = *(const LAS u32x4*)(Qs + t * MQ_STRIDE + 32 * j + 16);
          const f32x4 n0 = *(const LAS f32x4*)(nS + 16 * j), n1 = *(const LAS f32x4*)(nS + 16 * j + 4), n2 = *(const LAS f32x4*)(nS + 16 * j + 8), n3 = *(const LAS f32x4*)(nS + 16 * j + 12);
          float qn = bflo(q0.x) * n0[0] + bfhi(q0.x) * n0[1] + bflo(q0.y) * n0[2] + bfhi(q0.y) * n0[3] + bflo(q0.z) * n1[0] + bfhi(q0.z) * n1[1] + bflo(q0.w) * n1[2] + bfhi(q0.w) * n1[3]
                   + bflo(q1.x) * n2[0] + bfhi(q1.x) * n2[1] + bflo(q1.y) * n2[2] + bfhi(q1.y) * n2[3] + bflo(q1.z) * n3[0] + bfhi(q1.z) * n3[1] + bflo(q1.w) * n3[2] + bfhi(q1.w) * n3[3];
          float d = rs + iS[t] * qn;
          d += __shfl_xor(d, 1); d += __shfl_xor(d, 2); d += __shfl_xor(d, 4);
          if (j == 0) { const float fl = __expf(-(bS[t] + gS[t])); sm[SM_R + t] = 1.f / fmaxf(fabsf(d), fl); } }
    }
    __syncthreads();
    {
        const int t = srow, j = sseg; const float rd = sm[SM_R + t];
        float hv[16]; float ss = 0.f;
#pragma unroll
        for (int q = 0; q < 4; ++q) { const f32x4 x = *(const LAS f32x4*)(Hn + t * MH_STRIDE + 16 * j + 4 * q);
#pragma unroll
            for (int e = 0; e < 4; ++e) { const float v = x[e] * rd; hv[4 * q + e] = v; ss += v * v; } }
        ss += __shfl_xor(ss, 1); ss += __shfl_xor(ss, 2); ss += __shfl_xor(ss, 4);
        const float rstd = rsqrtf(ss * (1.f / 128.f) + 1e-6f);
        const unsigned mo[8] = {mc0.x, mc0.y, mc0.z, mc0.w, mc1.x, mc1.y, mc1.z, mc1.w};
        unsigned ow[8];
#pragma unroll
        for (int q = 0; q < 8; ++q) { const float g0 = A.mnorm_g[h * 128 + 16 * j + 2 * q], g1 = A.mnorm_g[h * 128 + 16 * j + 2 * q + 1];
            const float z0 = bflo(mo[q]), z1 = bfhi(mo[q]);
            ow[q] = pk2(hv[2 * q] * rstd * g0 * __builtin_amdgcn_rcpf(1.f + __expf(-z0)), hv[2 * q + 1] * rstd * g1 * __builtin_amdgcn_rcpf(1.f + __expf(-z1))); }
        bf16_t* op = ACT + (rowbase + c * 64 + t) * 1024 + h * 128 + 16 * j;
        *(u32x4*)op = (u32x4){ow[0], ow[1], ow[2], ow[3]}; *(u32x4*)(op + 8) = (u32x4){ow[4], ow[5], ow[6], ow[7]};
    }
}

__device__ __forceinline__ void phase3(const Args& A, LAS unsigned char* lds, int rep = 0) {
    const int tid = threadIdx.x;
    const float lam = ((const float*)(A.ws + WS_CTL))[1];
    unsigned* ctr = (unsigned*)(A.ws + WS_CTL) + 2 * rep;
    LAS int* slot = (LAS int*)(lds + LDS_BYTES - 64);
    const int nml = ((int)gridDim.x > 64) ? 32 : 1;
    if ((int)blockIdx.x < nml) for (int bh = blockIdx.x; bh < 32; bh += nml) mlstm_state(A, lds, bh >> 2, bh & 3);
    for (;;) {
        if (tid == 0) slot[0] = (int)atomicAdd(ctr, 1u);
        __syncthreads();
        const int it = slot[0];
        __syncthreads();
        if (it >= 512) break;
        attn_item(A, lds, (it & 31) >> 2, it & 3, 15 - (it >> 5), lam);
    }
    {
        const int lane = tid & 63, wave = tid >> 6;
        LAS float* scr = (LAS float*)(lds + wave * 16384);
        for (int r = blockIdx.x * 8 + wave; r < 1536; r += gridDim.x * 8) {
            if (r < 512) transpose_item(A.w_out, 1024, 0, (bf16_t*)(A.ws + WS_WOUT), scr, r / 32, r % 32, lane);
            else wprime_item(A, (r - 512) >> 6, (r - 512) & 63, lane);
        }
        quantise_tables(A, blockIdx.x * 8 + wave, gridDim.x * 8, 16384, 32768);
    }
}
__device__ __forceinline__ void phase3b(const Args& A, LAS unsigned char* lds) {
    const int tid = threadIdx.x;
    {
        const int lane = tid & 63, wave = tid >> 6;
        const bf16_t* WT = (const bf16_t*)(A.ws + WS_WQ); const float* MOD = (const float*)(A.ws + WS_MOD); float* SB = (float*)(A.ws + WS_SB);
        for (int n = blockIdx.x * 8 + wave; n < 2048; n += gridDim.x * 8) {
            const u32x4 w0 = *(const u32x4*)(WT + (size_t)n * 1024 + 16 * lane), w1 = *(const u32x4*)(WT + (size_t)n * 1024 + 16 * lane + 8);
            const unsigned ww[8] = {w0.x, w0.y, w0.z, w0.w, w1.x, w1.y, w1.z, w1.w};
            float sbv[8];
#pragma unroll
            for (int b = 0; b < 8; ++b) { const float* sp = MOD + b * 6144 + 3072 + 16 * lane; float d = 0.f;
#pragma unroll
                for (int q = 0; q < 4; ++q) { const f32x4 s4 = *(const f32x4*)(sp + 4 * q); d += bflo(ww[2 * q]) * s4[0] + bfhi(ww[2 * q]) * s4[1] + bflo(ww[2 * q + 1]) * s4[2] + bfhi(ww[2 * q + 1]) * s4[3]; }
                sbv[b] = wave_sum(d); }
            if (lane == 0) {
#pragma unroll
                for (int b = 0; b < 8; ++b) SB[b * 2048 + n] = sbv[b]; }
        }
    }
    int last_h = -1;
    for (int item = blockIdx.x; item < 1024; item += gridDim.x) mlstm_out(A, lds, item, last_h);
    __syncthreads();
}

__device__ __forceinline__ void phase5(const Args& A) {
    int tid_o = threadIdx.x; asm volatile("" : "+v"(tid_o)); const int tid = tid_o, lane = tid & 63, wave = tid >> 6, G = gridDim.x;
    const float* MOD = (const float*)(A.ws + WS_MOD);
    bf16_t* ACT = (bf16_t*)(A.ws + WS_ACT);
    for (int m = blockIdx.x * 8 + wave; m < T; m += G * 8) {
        const int b = m >> 11;
        const f32x4* xr = (const f32x4*)(A.out + (size_t)m * 1024) + lane;
        f32x4 v[4]; float ss = 0.f;
#pragma unroll
        for (int j = 0; j < 4; ++j) { v[j] = xr[64 * j]; ss += (v[j][0] * v[j][0] + v[j][1] * v[j][1]) + (v[j][2] * v[j][2] + v[j][3] * v[j][3]); }
        const float rstd = rsqrtf(wave_sum(ss) * (1.f / 1024.f) + 1e-6f);
        unsigned long long* o8 = (unsigned long long*)(ACT + (size_t)m * 1024) + lane;
#pragma unroll
        for (int j = 0; j < 4; ++j) { const int col = 4 * lane + 256 * j;
            const f32x4 g = *(const f32x4*)(A.norm2_g + col), sc = *(const f32x4*)(MOD + b * 6144 + 4096 + col), sh = *(const f32x4*)(MOD + b * 6144 + 3072 + col);
            v[j] = v[j] * rstd * g * (sc + 1.0f) + sh;
            o8[64 * j] = (unsigned long long)pk2(v[j][0], v[j][1]) | ((unsigned long long)pk2(v[j][2], v[j][3]) << 32); }
    }
}

__device__ __forceinline__ unsigned f2key(float f) { const unsigned u = __float_as_uint(f); return (u & 0x80000000u) ? ~u : (u | 0x80000000u); }
__device__ __forceinline__ float key2f(unsigned k) { const unsigned u = (k & 0x80000000u) ? (k & 0x7fffffffu) : ~k; return __uint_as_float(u); }
#define CE_DESC(a, b) do { const unsigned _mx = (a) > (b) ? (a) : (b), _mn = (a) > (b) ? (b) : (a); (a) = _mx; (b) = _mn; } while (0)
__device__ __forceinline__ void sort16_desc(unsigned (&k)[16]) {
#pragma unroll
    for (int size = 2; size <= 16; size <<= 1)
#pragma unroll
        for (int stride = size >> 1; stride > 0; stride >>= 1)
#pragma unroll
            for (int i = 0; i < 16; ++i) { const int j = i ^ stride;
                if (j > i) { if ((i & size) == 0) CE_DESC(k[i], k[j]); else CE_DESC(k[j], k[i]); } }
}
__device__ __forceinline__ void merge16(unsigned (&a)[16], const unsigned (&b)[16]) {
#pragma unroll
    for (int i = 0; i < 16; ++i) a[i] = a[i] > b[15 - i] ? a[i] : b[15 - i];
#pragma unroll
    for (int stride = 8; stride > 0; stride >>= 1)
#pragma unroll
        for (int i = 0; i < 16; ++i) { const int j = i ^ stride; if (j > i) CE_DESC(a[i], a[j]); }
}
constexpr int PE_IDX = 0, PE_SEL = 69632;
__device__ __forceinline__ float gelu_erf(float v) { return 0.5f * v * (1.f + erff(v * 0.70710678118654752f)); }
__device__ __forceinline__ float gelu_fast(float v) {
    const float av = fabsf(v), tt = __builtin_amdgcn_rcpf(av * 0.2316418882f + 1.0f);
    float q = tt * 0.5307027145f + (-0.7265760135f); q = q * tt + 0.7107068705f; q = q * tt + (-0.142248368f); q = q * tt + 0.127414796f; q = q * tt;
    const float e = __builtin_amdgcn_exp2f((v * v) * (-0.72134752044f));
    const float m = v * (q * e);
    return v < 0.f ? m : v - m;
}

__device__ __forceinline__ void peer_tile(const Args& A, LAS unsigned char* lds, int tile) {
    int tid_o = threadIdx.x; asm volatile("" : "+v"(tid_o)); const int tid = tid_o, lane = tid & 63, w = tid >> 6, g = lane >> 4, l15 = lane & 15;
    const bf16_t* QRY = (const bf16_t*)(A.ws + WS_QRY);
    const bf16_t* KEYS = (const bf16_t*)(A.ws + WS_KEYS);
    const bf16_t* ACT = (const bf16_t*)(A.ws + WS_ACT);
    const float* MOD = (const float*)(A.ws + WS_MOD);
    LAS unsigned* idx = (LAS unsigned*)(lds + PE_IDX) + (w * 64 + lane) * 33;
    LAS u32x2* SEL = (LAS u32x2*)(lds + PE_SEL);
    {
        const int tg = w & 3, hg = w >> 2, tl = 16 * tg + l15;
        const size_t m = (size_t)tile * 64 + tl;
        unsigned LA[4][2][16];
#pragma unroll
        for (int hh = 0; hh < 4; ++hh) {
            const int h = 4 * hg + hh;
#pragma unroll
            for (int p = 0; p < 2; ++p) {
                const int hp = 2 * h + p;
                unsigned k0[16], k1[16];
                { const bf16_t* sp = QRY + m * 2048 + hp * 128 + 32 * g;
                  const u32x4 s0 = *(const u32x4*)sp, s1 = *(const u32x4*)(sp + 8), s2 = *(const u32x4*)(sp + 16), s3 = *(const u32x4*)(sp + 24);
                  const unsigned sw[16] = {s0.x, s0.y, s0.z, s0.w, s1.x, s1.y, s1.z, s1.w, s2.x, s2.y, s2.z, s2.w, s3.x, s3.y, s3.z, s3.w};
#pragma unroll
                  for (int i = 0; i < 16; ++i) {
                      const float lo = (float)__builtin_bit_cast(_Float16, (unsigned short)(sw[i] & 0xffffu)), hi = (float)__builtin_bit_cast(_Float16, (unsigned short)(sw[i] >> 16));
                      const unsigned klo = (f2key(lo) & ~127u) | (unsigned)(127 - (32 * g + 2 * i)), khi = (f2key(hi) & ~127u) | (unsigned)(127 - (32 * g + 2 * i + 1));
                      if (i < 8) { k0[2 * i] = klo; k0[2 * i + 1] = khi; } else { k1[2 * (i - 8)] = klo; k1[2 * (i - 8) + 1] = khi; } } }
                sort16_desc(k0); sort16_desc(k1); merge16(k0, k1);
#pragma unroll
                for (int msk = 16; msk <= 32; msk <<= 1) {
#pragma unroll
                    for (int i = 0; i < 16; ++i) k1[i] = (unsigned)__shfl_xor((int)k0[i], msk);
                    merge16(k0, k1); }
#pragma unroll
                for (int i = 0; i < 16; ++i) LA[hh][p][i] = k0[i];
            }
        }
        {
            const int h = 4 * hg + g;
            unsigned L2[2][16];
#pragma unroll
            for (int p = 0; p < 2; ++p)
#pragma unroll
                for (int i = 0; i < 16; ++i) L2[p][i] = (g & 2) ? ((g & 1) ? LA[3][p][i] : LA[2][p][i]) : ((g & 1) ? LA[1][p][i] : LA[0][p][i]);
            float va[16], vb[16];
#pragma unroll
            for (int i = 0; i < 16; ++i) { va[i] = key2f(L2[0][i] & ~127u); vb[i] = key2f(L2[1][i] & ~127u); idx[i] = 127u - (L2[0][i] & 127u); idx[16 + i] = 127u - (L2[1][i] & 127u); }
#define CK(i, j) ((f2key(va[i] + vb[j]) & ~255u) | (unsigned)(255 - (16 * (i) + (j))))
            unsigned Lf[16], Bt[16];
#pragma unroll
            for (int j = 0; j < 16; ++j) Lf[j] = CK(0, j);
#pragma unroll
            for (int j = 0; j < 8; ++j) Bt[j] = CK(1, j);
#pragma unroll
            for (int j = 0; j < 5; ++j) Bt[8 + j] = CK(2, j);
#pragma unroll
            for (int j = 0; j < 3; ++j) Bt[13 + j] = CK(4, j);
            sort16_desc(Bt); merge16(Lf, Bt);
#pragma unroll
            for (int j = 0; j < 4; ++j) Bt[j] = CK(3, j);
            Bt[4] = CK(5, 0); Bt[5] = CK(5, 1); Bt[6] = CK(6, 0); Bt[7] = CK(6, 1); Bt[8] = CK(7, 0); Bt[9] = CK(7, 1);
            Bt[10] = CK(8, 0); Bt[11] = CK(9, 0); Bt[12] = CK(10, 0); Bt[13] = CK(11, 0); Bt[14] = CK(12, 0); Bt[15] = CK(13, 0);
            sort16_desc(Bt); merge16(Lf, Bt);
            { unsigned x0 = CK(14, 0), x1 = CK(15, 0);
#pragma unroll
              for (int i = 0; i < 16; ++i) CE_DESC(Lf[i], x0);
#pragma unroll
              for (int i = 0; i < 16; ++i) CE_DESC(Lf[i], x1); }
#undef CK
            float fv[16], den = 0.f; const float f0 = key2f(Lf[0] & ~255u);
#pragma unroll
            for (int k = 0; k < 16; ++k) { fv[k] = __expf(key2f(Lf[k] & ~255u) - f0); den += fv[k]; }
            const float rden = 1.f / den;
            LDS_WAIT();
#pragma unroll
            for (int k = 0; k < 16; ++k) { const unsigned code = 255u - (Lf[k] & 255u); const unsigned e = idx[code >> 4] * 128u + idx[16 + (code & 15u)];
                u32x2 sv; sv.x = e; sv.y = __float_as_uint(fv[k] * rden); SEL[(tl * 8 + h) * 16 + k] = sv; }
        }
    }
    __syncthreads();
    const unsigned char* T8 = A.ws + WS_T8; const float* SC = (const float*)(A.ws + WS_SC);
    LAS u32x2* SORT = (LAS u32x2*)(lds + PE_IDX);
    LAS int* OFFS = (LAS int*)(lds + PE_SEL + 65536);
    for (int ti = 0; ti < 8; ++ti) {
        const int tl = 8 * w + ti;
        const u32x2 e0 = SEL[tl * 128 + lane], e1 = SEL[tl * 128 + 64 + lane];
        const int p0 = (int)(e0.x >> 10), p1 = (int)(e1.x >> 10);
        int off = 0;
        for (int p = 0; p < 16; ++p) {
            const unsigned long long m0 = __ballot(p0 == p), m1 = __ballot(p1 == p);
            const int c0 = __popcll(m0), c1 = __popcll(m1);
            const int r0 = __builtin_amdgcn_mbcnt_hi((unsigned)(m0 >> 32), __builtin_amdgcn_mbcnt_lo((unsigned)m0, 0u));
            const int r1 = __builtin_amdgcn_mbcnt_hi((unsigned)(m1 >> 32), __builtin_amdgcn_mbcnt_lo((unsigned)m1, 0u));
            if (p0 == p) SORT[tl * 128 + off + r0] = e0;
            if (p1 == p) SORT[tl * 128 + off + c0 + r1] = e1;
            if (lane == 0) OFFS[tl * 17 + p] = off;
            off += c0 + c1;
        }
        if (lane == 0) OFFS[tl * 17 + 16] = off;
    }
    LDS_WAIT(); __builtin_amdgcn_wave_barrier();
    const unsigned char* T8v = T8 + (size_t)16384 * 1024;
    const bf16_t* A3 = (const bf16_t*)(A.ws + WS_A3); const float* RSq = (const float*)(A.ws + WS_RS);
    for (int pass = 0; pass < 2; ++pass) {
        const int tb = 8 * w + 4 * pass;
        u32x4 xpa[4], xpb[4]; f32x2 oacc[4][8];
#pragma unroll
        for (int tk = 0; tk < 4; ++tk) { const size_t m = (size_t)tile * 64 + tb + tk;
            { const u32x4 ra = *(const u32x4*)(A3 + m * 1024 + 16 * lane), rb = *(const u32x4*)(A3 + m * 1024 + 16 * lane + 8);
              float xr_; { const f32x4 p0 = *(const f32x4*)(RSq + m * 16), p1 = *(const f32x4*)(RSq + m * 16 + 4), p2 = *(const f32x4*)(RSq + m * 16 + 8), p3 = *(const f32x4*)(RSq + m * 16 + 12);
                const f32x4 ps = (p0 + p1) + (p2 + p3); xr_ = rsqrtf(((ps[0] + ps[1]) + (ps[2] + ps[3])) * (1.f / 1024.f) + 1e-6f); }
              const unsigned rr[8] = {ra.x, ra.y, ra.z, ra.w, rb.x, rb.y, rb.z, rb.w}; unsigned hh[8];
              const float* sp = MOD + (int)(m >> 11) * 6144 + 3072 + 16 * lane;
#pragma unroll
              for (int q = 0; q < 8; ++q) { const f32x2 sh = *(const f32x2*)(sp + 2 * q); hh[q] = pk2(bflo(rr[q]) * xr_ + sh[0], bfhi(rr[q]) * xr_ + sh[1]); }
              xpa[tk] = (u32x4){hh[0], hh[1], hh[2], hh[3]}; xpb[tk] = (u32x4){hh[4], hh[5], hh[6], hh[7]}; }
#pragma unroll
            for (int q = 0; q < 8; ++q) oacc[tk][q] = (f32x2){0.f, 0.f}; }
        int it_p = 0, it_tk = -1, it_j = 0, it_end = 0; bool it_done = false;
#define IT_ADVANCE() do { it_j += 4; while (it_j >= it_end) { if (it_done) break; ++it_tk; if (it_tk == 4) { it_tk = 0; ++it_p; if (it_p == 16) { it_done = true; it_p = 15; it_j = 0; it_end = 1; break; } } \
            it_j = __builtin_amdgcn_readfirstlane(OFFS[(tb + it_tk) * 17 + it_p]); it_end = __builtin_amdgcn_readfirstlane(OFFS[(tb + it_tk) * 17 + it_p + 1]); } } while (0)
#define LOAD_SET(U, V, CG, SU, SV) do { const int _tl = tb + it_tk; \
            _Pragma("unroll") for (int _k = 0; _k < 4; ++_k) { const int _jj = (it_j + _k < it_end) ? it_j + _k : it_end - 1; const unsigned _e = SORT[_tl * 128 + _jj].x; \
                U[_k] = *(const u32x4*)(T8 + (size_t)_e * 1024 + 16 * lane); V[_k] = *(const u32x4*)(T8v + (size_t)_e * 1024 + 16 * lane); } \
            const int _ms = lane >> 4; const bool _valid = it_j + _ms < it_end; const u32x2 _se = SORT[_tl * 128 + (_valid ? it_j + _ms : it_end - 1)]; \
            CG = _valid ? __uint_as_float(_se.y) : 0.f; SU = SC[_se.x]; SV = SC[16384 + _se.x]; } while (0)
        u32x4 uA[4], vA[4], uB[4], vB[4]; float cgA = 0.f, suA = 0.f, svA = 0.f, cgB = 0.f, suB = 0.f, svB = 0.f;
#pragma unroll
        for (int k = 0; k < 4; ++k) { uA[k] = (u32x4){0u, 0u, 0u, 0u}; vA[k] = uA[k]; uB[k] = uA[k]; vB[k] = uA[k]; }
        IT_ADVANCE();
        LOAD_SET(uA, vA, cgA, suA, svA);
        for (int p = 0; p < 16; ++p) {
#pragma unroll
            for (int tk = 0; tk < 4; ++tk) {
                const int tl = tb + tk;
                const int beg = __builtin_amdgcn_readfirstlane(OFFS[tl * 17 + p]), end = __builtin_amdgcn_readfirstlane(OFFS[tl * 17 + p + 1]);
                f32x2 xf[8];
                { const unsigned xx[8] = {xpa[tk].x, xpa[tk].y, xpa[tk].z, xpa[tk].w, xpb[tk].x, xpb[tk].y, xpb[tk].z, xpb[tk].w};
#pragma unroll
                  for (int q = 0; q < 8; ++q) xf[q] = (f32x2){bflo(xx[q]), bfhi(xx[q])}; }
#define COMPUTE_SET(U, V, CG, SU, SV) do { float pd[4]; \
                    _Pragma("unroll") for (int k = 0; k < 4; ++k) { f32x2 d = (f32x2){0.f, 0.f}; \
                        _Pragma("unroll") for (int q = 0; q < 4; ++q) { const int dw = (int)U[k][q]; \
                            d += __builtin_amdgcn_cvt_pk_f32_fp8(dw, false) * xf[2 * q]; d += __builtin_amdgcn_cvt_pk_f32_fp8(dw, true) * xf[2 * q + 1]; } \
                        pd[k] = d[0] + d[1]; } \
                    float s; \
                    { const auto r0 = __builtin_amdgcn_permlane32_swap(__float_as_uint(pd[0]), __float_as_uint(pd[2]), false, false); \
                      const auto r1 = __builtin_amdgcn_permlane32_swap(__float_as_uint(pd[1]), __float_as_uint(pd[3]), false, false); \
                      const float a0 = __uint_as_float(r0[0]) + __uint_as_float(r0[1]), a1 = __uint_as_float(r1[0]) + __uint_as_float(r1[1]); \
                      const auto r2 = __builtin_amdgcn_permlane16_swap(__float_as_uint(a0), __float_as_uint(a1), false, false); \
                      s = __uint_as_float(r2[0]) + __uint_as_float(r2[1]); \
                      s += __int_as_float(__builtin_amdgcn_mov_dpp(__float_as_int(s), 0xB1, 0xF, 0xF, true)); \
                      s += __int_as_float(__builtin_amdgcn_mov_dpp(__float_as_int(s), 0x4E, 0xF, 0xF, true)); \
                      s += __int_as_float(__builtin_amdgcn_mov_dpp(__float_as_int(s), 0x141, 0xF, 0xF, true)); \
                      s += __int_as_float(__builtin_amdgcn_mov_dpp(__float_as_int(s), 0x140, 0xF, 0xF, true)); } \
                    const float coef = CG * gelu_fast(s * SU) * SV; \
                    _Pragma("unroll") for (int k = 0; k < 4; ++k) { const float ck = __int_as_float(__builtin_amdgcn_readlane(__float_as_int(coef), 16 * k)); const f32x2 ck2 = (f32x2){ck, ck}; \
                        _Pragma("unroll") for (int qq = 0; qq < 4; ++qq) { const int dw = (int)V[k][qq]; \
                            oacc[tk][2 * qq] += ck2 * __builtin_amdgcn_cvt_pk_f32_fp8(dw, false); oacc[tk][2 * qq + 1] += ck2 * __builtin_amdgcn_cvt_pk_f32_fp8(dw, true); } } } while (0)
                for (int j0 = beg; j0 < end; j0 += 8) {
                    IT_ADVANCE();
                    LOAD_SET(uB, vB, cgB, suB, svB);
                    COMPUTE_SET(uA, vA, cgA, suA, svA);
                    if (j0 + 4 < end) {
                        IT_ADVANCE();
                        LOAD_SET(uA, vA, cgA, suA, svA);
                        COMPUTE_SET(uB, vB, cgB, suB, svB);
                    } else {
#pragma unroll
                        for (int k = 0; k < 4; ++k) { uA[k] = uB[k]; vA[k] = vB[k]; }
                        cgA = cgB; suA = suB; svA = svB;
                    }
                }
            }
        }
#undef COMPUTE_SET
#undef IT_ADVANCE
#undef LOAD_SET
#pragma unroll
        for (int tk = 0; tk < 4; ++tk) {
            const size_t m = (size_t)tile * 64 + tb + tk; const int b = (int)(m >> 11);
            float* orow = A.out + m * 1024 + 16 * lane;
            const float* g2 = MOD + b * 6144 + 5120 + 16 * lane;
            f32x4 xv[4]; float ss = 0.f;
#pragma unroll
            for (int j = 0; j < 4; ++j) { const f32x4 x1 = *(const f32x4*)(orow + 4 * j), gg = *(const f32x4*)(g2 + 4 * j);
                const f32x4 pe = (f32x4){oacc[tk][2 * j][0], oacc[tk][2 * j][1], oacc[tk][2 * j + 1][0], oacc[tk][2 * j + 1][1]};
                xv[j] = x1 + gg * pe; ss += (xv[j][0] * xv[j][0] + xv[j][1] * xv[j][1]) + (xv[j][2] * xv[j][2] + xv[j][3] * xv[j][3]); }
            const float rstd = rsqrtf(wave_sum(ss) * (1.f / 1024.f) + 1e-6f);
#pragma unroll
            for (int j = 0; j < 4; ++j) { const f32x4 fg = *(const f32x4*)(A.final_g + 16 * lane + 4 * j); *(f32x4*)(orow + 4 * j) = xv[j] * rstd * fg; }
        }
    }
    __syncthreads();
}


#define XB_TMO      128
#define XB_XCNT(j)  (256  + 64 * (j))
#define XB_XSUB(j)  (1280 + 64 * (j))
#define XB_XGEN(j)  (2304 + 64 * (j))
#define XB_TOP      3328
#define XB_TOPGEN   3392
#define XCD_BAR_WORDS 3456
#define XB_SPIN_CAP (1u << 18)

__device__ __forceinline__ unsigned xb_ld(unsigned* p)              { return __hip_atomic_load(p, __ATOMIC_RELAXED, __HIP_MEMORY_SCOPE_AGENT); }
__device__ __forceinline__ unsigned xb_add(unsigned* p, unsigned v) { return __hip_atomic_fetch_add(p, v, __ATOMIC_RELAXED, __HIP_MEMORY_SCOPE_AGENT); }
__device__ __forceinline__ unsigned xb_xcc_id() { return (unsigned)__builtin_amdgcn_s_getreg((3 << 11) | 20) & 0xFu; }
#define XB_SPIN(cond, bar) do { unsigned _sp = 0; while (cond) { __builtin_amdgcn_s_sleep(1); \
    if ((++_sp & 255u) == 0u) { if (xb_ld(&(bar)[XB_TMO])) break; if (_sp > XB_SPIN_CAP) { atomicAdd(&(bar)[XB_TMO], 1u); break; } } } } while (0)

struct XcdBarrier {
    unsigned* bar; unsigned x;
    volatile LAS unsigned* st;
};

__device__ __forceinline__ XcdBarrier xcd_barrier_post(unsigned* bar, volatile LAS unsigned* st) {
    XcdBarrier b; b.bar = bar; b.x = xb_xcc_id(); b.st = st;
    if (threadIdx.x == 0) (void)xb_add(&bar[XB_XCNT(b.x)], 1u);
    return b;
}
__device__ __forceinline__ void xcd_barrier_complete(unsigned* bar, unsigned x, unsigned& nloc, unsigned& nx) {
    const unsigned G = gridDim.x * gridDim.y * gridDim.z;
    unsigned sum, cnt, mine, sp = 0u;
    for (;;) {
        sum = 0u; cnt = 0u; mine = 0u;
#pragma unroll
        for (unsigned j = 0; j < 16; ++j) { const unsigned c = xb_ld(&bar[XB_XCNT(j)]); sum += c; cnt += (c > 0u) ? 1u : 0u; mine = (j == x) ? c : mine; }
        if (sum == G) break;
        __builtin_amdgcn_s_sleep(1);
        if ((++sp & 255u) == 0u) { if (xb_ld(&bar[XB_TMO])) break; if (sp > XB_SPIN_CAP) { atomicAdd(&bar[XB_TMO], 1u); break; } }
    }
    nloc = mine > 0u ? mine : 1u; nx = cnt > 0u ? cnt : 1u;
}

__device__ __forceinline__ void xcd_barrier(const XcdBarrier& b) {
    asm volatile("s_waitcnt vmcnt(0)" ::: "memory");
    __syncthreads();
    if (threadIdx.x == 0) {
        unsigned* bar = b.bar;
        __builtin_amdgcn_s_waitcnt(0);
        unsigned nloc = b.st[0], nx = b.st[1];
        if (nloc == 0u) { xcd_barrier_complete(bar, b.x, nloc, nx); b.st[0] = nloc; b.st[1] = nx; }
        const unsigned old = xb_add(&bar[XB_XSUB(b.x)], 1u);
        const unsigned gen = old / nloc;
        if (old + 1u == (gen + 1u) * nloc) {
            __builtin_amdgcn_fence(__ATOMIC_RELEASE, "agent");
            asm volatile("s_waitcnt vmcnt(0)" ::: "memory");
            const unsigned og = xb_add(&bar[XB_TOP], 1u);
            const unsigned tg = og / nx;
            if (og + 1u == (tg + 1u) * nx) xb_add(&bar[XB_TOPGEN], 1u);
            else XB_SPIN(xb_ld(&bar[XB_TOPGEN]) == tg, bar);
            __builtin_amdgcn_fence(__ATOMIC_ACQUIRE, "agent");
            xb_add(&bar[XB_XGEN(b.x)], 1u);
            asm volatile("s_waitcnt vmcnt(0)" ::: "memory");
        } else {
            XB_SPIN(xb_ld(&bar[XB_XGEN(b.x)]) == gen, bar);
            __builtin_amdgcn_fence(__ATOMIC_ACQUIRE, "agent");
            asm volatile("s_waitcnt vmcnt(0)" ::: "memory");
        }
    }
    __syncthreads();
}

__global__ void __launch_bounds__(512, 2) mega_fwd(Args A) {
    extern __shared__ __attribute__((aligned(16))) unsigned char lds_raw[];
    LAS unsigned char* lds = (LAS unsigned char*)lds_raw;
    cg::grid_group grid = cg::this_grid();
    const int G = gridDim.x;
    if (threadIdx.x < 4) ((LAS unsigned*)(lds + LDS_BYTES - 32))[threadIdx.x] = 0u;
    __syncthreads();
    if (A.ws == nullptr) grid.sync();
    const XcdBarrier xb = xcd_barrier_post((unsigned*)(A.ws + WS_BAR), (volatile LAS unsigned*)(lds + LDS_BYTES - 32));
    phase0(A, lds);
    xcd_barrier(xb);
    phase1(A, lds);
    phase0b(A, lds);
    xcd_barrier(xb);
    { pg8::Gemm gm{(const pg8::bf16_t*)(A.ws + WS_ACT), (const pg8::bf16_t*)(A.ws + WS_WIN), T, NP, DM}; pg8::StaticOrder S; S.init(T, NP, G, (int)blockIdx.x);
      pg8::EpiStoreBf16 E{(pg8::bf16_t*)(A.ws + WS_P), NP};
      pg8::gemm_phase<pg8::EpiStoreBf16, pg8::StaticOrder, true, true>((PG8_LAS unsigned char*)lds, gm, S, E); }
    { const int nshort = G - (896 % G == 0 ? 0 : 896 % G);
      const int first = G - nshort;
      if ((int)blockIdx.x >= first) quantise_tables(A, ((int)blockIdx.x - first) * 8 + (int)(threadIdx.x >> 6), nshort * 8, 0, 16384); }
    xcd_barrier(xb);
    phase3(A, lds);
    xcd_barrier(xb);
    phase3b(A, lds);
    xcd_barrier(xb);
    { pg8::Gemm gm{(const pg8::bf16_t*)(A.ws + WS_ACT), (const pg8::bf16_t*)(A.ws + WS_WOUT), T, DM, DM}; pg8::StaticOrder S; S.init(T, DM, G, (int)blockIdx.x);
      pg8::EpiResidNorm E{A.x, (const float*)(A.ws + WS_MOD), A.norm2_g, A.out, (pg8::bf16_t*)(A.ws + WS_A3), (float*)(A.ws + WS_RS)};
      pg8::gemm_phase<pg8::EpiResidNorm, pg8::StaticOrder, true, true>((PG8_LAS unsigned char*)lds, gm, S, E); }
    xcd_barrier(xb);
    { pg8::Gemm gm{(const pg8::bf16_t*)(A.ws + WS_A3), (const pg8::bf16_t*)(A.ws + WS_WQ), T, 2048, DM}; pg8::StaticOrder S; S.init(T, 2048, G, (int)blockIdx.x);
      pg8::EpiScoreF16 E{(pg8::bf16_t*)(A.ws + WS_QRY), 2048, (const float*)(A.ws + WS_RS), (const float*)(A.ws + WS_SB)};
      pg8::gemm_phase<pg8::EpiScoreF16, pg8::StaticOrder, true, true>((PG8_LAS unsigned char*)lds, gm, S, E); }
    xcd_barrier(xb);
    for (int tile = blockIdx.x; tile < T / 64; tile += G) peer_tile(A, lds, tile);
}

extern "C" void kernel_launch(void* const* d_in, const int* in_sizes, int n_in, void* d_out, int out_size, void* d_ws, size_t ws_size, hipStream_t stream) {
    static int grid = 0;
    if (grid == 0) {
        if (n_in != 22 || out_size != T * DM || ws_size < WS_END) { fprintf(stderr, "kernel_launch: unexpected shapes (n_in %d out %d ws %zu)\n", n_in, out_size, ws_size); grid = -1; return; }
        int dev = 0, cus = 0, per_cu = 0;
        if (hipGetDevice(&dev) != hipSuccess || hipDeviceGetAttribute(&cus, hipDeviceAttributeMultiprocessorCount, dev) != hipSuccess) { grid = -1; return; }
        if (hipFuncSetAttribute((const void*)mega_fwd, hipFuncAttributeMaxDynamicSharedMemorySize, LDS_BYTES) != hipSuccess) { fprintf(stderr, "kernel_launch: hipFuncSetAttribute failed\n"); grid = -1; return; }
        if (hipOccupancyMaxActiveBlocksPerMultiprocessor(&per_cu, (const void*)mega_fwd, 512, LDS_BYTES) != hipSuccess || per_cu < 1) { fprintf(stderr, "kernel_launch: occupancy query gave %d\n", per_cu); per_cu = 1; }
        (void)hipGetLastError();
        grid = cus * per_cu;
    }
    if (grid < 0) return;
    Args a{};
    const float** ap = (const float**)&a;
    for (int i = 0; i < 22; ++i) ap[i] = (const float*)d_in[i];
    a.out = (float*)d_out; a.ws = (unsigned char*)d_ws;
    if (hipMemsetAsync((unsigned char*)d_ws + WS_BAR, 0, XCD_BAR_WORDS * sizeof(unsigned), stream) != hipSuccess) { fprintf(stderr, "kernel_launch: memset of the barrier words failed\n"); return; }
    void* args[] = {&a};
    hipError_t e = hipLaunchCooperativeKernel((const void*)mega_fwd, dim3(grid), dim3(512), args, LDS_BYTES, stream);
    if (e != hipSuccess) fprintf(stderr, "kernel_launch: cooperative launch failed: %s (grid %d)\n", hipGetErrorString(e), grid);
}
```

```cpp
#include <hip/hip_runtime.h>
#include <hip/hip_cooperative_groups.h>
#include <cstdio>
#include <cstdint>
namespace cg = cooperative_groups;

namespace pg8 {
#define PG8_LAS __attribute__((address_space(3)))
typedef unsigned short bf16_t;
typedef short bf16x8 __attribute__((ext_vector_type(8)));
typedef float f32x4 __attribute__((ext_vector_type(4)));
typedef unsigned u32x4 __attribute__((ext_vector_type(4)));
constexpr int BM = 256, BK = 64, HALF = 128, HTB = HALF * BK * 2  , STAGE_BYTES = 8 * HTB, NXCD = 8, WGM = 8;

__host__ __device__ __forceinline__ int lds_byte(int r, int c) { const int st = (r >> 4) * 2 + (c >> 5), rr = r & 15, cc = c & 31, ob = rr * 64 + cc * 2; return st * 1024 + (ob ^ (((ob >> 9) & 1) << 5)); }
__host__ __device__ __forceinline__ void stage_rc(int b, int& R, int& C) { const int st = b / 1024, sb = b % 1024, swz = sb ^ (((sb >> 9) & 1) << 5); R = (st >> 1) * 16 + swz / 64; C = (st & 1) * 32 + (swz % 64) / 2; }
__host__ __device__ __forceinline__ int perm32(int rho) { const int n = rho >> 4, i = rho & 15; return 8 * (i >> 2) + 4 * n + (i & 3); }

struct Unit { int pm, pn; };
struct Gemm { const bf16_t* A; const bf16_t* Bt; int M, N, K; };

struct StaticOrder {
    int nM, nN, nwg, G, c;
    __host__ __device__ void init(int M, int N, int G_, int c_) { nM = M / BM; nN = N / BM; nwg = nM * nN; G = G_; c = c_; }
    __host__ __device__ bool next(int i, Unit& u) const {
        const long L = (long)i * G + c; if (L >= nwg) return false;
        int wgid = (int)L; { const int q = nwg / NXCD, r = nwg % NXCD, xcd = wgid % NXCD, off = wgid / NXCD; wgid = (xcd < r ? xcd * (q + 1) : r * (q + 1) + (xcd - r) * q) + off; }
        const int nig = WGM * nN, gid = wgid / nig, fm = gid * WGM, gsz = (nM - fm) < WGM ? (nM - fm) : WGM;
        u.pm = fm + ((wgid % nig) % gsz); u.pn = (wgid % nig) / gsz; return true;
    }
    __device__ __forceinline__ void a_ready(const Unit&) const {}
    __device__ __forceinline__ void done(const Unit&) const {}
};

__device__ __forceinline__ unsigned cvt_pk_bf16(float lo, float hi) { unsigned r; asm volatile("v_cvt_pk_bf16_f32 %0, %1, %2" : "=v"(r) : "v"(lo), "v"(hi)); return r; }

struct EpiStoreBf16 {
    static constexpr bool PERM = true, AFTER_DRAIN = false;
    bf16_t* O; int ldc;
    __device__ __forceinline__ void operator()(const f32x4 (&acc)[2][2][4][2], const Unit& u, int wr, int wc, int fr, int fq) const {
        const int row0 = u.pm * BM + wr * 64 + fr, col0 = u.pn * BM + wc * 32 + 8 * fq;
#pragma unroll
        for (int ai = 0; ai < 2; ++ai)
#pragma unroll
            for (int m = 0; m < 4; ++m) { bf16_t* rowp = O + (size_t)(row0 + ai * HALF + m * 16) * ldc + col0;
#pragma unroll
                for (int bj = 0; bj < 2; ++bj) { const f32x4 v0 = acc[ai][bj][m][0], v1 = acc[ai][bj][m][1];
                    u32x4 w; w.x = cvt_pk_bf16(v0[0], v0[1]); w.y = cvt_pk_bf16(v0[2], v0[3]); w.z = cvt_pk_bf16(v1[0], v1[1]); w.w = cvt_pk_bf16(v1[2], v1[3]);
                    *(u32x4*)(rowp + bj * HALF) = w; } }
    }
};
struct EpiStoreF16 {
    static constexpr bool PERM = true, AFTER_DRAIN = false;
    bf16_t* O; int ldc;
    static __device__ __forceinline__ unsigned pkh(float a, float b) { return (unsigned)__builtin_bit_cast(unsigned short, (_Float16)a) | ((unsigned)__builtin_bit_cast(unsigned short, (_Float16)b) << 16); }
    __device__ __forceinline__ void operator()(const f32x4 (&acc)[2][2][4][2], const Unit& u, int wr, int wc, int fr, int fq) const {
        const int row0 = u.pm * BM + wr * 64 + fr, col0 = u.pn * BM + wc * 32 + 8 * fq;
#pragma unroll
        for (int ai = 0; ai < 2; ++ai)
#pragma unroll
            for (int m = 0; m < 4; ++m) { bf16_t* rowp = O + (size_t)(row0 + ai * HALF + m * 16) * ldc + col0;
#pragma unroll
                for (int bj = 0; bj < 2; ++bj) { const f32x4 v0 = acc[ai][bj][m][0], v1 = acc[ai][bj][m][1];
                    u32x4 w; w.x = pkh(v0[0], v0[1]); w.y = pkh(v0[2], v0[3]); w.z = pkh(v1[0], v1[1]); w.w = pkh(v1[2], v1[3]);
                    *(u32x4*)(rowp + bj * HALF) = w; } }
    }
};
struct EpiResid {
    static constexpr bool PERM = true, AFTER_DRAIN = false;
    const float* x; const float* gate; float* out;
    __device__ __forceinline__ void operator()(const f32x4 (&acc)[2][2][4][2], const Unit& u, int wr, int wc, int fr, int fq) const {
        const int row0 = u.pm * BM + wr * 64 + fr, col0 = u.pn * BM + wc * 32 + 8 * fq;
#pragma unroll
        for (int ai = 0; ai < 2; ++ai)
#pragma unroll
            for (int m = 0; m < 4; ++m) { const int r = row0 + ai * HALF + m * 16; const float* gp = gate + (size_t)(r >> 11) * 6144;
#pragma unroll
                for (int bj = 0; bj < 2; ++bj) { const int c = col0 + bj * HALF;
                    const f32x4 xa = *(const f32x4*)(x + (size_t)r * 1024 + c), xb = *(const f32x4*)(x + (size_t)r * 1024 + c + 4);
                    const f32x4 ga = *(const f32x4*)(gp + c), gb = *(const f32x4*)(gp + c + 4);
                    *(f32x4*)(out + (size_t)r * 1024 + c) = xa + ga * acc[ai][bj][m][0];
                    *(f32x4*)(out + (size_t)r * 1024 + c + 4) = xb + gb * acc[ai][bj][m][1]; } }
    }
};
struct EpiResidNorm {
    static constexpr bool PERM = true, AFTER_DRAIN = false;
    const float* x; const float* mod; const float* ng; float* out; bf16_t* a3; float* rs;
    __device__ __forceinline__ void operator()(const f32x4 (&acc)[2][2][4][2], const Unit& u, int wr, int wc, int fr, int fq) const {
        const int row0 = u.pm * BM + wr * 64 + fr, col0 = u.pn * BM + wc * 32 + 8 * fq;
        const float* mp = mod + (size_t)((u.pm * BM) >> 11) * 6144;
        f32x4 g1v[2][2], csv[2][2];
#pragma unroll
        for (int bj = 0; bj < 2; ++bj)
#pragma unroll
            for (int n = 0; n < 2; ++n) { const int c = col0 + bj * HALF + 4 * n; g1v[bj][n] = *(const f32x4*)(mp + 2048 + c); csv[bj][n] = *(const f32x4*)(ng + c) * (*(const f32x4*)(mp + 4096 + c) + 1.0f); }
#pragma unroll
        for (int ai = 0; ai < 2; ++ai)
#pragma unroll
            for (int m = 0; m < 4; ++m) { const int r = row0 + ai * HALF + m * 16; float ss = 0.f;
#pragma unroll
                for (int bj = 0; bj < 2; ++bj) { const int c = col0 + bj * HALF;
                    const f32x4 xa = *(const f32x4*)(x + (size_t)r * 1024 + c), xb = *(const f32x4*)(x + (size_t)r * 1024 + c + 4);
                    const f32x4 v0 = xa + g1v[bj][0] * acc[ai][bj][m][0], v1 = xb + g1v[bj][1] * acc[ai][bj][m][1];
                    *(f32x4*)(out + (size_t)r * 1024 + c) = v0; *(f32x4*)(out + (size_t)r * 1024 + c + 4) = v1;
                    ss += (v0[0] * v0[0] + v0[1] * v0[1]) + (v0[2] * v0[2] + v0[3] * v0[3]) + (v1[0] * v1[0] + v1[1] * v1[1]) + (v1[2] * v1[2] + v1[3] * v1[3]);
                    const f32x4 a0 = v0 * csv[bj][0], a1 = v1 * csv[bj][1];
                    u32x4 w; w.x = cvt_pk_bf16(a0[0], a0[1]); w.y = cvt_pk_bf16(a0[2], a0[3]); w.z = cvt_pk_bf16(a1[0], a1[1]); w.w = cvt_pk_bf16(a1[2], a1[3]);
                    *(u32x4*)(a3 + (size_t)r * 1024 + c) = w; }
                ss += __shfl_xor(ss, 16); ss += __shfl_xor(ss, 32);
                if (fq == 0) rs[(size_t)r * 16 + (u.pn & 3) * 4 + wc] = ss; }
    }
};
struct EpiScoreF16 {
    static constexpr bool PERM = true, AFTER_DRAIN = false;
    bf16_t* O; int ldc; const float* rs; const float* sb;
    static __device__ __forceinline__ unsigned pkh(float a, float b) { return (unsigned)__builtin_bit_cast(unsigned short, (_Float16)a) | ((unsigned)__builtin_bit_cast(unsigned short, (_Float16)b) << 16); }
    __device__ __forceinline__ void operator()(const f32x4 (&acc)[2][2][4][2], const Unit& u, int wr, int wc, int fr, int fq) const {
        const int row0 = u.pm * BM + wr * 64 + fr, col0 = u.pn * BM + wc * 32 + 8 * fq;
        const float* sbp = sb + (size_t)((u.pm * BM) >> 11) * 2048;
        f32x4 bv[2][2];
#pragma unroll
        for (int bj = 0; bj < 2; ++bj)
#pragma unroll
            for (int n = 0; n < 2; ++n) bv[bj][n] = *(const f32x4*)(sbp + col0 + bj * HALF + 4 * n);
#pragma unroll
        for (int ai = 0; ai < 2; ++ai)
#pragma unroll
            for (int m = 0; m < 4; ++m) { const int r = row0 + ai * HALF + m * 16;
                float rstd; { const f32x4 p0 = *(const f32x4*)(rs + (size_t)r * 16), p1 = *(const f32x4*)(rs + (size_t)r * 16 + 4), p2 = *(const f32x4*)(rs + (size_t)r * 16 + 8), p3 = *(const f32x4*)(rs + (size_t)r * 16 + 12);
                  const f32x4 ps = (p0 + p1) + (p2 + p3); rstd = rsqrtf(((ps[0] + ps[1]) + (ps[2] + ps[3])) * (1.f / 1024.f) + 1e-6f); }
                bf16_t* rowp = O + (size_t)r * ldc + col0;
#pragma unroll
                for (int bj = 0; bj < 2; ++bj) { const f32x4 v0 = acc[ai][bj][m][0] * rstd + bv[bj][0], v1 = acc[ai][bj][m][1] * rstd + bv[bj][1];
                    u32x4 w; w.x = pkh(v0[0], v0[1]); w.y = pkh(v0[2], v0[3]); w.z = pkh(v1[0], v1[1]); w.w = pkh(v1[2], v1[3]);
                    *(u32x4*)(rowp + bj * HALF) = w; } }
    }
};
template <class Epi, class Sched, bool ALIGN_EPI = false, bool SP2 = false>
__device__ __forceinline__ void gemm_phase(PG8_LAS unsigned char* lds, const Gemm g, const Sched& S, const Epi& E) {
    int tid_o = threadIdx.x; asm volatile("" : "+v"(tid_o)); const int tid = tid_o, wid = __builtin_amdgcn_readfirstlane(tid >> 6), lane = tid & 63, wr = wid >> 2, wc = wid & 3, fr = lane & 15, fq = lane >> 4;
    const int K = g.K, nt = K / BK;
    unsigned voffA[2], voffB[2];
#pragma unroll
    for (int i = 0; i < 2; ++i) { int R, C; stage_rc(tid * 16 + i * 8192, R, C); const int Rb = Epi::PERM ? ((R & ~31) + perm32(R & 31)) : R;
        voffA[i] = (unsigned)(R * K + C) * 2u; voffB[i] = (unsigned)(Rb * K + C) * 2u; }
    const size_t kstep = (size_t)(BK * 2);
    const size_t hstep = (size_t)HALF * K * 2;
    const size_t tstep = 2 * hstep;
    const unsigned ldsw = (unsigned)wid * 1024u;
    const int aoff = lds_byte(wr * 64 + fr, fq * 8), boff = lds_byte(wc * 32 + fr, fq * 8);
#define PG8_SA(b, h) (((b) * 2 + (h)) * HTB)
#define PG8_SB(b, h) ((4 + (b) * 2 + (h)) * HTB)
#define PG8_STAGE(bufoff, gbase, voff) do { _Pragma("unroll") for (int _i = 0; _i < 2; ++_i) \
        __builtin_amdgcn_global_load_lds((const unsigned*)((const char*)(gbase) + (voff)[_i]), (PG8_LAS unsigned*)(lds + (bufoff) + ldsw + _i * 8192), 16, 0, 0); } while (0)
#define PG8_LDA(dst, b, h) do { _Pragma("unroll") for (int m = 0; m < 4; ++m) _Pragma("unroll") for (int k = 0; k < 2; ++k) dst[m][k] = *(const PG8_LAS bf16x8*)(lds + PG8_SA(b, h) + aoff + m * 2048 + k * 1024); } while (0)
#define PG8_LDB(dst, b, h) do { _Pragma("unroll") for (int n = 0; n < 2; ++n) _Pragma("unroll") for (int k = 0; k < 2; ++k) dst[n][k] = *(const PG8_LAS bf16x8*)(lds + PG8_SB(b, h) + boff + n * 2048 + k * 1024); } while (0)
#define PG8_MMA(ai, bj, At, Bt) do { __builtin_amdgcn_s_setprio(1); _Pragma("unroll") for (int m = 0; m < 4; ++m) _Pragma("unroll") for (int n = 0; n < 2; ++n) _Pragma("unroll") for (int k = 0; k < 2; ++k) \
        acc[ai][bj][m][n] = __builtin_amdgcn_mfma_f32_16x16x32_bf16(Bt[n][k], At[m][k], acc[ai][bj][m][n], 0, 0, 0); __builtin_amdgcn_s_setprio(0); } while (0)
#define PG8_WAIT_V(n) asm volatile("s_waitcnt vmcnt(" #n ")" ::: "memory")
#define PG8_WAIT_L(n) asm volatile("s_waitcnt lgkmcnt(" #n ")" ::: "memory")
#define PG8_BAR __builtin_amdgcn_s_barrier()
#define PG8_SCHED __builtin_amdgcn_sched_barrier(0)
    Unit cur, nxt; int ui = 0;
    if (!S.next(0, cur)) return;
    f32x4 acc[2][2][4][2];
#pragma unroll
    for (int a = 0; a < 2; ++a)
#pragma unroll
        for (int b = 0; b < 2; ++b)
#pragma unroll
            for (int m = 0; m < 4; ++m)
#pragma unroll
                for (int n = 0; n < 2; ++n) acc[a][b][m][n] = (f32x4){0.f, 0.f, 0.f, 0.f};
    bf16x8 At[4][2], B0[2][2], B1[2][2];
    const char* cA = (const char*)g.A + (size_t)cur.pm * tstep; const char* cB = (const char*)g.Bt + (size_t)cur.pn * tstep;
    S.a_ready(cur);
    if constexpr (SP2) {
        PG8_STAGE(PG8_SB(0, 0), cB, voffB); PG8_STAGE(PG8_SB(0, 1), cB + hstep, voffB); PG8_STAGE(PG8_SA(0, 0), cA, voffA); PG8_STAGE(PG8_SA(0, 1), cA + hstep, voffA);
        if (wr == 1) PG8_BAR;
        PG8_WAIT_V(2); PG8_BAR;
        PG8_STAGE(PG8_SB(1, 0), cB + kstep, voffB); PG8_STAGE(PG8_SA(1, 0), cA + kstep, voffA); PG8_STAGE(PG8_SB(1, 1), cB + hstep + kstep, voffB);
        PG8_WAIT_V(6); PG8_BAR;
    } else {
        PG8_STAGE(PG8_SB(0, 0), cB, voffB); PG8_STAGE(PG8_SA(0, 0), cA, voffA); PG8_STAGE(PG8_SB(0, 1), cB + hstep, voffB); PG8_STAGE(PG8_SA(0, 1), cA + hstep, voffA);
        if (wr == 1) PG8_BAR;
        PG8_WAIT_V(4); PG8_BAR;
        PG8_STAGE(PG8_SB(1, 0), cB + kstep, voffB); PG8_STAGE(PG8_SA(1, 0), cA + kstep, voffA); PG8_STAGE(PG8_SB(1, 1), cB + hstep + kstep, voffB);
        PG8_WAIT_V(6); PG8_BAR;
    }
    for (;;) {
        const bool has_next = S.next(ui + 1, nxt);
        const char* nA = has_next ? (const char*)g.A + (size_t)nxt.pm * tstep : cA; const char* nB = has_next ? (const char*)g.Bt + (size_t)nxt.pn * tstep : cB;
        for (int t = 0; t < nt; t += 2) {
            const bool last = (t == nt - 2);
            const char* a1 = cA + (size_t)(t + 1) * kstep;
            const char* a2 = last ? nA : cA + (size_t)(t + 2) * kstep; const char* b2 = last ? nB : cB + (size_t)(t + 2) * kstep;
            const char* a3 = a2 + kstep; const char* b3 = b2 + kstep;
            if (last && has_next) S.a_ready(nxt);
            if constexpr (SP2) {
            PG8_LDB(B0, 0, 0); PG8_LDB(B1, 0, 1); PG8_SCHED; PG8_LDA(At, 0, 0); PG8_STAGE(PG8_SA(1, 1), a1 + hstep, voffA);
            PG8_WAIT_V(8); PG8_WAIT_L(0); PG8_BAR; PG8_MMA(0, 0, At, B0); PG8_MMA(0, 1, At, B1); PG8_BAR; PG8_SCHED;
            PG8_LDA(At, 0, 1); PG8_STAGE(PG8_SB(0, 0), b2, voffB); PG8_STAGE(PG8_SB(0, 1), b2 + hstep, voffB); PG8_STAGE(PG8_SA(0, 0), a2, voffA);
            PG8_WAIT_V(8); PG8_WAIT_L(0); PG8_BAR; PG8_MMA(1, 0, At, B0); PG8_MMA(1, 1, At, B1); PG8_BAR; PG8_SCHED;
            PG8_LDB(B0, 1, 0); PG8_LDB(B1, 1, 1); PG8_SCHED; PG8_LDA(At, 1, 0); PG8_STAGE(PG8_SA(0, 1), a2 + hstep, voffA);
            PG8_WAIT_V(8); PG8_WAIT_L(0); PG8_BAR; PG8_MMA(0, 0, At, B0); PG8_MMA(0, 1, At, B1); PG8_BAR; PG8_SCHED;
            PG8_LDA(At, 1, 1); PG8_STAGE(PG8_SB(1, 0), b3, voffB); PG8_STAGE(PG8_SB(1, 1), b3 + hstep, voffB); PG8_STAGE(PG8_SA(1, 0), a3, voffA);
            PG8_WAIT_V(8); PG8_WAIT_L(0); PG8_BAR; PG8_MMA(1, 0, At, B0); PG8_MMA(1, 1, At, B1); PG8_BAR; PG8_SCHED;
            } else {
            PG8_LDB(B0, 0, 0); PG8_SCHED; PG8_LDA(At, 0, 0); PG8_STAGE(PG8_SA(1, 1), a1 + hstep, voffA);
            PG8_WAIT_L(8); PG8_BAR; PG8_WAIT_L(0); PG8_MMA(0, 0, At, B0); PG8_BAR; PG8_SCHED;
            PG8_LDB(B1, 0, 1); PG8_STAGE(PG8_SB(0, 0), b2, voffB);
            PG8_BAR; PG8_WAIT_L(0); PG8_MMA(0, 1, At, B1); PG8_BAR;
            PG8_LDA(At, 0, 1); PG8_STAGE(PG8_SA(0, 0), a2, voffA);
            PG8_BAR; PG8_WAIT_L(0); PG8_MMA(1, 0, At, B0); PG8_BAR; PG8_SCHED;
            PG8_STAGE(PG8_SB(0, 1), b2 + hstep, voffB);
            PG8_WAIT_V(6); PG8_BAR; PG8_MMA(1, 1, At, B1); PG8_BAR;
            PG8_LDB(B0, 1, 0); PG8_SCHED; PG8_LDA(At, 1, 0); PG8_STAGE(PG8_SA(0, 1), a2 + hstep, voffA);
            PG8_WAIT_L(8); PG8_BAR; PG8_WAIT_L(0); PG8_MMA(0, 0, At, B0); PG8_BAR; PG8_SCHED;
            PG8_LDB(B1, 1, 1); PG8_STAGE(PG8_SB(1, 0), b3, voffB);
            PG8_BAR; PG8_WAIT_L(0); PG8_MMA(0, 1, At, B1); PG8_BAR;
            PG8_LDA(At, 1, 1); PG8_STAGE(PG8_SA(1, 0), a3, voffA);
            PG8_BAR; PG8_WAIT_L(0); PG8_MMA(1, 0, At, B0); PG8_BAR; PG8_SCHED;
            PG8_STAGE(PG8_SB(1, 1), b3 + hstep, voffB);
            PG8_WAIT_V(6); PG8_BAR; PG8_MMA(1, 1, At, B1); PG8_BAR;
            }
        }
        if constexpr (ALIGN_EPI) { if (wr == 0) PG8_BAR; }
        if constexpr (!Epi::AFTER_DRAIN) { E(acc, cur, wr, wc, fr, fq); S.done(cur); }
        if (!has_next) break;
#pragma unroll
        for (int a = 0; a < 2; ++a)
#pragma unroll
            for (int b = 0; b < 2; ++b)
#pragma unroll
                for (int m = 0; m < 4; ++m)
#pragma unroll
                    for (int n = 0; n < 2; ++n) acc[a][b][m][n] = (f32x4){0.f, 0.f, 0.f, 0.f};
        cur = nxt; cA = nA; cB = nB; ++ui;
        if constexpr (ALIGN_EPI) { if (wr == 1) PG8_BAR; }
    }
    PG8_WAIT_V(0);
    if constexpr (!ALIGN_EPI) { if (wr == 0) PG8_BAR; }
    PG8_BAR;
    if constexpr (Epi::AFTER_DRAIN) { E.fused(acc, cur, wr, wc, fr, fq, lds, wid, lane); S.done(cur); }
#undef PG8_SA
#undef PG8_SB
#undef PG8_STAGE
#undef PG8_LDA
#undef PG8_LDB
#undef PG8_MMA
#undef PG8_WAIT_V
#undef PG8_WAIT_L
#undef PG8_BAR
#undef PG8_SCHED
}
}


#define LAS __attribute__((address_space(3)))
typedef unsigned short bf16_t;
typedef short bf16x8 __attribute__((ext_vector_type(8)));
typedef short s16x4 __attribute__((ext_vector_type(4)));
typedef short v4i16_t __attribute__((ext_vector_type(4)));
typedef float f32x4 __attribute__((ext_vector_type(4)));
typedef unsigned u32x4 __attribute__((ext_vector_type(4)));
typedef unsigned u32x2 __attribute__((ext_vector_type(2)));
typedef float f32x2 __attribute__((ext_vector_type(2)));

constexpr int T = 16384, DM = 1024, SEQ = 2048, NP = 3584;
constexpr size_t MiB = 1u << 20;
constexpr size_t WS_CTL = 0, WS_MOD = 4096, WS_GATES = 262144, WS_KEYS = 1 * MiB, WS_WIN = 2 * MiB, WS_WOUT = 9 * MiB, WS_WQ = 11 * MiB,
                 WS_T8 = 16 * MiB, WS_SC = 48 * MiB, WS_ACT = 80 * MiB, WS_P = 112 * MiB, WS_QRY = 112 * MiB, WS_END = 256 * MiB;
constexpr size_t WS_RS = 208 * MiB, WS_SB = 851968, WS_WGT = 917504, WS_A3 = 176 * MiB;
constexpr int LDS_BYTES = 147456;

__device__ __forceinline__ unsigned f2bf(float f) { unsigned u = __float_as_uint(f); return (u + 0x7fffu + ((u >> 16) & 1u)) >> 16; }
typedef __bf16 bf16x2_t __attribute__((ext_vector_type(2)));
__device__ __forceinline__ unsigned pk2(float lo, float hi) { const f32x2 v = {lo, hi}; const bf16x2_t b = __builtin_convertvector(v, bf16x2_t); return __builtin_bit_cast(unsigned, b); }
__device__ __forceinline__ float bflo(unsigned u) { return __uint_as_float(u << 16); }
__device__ __forceinline__ float bfhi(unsigned u) { return __uint_as_float(u & 0xffff0000u); }
__device__ __forceinline__ float wave_sum(float v) {
    { const auto r = __builtin_amdgcn_permlane32_swap(__float_as_uint(v), __float_as_uint(v), false, false); v = __uint_as_float(r[0]) + __uint_as_float(r[1]); }
    { const auto r = __builtin_amdgcn_permlane16_swap(__float_as_uint(v), __float_as_uint(v), false, false); v = __uint_as_float(r[0]) + __uint_as_float(r[1]); }
    v += __int_as_float(__builtin_amdgcn_mov_dpp(__float_as_int(v), 0xB1, 0xF, 0xF, true));
    v += __int_as_float(__builtin_amdgcn_mov_dpp(__float_as_int(v), 0x4E, 0xF, 0xF, true));
    v += __int_as_float(__builtin_amdgcn_mov_dpp(__float_as_int(v), 0x141, 0xF, 0xF, true));
    v += __int_as_float(__builtin_amdgcn_mov_dpp(__float_as_int(v), 0x140, 0xF, 0xF, true));
    return v;
}
__device__ __forceinline__ float xrow_max(float v) {
    { const auto r = __builtin_amdgcn_permlane16_swap(__float_as_uint(v), __float_as_uint(v), false, false); v = fmaxf(__uint_as_float(r[0]), __uint_as_float(r[1])); }
    { const auto r = __builtin_amdgcn_permlane32_swap(__float_as_uint(v), __float_as_uint(v), false, false); v = fmaxf(__uint_as_float(r[0]), __uint_as_float(r[1])); }
    return v;
}
__device__ __forceinline__ float xrow_sum(float v) {
    { const auto r = __builtin_amdgcn_permlane16_swap(__float_as_uint(v), __float_as_uint(v), false, false); v = __uint_as_float(r[0]) + __uint_as_float(r[1]); }
    { const auto r = __builtin_amdgcn_permlane32_swap(__float_as_uint(v), __float_as_uint(v), false, false); v = __uint_as_float(r[0]) + __uint_as_float(r[1]); }
    return v;
}
#define LDS_WAIT() asm volatile("s_waitcnt lgkmcnt(0)" ::: "memory")
__device__ __forceinline__ s16x4 vtr(LAS unsigned char* p) { return __builtin_bit_cast(s16x4, __builtin_amdgcn_ds_read_tr16_b64_v4i16((LAS v4i16_t*)p)); }
__device__ __forceinline__ bf16x8 cat8(s16x4 a, s16x4 b) { bf16x8 r; r[0] = a[0]; r[1] = a[1]; r[2] = a[2]; r[3] = a[3]; r[4] = b[0]; r[5] = b[1]; r[6] = b[2]; r[7] = b[3]; return r; }
__device__ __forceinline__ bf16x8 pack8(const f32x4 a, const f32x4 b) { u32x4 w; w.x = pk2(a[0], a[1]); w.y = pk2(a[2], a[3]); w.z = pk2(b[0], b[1]); w.w = pk2(b[2], b[3]); return __builtin_bit_cast(bf16x8, w); }
#define MFMA16(a, b, c) __builtin_amdgcn_mfma_f32_16x16x32_bf16((a), (b), (c), 0, 0, 0)

struct Args {
    const float *x, *c, *ada_w, *ada_b, *norm1_g, *w_in, *conv_w, *conv_b, *gate_b, *mnorm_g, *lq1, *lk1, *lq2, *lk2, *dnorm_g, *w_out, *norm2_g, *wq, *keys, *pu, *pv, *final_g;
    float* out; unsigned char* ws;
};

__device__ __forceinline__ void transpose_item(const float* W, int srcN, int soff, bf16_t* WT, LAS float* scr, int kb, int nb, int lane) {
    const int k0 = 64 * kb, n0 = 32 * nb;
    { f32x4 wv[8];
#pragma unroll
      for (int i = 0; i < 8; ++i) wv[i] = *(const f32x4*)(W + (size_t)(k0 + 8 * i + (lane >> 3)) * srcN + n0 + soff + 4 * (lane & 7));
#pragma unroll
      for (int i = 0; i < 8; ++i) { LAS float* d = scr + (8 * i + (lane >> 3)) * 33 + 4 * (lane & 7); d[0] = wv[i][0]; d[1] = wv[i][1]; d[2] = wv[i][2]; d[3] = wv[i][3]; } }
    LDS_WAIT(); asm volatile("" ::: "memory");
    const int c = lane & 7;
#pragma unroll
    for (int j = 0; j < 4; ++j) { const int n = (lane >> 3) + 8 * j; const LAS float* s = scr + (8 * c) * 33 + n;
        u32x4 o; o.x = pk2(s[0 * 33], s[1 * 33]); o.y = pk2(s[2 * 33], s[3 * 33]); o.z = pk2(s[4 * 33], s[5 * 33]); o.w = pk2(s[6 * 33], s[7 * 33]);
        *(u32x4*)(WT + (size_t)(n0 + n) * 1024 + k0 + 8 * c) = o; }
    LDS_WAIT(); asm volatile("" ::: "memory");
}

__device__ __forceinline__ bf16x8 pack8_sw(const f32x4 a, const f32x4 b) {
    u32x4 w; w.x = f2bf(a[0]) | (f2bf(a[1]) << 16); w.y = f2bf(a[2]) | (f2bf(a[3]) << 16); w.z = f2bf(b[0]) | (f2bf(b[1]) << 16); w.w = f2bf(b[2]) | (f2bf(b[3]) << 16); return __builtin_bit_cast(bf16x8, w); }
__device__ __forceinline__ void wprime_item(const Args& A, int hp, int kt, int lane) {
    const int g = lane >> 4, l15 = lane & 15;
    f32x4 acc[8];
#pragma unroll
    for (int nt = 0; nt < 8; ++nt) acc[nt] = (f32x4){0.f, 0.f, 0.f, 0.f};
#pragma unroll
    for (int ks = 0; ks < 4; ++ks) {
        const float* ap = A.wq + (size_t)(16 * kt + l15) * 2048 + hp * 128 + 32 * ks + 8 * g;
        const bf16x8 a = pack8(*(const f32x4*)ap, *(const f32x4*)(ap + 4));
#pragma unroll
        for (int nt = 0; nt < 8; ++nt) { const float* bp = A.keys + (size_t)(hp * 128 + 16 * nt + l15) * 128 + 32 * ks + 8 * g;
            const bf16x8 b = pack8(*(const f32x4*)bp, *(const f32x4*)(bp + 4)); acc[nt] = MFMA16(a, b, acc[nt]); }
    }
    bf16_t* WT = (bf16_t*)(A.ws + WS_WQ);
#pragma unroll
    for (int nt = 0; nt < 8; ++nt) { u32x2 o; o.x = pk2(acc[nt][0], acc[nt][1]); o.y = pk2(acc[nt][2], acc[nt][3]);
        *(u32x2*)(WT + (size_t)(hp * 128 + 16 * nt + l15) * 1024 + 16 * kt + 4 * g) = o; }
}

__device__ __forceinline__ void phase0(const Args& A, LAS unsigned char* lds) {
    int tid_o = threadIdx.x; asm volatile("" : "+v"(tid_o)); const int tid = tid_o, lane = tid & 63, wave = tid >> 6, G = gridDim.x;
    float* MOD = (float*)(A.ws + WS_MOD);
    if ((int)blockIdx.x < 192) {
        LAS float* sc = (LAS float*)lds;
        for (int i = tid; i < 8192; i += 512) { const float v = A.c[i]; sc[i] = v * __builtin_amdgcn_rcpf(1.f + __expf(-v)); }
        __syncthreads();
        for (int item = blockIdx.x; item < 192; item += G) {
            const int j0 = item * 32, kg = tid >> 3, cq = tid & 7;
            f32x4 wv[16];
#pragma unroll
            for (int kk = 0; kk < 16; ++kk) wv[kk] = *(const f32x4*)(A.ada_w + (size_t)(kg * 16 + kk) * 6144 + j0 + 4 * cq);
            f32x4 acc[8];
#pragma unroll
            for (int b = 0; b < 8; ++b) acc[b] = (f32x4){0.f, 0.f, 0.f, 0.f};
#pragma unroll
            for (int b = 0; b < 8; ++b)
#pragma unroll
                for (int k4 = 0; k4 < 4; ++k4) { const f32x4 s4 = *(const LAS f32x4*)(sc + b * 1024 + kg * 16 + 4 * k4);
                    acc[b] += wv[4 * k4] * s4[0]; acc[b] += wv[4 * k4 + 1] * s4[1]; acc[b] += wv[4 * k4 + 2] * s4[2]; acc[b] += wv[4 * k4 + 3] * s4[3]; }
            LAS float* part = (LAS float*)(lds + 32768);
#pragma unroll
            for (int b = 0; b < 8; ++b) *(LAS f32x4*)(part + (kg * 8 + b) * 32 + 4 * cq) = acc[b];
            __syncthreads();
            if (tid < 256) { const int b = tid >> 5, col = tid & 31; float s = A.ada_b[j0 + col];
              for (int k2 = 0; k2 < 64; ++k2) s += part[(k2 * 8 + b) * 32 + col];
              MOD[b * 6144 + j0 + col] = s; }
            __syncthreads();
        }
    }
    for (int i = (G - 1 - (int)blockIdx.x) * 512 + tid; i < 8192; i += G * 512) { const int gc = i >> 10, k = i & 1023; ((float*)(A.ws + WS_WGT))[i] = A.w_in[(size_t)k * 3592 + 2048 + gc]; }
    if (blockIdx.x == 0 && tid == 0) {
        float s1 = 0.f, s2 = 0.f;
        for (int i = 0; i < 64; ++i) { s1 += A.lq1[i] * A.lk1[i]; s2 += A.lq2[i] * A.lk2[i]; }
        ((float*)(A.ws + WS_CTL))[1] = expf(s1) - expf(s2) + 0.2f;
        ((unsigned*)(A.ws + WS_CTL))[0] = 0u; ((unsigned*)(A.ws + WS_CTL))[2] = 0u;
    }
}

__device__ __forceinline__ void phase0b(const Args& A, LAS unsigned char* lds) {
    int tid_o = threadIdx.x; asm volatile("" : "+v"(tid_o)); const int tid = tid_o, lane = tid & 63, wave = tid >> 6, G = gridDim.x;
    __syncthreads();
    {
        LAS float* scr = (LAS float*)(lds + wave * 16384);
        const int gw = blockIdx.x * 8 + wave, NGW = G * 8;
        for (int it = gw; it < 1792; it += NGW) { const int kb = it / 112, nb = it % 112; transpose_item(A.w_in, 3592, nb >= 64 ? 8 : 0, (bf16_t*)(A.ws + WS_WIN), scr, kb, nb, lane); }
    }
}

__device__ __forceinline__ void quantise_tables(const Args& A, int gw, int NGW, int row_lo, int row_hi) {
    int tid_o = threadIdx.x; asm volatile("" : "+v"(tid_o)); const int lane = tid_o & 63;
    unsigned char* T8 = A.ws + WS_T8; float* SC = (float*)(A.ws + WS_SC);
#pragma unroll 1
    for (int row = row_lo + gw; row < row_hi; row += 4 * NGW) {
        f32x4 v[4][4]; int rr[4];
#pragma unroll
        for (int q = 0; q < 4; ++q) { const int r = row + q * NGW; rr[q] = r; const int rc = r < row_hi ? r : row;
            const float* s = (rc < 16384 ? A.pu + (size_t)rc * 1024 : A.pv + (size_t)(rc - 16384) * 1024) + 16 * lane;
#pragma unroll
            for (int j = 0; j < 4; ++j) v[q][j] = *(const f32x4*)(s + 4 * j); }
#pragma unroll
        for (int q = 0; q < 4; ++q) {
            float mx = 0.f;
#pragma unroll
            for (int j = 0; j < 4; ++j)
#pragma unroll
                for (int e = 0; e < 4; ++e) mx = fmaxf(mx, fabsf(v[q][j][e]));
#pragma unroll
            for (int o = 1; o < 64; o <<= 1) mx = fmaxf(mx, __shfl_xor(mx, o));
            const float sc = fmaxf(mx, 1e-30f) * (1.f / 256.f), inv = 1.f / sc;
            u32x4 o4;
#pragma unroll
            for (int j = 0; j < 4; ++j) { int w0 = __builtin_amdgcn_cvt_pk_fp8_f32(v[q][j][0] * inv, v[q][j][1] * inv, 0, false); w0 = __builtin_amdgcn_cvt_pk_fp8_f32(v[q][j][2] * inv, v[q][j][3] * inv, w0, true); o4[j] = (unsigned)w0; }
            if (rr[q] < row_hi) { *(u32x4*)(T8 + (size_t)rr[q] * 1024 + 16 * lane) = o4; if (lane == 0) SC[rr[q]] = sc; }
        }
    }
}

__device__ __forceinline__ void phase1(const Args& A, LAS unsigned char* lds) {
    int tid_o = threadIdx.x; asm volatile("" : "+v"(tid_o)); const int tid = tid_o, lane = tid & 63, wave = tid >> 6, G = gridDim.x;
    const float* MOD = (const float*)(A.ws + WS_MOD);
    bf16_t* ACT = (bf16_t*)(A.ws + WS_ACT);
    float* GATES = (float*)(A.ws + WS_GATES);
    LAS float* WG = (LAS float*)lds;
    for (int i = tid; i < 8192; i += 512) WG[i] = ((const float*)(A.ws + WS_WGT))[i];
    __syncthreads();
    f32x4 vn[4];
    { const int m0 = (int)(blockIdx.x * 8 + wave) < T ? blockIdx.x * 8 + wave : 0; const f32x4* xr = (const f32x4*)(A.x + (size_t)m0 * 1024) + lane;
#pragma unroll
        for (int j = 0; j < 4; ++j) vn[j] = xr[64 * j]; }
    for (int m = blockIdx.x * 8 + wave; m < T; m += G * 8) {
        const int b = m >> 11;
        f32x4 v[4]; float ss = 0.f;
#pragma unroll
        for (int j = 0; j < 4; ++j) { v[j] = vn[j]; ss += (v[j][0] * v[j][0] + v[j][1] * v[j][1]) + (v[j][2] * v[j][2] + v[j][3] * v[j][3]); }
        { const int mn = (m + G * 8 < T) ? m + G * 8 : m; const f32x4* xr = (const f32x4*)(A.x + (size_t)mn * 1024) + lane;
#pragma unroll
            for (int j = 0; j < 4; ++j) vn[j] = xr[64 * j]; }
        f32x4 gg[4], scc[4], shh[4];
#pragma unroll
        for (int j = 0; j < 4; ++j) { const int col = 4 * lane + 256 * j; gg[j] = *(const f32x4*)(A.norm1_g + col); scc[j] = *(const f32x4*)(MOD + b * 6144 + 1024 + col); shh[j] = *(const f32x4*)(MOD + b * 6144 + col); }
        const float rstd = rsqrtf(wave_sum(ss) * (1.f / 1024.f) + 1e-6f);
        unsigned long long* o8 = (unsigned long long*)(ACT + (size_t)m * 1024) + lane;
#pragma unroll
        for (int j = 0; j < 4; ++j) { const f32x4 g = gg[j], sc = scc[j], sh = shh[j];
            v[j] = v[j] * rstd * g * (sc + 1.0f) + sh;
            o8[64 * j] = (unsigned long long)pk2(v[j][0], v[j][1]) | ((unsigned long long)pk2(v[j][2], v[j][3]) << 32); }
        float gd[8];
#pragma unroll
        for (int gc = 0; gc < 8; ++gc) { float d = 0.f;
#pragma unroll
            for (int j = 0; j < 4; ++j) { const f32x4 w = *(const LAS f32x4*)(WG + gc * 1024 + 256 * j + 4 * lane); d += (v[j][0] * w[0] + v[j][1] * w[1]) + (v[j][2] * w[2] + v[j][3] * w[3]); }
            gd[gc] = wave_sum(d); }
        if (lane == 0) {
            f32x4 ig, lf;
#pragma unroll
            for (int h = 0; h < 4; ++h) { ig[h] = gd[h] + A.gate_b[h]; const float z = gd[4 + h] + A.gate_b[4 + h]; lf[h] = fminf(z, 0.f) - log1pf(expf(-fabsf(z))); }
            *(f32x4*)(GATES + (size_t)m * 8) = ig; *(f32x4*)(GATES + (size_t)m * 8 + 4) = lf;
        }
    }
}

constexpr int AK_STRIDE = 272, AV_STRIDE = 288, AK_BYTES = 64 * AK_STRIDE, AV_BYTES = 64 * AV_STRIDE;
__device__ __forceinline__ void attn_item(const Args& A, LAS unsigned char* lds, int b, int h, int qb, float lam) {
    int tid_o = threadIdx.x; asm volatile("" : "+v"(tid_o)); const int tid = tid_o, lane = tid & 63, w = tid >> 6, g = lane >> 4, l15 = lane & 15;
    const bf16_t* P = (const bf16_t*)(A.ws + WS_P);
    bf16_t* ACT = (bf16_t*)(A.ws + WS_ACT);
    const int t0 = qb * 128, ntiles = 2 * (qb + 1);
    const size_t rowbase = (size_t)b * SEQ;
    bf16x8 qf[2][2];
    { const bf16_t* qp = P + (rowbase + t0 + 16 * w + l15) * NP + 2048 + h * 128 + 8 * g;
#pragma unroll
      for (int p = 0; p < 2; ++p)
#pragma unroll
          for (int ks = 0; ks < 2; ++ks) qf[p][ks] = *(const bf16x8*)(qp + p * 64 + ks * 32); }
    f32x4 o[2][8];
#pragma unroll
    for (int p = 0; p < 2; ++p)
#pragma unroll
        for (int vt = 0; vt < 8; ++vt) o[p][vt] = (f32x4){0.f, 0.f, 0.f, 0.f};
    float mrun[2] = {-1e30f, -1e30f}, lrun[2] = {0.f, 0.f};
    const int srow = tid >> 3, sseg = tid & 7;
    const bf16_t* kg = P + (rowbase + srow) * NP + 2560 + h * 128 + sseg * 16;
    const bf16_t* vg = P + (rowbase + srow) * NP + 3072 + h * 128 + sseg * 16;
    u32x4 kr0, kr1, vr0, vr1;
    kr0 = *(const u32x4*)(kg); kr1 = *(const u32x4*)(kg + 8); vr0 = *(const u32x4*)(vg); vr1 = *(const u32x4*)(vg + 8);
    { LAS unsigned char* kb = lds + srow * AK_STRIDE + sseg * 32; LAS unsigned char* vb = lds + 2 * AK_BYTES + srow * AV_STRIDE + sseg * 32;
      *(LAS u32x4*)kb = kr0; *(LAS u32x4*)(kb + 16) = kr1; *(LAS u32x4*)vb = vr0; *(LAS u32x4*)(vb + 16) = vr1; }
    __syncthreads();
    const float cs = 0.125f * 1.4426950408889634f;
    const int qabs = t0 + 16 * w + l15;
    for (int kt = 0; kt < ntiles; ++kt) {
        const int cur = kt & 1;
        if (kt + 1 < ntiles) { const size_t off = (size_t)(kt + 1) * 64 * NP;
            kr0 = *(const u32x4*)(kg + off); kr1 = *(const u32x4*)(kg + off + 8); vr0 = *(const u32x4*)(vg + off); vr1 = *(const u32x4*)(vg + off + 8); }
        if (64 * kt <= t0 + 16 * w + 15) {
            LAS unsigned char* Kb = lds + cur * AK_BYTES; LAS unsigned char* Vb = lds + 2 * AK_BYTES + cur * AV_BYTES;
            f32x4 s[2][4];
#pragma unroll
            for (int p = 0; p < 2; ++p)
#pragma unroll
                for (int k4 = 0; k4 < 4; ++k4) { f32x4 a = (f32x4){0.f, 0.f, 0.f, 0.f};
#pragma unroll
                    for (int ks = 0; ks < 2; ++ks) { const bf16x8 kf = *(const LAS bf16x8*)(Kb + (16 * k4 + l15) * AK_STRIDE + (p * 64 + ks * 32 + 8 * g) * 2); a = MFMA16(kf, qf[p][ks], a); }
                    s[p][k4] = a; }
            if (64 * kt + 63 > t0 + 16 * w) {
#pragma unroll
                for (int p = 0; p < 2; ++p)
#pragma unroll
                    for (int k4 = 0; k4 < 4; ++k4)
#pragma unroll
                        for (int r = 0; r < 4; ++r) { const int key = 64 * kt + 16 * k4 + 4 * g + r; if (key > qabs) s[p][k4][r] = -1e30f; }
            }
            bf16x8 pf[2][2];
#pragma unroll
            for (int p = 0; p < 2; ++p) {
                float mx = -1e30f;
#pragma unroll
                for (int k4 = 0; k4 < 4; ++k4)
#pragma unroll
                    for (int r = 0; r < 4; ++r) mx = fmaxf(mx, s[p][k4][r]);
                mx = xrow_max(mx);
                const float mnew = fmaxf(mrun[p], mx * cs), alpha = __builtin_amdgcn_exp2f(mrun[p] - mnew);
                mrun[p] = mnew;
                float ls = 0.f;
#pragma unroll
                for (int k4 = 0; k4 < 4; ++k4)
#pragma unroll
                    for (int r = 0; r < 4; ++r) { const float pv = __builtin_amdgcn_exp2f(s[p][k4][r] * cs - mnew); ls += pv; s[p][k4][r] = pv; }
                lrun[p] = lrun[p] * alpha + ls;
                if (__any(alpha != 1.f)) {
#pragma unroll
                    for (int vt = 0; vt < 8; ++vt) o[p][vt] = o[p][vt] * alpha; }
                pf[p][0] = pack8(s[p][0], s[p][1]); pf[p][1] = pack8(s[p][2], s[p][3]);
            }
#pragma unroll
            for (int ks2 = 0; ks2 < 2; ++ks2)
#pragma unroll
                for (int vt = 0; vt < 8; ++vt) {
                    LAS unsigned char* a0 = Vb + (32 * ks2 + 4 * g + (l15 >> 2)) * AV_STRIDE + (16 * vt + 4 * (lane & 3)) * 2;
                    const bf16x8 vf = cat8(vtr(a0), vtr(a0 + 16 * AV_STRIDE));
                    o[0][vt] = MFMA16(vf, pf[0][ks2], o[0][vt]);
                    o[1][vt] = MFMA16(vf, pf[1][ks2], o[1][vt]);
                }
        }
        if (kt + 1 < ntiles) { const int nx = cur ^ 1;
            LAS unsigned char* kb = lds + nx * AK_BYTES + srow * AK_STRIDE + sseg * 32; LAS unsigned char* vb = lds + 2 * AK_BYTES + nx * AV_BYTES + srow * AV_STRIDE + sseg * 32;
            *(LAS u32x4*)kb = kr0; *(LAS u32x4*)(kb + 16) = kr1; *(LAS u32x4*)vb = vr0; *(LAS u32x4*)(vb + 16) = vr1; }
        __syncthreads();
    }
    float inv[2];
#pragma unroll
    for (int p = 0; p < 2; ++p) { const float lt = xrow_sum(lrun[p]); inv[p] = 1.f / lt; }
    float ss = 0.f;
#pragma unroll
    for (int vt = 0; vt < 8; ++vt)
#pragma unroll
        for (int r = 0; r < 4; ++r) { const float ov = o[0][vt][r] * inv[0] - lam * (o[1][vt][r] * inv[1]); o[0][vt][r] = ov; ss += ov * ov; }
    ss = xrow_sum(ss);
    const float rstd = rsqrtf(ss * (1.f / 128.f) + 1e-6f) * 0.8f;
    bf16_t* op = ACT + (rowbase + qabs) * 1024 + 512 + h * 128 + 4 * g;
#pragma unroll
    for (int vt = 0; vt < 8; ++vt) { const f32x4 gn = *(const f32x4*)(A.dnorm_g + 16 * vt + 4 * g);
        u32x2 wv; wv.x = pk2(o[0][vt][0] * rstd * gn[0], o[0][vt][1] * rstd * gn[1]); wv.y = pk2(o[0][vt][2] * rstd * gn[2], o[0][vt][3] * rstd * gn[3]);
        *(u32x2*)(op + 16 * vt) = wv; }
}

constexpr int MQ_STRIDE = 272, MV_STRIDE = 288, MP_STRIDE = 144, MH_STRIDE = 132;
constexpr int ML_Q = 0, ML_K = 17408, ML_V = 34816, ML_P = 53248, ML_H = 62464, ML_CW = 96256, ML_SM = 101376;
constexpr int SM_E = 0, SM_G = 64, SM_B = 128, SM_W = 192, SM_I = 256, SM_R = 320, SM_N = 384, SM_NP = 512, SM_X = 1024;
constexpr size_t WS_CST = 224 * MiB, WS_NST = 15 * MiB, WS_MC = 15 * MiB + 512 * 1024, WS_BAR = 15 * MiB + 768 * 1024;

__device__ __forceinline__ void mlstm_state(const Args& A, LAS unsigned char* lds, int b, int h) {
    int tid_o = threadIdx.x; asm volatile("" : "+v"(tid_o)); const int tid = tid_o, lane = tid & 63, w = tid >> 6, g = lane >> 4, l15 = lane & 15;
    const bf16_t* P = (const bf16_t*)(A.ws + WS_P);
    const float* GATES = (const float*)(A.ws + WS_GATES);
    u32x4* CST = (u32x4*)(A.ws + WS_CST); float* NST = (float*)(A.ws + WS_NST); float* MCg = (float*)(A.ws + WS_MC);
    LAS float* sm = (LAS float*)(lds + ML_SM);
    LAS float* cw = (LAS float*)(lds + ML_CW);
    LAS unsigned char* Ks = lds + ML_K; LAS unsigned char* Vs = lds + ML_V;
    const size_t rowbase = (size_t)b * SEQ; const int bh = b * 4 + h;
    for (int i = tid; i < 640; i += 512) { const int j = i >> 7, ch = i & 127, cch = 512 + h * 128 + ch; cw[i] = (j < 4) ? A.conv_w[j * 1024 + cch] : A.conv_b[cch]; }
    if (tid < 128) sm[SM_N + tid] = 0.f;
    const int rg = tid >> 4, cs = tid & 15;
    const int ccol = 512 + h * 128 + 8 * cs;
    const int srow = tid >> 3, sseg = tid & 7;
    u32x4 cr[5], vr0, vr1; float gi = 0.f, gf = 0.f;
#define MS_PREFETCH(c) do { const int _r0 = (c) * 64 + 2 * rg - 3; \
        _Pragma("unroll") for (int _i = 0; _i < 5; ++_i) { const int _r = _r0 + _i; const u32x4 _v = *(const u32x4*)(P + (rowbase + (_r >= 0 ? _r : 0)) * NP + ccol); cr[_i] = (_r >= 0) ? _v : (u32x4){0u, 0u, 0u, 0u}; } \
        const bf16_t* _vp = P + (rowbase + (c) * 64 + srow) * NP + 1024 + h * 128 + sseg * 16; \
        vr0 = *(const u32x4*)(_vp); vr1 = *(const u32x4*)(_vp + 8); \
        } while (0)
    MS_PREFETCH(0);
    LAS float* Eall = (LAS float*)(lds + ML_Q);
#pragma unroll
    for (int cc = 0; cc < 4; ++cc) { const int c = w + 8 * cc;
        const float* gp = GATES + (rowbase + c * 64 + lane) * 8 + h; gi = gp[0]; gf = gp[4];
        float bc = gf;
#pragma unroll
        for (int o = 1; o < 64; o <<= 1) { const float t = __shfl_up(bc, o); if (lane >= o) bc += t; }
        const float e = gi - bc; float cm = e;
#pragma unroll
        for (int o = 1; o < 64; o <<= 1) { const float t = __shfl_up(cm, o); if (lane >= o) cm = fmaxf(cm, t); }
        Eall[c * 64 + lane] = e;
        if (lane == 63) { Eall[2048 + c] = bc; Eall[2048 + 32 + c] = cm; } }
    f32x4 C[8];
#pragma unroll
    for (int kt = 0; kt < 8; ++kt) C[kt] = (f32x4){0.f, 0.f, 0.f, 0.f};
    float mc = 0.f;
    __syncthreads();
    for (int c = 0; c < 32; ++c) {
        {
            float wt[5][8];
#pragma unroll
            for (int j = 0; j < 5; ++j) { const f32x4 a = *(const LAS f32x4*)(cw + j * 128 + 8 * cs), bb = *(const LAS f32x4*)(cw + j * 128 + 8 * cs + 4);
                wt[j][0] = a[0]; wt[j][1] = a[1]; wt[j][2] = a[2]; wt[j][3] = a[3]; wt[j][4] = bb[0]; wt[j][5] = bb[1]; wt[j][6] = bb[2]; wt[j][7] = bb[3]; }
            LAS unsigned char* dst = Ks + (2 * rg) * MQ_STRIDE + 16 * cs;
#pragma unroll
            for (int r = 0; r < 2; ++r) {
                float ov[8];
#pragma unroll
                for (int e = 0; e < 8; ++e) ov[e] = wt[4][e];
#pragma unroll
                for (int j = 0; j < 4; ++j) { const u32x4 x = cr[r + j];
                    ov[0] += wt[j][0] * bflo(x.x); ov[1] += wt[j][1] * bfhi(x.x); ov[2] += wt[j][2] * bflo(x.y); ov[3] += wt[j][3] * bfhi(x.y);
                    ov[4] += wt[j][4] * bflo(x.z); ov[5] += wt[j][5] * bfhi(x.z); ov[6] += wt[j][6] * bflo(x.w); ov[7] += wt[j][7] * bfhi(x.w); }
#pragma unroll
                for (int e = 0; e < 8; ++e) ov[e] = 0.08838834764831845f * ov[e] * __builtin_amdgcn_rcpf(1.f + __expf(-ov[e]));
                u32x4 o4; o4.x = pk2(ov[0], ov[1]); o4.y = pk2(ov[2], ov[3]); o4.z = pk2(ov[4], ov[5]); o4.w = pk2(ov[6], ov[7]);
                *(LAS u32x4*)(dst + r * MQ_STRIDE) = o4;
            }
            LAS unsigned char* vd = Vs + srow * MV_STRIDE + sseg * 32; *(LAS u32x4*)vd = vr0; *(LAS u32x4*)(vd + 16) = vr1;
            if (w == 0) {
                const float g63 = fmaxf(mc, Eall[2048 + 32 + c]);
                sm[SM_W + lane] = __expf(Eall[c * 64 + lane] - g63);
                if (lane == 63) { sm[SM_X] = __expf(mc - g63); sm[SM_X + 1] = Eall[2048 + c] + g63; }
            }
        }
        __syncthreads();
        { const int cn = (c + 1 < 32) ? c + 1 : 31; MS_PREFETCH(cn); }
        {
            const int item = bh * 32 + c;
#pragma unroll
            for (int k2 = 0; k2 < 4; ++k2) CST[((size_t)(item * 8 + w) * 4 + k2) * 64 + lane] = __builtin_bit_cast(u32x4, pack8(C[2 * k2], C[2 * k2 + 1]));
            if (tid < 128) NST[item * 128 + tid] = sm[SM_N + tid];
            if (tid == 0) MCg[item] = mc;
            LAS float* wS = sm + SM_W;
            const float decay = sm[SM_X];
            bf16x8 vfw[2];
#pragma unroll
            for (int ks = 0; ks < 2; ++ks) {
                LAS unsigned char* a0 = Vs + (32 * ks + 8 * g + (l15 >> 2)) * MV_STRIDE + (16 * w + 4 * (lane & 3)) * 2;
                const bf16x8 vf = cat8(vtr(a0), vtr(a0 + 4 * MV_STRIDE));
                const f32x4 w0 = *(const LAS f32x4*)(wS + 32 * ks + 8 * g), w1 = *(const LAS f32x4*)(wS + 32 * ks + 8 * g + 4);
                const u32x4 vu = __builtin_bit_cast(u32x4, vf);
                u32x4 o4; o4.x = pk2(bflo(vu.x) * w0[0], bfhi(vu.x) * w0[1]); o4.y = pk2(bflo(vu.y) * w0[2], bfhi(vu.y) * w0[3]);
                o4.z = pk2(bflo(vu.z) * w1[0], bfhi(vu.z) * w1[1]); o4.w = pk2(bflo(vu.w) * w1[2], bfhi(vu.w) * w1[3]);
                vfw[ks] = __builtin_bit_cast(bf16x8, o4);
            }
#pragma unroll
            for (int kt = 0; kt < 8; ++kt) C[kt] = C[kt] * decay;
#pragma unroll
            for (int ks = 0; ks < 2; ++ks)
#pragma unroll
                for (int kt = 0; kt < 8; ++kt) { LAS unsigned char* a0 = Ks + (32 * ks + 8 * g + (l15 >> 2)) * MQ_STRIDE + (16 * kt + 4 * (lane & 3)) * 2;
                    const bf16x8 ka = cat8(vtr(a0), vtr(a0 + 4 * MQ_STRIDE)); C[kt] = MFMA16(ka, vfw[ks], C[kt]); }
            { const int kd = tid & 127, sq = tid >> 7; float s = 0.f;
#pragma unroll
              for (int i = 0; i < 16; ++i) { const int s_ = 16 * sq + i; s += wS[s_] * __uint_as_float((unsigned)(*(const LAS bf16_t*)(Ks + s_ * MQ_STRIDE + kd * 2)) << 16); }
              sm[SM_NP + sq * 128 + kd] = s; }
            mc = sm[SM_X + 1];
            __syncthreads();
            if (tid < 128) sm[SM_N + tid] = decay * sm[SM_N + tid] + ((sm[SM_NP + tid] + sm[SM_NP + 128 + tid]) + (sm[SM_NP + 256 + tid] + sm[SM_NP + 384 + tid]));
        }
    }
#undef MS_PREFETCH
    __syncthreads();
}

__device__ __forceinline__ void mlstm_out(const Args& A, LAS unsigned char* lds, int item, int& last_h) {
    int tid_o = threadIdx.x; asm volatile("" : "+v"(tid_o)); const int tid = tid_o, lane = tid & 63, w = tid >> 6, g = lane >> 4, l15 = lane & 15;
    const int bh = item >> 5, c = item & 31, b = bh >> 2, h = bh & 3;
    const bf16_t* P = (const bf16_t*)(A.ws + WS_P);
    bf16_t* ACT = (bf16_t*)(A.ws + WS_ACT);
    const float* GATES = (const float*)(A.ws + WS_GATES);
    const u32x4* CST = (const u32x4*)(A.ws + WS_CST); const float* NST = (const float*)(A.ws + WS_NST); const float* MCg = (const float*)(A.ws + WS_MC);
    LAS float* sm = (LAS float*)(lds + ML_SM);
    LAS float* cw = (LAS float*)(lds + ML_CW);
    LAS unsigned char* Qs = lds + ML_Q; LAS unsigned char* Ks = lds + ML_K; LAS unsigned char* Vs = lds + ML_V; LAS unsigned char* Ps = lds + ML_P;
    LAS float* Hn = (LAS float*)(lds + ML_H);
    LAS float* eS = sm + SM_E; LAS float* gS = sm + SM_G; LAS float* bS = sm + SM_B; LAS float* iS = sm + SM_I; LAS float* nS = sm + SM_N;
    const size_t rowbase = (size_t)b * SEQ;
    const int rg = tid >> 5, cs = tid & 31;
    const int ccol = (cs < 16 ? 0 : 512) + h * 128 + 8 * (cs & 15);
    const int srow = tid >> 3, sseg = tid & 7;
    u32x4 cr[7], vr0, vr1, mc0, mc1, cfr[4]; float gi = 0.f, gf = 0.f, nval = 0.f;
    { const int r0 = c * 64 + 4 * rg - 3;
#pragma unroll
      for (int i = 0; i < 7; ++i) { const int r = r0 + i; const u32x4 v_ = *(const u32x4*)(P + (rowbase + (r >= 0 ? r : 0)) * NP + ccol); cr[i] = (r >= 0) ? v_ : (u32x4){0u, 0u, 0u, 0u}; }
      const bf16_t* vp = P + (rowbase + c * 64 + srow) * NP + h * 128 + sseg * 16;
      vr0 = *(const u32x4*)(vp + 1024); vr1 = *(const u32x4*)(vp + 1032); mc0 = *(const u32x4*)(vp + 1536); mc1 = *(const u32x4*)(vp + 1544);
      if (w == 0) { const float* gp = GATES + (rowbase + c * 64 + lane) * 8 + h; gi = gp[0]; gf = gp[4]; }
#pragma unroll
      for (int k2 = 0; k2 < 4; ++k2) cfr[k2] = CST[((size_t)(item * 8 + w) * 4 + k2) * 64 + lane];
      if (tid < 128) nval = NST[item * 128 + tid]; }
    const float mc = MCg[item];
    if (h != last_h) {
        for (int i = tid; i < 1280; i += 512) { const int j = i >> 8, ch = i & 255, cch = (ch < 128 ? h * 128 + ch : 512 + h * 128 + ch - 128);
            cw[i] = (j < 4) ? A.conv_w[j * 1024 + cch] : A.conv_b[cch]; }
        last_h = h;
        __syncthreads();
    }
    {
        float wt[5][8];
#pragma unroll
        for (int j = 0; j < 5; ++j) { const f32x4 a = *(const LAS f32x4*)(cw + j * 256 + 8 * cs), bb = *(const LAS f32x4*)(cw + j * 256 + 8 * cs + 4);
            wt[j][0] = a[0]; wt[j][1] = a[1]; wt[j][2] = a[2]; wt[j][3] = a[3]; wt[j][4] = bb[0]; wt[j][5] = bb[1]; wt[j][6] = bb[2]; wt[j][7] = bb[3]; }
        const float osc = (cs < 16) ? 1.0f : 0.08838834764831845f;
        LAS unsigned char* dst = (cs < 16 ? Qs : Ks) + (4 * rg) * MQ_STRIDE + 16 * (cs & 15);
#pragma unroll
        for (int r = 0; r < 4; ++r) {
            float ov[8];
#pragma unroll
            for (int e = 0; e < 8; ++e) ov[e] = wt[4][e];
#pragma unroll
            for (int j = 0; j < 4; ++j) { const u32x4 x = cr[r + j];
                ov[0] += wt[j][0] * bflo(x.x); ov[1] += wt[j][1] * bfhi(x.x); ov[2] += wt[j][2] * bflo(x.y); ov[3] += wt[j][3] * bfhi(x.y);
                ov[4] += wt[j][4] * bflo(x.z); ov[5] += wt[j][5] * bfhi(x.z); ov[6] += wt[j][6] * bflo(x.w); ov[7] += wt[j][7] * bfhi(x.w); }
#pragma unroll
            for (int e = 0; e < 8; ++e) ov[e] = osc * ov[e] * __builtin_amdgcn_rcpf(1.f + __expf(-ov[e]));
            u32x4 o4; o4.x = pk2(ov[0], ov[1]); o4.y = pk2(ov[2], ov[3]); o4.z = pk2(ov[4], ov[5]); o4.w = pk2(ov[6], ov[7]);
            *(LAS u32x4*)(dst + r * MQ_STRIDE) = o4;
        }
        LAS unsigned char* vd = Vs + srow * MV_STRIDE + sseg * 32; *(LAS u32x4*)vd = vr0; *(LAS u32x4*)(vd + 16) = vr1;
        if (tid < 128) nS[tid] = nval;
        if (w == 0) {
            float bc = gf;
#pragma unroll
            for (int o = 1; o < 64; o <<= 1) { const float t = __shfl_up(bc, o); if (lane >= o) bc += t; }
            const float e = gi - bc; float cm = e;
#pragma unroll
            for (int o = 1; o < 64; o <<= 1) { const float t = __shfl_up(cm, o); if (lane >= o) cm = fmaxf(cm, t); }
            const float gt = fmaxf(mc, cm);
            eS[lane] = e; gS[lane] = gt; bS[lane] = bc; iS[lane] = __expf(mc - gt);
        }
    }
    __syncthreads();
    {
        const int st = w >> 1;
#pragma unroll
        for (int ti = 0; ti < 2; ++ti) { const int tt = 2 * (w & 1) + ti;
            f32x4 a = (f32x4){0.f, 0.f, 0.f, 0.f};
#pragma unroll
            for (int ks = 0; ks < 4; ++ks) { const bf16x8 kf = *(const LAS bf16x8*)(Ks + (16 * st + l15) * MQ_STRIDE + (32 * ks + 8 * g) * 2);
                const bf16x8 qf = *(const LAS bf16x8*)(Qs + (16 * tt + l15) * MQ_STRIDE + (32 * ks + 8 * g) * 2); a = MFMA16(kf, qf, a); }
            const int t = 16 * tt + l15; const float gt = gS[t];
            float pv[4];
#pragma unroll
            for (int r = 0; r < 4; ++r) { const int s_ = 16 * st + 4 * g + r; pv[r] = (s_ <= t) ? a[r] * __expf(eS[s_] - gt) : 0.f; }
            u32x2 pw; pw.x = pk2(pv[0], pv[1]); pw.y = pk2(pv[2], pv[3]);
            *(LAS u32x2*)(Ps + t * MP_STRIDE + (16 * st + 4 * g) * 2) = pw;
        }
    }
    __syncthreads();
    {
        f32x4 apv[4], aqc[4];
#pragma unroll
        for (int tt = 0; tt < 4; ++tt) { apv[tt] = (f32x4){0.f, 0.f, 0.f, 0.f}; aqc[tt] = (f32x4){0.f, 0.f, 0.f, 0.f}; }
#pragma unroll
        for (int ks = 0; ks < 2; ++ks) {
            LAS unsigned char* a0 = Vs + (32 * ks + 8 * g + (l15 >> 2)) * MV_STRIDE + (16 * w + 4 * (lane & 3)) * 2;
            const bf16x8 vf = cat8(vtr(a0), vtr(a0 + 4 * MV_STRIDE));
#pragma unroll
            for (int tt = 0; tt < 4; ++tt) { const bf16x8 pf = *(const LAS bf16x8*)(Ps + (16 * tt + l15) * MP_STRIDE + (32 * ks + 8 * g) * 2); apv[tt] = MFMA16(pf, vf, apv[tt]); }
        }
#pragma unroll
        for (int k2 = 0; k2 < 4; ++k2) {
            const bf16x8 cf = __builtin_bit_cast(bf16x8, cfr[k2]);
#pragma unroll
            for (int tt = 0; tt < 4; ++tt) { LAS unsigned char* qa = Qs + (16 * tt + l15) * MQ_STRIDE + (32 * k2 + 4 * g) * 2;
                const bf16x8 qf = cat8(*(const LAS s16x4*)qa, *(const LAS s16x4*)(qa + 32)); aqc[tt] = MFMA16(qf, cf, aqc[tt]); }
        }
#pragma unroll
        for (int tt = 0; tt < 4; ++tt)
#pragma unroll
            for (int r = 0; r < 4; ++r) { const int t = 16 * tt + 4 * g + r; Hn[t * MH_STRIDE + 16 * w + l15] = apv[tt][r] + iS[t] * aqc[tt][r]; }
        { const int t = srow, j = sseg;
          const u32x4 pr = *(const LAS u32x4*)(Ps + t * MP_STRIDE + 16 * j);
          float rs = (bflo(pr.x) + bfhi(pr.x)) + (bflo(pr.y) + bfhi(pr.y)) + (bflo(pr.z) + bfhi(pr.z)) + (bflo(pr.w) + bfhi(pr.w));
          const u32x4 q0 = *(const LAS u32x4*)(Qs + t * MQ_STRIDE + 32 * j), q1 = *(const LAS u32x4*)(Qs + t * MQ_STRIDE + 32 * j + 16);
          const f32x4 n0 = *(const LAS f32x4*)(nS + 16 * j), n1 = *(const LAS f32x4*)(nS + 16 * j + 4), n2 = *(const LAS f32x4*)(nS + 16 * j + 8), n3 = *(const LAS f32x4*)(nS + 16 * j + 12);
          float qn = bflo(q0.x) * n0[0] + bfhi(q0.x) * n0[1] + bflo(q0.y) * n0[2] + bfhi(q0.y) * n0[3] + bflo(q0.z) * n1[0] + bfhi(q0.z) * n1[1] + bflo(q0.w) * n1[2] + bfhi(q0.w) * n1[3]
                   + bflo(q1.x) * n2[0] + bfhi(q1.x) * n2[1] + bflo(q1.y) * n2[2] + bfhi(q1.y) * n2[3] + bflo(q1.z) * n3[0] + bfhi(q1.z) * n3[1] + bflo(q1.w) * n3[2] + bfhi(q1.w) * n3[3];
          float d = rs + iS[t] * qn;
          d += __shfl_xor(d, 1); d += __shfl_xor(d, 2); d += __shfl_xor(d, 4);
          if (j == 0) { const float fl = __expf(-(bS[t] + gS[t])); sm[SM_R + t] = 1.f / fmaxf(fabsf(d), fl); } }
    }
    __syncthreads();
    {
        const int t = srow, j = sseg; const float rd = sm[SM_R + t];
        float hv[16]; float ss = 0.f;
#pragma unroll
        for (int q = 0; q < 4; ++q) { const f32x4 x = *(const LAS f32x4*)(Hn + t * MH_STRIDE + 16 * j + 4 * q);
#pragma unroll
            for (int e = 0; e < 4; ++e) { const float v = x[e] * rd; hv[4 * q + e] = v; ss += v * v; } }
        ss += __shfl_xor(ss, 1); ss += __shfl_xor(ss, 2); ss += __shfl_xor(ss, 4);
        const float rstd = rsqrtf(ss * (1.f / 128.f) + 1e-6f);
        const unsigned mo[8] = {mc0.x, mc0.y, mc0.z, mc0.w, mc1.x, mc1.y, mc1.z, mc1.w};
        unsigned ow[8];
#pragma unroll
        for (int q = 0; q < 8; ++q) { const float g0 = A.mnorm_g[h * 128 + 16 * j + 2 * q], g1 = A.mnorm_g[h * 128 + 16 * j + 2 * q + 1];
            const float z0 = bflo(mo[q]), z1 = bfhi(mo[q]);
            ow[q] = pk2(hv[2 * q] * rstd * g0 * __builtin_amdgcn_rcpf(1.f + __expf(-z0)), hv[2 * q + 1] * rstd * g1 * __builtin_amdgcn_rcpf(1.f + __expf(-z1))); }
        bf16_t* op = ACT + (rowbase + c * 64 + t) * 1024 + h * 128 + 16 * j;
        *(u32x4*)op = (u32x4){ow[0], ow[1], ow[2], ow[3]}; *(u32x4*)(op + 8) = (u32x4){ow[4], ow[5], ow[6], ow[7]};
    }
}

__device__ __forceinline__ void phase3(const Args& A, LAS unsigned char* lds, int rep = 0) {
    const int tid = threadIdx.x;
    const float lam = ((const float*)(A.ws + WS_CTL))[1];
    unsigned* ctr = (unsigned*)(A.ws + WS_CTL) + 2 * rep;
    LAS int* slot = (LAS int*)(lds + LDS_BYTES - 64);
    const int nml = ((int)gridDim.x > 64) ? 32 : 1;
    if ((int)blockIdx.x < nml) for (int bh = blockIdx.x; bh < 32; bh += nml) mlstm_state(A, lds, bh >> 2, bh & 3);
    for (;;) {
        if (tid == 0) slot[0] = (int)atomicAdd(ctr, 1u);
        __syncthreads();
        const int it = slot[0];
        __syncthreads();
        if (it >= 512) break;
        attn_item(A, lds, (it & 31) >> 2, it & 3, 15 - (it >> 5), lam);
    }
    {
        const int lane = tid & 63, wave = tid >> 6;
        LAS float* scr = (LAS float*)(lds + wave * 16384);
        for (int r = blockIdx.x * 8 + wave; r < 1536; r += gridDim.x * 8) {
            if (r < 512) transpose_item(A.w_out, 1024, 0, (bf16_t*)(A.ws + WS_WOUT), scr, r / 32, r % 32, lane);
            else wprime_item(A, (r - 512) >> 6, (r - 512) & 63, lane);
        }
        quantise_tables(A, blockIdx.x * 8 + wave, gridDim.x * 8, 16384, 32768);
    }
}
__device__ __forceinline__ void phase3b(const Args& A, LAS unsigned char* lds) {
    const int tid = threadIdx.x;
    {
        const int lane = tid & 63, wave = tid >> 6;
        const bf16_t* WT = (const bf16_t*)(A.ws + WS_WQ); const float* MOD = (const float*)(A.ws + WS_MOD); float* SB = (float*)(A.ws + WS_SB);
        for (int n = blockIdx.x * 8 + wave; n < 2048; n += gridDim.x * 8) {
            const u32x4 w0 = *(const u32x4*)(WT + (size_t)n * 1024 + 16 * lane), w1 = *(const u32x4*)(WT + (size_t)n * 1024 + 16 * lane + 8);
            const unsigned ww[8] = {w0.x, w0.y, w0.z, w0.w, w1.x, w1.y, w1.z, w1.w};
            float sbv[8];
#pragma unroll
            for (int b = 0; b < 8; ++b) { const float* sp = MOD + b * 6144 + 3072 + 16 * lane; float d = 0.f;
#pragma unroll
                for (int q = 0; q < 4; ++q) { const f32x4 s4 = *(const f32x4*)(sp + 4 * q); d += bflo(ww[2 * q]) * s4[0] + bfhi(ww[2 * q]) * s4[1] + bflo(ww[2 * q + 1]) * s4[2] + bfhi(ww[2 * q + 1]) * s4[3]; }
                sbv[b] = wave_sum(d); }
            if (lane == 0) {
#pragma unroll
                for (int b = 0; b < 8; ++b) SB[b * 2048 + n] = sbv[b]; }
        }
    }
    int last_h = -1;
    for (int item = blockIdx.x; item < 1024; item += gridDim.x) mlstm_out(A, lds, item, last_h);
    __syncthreads();
}

__device__ __forceinline__ void phase5(const Args& A) {
    int tid_o = threadIdx.x; asm volatile("" : "+v"(tid_o)); const int tid = tid_o, lane = tid & 63, wave = tid >> 6, G = gridDim.x;
    const float* MOD = (const float*)(A.ws + WS_MOD);
    bf16_t* ACT = (bf16_t*)(A.ws + WS_ACT);
    for (int m = blockIdx.x * 8 + wave; m < T; m += G * 8) {
        const int b = m >> 11;
        const f32x4* xr = (const f32x4*)(A.out + (size_t)m * 1024) + lane;
        f32x4 v[4]; float ss = 0.f;
#pragma unroll
        for (int j = 0; j < 4; ++j) { v[j] = xr[64 * j]; ss += (v[j][0] * v[j][0] + v[j][1] * v[j][1]) + (v[j][2] * v[j][2] + v[j][3] * v[j][3]); }
        const float rstd = rsqrtf(wave_sum(ss) * (1.f / 1024.f) + 1e-6f);
        unsigned long long* o8 = (unsigned long long*)(ACT + (size_t)m * 1024) + lane;
#pragma unroll
        for (int j = 0; j < 4; ++j) { const int col = 4 * lane + 256 * j;
            const f32x4 g = *(const f32x4*)(A.norm2_g + col), sc = *(const f32x4*)(MOD + b * 6144 + 4096 + col), sh = *(const f32x4*)(MOD + b * 6144 + 3072 + col);
            v[j] = v[j] * rstd * g * (sc + 1.0f) + sh;
            o8[64 * j] = (unsigned long long)pk2(v[j][0], v[j][1]) | ((unsigned long long)pk2(v[j][2], v[j][3]) << 32); }
    }
}

__device__ __forceinline__ unsigned f2key(float f) { const unsigned u = __float_as_uint(f); return (u & 0x80000000u) ? ~u : (u | 0x80000000u); }
__device__ __forceinline__ float key2f(unsigned k) { const unsigned u = (k & 0x80000000u) ? (k & 0x7fffffffu) : ~k; return __uint_as_float(u); }
#define CE_DESC(a, b) do { const unsigned _mx = (a) > (b) ? (a) : (b), _mn = (a) > (b) ? (b) : (a); (a) = _mx; (b) = _mn; } while (0)
__device__ __forceinline__ void sort16_desc(unsigned (&k)[16]) {
#pragma unroll
    for (int size = 2; size <= 16; size <<= 1)
#pragma unroll
        for (int stride = size >> 1; stride > 0; stride >>= 1)
#pragma unroll
            for (int i = 0; i < 16; ++i) { const int j = i ^ stride;
                if (j > i) { if ((i & size) == 0) CE_DESC(k[i], k[j]); else CE_DESC(k[j], k[i]); } }
}
__device__ __forceinline__ void merge16(unsigned (&a)[16], const unsigned (&b)[16]) {
#pragma unroll
    for (int i = 0; i < 16; ++i) a[i] = a[i] > b[15 - i] ? a[i] : b[15 - i];
#pragma unroll
    for (int stride = 8; stride > 0; stride >>= 1)
#pragma unroll
        for (int i = 0; i < 16; ++i) { const int j = i ^ stride; if (j > i) CE_DESC(a[i], a[j]); }
}
constexpr int PE_IDX = 0, PE_SEL = 69632;
__device__ __forceinline__ float gelu_erf(float v) { return 0.5f * v * (1.f + erff(v * 0.70710678118654752f)); }
__device__ __forceinline__ float gelu_fast(float v) {
    const float av = fabsf(v), tt = __builtin_amdgcn_rcpf(av * 0.2316418882f + 1.0f);
    float q = tt * 0.5307027145f + (-0.7265760135f); q = q * tt + 0.7107068705f; q = q * tt + (-0.142248368f); q = q * tt + 0.127414796f; q = q * tt;
    const float e = __builtin_amdgcn_exp2f((v * v) * (-0.72134752044f));
    const float m = v * (q * e);
    return v < 0.f ? m : v - m;
}

__device__ __forceinline__ void peer_tile(const Args& A, LAS unsigned char* lds, int tile) {
    int tid_o = threadIdx.x; asm volatile("" : "+v"(tid_o)); const int tid = tid_o, lane = tid & 63, w = tid >> 6, g = lane >> 4, l15 = lane & 15;
    const bf16_t* QRY = (const bf16_t*)(A.ws + WS_QRY);
    const bf16_t* KEYS = (const bf16_t*)(A.ws + WS_KEYS);
    const bf16_t* ACT = (const bf16_t*)(A.ws + WS_ACT);
    const float* MOD = (const float*)(A.ws + WS_MOD);
    LAS unsigned* idx = (LAS unsigned*)(lds + PE_IDX) + (w * 64 + lane) * 33;
    LAS u32x2* SEL = (LAS u32x2*)(lds + PE_SEL);
    {
        const int tg = w & 3, hg = w >> 2, tl = 16 * tg + l15;
        const size_t m = (size_t)tile * 64 + tl;
        unsigned LA[4][2][16];
#pragma unroll
        for (int hh = 0; hh < 4; ++hh) {
            const int h = 4 * hg + hh;
#pragma unroll
            for (int p = 0; p < 2; ++p) {
                const int hp = 2 * h + p;
                unsigned k0[16], k1[16];
                { const bf16_t* sp = QRY + m * 2048 + hp * 128 + 32 * g;
                  const u32x4 s0 = *(const u32x4*)sp, s1 = *(const u32x4*)(sp + 8), s2 = *(const u32x4*)(sp + 16), s3 = *(const u32x4*)(sp + 24);
                  const unsigned sw[16] = {s0.x, s0.y, s0.z, s0.w, s1.x, s1.y, s1.z, s1.w, s2.x, s2.y, s2.z, s2.w, s3.x, s3.y, s3.z, s3.w};
#pragma unroll
                  for (int i = 0; i < 16; ++i) {
                      const float lo = (float)__builtin_bit_cast(_Float16, (unsigned short)(sw[i] & 0xffffu)), hi = (float)__builtin_bit_cast(_Float16, (unsigned short)(sw[i] >> 16));
                      const unsigned klo = (f2key(lo) & ~127u) | (unsigned)(127 - (32 * g + 2 * i)), khi = (f2key(hi) & ~127u) | (unsigned)(127 - (32 * g + 2 * i + 1));
                      if (i < 8) { k0[2 * i] = klo; k0[2 * i + 1] = khi; } else { k1[2 * (i - 8)] = klo; k1[2 * (i - 8) + 1] = khi; } } }
                sort16_desc(k0); sort16_desc(k1); merge16(k0, k1);
#pragma unroll
                for (int msk = 16; msk <= 32; msk <<= 1) {
#pragma unroll
                    for (int i = 0; i < 16; ++i) k1[i] = (unsigned)__shfl_xor((int)k0[i], msk);
                    merge16(k0, k1); }
#pragma unroll
                for (int i = 0; i < 16; ++i) LA[hh][p][i] = k0[i];
            }
        }
        {
            const int h = 4 * hg + g;
            unsigned L2[2][16];
#pragma unroll
            for (int p = 0; p < 2; ++p)
#pragma unroll
                for (int i = 0; i < 16; ++i) L2[p][i] = (g & 2) ? ((g & 1) ? LA[3][p][i] : LA[2][p][i]) : ((g & 1) ? LA[1][p][i] : LA[0][p][i]);
            float va[16], vb[16];
#pragma unroll
            for (int i = 0; i < 16; ++i) { va[i] = key2f(L2[0][i] & ~127u); vb[i] = key2f(L2[1][i] & ~127u); idx[i] = 127u - (L2[0][i] & 127u); idx[16 + i] = 127u - (L2[1][i] & 127u); }
#define CK(i, j) ((f2key(va[i] + vb[j]) & ~255u) | (unsigned)(255 - (16 * (i) + (j))))
            unsigned Lf[16], Bt[16];
#pragma unroll
            for (int j = 0; j < 16; ++j) Lf[j] = CK(0, j);
#pragma unroll
            for (int j = 0; j < 8; ++j) Bt[j] = CK(1, j);
#pragma unroll
            for (int j = 0; j < 5; ++j) Bt[8 + j] = CK(2, j);
#pragma unroll
            for (int j = 0; j < 3; ++j) Bt[13 + j] = CK(4, j);
            sort16_desc(Bt); merge16(Lf, Bt);
#pragma unroll
            for (int j = 0; j < 4; ++j) Bt[j] = CK(3, j);
            Bt[4] = CK(5, 0); Bt[5] = CK(5, 1); Bt[6] = CK(6, 0); Bt[7] = CK(6, 1); Bt[8] = CK(7, 0); Bt[9] = CK(7, 1);
            Bt[10] = CK(8, 0); Bt[11] = CK(9, 0); Bt[12] = CK(10, 0); Bt[13] = CK(11, 0); Bt[14] = CK(12, 0); Bt[15] = CK(13, 0);
            sort16_desc(Bt); merge16(Lf, Bt);
            { unsigned x0 = CK(14, 0), x1 = CK(15, 0);
#pragma unroll
              for (int i = 0; i < 16; ++i) CE_DESC(Lf[i], x0);
#pragma unroll
              for (int i = 0; i < 16; ++i) CE_DESC(Lf[i], x1); }
#undef CK
            float fv[16], den = 0.f; const float f0 = key2f(Lf[0] & ~255u);
#pragma unroll
            for (int k = 0; k < 16; ++k) { fv[k] = __expf(key2f(Lf[k] & ~255u) - f0); den += fv[k]; }
            const float rden = 1.f / den;
            LDS_WAIT();
#pragma unroll
            for (int k = 0; k < 16; ++k) { const unsigned code = 255u - (Lf[k] & 255u); const unsigned e = idx[code >> 4] * 128u + idx[16 + (code & 15u)];
                u32x2 sv; sv.x = e; sv.y = __float_as_uint(fv[k] * rden); SEL[(tl * 8 + h) * 16 + k] = sv; }
        }
    }
    __syncthreads();
    const unsigned char* T8 = A.ws + WS_T8; const float* SC = (const float*)(A.ws + WS_SC);
    LAS u32x2* SORT = (LAS u32x2*)(lds + PE_IDX);
    LAS int* OFFS = (LAS int*)(lds + PE_SEL + 65536);
    for (int ti = 0; ti < 8; ++ti) {
        const int tl = 8 * w + ti;
        const u32x2 e0 = SEL[tl * 128 + lane], e1 = SEL[tl * 128 + 64 + lane];
        const int p0 = (int)(e0.x >> 10), p1 = (int)(e1.x >> 10);
        int off = 0;
        for (int p = 0; p < 16; ++p) {
            const unsigned long long m0 = __ballot(p0 == p), m1 = __ballot(p1 == p);
            const int c0 = __popcll(m0), c1 = __popcll(m1);
            const int r0 = __builtin_amdgcn_mbcnt_hi((unsigned)(m0 >> 32), __builtin_amdgcn_mbcnt_lo((unsigned)m0, 0u));
            const int r1 = __builtin_amdgcn_mbcnt_hi((unsigned)(m1 >> 32), __builtin_amdgcn_mbcnt_lo((unsigned)m1, 0u));
            if (p0 == p) SORT[tl * 128 + off + r0] = e0;
            if (p1 == p) SORT[tl * 128 + off + c0 + r1] = e1;
            if (lane == 0) OFFS[tl * 17 + p] = off;
            off += c0 + c1;
        }
        if (lane == 0) OFFS[tl * 17 + 16] = off;
    }
    LDS_WAIT(); __builtin_amdgcn_wave_barrier();
    const unsigned char* T8v = T8 + (size_t)16384 * 1024;
    const bf16_t* A3 = (const bf16_t*)(A.ws + WS_A3); const float* RSq = (const float*)(A.ws + WS_RS);
    for (int pass = 0; pass < 2; ++pass) {
        const int tb = 8 * w + 4 * pass;
        u32x4 xpa[4], xpb[4]; f32x2 oacc[4][8];
#pragma unroll
        for (int tk = 0; tk < 4; ++tk) { const size_t m = (size_t)tile * 64 + tb + tk;
            { const u32x4 ra = *(const u32x4*)(A3 + m * 1024 + 16 * lane), rb = *(const u32x4*)(A3 + m * 1024 + 16 * lane + 8);
              float xr_; { const f32x4 p0 = *(const f32x4*)(RSq + m * 16), p1 = *(const f32x4*)(RSq + m * 16 + 4), p2 = *(const f32x4*)(RSq + m * 16 + 8), p3 = *(const f32x4*)(RSq + m * 16 + 12);
                const f32x4 ps = (p0 + p1) + (p2 + p3); xr_ = rsqrtf(((ps[0] + ps[1]) + (ps[2] + ps[3])) * (1.f / 1024.f) + 1e-6f); }
              const unsigned rr[8] = {ra.x, ra.y, ra.z, ra.w, rb.x, rb.y, rb.z, rb.w}; unsigned hh[8];
              const float* sp = MOD + (int)(m >> 11) * 6144 + 3072 + 16 * lane;
#pragma unroll
              for (int q = 0; q < 8; ++q) { const f32x2 sh = *(const f32x2*)(sp + 2 * q); hh[q] = pk2(bflo(rr[q]) * xr_ + sh[0], bfhi(rr[q]) * xr_ + sh[1]); }
              xpa[tk] = (u32x4){hh[0], hh[1], hh[2], hh[3]}; xpb[tk] = (u32x4){hh[4], hh[5], hh[6], hh[7]}; }
#pragma unroll
            for (int q = 0; q < 8; ++q) oacc[tk][q] = (f32x2){0.f, 0.f}; }
        int it_p = 0, it_tk = -1, it_j = 0, it_end = 0; bool it_done = false;
#define IT_ADVANCE() do { it_j += 4; while (it_j >= it_end) { if (it_done) break; ++it_tk; if (it_tk == 4) { it_tk = 0; ++it_p; if (it_p == 16) { it_done = true; it_p = 15; it_j = 0; it_end = 1; break; } } \
            it_j = __builtin_amdgcn_readfirstlane(OFFS[(tb + it_tk) * 17 + it_p]); it_end = __builtin_amdgcn_readfirstlane(OFFS[(tb + it_tk) * 17 + it_p + 1]); } } while (0)
#define LOAD_SET(U, V, CG, SU, SV) do { const int _tl = tb + it_tk; \
            _Pragma("unroll") for (int _k = 0; _k < 4; ++_k) { const int _jj = (it_j + _k < it_end) ? it_j + _k : it_end - 1; const unsigned _e = SORT[_tl * 128 + _jj].x; \
                U[_k] = *(const u32x4*)(T8 + (size_t)_e * 1024 + 16 * lane); V[_k] = *(const u32x4*)(T8v + (size_t)_e * 1024 + 16 * lane); } \
            const int _ms = lane >> 4; const bool _valid = it_j + _ms < it_end; const u32x2 _se = SORT[_tl * 128 + (_valid ? it_j + _ms : it_end - 1)]; \
            CG = _valid ? __uint_as_float(_se.y) : 0.f; SU = SC[_se.x]; SV = SC[16384 + _se.x]; } while (0)
        u32x4 uA[4], vA[4], uB[4], vB[4]; float cgA = 0.f, suA = 0.f, svA = 0.f, cgB = 0.f, suB = 0.f, svB = 0.f;
#pragma unroll
        for (int k = 0; k < 4; ++k) { uA[k] = (u32x4){0u, 0u, 0u, 0u}; vA[k] = uA[k]; uB[k] = uA[k]; vB[k] = uA[k]; }
        IT_ADVANCE();
        LOAD_SET(uA, vA, cgA, suA, svA);
        for (int p = 0; p < 16; ++p) {
#pragma unroll
            for (int tk = 0; tk < 4; ++tk) {
                const int tl = tb + tk;
                const int beg = __builtin_amdgcn_readfirstlane(OFFS[tl * 17 + p]), end = __builtin_amdgcn_readfirstlane(OFFS[tl * 17 + p + 1]);
                f32x2 xf[8];
                { const unsigned xx[8] = {xpa[tk].x, xpa[tk].y, xpa[tk].z, xpa[tk].w, xpb[tk].x, xpb[tk].y, xpb[tk].z, xpb[tk].w};
#pragma unroll
                  for (int q = 0; q < 8; ++q) xf[q] = (f32x2){bflo(xx[q]), bfhi(xx[q])}; }
#define COMPUTE_SET(U, V, CG, SU, SV) do { float pd[4]; \
                    _Pragma("unroll") for (int k = 0; k < 4; ++k) { f32x2 d = (f32x2){0.f, 0.f}; \
                        _Pragma("unroll") for (int q = 0; q < 4; ++q) { const int dw = (int)U[k][q]; \
                            d += __builtin_amdgcn_cvt_pk_f32_fp8(dw, false) * xf[2 * q]; d += __builtin_amdgcn_cvt_pk_f32_fp8(dw, true) * xf[2 * q + 1]; } \
                        pd[k] = d[0] + d[1]; } \
                    float s; \
                    { const auto r0 = __builtin_amdgcn_permlane32_swap(__float_as_uint(pd[0]), __float_as_uint(pd[2]), false, false); \
                      const auto r1 = __builtin_amdgcn_permlane32_swap(__float_as_uint(pd[1]), __float_as_uint(pd[3]), false, false); \
                      const float a0 = __uint_as_float(r0[0]) + __uint_as_float(r0[1]), a1 = __uint_as_float(r1[0]) + __uint_as_float(r1[1]); \
                      const auto r2 = __builtin_amdgcn_permlane16_swap(__float_as_uint(a0), __float_as_uint(a1), false, false); \
                      s = __uint_as_float(r2[0]) + __uint_as_float(r2[1]); \
                      s += __int_as_float(__builtin_amdgcn_mov_dpp(__float_as_int(s), 0xB1, 0xF, 0xF, true)); \
                      s += __int_as_float(__builtin_amdgcn_mov_dpp(__float_as_int(s), 0x4E, 0xF, 0xF, true)); \
                      s += __int_as_float(__builtin_amdgcn_mov_dpp(__float_as_int(s), 0x141, 0xF, 0xF, true)); \
                      s += __int_as_float(__builtin_amdgcn_mov_dpp(__float_as_int(s), 0x140, 0xF, 0xF, true)); } \
                    const float coef = CG * gelu_fast(s * SU) * SV; \
                    _Pragma("unroll") for (int k = 0; k < 4; ++k) { const float ck = __int_as_float(__builtin_amdgcn_readlane(__float_as_int(coef), 16 * k)); const f32x2 ck2 = (f32x2){ck, ck}; \
                        _Pragma("unroll") for (int qq = 0; qq < 4; ++qq) { const int dw = (int)V[k][qq]; \
                            oacc[tk][2 * qq] += ck2 * __builtin_amdgcn_cvt_pk_f32_fp8(dw, false); oacc[tk][2 * qq + 1] += ck2 * __builtin_amdgcn_cvt_pk_f32_fp8(dw, true); } } } while (0)
                for (int j0 = beg; j0 < end; j0 += 8) {
                    IT_ADVANCE();
                    LOAD_SET(uB, vB, cgB, suB, svB);
                    COMPUTE_SET(uA, vA, cgA, suA, svA);
                    if (j0 + 4 < end) {
                        IT_ADVANCE();
                        LOAD_SET(uA, vA, cgA, suA, svA);
                        COMPUTE_SET(uB, vB, cgB, suB, svB);
                    } else {
#pragma unroll
                        for (int k = 0; k < 4; ++k) { uA[k] = uB[k]; vA[k] = vB[k]; }
                        cgA = cgB; suA = suB; svA = svB;
                    }
                }
            }
        }
#undef COMPUTE_SET
#undef IT_ADVANCE
#undef LOAD_SET
#pragma unroll
        for (int tk = 0; tk < 4; ++tk) {
            const size_t m = (size_t)tile * 64 + tb + tk; const int b = (int)(m >> 11);
            float* orow = A.out + m * 1024 + 16 * lane;
            const float* g2 = MOD + b * 6144 + 5120 + 16 * lane;
            f32x4 xv[4]; float ss = 0.f;
#pragma unroll
            for (int j = 0; j < 4; ++j) { const f32x4 x1 = *(const f32x4*)(orow + 4 * j), gg = *(const f32x4*)(g2 + 4 * j);
                const f32x4 pe = (f32x4){oacc[tk][2 * j][0], oacc[tk][2 * j][1], oacc[tk][2 * j + 1][0], oacc[tk][2 * j + 1][1]};
                xv[j] = x1 + gg * pe; ss += (xv[j][0] * xv[j][0] + xv[j][1] * xv[j][1]) + (xv[j][2] * xv[j][2] + xv[j][3] * xv[j][3]); }
            const float rstd = rsqrtf(wave_sum(ss) * (1.f / 1024.f) + 1e-6f);
#pragma unroll
            for (int j = 0; j < 4; ++j) { const f32x4 fg = *(const f32x4*)(A.final_g + 16 * lane + 4 * j); *(f32x4*)(orow + 4 * j) = xv[j] * rstd * fg; }
        }
    }
    __syncthreads();
}


#define XB_TMO      128
#define XB_XCNT(j)  (256  + 64 * (j))
#define XB_XSUB(j)  (1280 + 64 * (j))
#define XB_XGEN(j)  (2304 + 64 * (j))
#define XB_TOP      3328
#define XB_TOPGEN   3392
#define XCD_BAR_WORDS 3456
#define XB_SPIN_CAP (1u << 18)

__device__ __forceinline__ unsigned xb_ld(unsigned* p)              { return __hip_atomic_load(p, __ATOMIC_RELAXED, __HIP_MEMORY_SCOPE_AGENT); }
__device__ __forceinline__ unsigned xb_add(unsigned* p, unsigned v) { return __hip_atomic_fetch_add(p, v, __ATOMIC_RELAXED, __HIP_MEMORY_SCOPE_AGENT); }
__device__ __forceinline__ unsigned xb_xcc_id() { return (unsigned)__builtin_amdgcn_s_getreg((3 << 11) | 20) & 0xFu; }
#define XB_SPIN(cond, bar) do { unsigned _sp = 0; while (cond) { __builtin_amdgcn_s_sleep(1); \
    if ((++_sp & 255u) == 0u) { if (xb_ld(&(bar)[XB_TMO])) break; if (_sp > XB_SPIN_CAP) { atomicAdd(&(bar)[XB_TMO], 1u); break; } } } } while (0)

struct XcdBarrier {
    unsigned* bar; unsigned x;
    volatile LAS unsigned* st;
};

__device__ __forceinline__ XcdBarrier xcd_barrier_post(unsigned* bar, volatile LAS unsigned* st) {
    XcdBarrier b; b.bar = bar; b.x = xb_xcc_id(); b.st = st;
    if (threadIdx.x == 0) (void)xb_add(&bar[XB_XCNT(b.x)], 1u);
    return b;
}
__device__ __forceinline__ void xcd_barrier_complete(unsigned* bar, unsigned x, unsigned& nloc, unsigned& nx) {
    const unsigned G = gridDim.x * gridDim.y * gridDim.z;
    unsigned sum, cnt, mine, sp = 0u;
    for (;;) {
        sum = 0u; cnt = 0u; mine = 0u;
#pragma unroll
        for (unsigned j = 0; j < 16; ++j) { const unsigned c = xb_ld(&bar[XB_XCNT(j)]); sum += c; cnt += (c > 0u) ? 1u : 0u; mine = (j == x) ? c : mine; }
        if (sum == G) break;
        __builtin_amdgcn_s_sleep(1);
        if ((++sp & 255u) == 0u) { if (xb_ld(&bar[XB_TMO])) break; if (sp > XB_SPIN_CAP) { atomicAdd(&bar[XB_TMO], 1u); break; } }
    }
    nloc = mine > 0u ? mine : 1u; nx = cnt > 0u ? cnt : 1u;
}

__device__ __forceinline__ void xcd_barrier(const XcdBarrier& b) {
    asm volatile("s_waitcnt vmcnt(0)" ::: "memory");
    __syncthreads();
    if (threadIdx.x == 0) {
        unsigned* bar = b.bar;
        __builtin_amdgcn_s_waitcnt(0);
        unsigned nloc = b.st[0], nx = b.st[1];
        if (nloc == 0u) { xcd_barrier_complete(bar, b.x, nloc, nx); b.st[0] = nloc; b.st[1] = nx; }
        const unsigned old = xb_add(&bar[XB_XSUB(b.x)], 1u);
        const unsigned gen = old / nloc;
        if (old + 1u == (gen + 1u) * nloc) {
            __builtin_amdgcn_fence(__ATOMIC_RELEASE, "agent");
            asm volatile("s_waitcnt vmcnt(0)" ::: "memory");
            const unsigned og = xb_add(&bar[XB_TOP], 1u);
            const unsigned tg = og / nx;
            if (og + 1u == (tg + 1u) * nx) xb_add(&bar[XB_TOPGEN], 1u);
            else XB_SPIN(xb_ld(&bar[XB_TOPGEN]) == tg, bar);
            __builtin_amdgcn_fence(__ATOMIC_ACQUIRE, "agent");
            xb_add(&bar[XB_XGEN(b.x)], 1u);
            asm volatile("s_waitcnt vmcnt(0)" ::: "memory");
        } else {
            XB_SPIN(xb_ld(&bar[XB_XGEN(b.x)]) == gen, bar);
            __builtin_amdgcn_fence(__ATOMIC_ACQUIRE, "agent");
            asm volatile("s_waitcnt vmcnt(0)" ::: "memory");
        }
    }
    __syncthreads();
}

__global__ void __launch_bounds__(512, 2) mega_fwd(Args A) {
    extern __shared__ __attribute__((aligned(16))) unsigned char lds_raw[];
    LAS unsigned char* lds = (LAS unsigned char*)lds_raw;
    cg::grid_group grid = cg::this_grid();
    const int G = gridDim.x;
    if (threadIdx.x < 4) ((LAS unsigned*)(lds + LDS_BYTES - 32))[threadIdx.x] = 0u;
    __syncthreads();
    if (A.ws == nullptr) grid.sync();
    const XcdBarrier xb = xcd_barrier_post((unsigned*)(A.ws + WS_BAR), (volatile LAS unsigned*)(lds + LDS_BYTES - 32));
    phase0(A, lds);
    xcd_barrier(xb);
    phase1(A, lds);
    phase0b(A, lds);
    xcd_barrier(xb);
    { pg8::Gemm gm{(const pg8::bf16_t*)(A.ws + WS_ACT), (const pg8::bf16_t*)(A.ws + WS_WIN), T, NP, DM}; pg8::StaticOrder S; S.init(T, NP, G, (int)blockIdx.x);
      pg8::EpiStoreBf16 E{(pg8::bf16_t*)(A.ws + WS_P), NP};
      pg8::gemm_phase<pg8::EpiStoreBf16, pg8::StaticOrder, true, true>((PG8_LAS unsigned char*)lds, gm, S, E); }
    { const int nshort = G - (896 % G == 0 ? 0 : 896 % G);
      const int first = G - nshort;
      if ((int)blockIdx.x >= first) quantise_tables(A, ((int)blockIdx.x - first) * 8 + (int)(threadIdx.x >> 6), nshort * 8, 0, 16384); }
    xcd_barrier(xb);
    phase3(A, lds);
    xcd_barrier(xb);
    phase3b(A, lds);
    xcd_barrier(xb);
    { pg8::Gemm gm{(const pg8::bf16_t*)(A.ws + WS_ACT), (const pg8::bf16_t*)(A.ws + WS_WOUT), T, DM, DM}; pg8::StaticOrder S; S.init(T, DM, G, (int)blockIdx.x);
      pg8::EpiResidNorm E{A.x, (const float*)(A.ws + WS_MOD), A.norm2_g, A.out, (pg8::bf16_t*)(A.ws + WS_A3), (float*)(A.ws + WS_RS)};
      pg8::gemm_phase<pg8::EpiResidNorm, pg8::StaticOrder, true, true>((PG8_LAS unsigned char*)lds, gm, S, E); }
    xcd_barrier(xb);
    { pg8::Gemm gm{(const pg8::bf16_t*)(A.ws + WS_A3), (const pg8::bf16_t*)(A.ws + WS_WQ), T, 2048, DM}; pg8::StaticOrder S; S.init(T, 2048, G, (int)blockIdx.x);
      pg8::EpiScoreF16 E{(pg8::bf16_t*)(A.ws + WS_QRY), 2048, (const float*)(A.ws + WS_RS), (const float*)(A.ws + WS_SB)};
      pg8::gemm_phase<pg8::EpiScoreF16, pg8::StaticOrder, true, true>((PG8_LAS unsigned char*)lds, gm, S, E); }
    xcd_barrier(xb);
    for (int tile = blockIdx.x; tile < T / 64; tile += G) peer_tile(A, lds, tile);
}

extern "C" void kernel_launch(void* const* d_in, const int* in_sizes, int n_in, void* d_out, int out_size, void* d_ws, size_t ws_size, hipStream_t stream) {
    static int grid = 0;
    if (grid == 0) {
        if (n_in != 22 || out_size != T * DM || ws_size < WS_END) { fprintf(stderr, "kernel_launch: unexpected shapes (n_in %d out %d ws %zu)\n", n_in, out_size, ws_size); grid = -1; return; }
        int dev = 0, cus = 0, per_cu = 0;
        if (hipGetDevice(&dev) != hipSuccess || hipDeviceGetAttribute(&cus, hipDeviceAttributeMultiprocessorCount, dev) != hipSuccess) { grid = -1; return; }
        if (hipFuncSetAttribute((const void*)mega_fwd, hipFuncAttributeMaxDynamicSharedMemorySize, LDS_BYTES) != hipSuccess) { fprintf(stderr, "kernel_launch: hipFuncSetAttribute failed\n"); grid = -1; return; }
        if (hipOccupancyMaxActiveBlocksPerMultiprocessor(&per_cu, (const void*)mega_fwd, 512, LDS_BYTES) != hipSuccess || per_cu < 1) { fprintf(stderr, "kernel_launch: occupancy query gave %d\n", per_cu); per_cu = 1; }
        (void)hipGetLastError();
        grid = cus * per_cu;
    }
    if (grid < 0) return;
    Args a{};
    const float** ap = (const float**)&a;
    for (int i = 0; i < 22; ++i) ap[i] = (const float*)d_in[i];
    a.out = (float*)d_out; a.ws = (unsigned char*)d_ws;
    if (hipMemsetAsync((unsigned char*)d_ws + WS_BAR, 0, XCD_BAR_WORDS * sizeof(unsigned), stream) != hipSuccess) { fprintf(stderr, "kernel_launch: memset of the barrier words failed\n"); return; }
    void* args[] = {&a};
    hipError_t e = hipLaunchCooperativeKernel((const void*)mega_fwd, dim3(grid), dim3(512), args, LDS_BYTES, stream);
    if (e != hipSuccess) fprintf(stderr, "kernel_launch: cooperative launch failed: %s (grid %d)\n", hipGetErrorString(e), grid);
}
```

```cpp
#include <hip/hip_runtime.h>
#include <hip/hip_cooperative_groups.h>
#include <cstdio>
#include <cstdint>
namespace cg = cooperative_groups;

namespace pg8 {
#define PG8_LAS __attribute__((address_space(3)))
typedef unsigned short bf16_t;
typedef short bf16x8 __attribute__((ext_vector_type(8)));
typedef float f32x4 __attribute__((ext_vector_type(4)));
typedef unsigned u32x4 __attribute__((ext_vector_type(4)));
constexpr int BM = 256, BK = 64, HALF = 128, HTB = HALF * BK * 2  , STAGE_BYTES = 8 * HTB, NXCD = 8, WGM = 8;

__host__ __device__ __forceinline__ int lds_byte(int r, int c) { const int st = (r >> 4) * 2 + (c >> 5), rr = r & 15, cc = c & 31, ob = rr * 64 + cc * 2; return st * 1024 + (ob ^ (((ob >> 9) & 1) << 5)); }
__host__ __device__ __forceinline__ void stage_rc(int b, int& R, int& C) { const int st = b / 1024, sb = b % 1024, swz = sb ^ (((sb >> 9) & 1) << 5); R = (st >> 1) * 16 + swz / 64; C = (st & 1) * 32 + (swz % 64) / 2; }
__host__ __device__ __forceinline__ int perm32(int rho) { const int n = rho >> 4, i = rho & 15; return 8 * (i >> 2) + 4 * n + (i & 3); }

struct Unit { int pm, pn; };
struct Gemm { const bf16_t* A; const bf16_t* Bt; int M, N, K; };

struct StaticOrder {
    int nM, nN, nwg, G, c;
    __host__ __device__ void init(int M, int N, int G_, int c_) { nM = M / BM; nN = N / BM; nwg = nM * nN; G = G_; c = c_; }
    __host__ __device__ bool next(int i, Unit& u) const {
        const long L = (long)i * G + c; if (L >= nwg) return false;
        int wgid = (int)L; { const int q = nwg / NXCD, r = nwg % NXCD, xcd = wgid % NXCD, off = wgid / NXCD; wgid = (xcd < r ? xcd * (q + 1) : r * (q + 1) + (xcd - r) * q) + off; }
        const int nig = WGM * nN, gid = wgid / nig, fm = gid * WGM, gsz = (nM - fm) < WGM ? (nM - fm) : WGM;
        u.pm = fm + ((wgid % nig) % gsz); u.pn = (wgid % nig) / gsz; return true;
    }
    __device__ __forceinline__ void a_ready(const Unit&) const {}
    __device__ __forceinline__ void done(const Unit&) const {}
};

__device__ __forceinline__ unsigned cvt_pk_bf16(float lo, float hi) { unsigned r; asm volatile("v_cvt_pk_bf16_f32 %0, %1, %2" : "=v"(r) : "v"(lo), "v"(hi)); return r; }

struct EpiStoreBf16 {
    static constexpr bool PERM = true, AFTER_DRAIN = false;
    bf16_t* O; int ldc;
    __device__ __forceinline__ void operator()(const f32x4 (&acc)[2][2][4][2], const Unit& u, int wr, int wc, int fr, int fq) const {
        const int row0 = u.pm * BM + wr * 64 + fr, col0 = u.pn * BM + wc * 32 + 8 * fq;
#pragma unroll
        for (int ai = 0; ai < 2; ++ai)
#pragma unroll
            for (int m = 0; m < 4; ++m) { bf16_t* rowp = O + (size_t)(row0 + ai * HALF + m * 16) * ldc + col0;
#pragma unroll
                for (int bj = 0; bj < 2; ++bj) { const f32x4 v0 = acc[ai][bj][m][0], v1 = acc[ai][bj][m][1];
                    u32x4 w; w.x = cvt_pk_bf16(v0[0], v0[1]); w.y = cvt_pk_bf16(v0[2], v0[3]); w.z = cvt_pk_bf16(v1[0], v1[1]); w.w = cvt_pk_bf16(v1[2], v1[3]);
                    *(u32x4*)(rowp + bj * HALF) = w; } }
    }
};
struct EpiStoreF16 {
    static constexpr bool PERM = true, AFTER_DRAIN = false;
    bf16_t* O; int ldc;
    static __device__ __forceinline__ unsigned pkh(float a, float b) { return (unsigned)__builtin_bit_cast(unsigned short, (_Float16)a) | ((unsigned)__builtin_bit_cast(unsigned short, (_Float16)b) << 16); }
    __device__ __forceinline__ void operator()(const f32x4 (&acc)[2][2][4][2], const Unit& u, int wr, int wc, int fr, int fq) const {
        const int row0 = u.pm * BM + wr * 64 + fr, col0 = u.pn * BM + wc * 32 + 8 * fq;
#pragma unroll
        for (int ai = 0; ai < 2; ++ai)
#pragma unroll
            for (int m = 0; m < 4; ++m) { bf16_t* rowp = O + (size_t)(row0 + ai * HALF + m * 16) * ldc + col0;
#pragma unroll
                for (int bj = 0; bj < 2; ++bj) { const f32x4 v0 = acc[ai][bj][m][0], v1 = acc[ai][bj][m][1];
                    u32x4 w; w.x = pkh(v0[0], v0[1]); w.y = pkh(v0[2], v0[3]); w.z = pkh(v1[0], v1[1]); w.w = pkh(v1[2], v1[3]);
                    *(u32x4*)(rowp + bj * HALF) = w; } }
    }
};
struct EpiResid {
    static constexpr bool PERM = true, AFTER_DRAIN = false;
    const float* x; const float* gate; float* out;
    __device__ __forceinline__ void operator()(const f32x4 (&acc)[2][2][4][2], const Unit& u, int wr, int wc, int fr, int fq) const {
        const int row0 = u.pm * BM + wr * 64 + fr, col0 = u.pn * BM + wc * 32 + 8 * fq;
#pragma unroll
        for (int ai = 0; ai < 2; ++ai)
#pragma unroll
            for (int m = 0; m < 4; ++m) { const int r = row0 + ai * HALF + m * 16; const float* gp = gate + (size_t)(r >> 11) * 6144;
#pragma unroll
                for (int bj = 0; bj < 2; ++bj) { const int c = col0 + bj * HALF;
                    const f32x4 xa = *(const f32x4*)(x + (size_t)r * 1024 + c), xb = *(const f32x4*)(x + (size_t)r * 1024 + c + 4);
                    const f32x4 ga = *(const f32x4*)(gp + c), gb = *(const f32x4*)(gp + c + 4);
                    *(f32x4*)(out + (size_t)r * 1024 + c) = xa + ga * acc[ai][bj][m][0];
                    *(f32x4*)(out + (size_t)r * 1024 + c + 4) = xb + gb * acc[ai][bj][m][1]; } }
    }
};
struct EpiResidNorm {
    static constexpr bool PERM = true, AFTER_DRAIN = false;
    const float* x; const float* mod; const float* ng; float* out; bf16_t* a3; float* rs;
    __device__ __forceinline__ void operator()(const f32x4 (&acc)[2][2][4][2], const Unit& u, int wr, int wc, int fr, int fq) const {
        const int row0 = u.pm * BM + wr * 64 + fr, col0 = u.pn * BM + wc * 32 + 8 * fq;
        const float* mp = mod + (size_t)((u.pm * BM) >> 11) * 6144;
        f32x4 g1v[2][2], csv[2][2];
#pragma unroll
        for (int bj = 0; bj < 2; ++bj)
#pragma unroll
            for (int n = 0; n < 2; ++n) { const int c = col0 + bj * HALF + 4 * n; g1v[bj][n] = *(const f32x4*)(mp + 2048 + c); csv[bj][n] = *(const f32x4*)(ng + c) * (*(const f32x4*)(mp + 4096 + c) + 1.0f); }
#pragma unroll
        for (int ai = 0; ai < 2; ++ai)
#pragma unroll
            for (int m = 0; m < 4; ++m) { const int r = row0 + ai * HALF + m * 16; float ss = 0.f;
#pragma unroll
                for (int bj = 0; bj < 2; ++bj) { const int c = col0 + bj * HALF;
                    const f32x4 xa = *(const f32x4*)(x + (size_t)r * 1024 + c), xb = *(const f32x4*)(x + (size_t)r * 1024 + c + 4);
                    const f32x4 v0 = xa + g1v[bj][0] * acc[ai][bj][m][0], v1 = xb + g1v[bj][1] * acc[ai][bj][m][1];
                    *(f32x4*)(out + (size_t)r * 1024 + c) = v0; *(f32x4*)(out + (size_t)r * 1024 + c + 4) = v1;
                    ss += (v0[0] * v0[0] + v0[1] * v0[1]) + (v0[2] * v0[2] + v0[3] * v0[3]) + (v1[0] * v1[0] + v1[1] * v1[1]) + (v1[2] * v1[2] + v1[3] * v1[3]);
                    const f32x4 a0 = v0 * csv[bj][0], a1 = v1 * csv[bj][1];
                    u32x4 w; w.x = cvt_pk_bf16(a0[0], a0[1]); w.y = cvt_pk_bf16(a0[2], a0[3]); w.z = cvt_pk_bf16(a1[0], a1[1]); w.w = cvt_pk_bf16(a1[2], a1[3]);
                    *(u32x4*)(a3 + (size_t)r * 1024 + c) = w; }
                ss += __shfl_xor(ss, 16); ss += __shfl_xor(ss, 32);
                if (fq == 0) rs[(size_t)r * 16 + (u.pn & 3) * 4 + wc] = ss; }
    }
};
struct EpiScoreF16 {
    static constexpr bool PERM = true, AFTER_DRAIN = false;
    bf16_t* O; int ldc; const float* rs; const float* sb;
    static __device__ __forceinline__ unsigned pkh(float a, float b) { return (unsigned)__builtin_bit_cast(unsigned short, (_Float16)a) | ((unsigned)__builtin_bit_cast(unsigned short, (_Float16)b) << 16); }
    __device__ __forceinline__ void operator()(const f32x4 (&acc)[2][2][4][2], const Unit& u, int wr, int wc, int fr, int fq) const {
        const int row0 = u.pm * BM + wr * 64 + fr, col0 = u.pn * BM + wc * 32 + 8 * fq;
        const float* sbp = sb + (size_t)((u.pm * BM) >> 11) * 2048;
        f32x4 bv[2][2];
#pragma unroll
        for (int bj = 0; bj < 2; ++bj)
#pragma unroll
            for (int n = 0; n < 2; ++n) bv[bj][n] = *(const f32x4*)(sbp + col0 + bj * HALF + 4 * n);
#pragma unroll
        for (int ai = 0; ai < 2; ++ai)
#pragma unroll
            for (int m = 0; m < 4; ++m) { const int r = row0 + ai * HALF + m * 16;
                float rstd; { const f32x4 p0 = *(const f32x4*)(rs + (size_t)r * 16), p1 = *(const f32x4*)(rs + (size_t)r * 16 + 4), p2 = *(const f32x4*)(rs + (size_t)r * 16 + 8), p3 = *(const f32x4*)(rs + (size_t)r * 16 + 12);
                  const f32x4 ps = (p0 + p1) + (p2 + p3); rstd = rsqrtf(((ps[0] + ps[1]) + (ps[2] + ps[3])) * (1.f / 1024.f) + 1e-6f); }
                bf16_t* rowp = O + (size_t)r * ldc + col0;
#pragma unroll
                for (int bj = 0; bj < 2; ++bj) { const f32x4 v0 = acc[ai][bj][m][0] * rstd + bv[bj][0], v1 = acc[ai][bj][m][1] * rstd + bv[bj][1];
                    u32x4 w; w.x = pkh(v0[0], v0[1]); w.y = pkh(v0[2], v0[3]); w.z = pkh(v1[0], v1[1]); w.w = pkh(v1[2], v1[3]);
                    *(u32x4*)(rowp + bj * HALF) = w; } }
    }
};
template <class Epi, class Sched, bool ALIGN_EPI = false, bool SP2 = false>
__device__ __forceinline__ void gemm_phase(PG8_LAS unsigned char* lds, const Gemm g, const Sched& S, const Epi& E) {
    int tid_o = threadIdx.x; asm volatile("" : "+v"(tid_o)); const int tid = tid_o, wid = __builtin_amdgcn_readfirstlane(tid >> 6), lane = tid & 63, wr = wid >> 2, wc = wid & 3, fr = lane & 15, fq = lane >> 4;
    const int K = g.K, nt = K / BK;
    unsigned voffA[2], voffB[2];
#pragma unroll
    for (int i = 0; i < 2; ++i) { int R, C; stage_rc(tid * 16 + i * 8192, R, C); const int Rb = Epi::PERM ? ((R & ~31) + perm32(R & 31)) : R;
        voffA[i] = (unsigned)(R * K + C) * 2u; voffB[i] = (unsigned)(Rb * K + C) * 2u; }
    const size_t kstep = (size_t)(BK * 2);
    const size_t hstep = (size_t)HALF * K * 2;
    const size_t tstep = 2 * hstep;
    const unsigned ldsw = (unsigned)wid * 1024u;
    const int aoff = lds_byte(wr * 64 + fr, fq * 8), boff = lds_byte(wc * 32 + fr, fq * 8);
#define PG8_SA(b, h) (((b) * 2 + (h)) * HTB)
#define PG8_SB(b, h) ((4 + (b) * 2 + (h)) * HTB)
#define PG8_STAGE(bufoff, gbase, voff) do { _Pragma("unroll") for (int _i = 0; _i < 2; ++_i) \
        __builtin_amdgcn_global_load_lds((const unsigned*)((const char*)(gbase) + (voff)[_i]), (PG8_LAS unsigned*)(lds + (bufoff) + ldsw + _i * 8192), 16, 0, 0); } while (0)
#define PG8_LDA(dst, b, h) do { _Pragma("unroll") for (int m = 0; m < 4; ++m) _Pragma("unroll") for (int k = 0; k < 2; ++k) dst[m][k] = *(const PG8_LAS bf16x8*)(lds + PG8_SA(b, h) + aoff + m * 2048 + k * 1024); } while (0)
#define PG8_LDB(dst, b, h) do { _Pragma("unroll") for (int n = 0; n < 2; ++n) _Pragma("unroll") for (int k = 0; k < 2; ++k) dst[n][k] = *(const PG8_LAS bf16x8*)(lds + PG8_SB(b, h) + boff + n * 2048 + k * 1024); } while (0)
#define PG8_MMA(ai, bj, At, Bt) do { __builtin_amdgcn_s_setprio(1); _Pragma("unroll") for (int m = 0; m < 4; ++m) _Pragma("unroll") for (int n = 0; n < 2; ++n) _Pragma("unroll") for (int k = 0; k < 2; ++k) \
        acc[ai][bj][m][n] = __builtin_amdgcn_mfma_f32_16x16x32_bf16(Bt[n][k], At[m][k], acc[ai][bj][m][n], 0, 0, 0); __builtin_amdgcn_s_setprio(0); } while (0)
#define PG8_WAIT_V(n) asm volatile("s_waitcnt vmcnt(" #n ")" ::: "memory")
#define PG8_WAIT_L(n) asm volatile("s_waitcnt lgkmcnt(" #n ")" ::: "memory")
#define PG8_BAR __builtin_amdgcn_s_barrier()
#define PG8_SCHED __builtin_amdgcn_sched_barrier(0)
    Unit cur, nxt; int ui = 0;
    if (!S.next(0, cur)) return;
    f32x4 acc[2][2][4][2];
#pragma unroll
    for (int a = 0; a < 2; ++a)
#pragma unroll
        for (int b = 0; b < 2; ++b)
#pragma unroll
            for (int m = 0; m < 4; ++m)
#pragma unroll
                for (int n = 0; n < 2; ++n) acc[a][b][m][n] = (f32x4){0.f, 0.f, 0.f, 0.f};
    bf16x8 At[4][2], B0[2][2], B1[2][2];
    const char* cA = (const char*)g.A + (size_t)cur.pm * tstep; const char* cB = (const char*)g.Bt + (size_t)cur.pn * tstep;
    S.a_ready(cur);
    if constexpr (SP2) {
        PG8_STAGE(PG8_SB(0, 0), cB, voffB); PG8_STAGE(PG8_SB(0, 1), cB + hstep, voffB); PG8_STAGE(PG8_SA(0, 0), cA, voffA); PG8_STAGE(PG8_SA(0, 1), cA + hstep, voffA);
        if (wr == 1) PG8_BAR;
        PG8_WAIT_V(2); PG8_BAR;
        PG8_STAGE(PG8_SB(1, 0), cB + kstep, voffB); PG8_STAGE(PG8_SA(1, 0), cA + kstep, voffA); PG8_STAGE(PG8_SB(1, 1), cB + hstep + kstep, voffB);
        PG8_WAIT_V(6); PG8_BAR;
    } else {
        PG8_STAGE(PG8_SB(0, 0), cB, voffB); PG8_STAGE(PG8_SA(0, 0), cA, voffA); PG8_STAGE(PG8_SB(0, 1), cB + hstep, voffB); PG8_STAGE(PG8_SA(0, 1), cA + hstep, voffA);
        if (wr == 1) PG8_BAR;
        PG8_WAIT_V(4); PG8_BAR;
        PG8_STAGE(PG8_SB(1, 0), cB + kstep, voffB); PG8_STAGE(PG8_SA(1, 0), cA + kstep, voffA); PG8_STAGE(PG8_SB(1, 1), cB + hstep + kstep, voffB);
        PG8_WAIT_V(6); PG8_BAR;
    }
    for (;;) {
        const bool has_next = S.next(ui + 1, nxt);
        const char* nA = has_next ? (const char*)g.A + (size_t)nxt.pm * tstep : cA; const char* nB = has_next ? (const char*)g.Bt + (size_t)nxt.pn * tstep : cB;
        for (int t = 0; t < nt; t += 2) {
            const bool last = (t == nt - 2);
            const char* a1 = cA + (size_t)(t + 1) * kstep;
            const char* a2 = last ? nA : cA + (size_t)(t + 2) * kstep; const char* b2 = last ? nB : cB + (size_t)(t + 2) * kstep;
            const char* a3 = a2 + kstep; const char* b3 = b2 + kstep;
            if (last && has_next) S.a_ready(nxt);
            if constexpr (SP2) {
            PG8_LDB(B0, 0, 0); PG8_LDB(B1, 0, 1); PG8_SCHED; PG8_LDA(At, 0, 0); PG8_STAGE(PG8_SA(1, 1), a1 + hstep, voffA);
            PG8_WAIT_V(8); PG8_WAIT_L(0); PG8_BAR; PG8_MMA(0, 0, At, B0); PG8_MMA(0, 1, At, B1); PG8_BAR; PG8_SCHED;
            PG8_LDA(At, 0, 1); PG8_STAGE(PG8_SB(0, 0), b2, voffB); PG8_STAGE(PG8_SB(0, 1), b2 + hstep, voffB); PG8_STAGE(PG8_SA(0, 0), a2, voffA);
            PG8_WAIT_V(8); PG8_WAIT_L(0); PG8_BAR; PG8_MMA(1, 0, At, B0); PG8_MMA(1, 1, At, B1); PG8_BAR; PG8_SCHED;
            PG8_LDB(B0, 1, 0); PG8_LDB(B1, 1, 1); PG8_SCHED; PG8_LDA(At, 1, 0); PG8_STAGE(PG8_SA(0, 1), a2 + hstep, voffA);
            PG8_WAIT_V(8); PG8_WAIT_L(0); PG8_BAR; PG8_MMA(0, 0, At, B0); PG8_MMA(0, 1, At, B1); PG8_BAR; PG8_SCHED;
            PG8_LDA(At, 1, 1); PG8_STAGE(PG8_SB(1, 0), b3, voffB); PG8_STAGE(PG8_SB(1, 1), b3 + hstep, voffB); PG8_STAGE(PG8_SA(1, 0), a3, voffA);
            PG8_WAIT_V(8); PG8_WAIT_L(0); PG8_BAR; PG8_MMA(1, 0, At, B0); PG8_MMA(1, 1, At, B1); PG8_BAR; PG8_SCHED;
            } else {
            PG8_LDB(B0, 0, 0); PG8_SCHED; PG8_LDA(At, 0, 0); PG8_STAGE(PG8_SA(1, 1), a1 + hstep, voffA);
            PG8_WAIT_L(8); PG8_BAR; PG8_WAIT_L(0); PG8_MMA(0, 0, At, B0); PG8_BAR; PG8_SCHED;
            PG8_LDB(B1, 0, 1); PG8_STAGE(PG8_SB(0, 0), b2, voffB);
            PG8_BAR; PG8_WAIT_L(0); PG8_MMA(0, 1, At, B1); PG8_BAR;
            PG8_LDA(At, 0, 1); PG8_STAGE(PG8_SA(0, 0), a2, voffA);
            PG8_BAR; PG8_WAIT_L(0); PG8_MMA(1, 0, At, B0); PG8_BAR; PG8_SCHED;
            PG8_STAGE(PG8_SB(0, 1), b2 + hstep, voffB);
            PG8_WAIT_V(6); PG8_BAR; PG8_MMA(1, 1, At, B1); PG8_BAR;
            PG8_LDB(B0, 1, 0); PG8_SCHED; PG8_LDA(At, 1, 0); PG8_STAGE(PG8_SA(0, 1), a2 + hstep, voffA);
            PG8_WAIT_L(8); PG8_BAR; PG8_WAIT_L(0); PG8_MMA(0, 0, At, B0); PG8_BAR; PG8_SCHED;
            PG8_LDB(B1, 1, 1); PG8_STAGE(PG8_SB(1, 0), b3, voffB);
            PG8_BAR; PG8_WAIT_L(0); PG8_MMA(0, 1, At, B1); PG8_BAR;
            PG8_LDA(At, 1, 1); PG8_STAGE(PG8_SA(1, 0), a3, voffA);
            PG8_BAR; PG8_WAIT_L(0); PG8_MMA(1, 0, At, B0); PG8_BAR; PG8_SCHED;
            PG8_STAGE(PG8_SB(1, 1), b3 + hstep, voffB);
            PG8_WAIT_V(6); PG8_BAR; PG8_MMA(1, 1, At, B1); PG8_BAR;
            }
        }
        if constexpr (ALIGN_EPI) { if (wr == 0) PG8_BAR; }
        if constexpr (!Epi::AFTER_DRAIN) { E(acc, cur, wr, wc, fr, fq); S.done(cur); }
        if (!has_next) break;
#pragma unroll
        for (int a = 0; a < 2; ++a)
#pragma unroll
            for (int b = 0; b < 2; ++b)
#pragma unroll
                for (int m = 0; m < 4; ++m)
#pragma unroll
                    for (int n = 0; n < 2; ++n) acc[a][b][m][n] = (f32x4){0.f, 0.f, 0.f, 0.f};
        cur = nxt; cA = nA; cB = nB; ++ui;
        if constexpr (ALIGN_EPI) { if (wr == 1) PG8_BAR; }
    }
    PG8_WAIT_V(0);
    if constexpr (!ALIGN_EPI) { if (wr == 0) PG8_BAR; }
    PG8_BAR;
    if constexpr (Epi::AFTER_DRAIN) { E.fused(acc, cur, wr, wc, fr, fq, lds, wid, lane); S.done(cur); }
#undef PG8_SA
#undef PG8_SB
#undef PG8_STAGE
#undef PG8_LDA
#undef PG8_LDB
#undef PG8_MMA
#undef PG8_WAIT_V
#undef PG8_WAIT_L
#undef PG8_BAR
#undef PG8_SCHED
}
}


#define LAS __attribute__((address_space(3)))
typedef unsigned short bf16_t;
typedef short bf16x8 __attribute__((ext_vector_type(8)));
typedef short s16x4 __attribute__((ext_vector_type(4)));
typedef short v4i16_t __attribute__((ext_vector_type(4)));
typedef float f32x4 __attribute__((ext_vector_type(4)));
typedef unsigned u32x4 __attribute__((ext_vector_type(4)));
typedef unsigned u32x2 __attribute__((ext_vector_type(2)));
typedef float f32x2 __attribute__((ext_vector_type(2)));

constexpr int T = 16384, DM = 1024, SEQ = 2048, NP = 3584;
constexpr size_t MiB = 1u << 20;
constexpr size_t WS_CTL = 0, WS_MOD = 4096, WS_GATES = 262144, WS_KEYS = 1 * MiB, WS_WIN = 2 * MiB, WS_WOUT = 9 * MiB, WS_WQ = 11 * MiB,
                 WS_T8 = 16 * MiB, WS_SC = 48 * MiB, WS_ACT = 80 * MiB, WS_P = 112 * MiB, WS_QRY = 112 * MiB, WS_END = 256 * MiB;
constexpr size_t WS_RS = 208 * MiB, WS_SB = 851968, WS_WGT = 917504, WS_A3 = 176 * MiB;
constexpr int LDS_BYTES = 147456;

__device__ __forceinline__ unsigned f2bf(float f) { unsigned u = __float_as_uint(f); return (u + 0x7fffu + ((u >> 16) & 1u)) >> 16; }
typedef __bf16 bf16x2_t __attribute__((ext_vector_type(2)));
__device__ __forceinline__ unsigned pk2(float lo, float hi) { const f32x2 v = {lo, hi}; const bf16x2_t b = __builtin_convertvector(v, bf16x2_t); return __builtin_bit_cast(unsigned, b); }
__device__ __forceinline__ float bflo(unsigned u) { return __uint_as_float(u << 16); }
__device__ __forceinline__ float bfhi(unsigned u) { return __uint_as_float(u & 0xffff0000u); }
__device__ __forceinline__ float wave_sum(float v) {
    { const auto r = __builtin_amdgcn_permlane32_swap(__float_as_uint(v), __float_as_uint(v), false, false); v = __uint_as_float(r[0]) + __uint_as_float(r[1]); }
    { const auto r = __builtin_amdgcn_permlane16_swap(__float_as_uint(v), __float_as_uint(v), false, false); v = __uint_as_float(r[0]) + __uint_as_float(r[1]); }
    v += __int_as_float(__builtin_amdgcn_mov_dpp(__float_as_int(v), 0xB1, 0xF, 0xF, true));
    v += __int_as_float(__builtin_amdgcn_mov_dpp(__float_as_int(v), 0x4E, 0xF, 0xF, true));
    v += __int_as_float(__builtin_amdgcn_mov_dpp(__float_as_int(v), 0x141, 0xF, 0xF, true));
    v += __int_as_float(__builtin_amdgcn_mov_dpp(__float_as_int(v), 0x140, 0xF, 0xF, true));
    return v;
}
__device__ __forceinline__ float xrow_max(float v) {
    { const auto r = __builtin_amdgcn_permlane16_swap(__float_as_uint(v), __float_as_uint(v), false, false); v = fmaxf(__uint_as_float(r[0]), __uint_as_float(r[1])); }
    { const auto r = __builtin_amdgcn_permlane32_swap(__float_as_uint(v), __float_as_uint(v), false, false); v = fmaxf(__uint_as_float(r[0]), __uint_as_float(r[1])); }
    return v;
}
__device__ __forceinline__ float xrow_sum(float v) {
    { const auto r = __builtin_amdgcn_permlane16_swap(__float_as_uint(v), __float_as_uint(v), false, false); v = __uint_as_float(r[0]) + __uint_as_float(r[1]); }
    { const auto r = __builtin_amdgcn_permlane32_swap(__float_as_uint(v), __float_as_uint(v), false, false); v = __uint_as_float(r[0]) + __uint_as_float(r[1]); }
    return v;
}
#define LDS_WAIT() asm volatile("s_waitcnt lgkmcnt(0)" ::: "memory")
__device__ __forceinline__ s16x4 vtr(LAS unsigned char* p) { return __builtin_bit_cast(s16x4, __builtin_amdgcn_ds_read_tr16_b64_v4i16((LAS v4i16_t*)p)); }
__device__ __forceinline__ bf16x8 cat8(s16x4 a, s16x4 b) { bf16x8 r; r[0] = a[0]; r[1] = a[1]; r[2] = a[2]; r[3] = a[3]; r[4] = b[0]; r[5] = b[1]; r[6] = b[2]; r[7] = b[3]; return r; }
__device__ __forceinline__ bf16x8 pack8(const f32x4 a, const f32x4 b) { u32x4 w; w.x = pk2(a[0], a[1]); w.y = pk2(a[2], a[3]); w.z = pk2(b[0], b[1]); w.w = pk2(b[2], b[3]); return __builtin_bit_cast(bf16x8, w); }
#define MFMA16(a, b, c) __builtin_amdgcn_mfma_f32_16x16x32_bf16((a), (b), (c), 0, 0, 0)

struct Args {
    const float *x, *c, *ada_w, *ada_b, *norm1_g, *w_in, *conv_w, *conv_b, *gate_b, *mnorm_g, *lq1, *lk1, *lq2, *lk2, *dnorm_g, *w_out, *norm2_g, *wq, *keys, *pu, *pv, *final_g;
    float* out; unsigned char* ws;
};

__device__ __forceinline__ void transpose_item(const float* W, int srcN, int soff, bf16_t* WT, LAS float* scr, int kb, int nb, int lane) {
    const int k0 = 64 * kb, n0 = 32 * nb;
    { f32x4 wv[8];
#pragma unroll
      for (int i = 0; i < 8; ++i) wv[i] = *(const f32x4*)(W + (size_t)(k0 + 8 * i + (lane >> 3)) * srcN + n0 + soff + 4 * (lane & 7));
#pragma unroll
      for (int i = 0; i < 8; ++i) { LAS float* d = scr + (8 * i + (lane >> 3)) * 33 + 4 * (lane & 7); d[0] = wv[i][0]; d[1] = wv[i][1]; d[2] = wv[i][2]; d[3] = wv[i][3]; } }
    LDS_WAIT(); asm volatile("" ::: "memory");
    const int c = lane & 7;
#pragma unroll
    for (int j = 0; j < 4; ++j) { const int n = (lane >> 3) + 8 * j; const LAS float* s = scr + (8 * c) * 33 + n;
        u32x4 o; o.x = pk2(s[0 * 33], s[1 * 33]); o.y = pk2(s[2 * 33], s[3 * 33]); o.z = pk2(s[4 * 33], s[5 * 33]); o.w = pk2(s[6 * 33], s[7 * 33]);
        *(u32x4*)(WT + (size_t)(n0 + n) * 1024 + k0 + 8 * c) = o; }
    LDS_WAIT(); asm volatile("" ::: "memory");
}

__device__ __forceinline__ bf16x8 pack8_sw(const f32x4 a, const f32x4 b) {
    u32x4 w; w.x = f2bf(a[0]) | (f2bf(a[1]) << 16); w.y = f2bf(a[2]) | (f2bf(a[3]) << 16); w.z = f2bf(b[0]) | (f2bf(b[1]) << 16); w.w = f2bf(b[2]) | (f2bf(b[3]) << 16); return __builtin_bit_cast(bf16x8, w); }
__device__ __forceinline__ void wprime_item(const Args& A, int hp, int kt, int lane) {
    const int g = lane >> 4, l15 = lane & 15;
    f32x4 acc[8];
#pragma unroll
    for (int nt = 0; nt < 8; ++nt) acc[nt] = (f32x4){0.f, 0.f, 0.f, 0.f};
#pragma unroll
    for (int ks = 0; ks < 4; ++ks) {
        const float* ap = A.wq + (size_t)(16 * kt + l15) * 2048 + hp * 128 + 32 * ks + 8 * g;
        const bf16x8 a = pack8(*(const f32x4*)ap, *(const f32x4*)(ap + 4));
#pragma unroll
        for (int nt = 0; nt < 8; ++nt) { const float* bp = A.keys + (size_t)(hp * 128 + 16 * nt + l15) * 128 + 32 * ks + 8 * g;
            const bf16x8 b = pack8(*(const f32x4*)bp, *(const f32x4*)(bp + 4)); acc[nt] = MFMA16(a, b, acc[nt]); }
    }
    bf16_t* WT = (bf16_t*)(A.ws + WS_WQ);
#pragma unroll
    for (int nt = 0; nt < 8; ++nt) { u32x2 o; o.x = pk2(acc[nt][0], acc[nt][1]); o.y = pk2(acc[nt][2], acc[nt][3]);
        *(u32x2*)(WT + (size_t)(hp * 128 + 16 * nt + l15) * 1024 + 16 * kt + 4 * g) = o; }
}

__device__ __forceinline__ void phase0(const Args& A, LAS unsigned char* lds) {
    int tid_o = threadIdx.x; asm volatile("" : "+v"(tid_o)); const int tid = tid_o, lane = tid & 63, wave = tid >> 6, G = gridDim.x;
    float* MOD = (float*)(A.ws + WS_MOD);
    if ((int)blockIdx.x < 192) {
        LAS float* sc = (LAS float*)lds;
        for (int i = tid; i < 8192; i += 512) { const float v = A.c[i]; sc[i] = v * __builtin_amdgcn_rcpf(1.f + __expf(-v)); }
        __syncthreads();
        for (int item = blockIdx.x; item < 192; item += G) {
            const int j0 = item * 32, kg = tid >> 3, cq = tid & 7;
            f32x4 wv[16];
#pragma unroll
            for (int kk = 0; kk < 16; ++kk) wv[kk] = *(const f32x4*)(A.ada_w + (size_t)(kg * 16 + kk) * 6144 + j0 + 4 * cq);
            f32x4 acc[8];
#pragma unroll
            for (int b = 0; b < 8; ++b) acc[b] = (f32x4){0.f, 0.f, 0.f, 0.f};
#pragma unroll
            for (int b = 0; b < 8; ++b)
#pragma unroll
                for (int k4 = 0; k4 < 4; ++k4) { const f32x4 s4 = *(const LAS f32x4*)(sc + b * 1024 + kg * 16 + 4 * k4);
                    acc[b] += wv[4 * k4] * s4[0]; acc[b] += wv[4 * k4 + 1] * s4[1]; acc[b] += wv[4 * k4 + 2] * s4[2]; acc[b] += wv[4 * k4 + 3] * s4[3]; }
            LAS float* part = (LAS float*)(lds + 32768);
#pragma unroll
            for (int b = 0; b < 8; ++b) *(LAS f32x4*)(part + (kg * 8 + b) * 32 + 4 * cq) = acc[b];
            __syncthreads();
            if (tid < 256) { const int b = tid >> 5, col = tid & 31; float s = A.ada_b[j0 + col];
              for (int k2 = 0; k2 < 64; ++k2) s += part[(k2 * 8 + b) * 32 + col];
              MOD[b * 6144 + j0 + col] = s; }
            __syncthreads();
        }
    }
    for (int i = (G - 1 - (int)blockIdx.x) * 512 + tid; i < 8192; i += G * 512) { const int gc = i >> 10, k = i & 1023; ((float*)(A.ws + WS_WGT))[i] = A.w_in[(size_t)k * 3592 + 2048 + gc]; }
    if (blockIdx.x == 0 && tid == 0) {
        float s1 = 0.f, s2 = 0.f;
        for (int i = 0; i < 64; ++i) { s1 += A.lq1[i] * A.lk1[i]; s2 += A.lq2[i] * A.lk2[i]; }
        ((float*)(A.ws + WS_CTL))[1] = expf(s1) - expf(s2) + 0.2f;
        ((unsigned*)(A.ws + WS_CTL))[0] = 0u; ((unsigned*)(A.ws + WS_CTL))[2] = 0u;
    }
}

__device__ __forceinline__ void phase0b(const Args& A, LAS unsigned char* lds) {
    int tid_o = threadIdx.x; asm volatile("" : "+v"(tid_o)); const int tid = tid_o, lane = tid & 63, wave = tid >> 6, G = gridDim.x;
    __syncthreads();
    {
        LAS float* scr = (LAS float*)(lds + wave * 16384);
        const int gw = blockIdx.x * 8 + wave, NGW = G * 8;
        for (int it = gw; it < 1792; it += NGW) { const int kb = it / 112, nb = it % 112; transpose_item(A.w_in, 3592, nb >= 64 ? 8 : 0, (bf16_t*)(A.ws + WS_WIN), scr, kb, nb, lane); }
    }
}

__device__ __forceinline__ void quantise_tables(const Args& A, int gw, int NGW, int row_lo, int row_hi) {
    int tid_o = threadIdx.x; asm volatile("" : "+v"(tid_o)); const int lane = tid_o & 63;
    unsigned char* T8 = A.ws + WS_T8; float* SC = (float*)(A.ws + WS_SC);
#pragma unroll 1
    for (int row = row_lo + gw; row < row_hi; row += 4 * NGW) {
        f32x4 v[4][4]; int rr[4];
#pragma unroll
        for (int q = 0; q < 4; ++q) { const int r = row + q * NGW; rr[q] = r; const int rc = r < row_hi ? r : row;
            const float* s = (rc < 16384 ? A.pu + (size_t)rc * 1024 : A.pv + (size_t)(rc - 16384) * 1024) + 16 * lane;
#pragma unroll
            for (int j = 0; j < 4; ++j) v[q][j] = *(const f32x4*)(s + 4 * j); }
#pragma unroll
        for (int q = 0; q < 4; ++q) {
            float mx = 0.f;
#pragma unroll
            for (int j = 0; j < 4; ++j)
#pragma unroll
                for (int e = 0; e < 4; ++e) mx = fmaxf(mx, fabsf(v[q][j][e]));
#pragma unroll
            for (int o = 1; o < 64; o <<= 1) mx = fmaxf(mx, __shfl_xor(mx, o));
            const float sc = fmaxf(mx, 1e-30f) * (1.f / 256.f), inv = 1.f / sc;
            u32x4 o4;
#pragma unroll
            for (int j = 0; j < 4; ++j) { int w0 = __builtin_amdgcn_cvt_pk_fp8_f32(v[q][j][0] * inv, v[q][j][1] * inv, 0, false); w0 = __builtin_amdgcn_cvt_pk_fp8_f32(v[q][j][2] * inv, v[q][j][3] * inv, w0, true); o4[j] = (unsigned)w0; }
            if (rr[q] < row_hi) { *(u32x4*)(T8 + (size_t)rr[q] * 1024 + 16 * lane) = o4; if (lane == 0) SC[rr[q]] = sc; }
        }
    }
}

__device__ __forceinline__ void phase1(const Args& A, LAS unsigned char* lds) {
    int tid_o = threadIdx.x; asm volatile("" : "+v"(tid_o)); const int tid = tid_o, lane = tid & 63, wave = tid >> 6, G = gridDim.x;
    const float* MOD = (const float*)(A.ws + WS_MOD);
    bf16_t* ACT = (bf16_t*)(A.ws + WS_ACT);
    float* GATES = (float*)(A.ws + WS_GATES);
    LAS float* WG = (LAS float*)lds;
    for (int i = tid; i < 8192; i += 512) WG[i] = ((const float*)(A.ws + WS_WGT))[i];
    __syncthreads();
    f32x4 vn[4];
    { const int m0 = (int)(blockIdx.x * 8 + wave) < T ? blockIdx.x * 8 + wave : 0; const f32x4* xr = (const f32x4*)(A.x + (size_t)m0 * 1024) + lane;
#pragma unroll
        for (int j = 0; j < 4; ++j) vn[j] = xr[64 * j]; }
    for (int m = blockIdx.x * 8 + wave; m < T; m += G * 8) {
        const int b = m >> 11;
        f32x4 v[4]; float ss = 0.f;
#pragma unroll
        for (int j = 0; j < 4; ++j) { v[j] = vn[j]; ss += (v[j][0] * v[j][0] + v[j][1] * v[j][1]) + (v[j][2] * v[j][2] + v[j][3] * v[j][3]); }
        { const int mn = (m + G * 8 < T) ? m + G * 8 : m; const f32x4* xr = (const f32x4*)(A.x + (size_t)mn * 1024) + lane;
#pragma unroll
            for (int j = 0; j < 4; ++j) vn[j] = xr[64 * j]; }
        f32x4 gg[4], scc[4], shh[4];
#pragma unroll
        for (int j = 0; j < 4; ++j) { const int col = 4 * lane + 256 * j; gg[j] = *(const f32x4*)(A.norm1_g + col); scc[j] = *(const f32x4*)(MOD + b * 6144 + 1024 + col); shh[j] = *(const f32x4*)(MOD + b * 6144 + col); }
        const float rstd = rsqrtf(wave_sum(ss) * (1.f / 1024.f) + 1e-6f);
        unsigned long long* o8 = (unsigned long long*)(ACT + (size_t)m * 1024) + lane;
#pragma unroll
        for (int j = 0; j < 4; ++j) { const f32x4 g = gg[j], sc = scc[j], sh = shh[j];
            v[j] = v[j] * rstd * g * (sc + 1.0f) + sh;
            o8[64 * j] = (unsigned long long)pk2(v[j][0], v[j][1]) | ((unsigned long long)pk2(v[j][2], v[j][3]) << 32); }
        float gd[8];
#pragma unroll
        for (int gc = 0; gc < 8; ++gc) { float d = 0.f;
#pragma unroll
            for (int j = 0; j < 4; ++j) { const f32x4 w = *(const LAS f32x4*)(WG + gc * 1024 + 256 * j + 4 * lane); d += (v[j][0] * w[0] + v[j][1] * w[1]) + (v[j][2] * w[2] + v[j][3] * w[3]); }
            gd[gc] = wave_sum(d); }
        if (lane == 0) {
            f32x4 ig, lf;
#pragma unroll
            for (int h = 0; h < 4; ++h) { ig[h] = gd[h] + A.gate_b[h]; const float z = gd[4 + h] + A.gate_b[4 + h]; lf[h] = fminf(z, 0.f) - log1pf(expf(-fabsf(z))); }
            *(f32x4*)(GATES + (size_t)m * 8) = ig; *(f32x4*)(GATES + (size_t)m * 8 + 4) = lf;
        }
    }
}

constexpr int AK_STRIDE = 288  , AV_STRIDE = 288, AK_BYTES = 64 * AK_STRIDE, AV_BYTES = 64 * AV_STRIDE;
__device__ __forceinline__ void attn_item(const Args& A, LAS unsigned char* lds, int b, int h, int qb, float lam) {
    int tid_o = threadIdx.x; asm volatile("" : "+v"(tid_o)); const int tid = tid_o, lane = tid & 63, w = tid >> 6, g = lane >> 4, l15 = lane & 15;
    const bf16_t* P = (const bf16_t*)(A.ws + WS_P);
    bf16_t* ACT = (bf16_t*)(A.ws + WS_ACT);
    const int t0 = qb * 128, ntiles = 2 * (qb + 1);
    const size_t rowbase = (size_t)b * SEQ;
    bf16x8 qf[2][2];
    { const bf16_t* qp = P + (rowbase + t0 + 16 * w + l15) * NP + 2048 + h * 128 + 8 * g;
#pragma unroll
      for (int p = 0; p < 2; ++p)
#pragma unroll
          for (int ks = 0; ks < 2; ++ks) qf[p][ks] = *(const bf16x8*)(qp + p * 64 + ks * 32); }
    f32x4 o[2][8];
#pragma unroll
    for (int p = 0; p < 2; ++p)
#pragma unroll
        for (int vt = 0; vt < 8; ++vt) o[p][vt] = (f32x4){0.f, 0.f, 0.f, 0.f};
    float mrun[2] = {-1e30f, -1e30f}, lrun[2] = {0.f, 0.f};
    const int srow = tid >> 3, sseg = tid & 7;
    const bf16_t* kg = P + (rowbase + srow) * NP + 2560 + h * 128 + sseg * 16;
    const bf16_t* vg = P + (rowbase + srow) * NP + 3072 + h * 128 + sseg * 16;
    u32x4 kr0, kr1, vr0, vr1;
    kr0 = *(const u32x4*)(kg); kr1 = *(const u32x4*)(kg + 8); vr0 = *(const u32x4*)(vg); vr1 = *(const u32x4*)(vg + 8);
    { LAS unsigned char* kb = lds + srow * AK_STRIDE + sseg * 32; LAS unsigned char* vb = lds + 2 * AK_BYTES + srow * AV_STRIDE + sseg * 32;
      *(LAS u32x4*)kb = kr0; *(LAS u32x4*)(kb + 16) = kr1; *(LAS u32x4*)vb = vr0; *(LAS u32x4*)(vb + 16) = vr1; }
    __syncthreads();
    const float cs = 0.125f * 1.4426950408889634f;
    const int qabs = t0 + 16 * w + l15;
    for (int kt = 0; kt < ntiles; ++kt) {
        const int cur = kt & 1;
        if (kt + 1 < ntiles) { const size_t off = (size_t)(kt + 1) * 64 * NP;
            kr0 = *(const u32x4*)(kg + off); kr1 = *(const u32x4*)(kg + off + 8); vr0 = *(const u32x4*)(vg + off); vr1 = *(const u32x4*)(vg + off + 8); }
        if (64 * kt <= t0 + 16 * w + 15) {
            LAS unsigned char* Kb = lds + cur * AK_BYTES; LAS unsigned char* Vb = lds + 2 * AK_BYTES + cur * AV_BYTES;
            f32x4 s[2][4];
#pragma unroll
            for (int p = 0; p < 2; ++p)
#pragma unroll
                for (int k4 = 0; k4 < 4; ++k4) { f32x4 a = (f32x4){0.f, 0.f, 0.f, 0.f};
#pragma unroll
                    for (int ks = 0; ks < 2; ++ks) { const bf16x8 kf = *(const LAS bf16x8*)(Kb + (16 * k4 + l15) * AK_STRIDE + (p * 64 + ks * 32 + 8 * g) * 2); a = MFMA16(kf, qf[p][ks], a); }
                    s[p][k4] = a; }
            if (64 * kt + 63 > t0 + 16 * w) {
#pragma unroll
                for (int p = 0; p < 2; ++p)
#pragma unroll
                    for (int k4 = 0; k4 < 4; ++k4)
#pragma unroll
                        for (int r = 0; r < 4; ++r) { const int key = 64 * kt + 16 * k4 + 4 * g + r; if (key > qabs) s[p][k4][r] = -1e30f; }
            }
            bf16x8 pf[2][2];
#pragma unroll
            for (int p = 0; p < 2; ++p) {
                float mx = -1e30f;
#pragma unroll
                for (int k4 = 0; k4 < 4; ++k4)
#pragma unroll
                    for (int r = 0; r < 4; ++r) mx = fmaxf(mx, s[p][k4][r]);
                mx = xrow_max(mx);
                const float mnew = fmaxf(mrun[p], mx * cs), alpha = __builtin_amdgcn_exp2f(mrun[p] - mnew);
                mrun[p] = mnew;
                float ls = 0.f;
#pragma unroll
                for (int k4 = 0; k4 < 4; ++k4)
#pragma unroll
                    for (int r = 0; r < 4; ++r) { const float pv = __builtin_amdgcn_exp2f(s[p][k4][r] * cs - mnew); ls += pv; s[p][k4][r] = pv; }
                lrun[p] = lrun[p] * alpha + ls;
                if (__any(alpha != 1.f)) {
#pragma unroll
                    for (int vt = 0; vt < 8; ++vt) o[p][vt] = o[p][vt] * alpha; }
                pf[p][0] = pack8(s[p][0], s[p][1]); pf[p][1] = pack8(s[p][2], s[p][3]);
            }
#pragma unroll
            for (int ks2 = 0; ks2 < 2; ++ks2)
#pragma unroll
                for (int vt = 0; vt < 8; ++vt) {
                    LAS unsigned char* a0 = Vb + (32 * ks2 + 4 * g + (l15 >> 2)) * AV_STRIDE + (16 * vt + 4 * (lane & 3)) * 2;
                    const bf16x8 vf = cat8(vtr(a0), vtr(a0 + 16 * AV_STRIDE));
                    o[0][vt] = MFMA16(vf, pf[0][ks2], o[0][vt]);
                    o[1][vt] = MFMA16(vf, pf[1][ks2], o[1][vt]);
                }
        }
        if (kt + 1 < ntiles) { const int nx = cur ^ 1;
            LAS unsigned char* kb = lds + nx * AK_BYTES + srow * AK_STRIDE + sseg * 32; LAS unsigned char* vb = lds + 2 * AK_BYTES + nx * AV_BYTES + srow * AV_STRIDE + sseg * 32;
            *(LAS u32x4*)kb = kr0; *(LAS u32x4*)(kb + 16) = kr1; *(LAS u32x4*)vb = vr0; *(LAS u32x4*)(vb + 16) = vr1; }
        __syncthreads();
    }
    float inv[2];
#pragma unroll
    for (int p = 0; p < 2; ++p) { const float lt = xrow_sum(lrun[p]); inv[p] = 1.f / lt; }
    float ss = 0.f;
#pragma unroll
    for (int vt = 0; vt < 8; ++vt)
#pragma unroll
        for (int r = 0; r < 4; ++r) { const float ov = o[0][vt][r] * inv[0] - lam * (o[1][vt][r] * inv[1]); o[0][vt][r] = ov; ss += ov * ov; }
    ss = xrow_sum(ss);
    const float rstd = rsqrtf(ss * (1.f / 128.f) + 1e-6f) * 0.8f;
    bf16_t* op = ACT + (rowbase + qabs) * 1024 + 512 + h * 128 + 4 * g;
#pragma unroll
    for (int vt = 0; vt < 8; ++vt) { const f32x4 gn = *(const f32x4*)(A.dnorm_g + 16 * vt + 4 * g);
        u32x2 wv; wv.x = pk2(o[0][vt][0] * rstd * gn[0], o[0][vt][1] * rstd * gn[1]); wv.y = pk2(o[0][vt][2] * rstd * gn[2], o[0][vt][3] * rstd * gn[3]);
        *(u32x2*)(op + 16 * vt) = wv; }
}

constexpr int MQ_STRIDE = 272, MV_STRIDE = 288, MP_STRIDE = 144, MH_STRIDE = 132;
constexpr int ML_Q = 0, ML_K = 17408, ML_V = 34816, ML_P = 53248, ML_H = 62464, ML_CW = 96256, ML_SM = 101376;
constexpr int SM_E = 0, SM_G = 64, SM_B = 128, SM_W = 192, SM_I = 256, SM_R = 320, SM_N = 384, SM_NP = 512, SM_X = 1024;
constexpr size_t WS_CST = 224 * MiB, WS_NST = 15 * MiB, WS_MC = 15 * MiB + 512 * 1024, WS_BAR = 15 * MiB + 768 * 1024;

__device__ __forceinline__ void mlstm_state(const Args& A, LAS unsigned char* lds, int b, int h) {
    int tid_o = threadIdx.x; asm volatile("" : "+v"(tid_o)); const int tid = tid_o, lane = tid & 63, w = tid >> 6, g = lane >> 4, l15 = lane & 15;
    const bf16_t* P = (const bf16_t*)(A.ws + WS_P);
    const float* GATES = (const float*)(A.ws + WS_GATES);
    u32x4* CST = (u32x4*)(A.ws + WS_CST); float* NST = (float*)(A.ws + WS_NST); float* MCg = (float*)(A.ws + WS_MC);
    LAS float* sm = (LAS float*)(lds + ML_SM);
    LAS float* cw = (LAS float*)(lds + ML_CW);
    LAS unsigned char* Ks = lds + ML_K; LAS unsigned char* Vs = lds + ML_V;
    const size_t rowbase = (size_t)b * SEQ; const int bh = b * 4 + h;
    for (int i = tid; i < 640; i += 512) { const int j = i >> 7, ch = i & 127, cch = 512 + h * 128 + ch; cw[i] = (j < 4) ? A.conv_w[j * 1024 + cch] : A.conv_b[cch]; }
    if (tid < 128) sm[SM_N + tid] = 0.f;
    const int rg = tid >> 4, cs = tid & 15;
    const int ccol = 512 + h * 128 + 8 * cs;
    const int srow = tid >> 3, sseg = tid & 7;
    u32x4 cr[5], vr0, vr1; float gi = 0.f, gf = 0.f;
#define MS_PREFETCH(c) do { const int _r0 = (c) * 64 + 2 * rg - 3; \
        _Pragma("unroll") for (int _i = 0; _i < 5; ++_i) { const int _r = _r0 + _i; const u32x4 _v = *(const u32x4*)(P + (rowbase + (_r >= 0 ? _r : 0)) * NP + ccol); cr[_i] = (_r >= 0) ? _v : (u32x4){0u, 0u, 0u, 0u}; } \
        const bf16_t* _vp = P + (rowbase + (c) * 64 + srow) * NP + 1024 + h * 128 + sseg * 16; \
        vr0 = *(const u32x4*)(_vp); vr1 = *(const u32x4*)(_vp + 8); \
        } while (0)
    MS_PREFETCH(0);
    LAS float* Eall = (LAS float*)(lds + ML_Q);
#pragma unroll
    for (int cc = 0; cc < 4; ++cc) { const int c = w + 8 * cc;
        const float* gp = GATES + (rowbase + c * 64 + lane) * 8 + h; gi = gp[0]; gf = gp[4];
        float bc = gf;
#pragma unroll
        for (int o = 1; o < 64; o <<= 1) { const float t = __shfl_up(bc, o); if (lane >= o) bc += t; }
        const float e = gi - bc; float cm = e;
#pragma unroll
        for (int o = 1; o < 64; o <<= 1) { const float t = __shfl_up(cm, o); if (lane >= o) cm = fmaxf(cm, t); }
        Eall[c * 64 + lane] = e;
        if (lane == 63) { Eall[2048 + c] = bc; Eall[2048 + 32 + c] = cm; } }
    f32x4 C[8];
#pragma unroll
    for (int kt = 0; kt < 8; ++kt) C[kt] = (f32x4){0.f, 0.f, 0.f, 0.f};
    float mc = 0.f;
    __syncthreads();
    for (int c = 0; c < 32; ++c) {
        {
            float wt[5][8];
#pragma unroll
            for (int j = 0; j < 5; ++j) { const f32x4 a = *(const LAS f32x4*)(cw + j * 128 + 8 * cs), bb = *(const LAS f32x4*)(cw + j * 128 + 8 * cs + 4);
                wt[j][0] = a[0]; wt[j][1] = a[1]; wt[j][2] = a[2]; wt[j][3] = a[3]; wt[j][4] = bb[0]; wt[j][5] = bb[1]; wt[j][6] = bb[2]; wt[j][7] = bb[3]; }
            LAS unsigned char* dst = Ks + (2 * rg) * MQ_STRIDE + 16 * cs;
#pragma unroll
            for (int r = 0; r < 2; ++r) {
                float ov[8];
#pragma unroll
                for (int e = 0; e < 8; ++e) ov[e] = wt[4][e];
#pragma unroll
                for (int j = 0; j < 4; ++j) { const u32x4 x = cr[r + j];
                    ov[0] += wt[j][0] * bflo(x.x); ov[1] += wt[j][1] * bfhi(x.x); ov[2] += wt[j][2] * bflo(x.y); ov[3] += wt[j][3] * bfhi(x.y);
                    ov[4] += wt[j][4] * bflo(x.z); ov[5] += wt[j][5] * bfhi(x.z); ov[6] += wt[j][6] * bflo(x.w); ov[7] += wt[j][7] * bfhi(x.w); }
#pragma unroll
                for (int e = 0; e < 8; ++e) ov[e] = 0.08838834764831845f * ov[e] * __builtin_amdgcn_rcpf(1.f + __expf(-ov[e]));
                u32x4 o4; o4.x = pk2(ov[0], ov[1]); o4.y = pk2(ov[2], ov[3]); o4.z = pk2(ov[4], ov[5]); o4.w = pk2(ov[6], ov[7]);
                *(LAS u32x4*)(dst + r * MQ_STRIDE) = o4;
            }
            LAS unsigned char* vd = Vs + srow * MV_STRIDE + sseg * 32; *(LAS u32x4*)vd = vr0; *(LAS u32x4*)(vd + 16) = vr1;
            if (w == 0) {
                const float g63 = fmaxf(mc, Eall[2048 + 32 + c]);
                sm[SM_W + lane] = __expf(Eall[c * 64 + lane] - g63);
                if (lane == 63) { sm[SM_X] = __expf(mc - g63); sm[SM_X + 1] = Eall[2048 + c] + g63; }
            }
        }
        __syncthreads();
        { const int cn = (c + 1 < 32) ? c + 1 : 31; MS_PREFETCH(cn); }
        {
            const int item = bh * 32 + c;
#pragma unroll
            for (int k2 = 0; k2 < 4; ++k2) CST[((size_t)(item * 8 + w) * 4 + k2) * 64 + lane] = __builtin_bit_cast(u32x4, pack8(C[2 * k2], C[2 * k2 + 1]));
            if (tid < 128) NST[item * 128 + tid] = sm[SM_N + tid];
            if (tid == 0) MCg[item] = mc;
            LAS float* wS = sm + SM_W;
            const float decay = sm[SM_X];
            bf16x8 vfw[2];
#pragma unroll
            for (int ks = 0; ks < 2; ++ks) {
                LAS unsigned char* a0 = Vs + (32 * ks + 8 * g + (l15 >> 2)) * MV_STRIDE + (16 * w + 4 * (lane & 3)) * 2;
                const bf16x8 vf = cat8(vtr(a0), vtr(a0 + 4 * MV_STRIDE));
                const f32x4 w0 = *(const LAS f32x4*)(wS + 32 * ks + 8 * g), w1 = *(const LAS f32x4*)(wS + 32 * ks + 8 * g + 4);
                const u32x4 vu = __builtin_bit_cast(u32x4, vf);
                u32x4 o4; o4.x = pk2(bflo(vu.x) * w0[0], bfhi(vu.x) * w0[1]); o4.y = pk2(bflo(vu.y) * w0[2], bfhi(vu.y) * w0[3]);
                o4.z = pk2(bflo(vu.z) * w1[0], bfhi(vu.z) * w1[1]); o4.w = pk2(bflo(vu.w) * w1[2], bfhi(vu.w) * w1[3]);
                vfw[ks] = __builtin_bit_cast(bf16x8, o4);
            }
#pragma unroll
            for (int kt = 0; kt < 8; ++kt) C[kt] = C[kt] * decay;
#pragma unroll
            for (int ks = 0; ks < 2; ++ks)
#pragma unroll
                for (int kt = 0; kt < 8; ++kt) { LAS unsigned char* a0 = Ks + (32 * ks + 8 * g + (l15 >> 2)) * MQ_STRIDE + (16 * kt + 4 * (lane & 3)) * 2;
                    const bf16x8 ka = cat8(vtr(a0), vtr(a0 + 4 * MQ_STRIDE)); C[kt] = MFMA16(ka, vfw[ks], C[kt]); }
            { const int kd = tid & 127, sq = tid >> 7; float s = 0.f;
#pragma unroll
              for (int i = 0; i < 16; ++i) { const int s_ = 16 * sq + i; s += wS[s_] * __uint_as_float((unsigned)(*(const LAS bf16_t*)(Ks + s_ * MQ_STRIDE + kd * 2)) << 16); }
              sm[SM_NP + sq * 128 + kd] = s; }
            mc = sm[SM_X + 1];
            __syncthreads();
            if (tid < 128) sm[SM_N + tid] = decay * sm[SM_N + tid] + ((sm[SM_NP + tid] + sm[SM_NP + 128 + tid]) + (sm[SM_NP + 256 + tid] + sm[SM_NP + 384 + tid]));
        }
    }
#undef MS_PREFETCH
    __syncthreads();
}

__device__ __forceinline__ void mlstm_out(const Args& A, LAS unsigned char* lds, int item, int& last_h) {
    int tid_o = threadIdx.x; asm volatile("" : "+v"(tid_o)); const int tid = tid_o, lane = tid & 63, w = tid >> 6, g = lane >> 4, l15 = lane & 15;
    const int bh = item >> 5, c = item & 31, b = bh >> 2, h = bh & 3;
    const bf16_t* P = (const bf16_t*)(A.ws + WS_P);
    bf16_t* ACT = (bf16_t*)(A.ws + WS_ACT);
    const float* GATES = (const float*)(A.ws + WS_GATES);
    const u32x4* CST = (const u32x4*)(A.ws + WS_CST); const float* NST = (const float*)(A.ws + WS_NST); const float* MCg = (const float*)(A.ws + WS_MC);
    LAS float* sm = (LAS float*)(lds + ML_SM);
    LAS float* cw = (LAS float*)(lds + ML_CW);
    LAS unsigned char* Qs = lds + ML_Q; LAS unsigned char* Ks = lds + ML_K; LAS unsigned char* Vs = lds + ML_V; LAS unsigned char* Ps = lds + ML_P;
    LAS float* Hn = (LAS float*)(lds + ML_H);
    LAS float* eS = sm + SM_E; LAS float* gS = sm + SM_G; LAS float* bS = sm + SM_B; LAS float* iS = sm + SM_I; LAS float* nS = sm + SM_N;
    const size_t rowbase = (size_t)b * SEQ;
    const int rg = tid >> 5, cs = tid & 31;
    const int ccol = (cs < 16 ? 0 : 512) + h * 128 + 8 * (cs & 15);
    const int srow = tid >> 3, sseg = tid & 7;
    u32x4 cr[7], vr0, vr1, mc0, mc1, cfr[4]; float gi = 0.f, gf = 0.f, nval = 0.f;
    { const int r0 = c * 64 + 4 * rg - 3;
#pragma unroll
      for (int i = 0; i < 7; ++i) { const int r = r0 + i; const u32x4 v_ = *(const u32x4*)(P + (rowbase + (r >= 0 ? r : 0)) * NP + ccol); cr[i] = (r >= 0) ? v_ : (u32x4){0u, 0u, 0u, 0u}; }
      const bf16_t* vp = P + (rowbase + c * 64 + srow) * NP + h * 128 + sseg * 16;
      vr0 = *(const u32x4*)(vp + 1024); vr1 = *(const u32x4*)(vp + 1032); mc0 = *(const u32x4*)(vp + 1536); mc1 = *(const u32x4*)(vp + 1544);
      if (w == 0) { const float* gp = GATES + (rowbase + c * 64 + lane) * 8 + h; gi = gp[0]; gf = gp[4]; }
#pragma unroll
      for (int k2 = 0; k2 < 4; ++k2) cfr[k2] = CST[((size_t)(item * 8 + w) * 4 + k2) * 64 + lane];
      if (tid < 128) nval = NST[item * 128 + tid]; }
    const float mc = MCg[item];
    if (h != last_h) {
        for (int i = tid; i < 1280; i += 512) { const int j = i >> 8, ch = i & 255, cch = (ch < 128 ? h * 128 + ch : 512 + h * 128 + ch - 128);
            cw[i] = (j < 4) ? A.conv_w[j * 1024 + cch] : A.conv_b[cch]; }
        last_h = h;
        __syncthreads();
    }
    {
        float wt[5][8];
#pragma unroll
        for (int j = 0; j < 5; ++j) { const f32x4 a = *(const LAS f32x4*)(cw + j * 256 + 8 * cs), bb = *(const LAS f32x4*)(cw + j * 256 + 8 * cs + 4);
            wt[j][0] = a[0]; wt[j][1] = a[1]; wt[j][2] = a[2]; wt[j][3] = a[3]; wt[j][4] = bb[0]; wt[j][5] = bb[1]; wt[j][6] = bb[2]; wt[j][7] = bb[3]; }
        const float osc = (cs < 16) ? 1.0f : 0.08838834764831845f;
        LAS unsigned char* dst = (cs < 16 ? Qs : Ks) + (4 * rg) * MQ_STRIDE + 16 * (cs & 15);
#pragma unroll
        for (int r = 0; r < 4; ++r) {
            float ov[8];
#pragma unroll
            for (int e = 0; e < 8; ++e) ov[e] = wt[4][e];
#pragma unroll
            for (int j = 0; j < 4; ++j) { const u32x4 x = cr[r + j];
                ov[0] += wt[j][0] * bflo(x.x); ov[1] += wt[j][1] * bfhi(x.x); ov[2] += wt[j][2] * bflo(x.y); ov[3] += wt[j][3] * bfhi(x.y);
                ov[4] += wt[j][4] * bflo(x.z); ov[5] += wt[j][5] * bfhi(x.z); ov[6] += wt[j][6] * bflo(x.w); ov[7] += wt[j][7] * bfhi(x.w); }
#pragma unroll
            for (int e = 0; e < 8; ++e) ov[e] = osc * ov[e] * __builtin_amdgcn_rcpf(1.f + __expf(-ov[e]));
            u32x4 o4; o4.x = pk2(ov[0], ov[1]); o4.y = pk2(ov[2], ov[3]); o4.z = pk2(ov[4], ov[5]); o4.w = pk2(ov[6], ov[7]);
            *(LAS u32x4*)(dst + r * MQ_STRIDE) = o4;
        }
        LAS unsigned char* vd = Vs + srow * MV_STRIDE + sseg * 32; *(LAS u32x4*)vd = vr0; *(LAS u32x4*)(vd + 16) = vr1;
        if (tid < 128) nS[tid] = nval;
        if (w == 0) {
            float bc = gf;
#pragma unroll
            for (int o = 1; o < 64; o <<= 1) { const float t = __shfl_up(bc, o); if (lane >= o) bc += t; }
            const float e = gi - bc; float cm = e;
#pragma unroll
            for (int o = 1; o < 64; o <<= 1) { const float t = __shfl_up(cm, o); if (lane >= o) cm = fmaxf(cm, t); }
            const float gt = fmaxf(mc, cm);
            eS[lane] = e; gS[lane] = gt; bS[lane] = bc; iS[lane] = __expf(mc - gt);
        }
    }
    __syncthreads();
    {
        const int st = w >> 1;
#pragma unroll
        for (int ti = 0; ti < 2; ++ti) { const int tt = 2 * (w & 1) + ti;
            f32x4 a = (f32x4){0.f, 0.f, 0.f, 0.f};
#pragma unroll
            for (int ks = 0; ks < 4; ++ks) { const bf16x8 kf = *(const LAS bf16x8*)(Ks + (16 * st + l15) * MQ_STRIDE + (32 * ks + 8 * g) * 2);
                const bf16x8 qf = *(const LAS bf16x8*)(Qs + (16 * tt + l15) * MQ_STRIDE + (32 * ks + 8 * g) * 2); a = MFMA16(kf, qf, a); }
            const int t = 16 * tt + l15; const float gt = gS[t];
            float pv[4];
#pragma unroll
            for (int r = 0; r < 4; ++r) { const int s_ = 16 * st + 4 * g + r; pv[r] = (s_ <= t) ? a[r] * __expf(eS[s_] - gt) : 0.f; }
            u32x2 pw; pw.x = pk2(pv[0], pv[1]); pw.y = pk2(pv[2], pv[3]);
            *(LAS u32x2*)(Ps + t * MP_STRIDE + (16 * st + 4 * g) * 2) = pw;
        }
    }
    __syncthreads();
    {
        f32x4 apv[4], aqc[4];
#pragma unroll
        for (int tt = 0; tt < 4; ++tt) { apv[tt] = (f32x4){0.f, 0.f, 0.f, 0.f}; aqc[tt] = (f32x4){0.f, 0.f, 0.f, 0.f}; }
#pragma unroll
        for (int ks = 0; ks < 2; ++ks) {
            LAS unsigned char* a0 = Vs + (32 * ks + 8 * g + (l15 >> 2)) * MV_STRIDE + (16 * w + 4 * (lane & 3)) * 2;
            const bf16x8 vf = cat8(vtr(a0), vtr(a0 + 4 * MV_STRIDE));
#pragma unroll
            for (int tt = 0; tt < 4; ++tt) { const bf16x8 pf = *(const LAS bf16x8*)(Ps + (16 * tt + l15) * MP_STRIDE + (32 * ks + 8 * g) * 2); apv[tt] = MFMA16(pf, vf, apv[tt]); }
        }
#pragma unroll
        for (int k2 = 0; k2 < 4; ++k2) {
            const bf16x8 cf = __builtin_bit_cast(bf16x8, cfr[k2]);
#pragma unroll
            for (int tt = 0; tt < 4; ++tt) { LAS unsigned char* qa = Qs + (16 * tt + l15) * MQ_STRIDE + (32 * k2 + 4 * g) * 2;
                const bf16x8 qf = cat8(*(const LAS s16x4*)qa, *(const LAS s16x4*)(qa + 32)); aqc[tt] = MFMA16(qf, cf, aqc[tt]); }
        }
#pragma unroll
        for (int tt = 0; tt < 4; ++tt)
#pragma unroll
            for (int r = 0; r < 4; ++r) { const int t = 16 * tt + 4 * g + r; Hn[t * MH_STRIDE + 16 * w + l15] = apv[tt][r] + iS[t] * aqc[tt][r]; }
        { const int t = srow, j = sseg;
          const u32x4 pr = *(const LAS u32x4*)(Ps + t * MP_STRIDE + 16 * j);
          float rs = (bflo(pr.x) + bfhi(pr.x)) + (bflo(pr.y) + bfhi(pr.y)) + (bflo(pr.z) + bfhi(pr.z)) + (bflo(pr.w) + bfhi(pr.w));
          const u32x4 q0 = *(const LAS u32x4*)(Qs + t * MQ_STRIDE + 32 * j), q1 = *(const LAS u32x4*)(Qs + t * MQ_STRIDE + 32 * j + 16);
          const f32x4 n0 = *(const LAS f32x4*)(nS + 16 * j), n1 = *(const LAS f32x4*)(nS + 16 * j + 4), n2 = *(const LAS f32x4*)(nS + 16 * j + 8), n3 = *(const LAS f32x4*)(nS + 16 * j + 12);
          float qn = bflo(q0.x) * n0[0] + bfhi(q0.x) * n0[1] + bflo(q0.y) * n0[2] + bfhi(q0.y) * n0[3] + bflo(q0.z) * n1[0] + bfhi(q0.z) * n1[1] + bflo(q0.w) * n1[2] + bfhi(q0.w) * n1[3]
                   + bflo(q1.x) * n2[0] + bfhi(q1.x) * n2[1] + bflo(q1.y) * n2[2] + bfhi(q1.y) * n2[3] + bflo(q1.z) * n3[0] + bfhi(q1.z) * n3[1] + bflo(q1.w) * n3[2] + bfhi(q1.w) * n3[3];
          float d = rs + iS[t] * qn;
          d += __shfl_xor(d, 1); d += __shfl_xor(d, 2); d += __shfl_xor(d, 4);
          if (j == 0) { const float fl = __expf(-(bS[t] + gS[t])); sm[SM_R + t] = 1.f / fmaxf(fabsf(d), fl); } }
    }
    __syncthreads();
    {
        const int t = srow, j = sseg; const float rd = sm[SM_R + t];
        float hv[16]; float ss = 0.f;
#pragma unroll
        for (int q = 0; q < 4; ++q) { const f32x4 x = *(const LAS f32x4*)(Hn + t * MH_STRIDE + 16 * j + 4 * q);
#pragma unroll
            for (int e = 0; e < 4; ++e) { const float v = x[e] * rd; hv[4 * q + e] = v; ss += v * v; } }
        ss += __shfl_xor(ss, 1); ss += __shfl_xor(ss, 2); ss += __shfl_xor(ss, 4);
        const float rstd = rsqrtf(ss * (1.f / 128.f) + 1e-6f);
        const unsigned mo[8] = {mc0.x, mc0.y, mc0.z, mc0.w, mc1.x, mc1.y, mc1.z, mc1.w};
        unsigned ow[8];
#pragma unroll
        for (int q = 0; q < 8; ++q) { const float g0 = A.mnorm_g[h * 128 + 16 * j + 2 * q], g1 = A.mnorm_g[h * 128 + 16 * j + 2 * q + 1];
            const float z0 = bflo(mo[q]), z1 = bfhi(mo[q]);
            ow[q] = pk2(hv[2 * q] * rstd * g0 * __builtin_amdgcn_rcpf(1.f + __expf(-z0)), hv[2 * q + 1] * rstd * g1 * __builtin_amdgcn_rcpf(1.f + __expf(-z1))); }
        bf16_t* op = ACT + (rowbase + c * 64 + t) * 1024 + h * 128 + 16 * j;
        *(u32x4*)op = (u32x4){ow[0], ow[1], ow[2], ow[3]}; *(u32x4*)(op + 8) = (u32x4){ow[4], ow[5], ow[6], ow[7]};
    }
}

__device__ __forceinline__ void phase3(const Args& A, LAS unsigned char* lds, int rep = 0) {
    const int tid = threadIdx.x;
    const float lam = ((const float*)(A.ws + WS_CTL))[1];
    unsigned* ctr = (unsigned*)(A.ws + WS_CTL) + 2 * rep;
    LAS int* slot = (LAS int*)(lds + LDS_BYTES - 64);
    const int nml = ((int)gridDim.x > 64) ? 32 : 1;
    if ((int)blockIdx.x < nml) for (int bh = blockIdx.x; bh < 32; bh += nml) mlstm_state(A, lds, bh >> 2, bh & 3);
    for (;;) {
        if (tid == 0) slot[0] = (int)atomicAdd(ctr, 1u);
        __syncthreads();
        const int it = slot[0];
        __syncthreads();
        if (it >= 512) break;
        attn_item(A, lds, (it & 31) >> 2, it & 3, 15 - (it >> 5), lam);
    }
    {
        const int lane = tid & 63, wave = tid >> 6;
        LAS float* scr = (LAS float*)(lds + wave * 16384);
        for (int r = blockIdx.x * 8 + wave; r < 1536; r += gridDim.x * 8) {
            if (r < 512) transpose_item(A.w_out, 1024, 0, (bf16_t*)(A.ws + WS_WOUT), scr, r / 32, r % 32, lane);
            else wprime_item(A, (r - 512) >> 6, (r - 512) & 63, lane);
        }
        quantise_tables(A, blockIdx.x * 8 + wave, gridDim.x * 8, 16384, 32768);
    }
}
__device__ __forceinline__ void phase3b(const Args& A, LAS unsigned char* lds) {
    const int tid = threadIdx.x;
    {
        const int lane = tid & 63, wave = tid >> 6;
        const bf16_t* WT = (const bf16_t*)(A.ws + WS_WQ); const float* MOD = (const float*)(A.ws + WS_MOD); float* SB = (float*)(A.ws + WS_SB);
        for (int n = blockIdx.x * 8 + wave; n < 2048; n += gridDim.x * 8) {
            const u32x4 w0 = *(const u32x4*)(WT + (size_t)n * 1024 + 16 * lane), w1 = *(const u32x4*)(WT + (size_t)n * 1024 + 16 * lane + 8);
            const unsigned ww[8] = {w0.x, w0.y, w0.z, w0.w, w1.x, w1.y, w1.z, w1.w};
            float sbv[8];
#pragma unroll
            for (int b = 0; b < 8; ++b) { const float* sp = MOD + b * 6144 + 3072 + 16 * lane; float d = 0.f;
#pragma unroll
                for (int q = 0; q < 4; ++q) { const f32x4 s4 = *(const f32x4*)(sp + 4 * q); d += bflo(ww[2 * q]) * s4[0] + bfhi(ww[2 * q]) * s4[1] + bflo(ww[2 * q + 1]) * s4[2] + bfhi(ww[2 * q + 1]) * s4[3]; }
                sbv[b] = wave_sum(d); }
            if (lane == 0) {
#pragma unroll
                for (int b = 0; b < 8; ++b) SB[b * 2048 + n] = sbv[b]; }
        }
    }
    int last_h = -1;
    for (int item = blockIdx.x; item < 1024; item += gridDim.x) mlstm_out(A, lds, item, last_h);
    __syncthreads();
}

__device__ __forceinline__ void phase5(const Args& A) {
    int tid_o = threadIdx.x; asm volatile("" : "+v"(tid_o)); const int tid = tid_o, lane = tid & 63, wave = tid >> 6, G = gridDim.x;
    const float* MOD = (const float*)(A.ws + WS_MOD);
    bf16_t* ACT = (bf16_t*)(A.ws + WS_ACT);
    for (int m = blockIdx.x * 8 + wave; m < T; m += G * 8) {
        const int b = m >> 11;
        const f32x4* xr = (const f32x4*)(A.out + (size_t)m * 1024) + lane;
        f32x4 v[4]; float ss = 0.f;
#pragma unroll
        for (int j = 0; j < 4; ++j) { v[j] = xr[64 * j]; ss += (v[j][0] * v[j][0] + v[j][1] * v[j][1]) + (v[j][2] * v[j][2] + v[j][3] * v[j][3]); }
        const float rstd = rsqrtf(wave_sum(ss) * (1.f / 1024.f) + 1e-6f);
        unsigned long long* o8 = (unsigned long long*)(ACT + (size_t)m * 1024) + lane;
#pragma unroll
        for (int j = 0; j < 4; ++j) { const int col = 4 * lane + 256 * j;
            const f32x4 g = *(const f32x4*)(A.norm2_g + col), sc = *(const f32x4*)(MOD + b * 6144 + 4096 + col), sh = *(const f32x4*)(MOD + b * 6144 + 3072 + col);
            v[j] = v[j] * rstd * g * (sc + 1.0f) + sh;
            o8[64 * j] = (unsigned long long)pk2(v[j][0], v[j][1]) | ((unsigned long long)pk2(v[j][2], v[j][3]) << 32); }
    }
}

__device__ __forceinline__ unsigned f2key(float f) { const unsigned u = __float_as_uint(f); return (u & 0x80000000u) ? ~u : (u | 0x80000000u); }
__device__ __forceinline__ float key2f(unsigned k) { const unsigned u = (k & 0x80000000u) ? (k & 0x7fffffffu) : ~k; return __uint_as_float(u); }
#define CE_DESC(a, b) do { const unsigned _mx = (a) > (b) ? (a) : (b), _mn = (a) > (b) ? (b) : (a); (a) = _mx; (b) = _mn; } while (0)
__device__ __forceinline__ void sort16_desc(unsigned (&k)[16]) {
#pragma unroll
    for (int size = 2; size <= 16; size <<= 1)
#pragma unroll
        for (int stride = size >> 1; stride > 0; stride >>= 1)
#pragma unroll
            for (int i = 0; i < 16; ++i) { const int j = i ^ stride;
                if (j > i) { if ((i & size) == 0) CE_DESC(k[i], k[j]); else CE_DESC(k[j], k[i]); } }
}
__device__ __forceinline__ void merge16(unsigned (&a)[16], const unsigned (&b)[16]) {
#pragma unroll
    for (int i = 0; i < 16; ++i) a[i] = a[i] > b[15 - i] ? a[i] : b[15 - i];
#pragma unroll
    for (int stride = 8; stride > 0; stride >>= 1)
#pragma unroll
        for (int i = 0; i < 16; ++i) { const int j = i ^ stride; if (j > i) CE_DESC(a[i], a[j]); }
}
constexpr int PE_IDX = 0, PE_SEL = 69632;
__device__ __forceinline__ float gelu_erf(float v) { return 0.5f * v * (1.f + erff(v * 0.70710678118654752f)); }
__device__ __forceinline__ float gelu_fast(float v) {
    const float av = fabsf(v), tt = __builtin_amdgcn_rcpf(av * 0.2316418882f + 1.0f);
    float q = tt * 0.5307027145f + (-0.7265760135f); q = q * tt + 0.7107068705f; q = q * tt + (-0.142248368f); q = q * tt + 0.127414796f; q = q * tt;
    const float e = __builtin_amdgcn_exp2f((v * v) * (-0.72134752044f));
    const float m = v * (q * e);
    return v < 0.f ? m : v - m;
}

__device__ __forceinline__ void peer_tile(const Args& A, LAS unsigned char* lds, int tile) {
    int tid_o = threadIdx.x; asm volatile("" : "+v"(tid_o)); const int tid = tid_o, lane = tid & 63, w = tid >> 6, g = lane >> 4, l15 = lane & 15;
    const bf16_t* QRY = (const bf16_t*)(A.ws + WS_QRY);
    const bf16_t* KEYS = (const bf16_t*)(A.ws + WS_KEYS);
    const bf16_t* ACT = (const bf16_t*)(A.ws + WS_ACT);
    const float* MOD = (const float*)(A.ws + WS_MOD);
    LAS unsigned* idx = (LAS unsigned*)(lds + PE_IDX) + (w * 64 + lane) * 33;
    LAS u32x2* SEL = (LAS u32x2*)(lds + PE_SEL);
    {
        const int tg = w & 3, hg = w >> 2, tl = 16 * tg + l15;
        const size_t m = (size_t)tile * 64 + tl;
        unsigned LA[4][2][16];
#pragma unroll
        for (int hh = 0; hh < 4; ++hh) {
            const int h = 4 * hg + hh;
#pragma unroll
            for (int p = 0; p < 2; ++p) {
                const int hp = 2 * h + p;
                unsigned k0[16], k1[16];
                { const bf16_t* sp = QRY + m * 2048 + hp * 128 + 32 * g;
                  const u32x4 s0 = *(const u32x4*)sp, s1 = *(const u32x4*)(sp + 8), s2 = *(const u32x4*)(sp + 16), s3 = *(const u32x4*)(sp + 24);
                  const unsigned sw[16] = {s0.x, s0.y, s0.z, s0.w, s1.x, s1.y, s1.z, s1.w, s2.x, s2.y, s2.z, s2.w, s3.x, s3.y, s3.z, s3.w};
#pragma unroll
                  for (int i = 0; i < 16; ++i) {
                      const float lo = (float)__builtin_bit_cast(_Float16, (unsigned short)(sw[i] & 0xffffu)), hi = (float)__builtin_bit_cast(_Float16, (unsigned short)(sw[i] >> 16));
                      const unsigned klo = (f2key(lo) & ~127u) | (unsigned)(127 - (32 * g + 2 * i)), khi = (f2key(hi) & ~127u) | (unsigned)(127 - (32 * g + 2 * i + 1));
                      if (i < 8) { k0[2 * i] = klo; k0[2 * i + 1] = khi; } else { k1[2 * (i - 8)] = klo; k1[2 * (i - 8) + 1] = khi; } } }
                sort16_desc(k0); sort16_desc(k1); merge16(k0, k1);
#pragma unroll
                for (int msk = 16; msk <= 32; msk <<= 1) {
#pragma unroll
                    for (int i = 0; i < 16; ++i) k1[i] = (unsigned)__shfl_xor((int)k0[i], msk);
                    merge16(k0, k1); }
#pragma unroll
                for (int i = 0; i < 16; ++i) LA[hh][p][i] = k0[i];
            }
        }
        {
            const int h = 4 * hg + g;
            unsigned L2[2][16];
#pragma unroll
            for (int p = 0; p < 2; ++p)
#pragma unroll
                for (int i = 0; i < 16; ++i) L2[p][i] = (g & 2) ? ((g & 1) ? LA[3][p][i] : LA[2][p][i]) : ((g & 1) ? LA[1][p][i] : LA[0][p][i]);
            float va[16], vb[16];
#pragma unroll
            for (int i = 0; i < 16; ++i) { va[i] = key2f(L2[0][i] & ~127u); vb[i] = key2f(L2[1][i] & ~127u); idx[i] = 127u - (L2[0][i] & 127u); idx[16 + i] = 127u - (L2[1][i] & 127u); }
#define CK(i, j) ((f2key(va[i] + vb[j]) & ~255u) | (unsigned)(255 - (16 * (i) + (j))))
            unsigned Lf[16], Bt[16];
#pragma unroll
            for (int j = 0; j < 16; ++j) Lf[j] = CK(0, j);
#pragma unroll
            for (int j = 0; j < 8; ++j) Bt[j] = CK(1, j);
#pragma unroll
            for (int j = 0; j < 5; ++j) Bt[8 + j] = CK(2, j);
#pragma unroll
            for (int j = 0; j < 3; ++j) Bt[13 + j] = CK(4, j);
            sort16_desc(Bt); merge16(Lf, Bt);
#pragma unroll
            for (int j = 0; j < 4; ++j) Bt[j] = CK(3, j);
            Bt[4] = CK(5, 0); Bt[5] = CK(5, 1); Bt[6] = CK(6, 0); Bt[7] = CK(6, 1); Bt[8] = CK(7, 0); Bt[9] = CK(7, 1);
            Bt[10] = CK(8, 0); Bt[11] = CK(9, 0); Bt[12] = CK(10, 0); Bt[13] = CK(11, 0); Bt[14] = CK(12, 0); Bt[15] = CK(13, 0);
            sort16_desc(Bt); merge16(Lf, Bt);
            { unsigned x0 = CK(14, 0), x1 = CK(15, 0);
#pragma unroll
              for (int i = 0; i < 16; ++i) CE_DESC(Lf[i], x0);
#pragma unroll
              for (int i = 0; i < 16; ++i) CE_DESC(Lf[i], x1); }
#undef CK
            float fv[16], den = 0.f; const float f0 = key2f(Lf[0] & ~255u);
#pragma unroll
            for (int k = 0; k < 16; ++k) { fv[k] = __expf(key2f(Lf[k] & ~255u) - f0); den += fv[k]; }
            const float rden = 1.f / den;
            LDS_WAIT();
#pragma unroll
            for (int k = 0; k < 16; ++k) { const unsigned code = 255u - (Lf[k] & 255u); const unsigned e = idx[code >> 4] * 128u + idx[16 + (code & 15u)];
                u32x2 sv; sv.x = e; sv.y = __float_as_uint(fv[k] * rden); SEL[(tl * 8 + h) * 16 + k] = sv; }
        }
    }
    __syncthreads();
    const unsigned char* T8 = A.ws + WS_T8; const float* SC = (const float*)(A.ws + WS_SC);
    LAS u32x2* SORT = (LAS u32x2*)(lds + PE_IDX);
    LAS int* OFFS = (LAS int*)(lds + PE_SEL + 65536);
    for (int ti = 0; ti < 8; ++ti) {
        const int tl = 8 * w + ti;
        const u32x2 e0 = SEL[tl * 128 + lane], e1 = SEL[tl * 128 + 64 + lane];
        const int p0 = (int)(e0.x >> 10), p1 = (int)(e1.x >> 10);
        int off = 0;
        for (int p = 0; p < 16; ++p) {
            const unsigned long long m0 = __ballot(p0 == p), m1 = __ballot(p1 == p);
            const int c0 = __popcll(m0), c1 = __popcll(m1);
            const int r0 = __builtin_amdgcn_mbcnt_hi((unsigned)(m0 >> 32), __builtin_amdgcn_mbcnt_lo((unsigned)m0, 0u));
            const int r1 = __builtin_amdgcn_mbcnt_hi((unsigned)(m1 >> 32), __builtin_amdgcn_mbcnt_lo((unsigned)m1, 0u));
            if (p0 == p) SORT[tl * 128 + off + r0] = e0;
            if (p1 == p) SORT[tl * 128 + off + c0 + r1] = e1;
            if (lane == 0) OFFS[tl * 17 + p] = off;
            off += c0 + c1;
        }
        if (lane == 0) OFFS[tl * 17 + 16] = off;
    }
    LDS_WAIT(); __builtin_amdgcn_wave_barrier();
    const unsigned char* T8v = T8 + (size_t)16384 * 1024;
    const bf16_t* A3 = (const bf16_t*)(A.ws + WS_A3); const float* RSq = (const float*)(A.ws + WS_RS);
    for (int pass = 0; pass < 2; ++pass) {
        const int tb = 8 * w + 4 * pass;
        u32x4 xpa[4], xpb[4]; f32x2 oacc[4][8];
#pragma unroll
        for (int tk = 0; tk < 4; ++tk) { const size_t m = (size_t)tile * 64 + tb + tk;
            { const u32x4 ra = *(const u32x4*)(A3 + m * 1024 + 16 * lane), rb = *(const u32x4*)(A3 + m * 1024 + 16 * lane + 8);
              float xr_; { const f32x4 p0 = *(const f32x4*)(RSq + m * 16), p1 = *(const f32x4*)(RSq + m * 16 + 4), p2 = *(const f32x4*)(RSq + m * 16 + 8), p3 = *(const f32x4*)(RSq + m * 16 + 12);
                const f32x4 ps = (p0 + p1) + (p2 + p3); xr_ = rsqrtf(((ps[0] + ps[1]) + (ps[2] + ps[3])) * (1.f / 1024.f) + 1e-6f); }
              const unsigned rr[8] = {ra.x, ra.y, ra.z, ra.w, rb.x, rb.y, rb.z, rb.w}; unsigned hh[8];
              const float* sp = MOD + (int)(m >> 11) * 6144 + 3072 + 16 * lane;
#pragma unroll
              for (int q = 0; q < 8; ++q) { const f32x2 sh = *(const f32x2*)(sp + 2 * q); hh[q] = pk2(bflo(rr[q]) * xr_ + sh[0], bfhi(rr[q]) * xr_ + sh[1]); }
              xpa[tk] = (u32x4){hh[0], hh[1], hh[2], hh[3]}; xpb[tk] = (u32x4){hh[4], hh[5], hh[6], hh[7]}; }
#pragma unroll
            for (int q = 0; q < 8; ++q) oacc[tk][q] = (f32x2){0.f, 0.f}; }
        int it_p = 0, it_tk = -1, it_j = 0, it_end = 0; bool it_done = false;
#define IT_ADVANCE() do { it_j += 4; while (it_j >= it_end) { if (it_done) break; ++it_tk; if (it_tk == 4) { it_tk = 0; ++it_p; if (it_p == 16) { it_done = true; it_p = 15; it_j = 0; it_end = 1; break; } } \
            it_j = __builtin_amdgcn_readfirstlane(OFFS[(tb + it_tk) * 17 + it_p]); it_end = __builtin_amdgcn_readfirstlane(OFFS[(tb + it_tk) * 17 + it_p + 1]); } } while (0)
#define LOAD_SET(U, V, CG, SU, SV) do { const int _tl = tb + it_tk; \
            _Pragma("unroll") for (int _k = 0; _k < 4; ++_k) { const int _jj = (it_j + _k < it_end) ? it_j + _k : it_end - 1; const unsigned _e = SORT[_tl * 128 + _jj].x; \
                U[_k] = *(const u32x4*)(T8 + (size_t)_e * 1024 + 16 * lane); V[_k] = *(const u32x4*)(T8v + (size_t)_e * 1024 + 16 * lane); } \
            const int _ms = lane >> 4; const bool _valid = it_j + _ms < it_end; const u32x2 _se = SORT[_tl * 128 + (_valid ? it_j + _ms : it_end - 1)]; \
            CG = _valid ? __uint_as_float(_se.y) : 0.f; SU = SC[_se.x]; SV = SC[16384 + _se.x]; } while (0)
        u32x4 uA[4], vA[4], uB[4], vB[4]; float cgA = 0.f, suA = 0.f, svA = 0.f, cgB = 0.f, suB = 0.f, svB = 0.f;
#pragma unroll
        for (int k = 0; k < 4; ++k) { uA[k] = (u32x4){0u, 0u, 0u, 0u}; vA[k] = uA[k]; uB[k] = uA[k]; vB[k] = uA[k]; }
        IT_ADVANCE();
        LOAD_SET(uA, vA, cgA, suA, svA);
        for (int p = 0; p < 16; ++p) {
#pragma unroll
            for (int tk = 0; tk < 4; ++tk) {
                const int tl = tb + tk;
                const int beg = __builtin_amdgcn_readfirstlane(OFFS[tl * 17 + p]), end = __builtin_amdgcn_readfirstlane(OFFS[tl * 17 + p + 1]);
                f32x2 xf[8];
                { const unsigned xx[8] = {xpa[tk].x, xpa[tk].y, xpa[tk].z, xpa[tk].w, xpb[tk].x, xpb[tk].y, xpb[tk].z, xpb[tk].w};
#pragma unroll
                  for (int q = 0; q < 8; ++q) xf[q] = (f32x2){bflo(xx[q]), bfhi(xx[q])}; }
#define COMPUTE_SET(U, V, CG, SU, SV) do { float pd[4]; \
                    _Pragma("unroll") for (int k = 0; k < 4; ++k) { f32x2 d = (f32x2){0.f, 0.f}; \
                        _Pragma("unroll") for (int q = 0; q < 4; ++q) { const int dw = (int)U[k][q]; \
                            d += __builtin_amdgcn_cvt_pk_f32_fp8(dw, false) * xf[2 * q]; d += __builtin_amdgcn_cvt_pk_f32_fp8(dw, true) * xf[2 * q + 1]; } \
                        pd[k] = d[0] + d[1]; } \
                    float s; \
                    { const auto r0 = __builtin_amdgcn_permlane32_swap(__float_as_uint(pd[0]), __float_as_uint(pd[2]), false, false); \
                      const auto r1 = __builtin_amdgcn_permlane32_swap(__float_as_uint(pd[1]), __float_as_uint(pd[3]), false, false); \
                      const float a0 = __uint_as_float(r0[0]) + __uint_as_float(r0[1]), a1 = __uint_as_float(r1[0]) + __uint_as_float(r1[1]); \
                      const auto r2 = __builtin_amdgcn_permlane16_swap(__float_as_uint(a0), __float_as_uint(a1), false, false); \
                      s = __uint_as_float(r2[0]) + __uint_as_float(r2[1]); \
                      s += __int_as_float(__builtin_amdgcn_mov_dpp(__float_as_int(s), 0xB1, 0xF, 0xF, true)); \
                      s += __int_as_float(__builtin_amdgcn_mov_dpp(__float_as_int(s), 0x4E, 0xF, 0xF, true)); \
                      s += __int_as_float(__builtin_amdgcn_mov_dpp(__float_as_int(s), 0x141, 0xF, 0xF, true)); \
                      s += __int_as_float(__builtin_amdgcn_mov_dpp(__float_as_int(s), 0x140, 0xF, 0xF, true)); } \
                    const float coef = CG * gelu_fast(s * SU) * SV; \
                    _Pragma("unroll") for (int k = 0; k < 4; ++k) { const float ck = __int_as_float(__builtin_amdgcn_readlane(__float_as_int(coef), 16 * k)); const f32x2 ck2 = (f32x2){ck, ck}; \
                        _Pragma("unroll") for (int qq = 0; qq < 4; ++qq) { const int dw = (int)V[k][qq]; \
                            oacc[tk][2 * qq] += ck2 * __builtin_amdgcn_cvt_pk_f32_fp8(dw, false); oacc[tk][2 * qq + 1] += ck2 * __builtin_amdgcn_cvt_pk_f32_fp8(dw, true); } } } while (0)
                for (int j0 = beg; j0 < end; j0 += 8) {
                    IT_ADVANCE();
                    LOAD_SET(uB, vB, cgB, suB, svB);
                    COMPUTE_SET(uA, vA, cgA, suA, svA);
                    if (j0 + 4 < end) {
                        IT_ADVANCE();
                        LOAD_SET(uA, vA, cgA, suA, svA);
                        COMPUTE_SET(uB, vB, cgB, suB, svB);
                    } else {
#pragma unroll
                        for (int k = 0; k < 4; ++k) { uA[k] = uB[k]; vA[k] = vB[k]; }
                        cgA = cgB; suA = suB; svA = svB;
                    }
                }
            }
        }
#undef COMPUTE_SET
#undef IT_ADVANCE
#undef LOAD_SET
#pragma unroll
        for (int tk = 0; tk < 4; ++tk) {
            const size_t m = (size_t)tile * 64 + tb + tk; const int b = (int)(m >> 11);
            float* orow = A.out + m * 1024 + 16 * lane;
            const float* g2 = MOD + b * 6144 + 5120 + 16 * lane;
            f32x4 xv[4]; float ss = 0.f;
#pragma unroll
            for (int j = 0; j < 4; ++j) { const f32x4 x1 = *(const f32x4*)(orow + 4 * j), gg = *(const f32x4*)(g2 + 4 * j);
                const f32x4 pe = (f32x4){oacc[tk][2 * j][0], oacc[tk][2 * j][1], oacc[tk][2 * j + 1][0], oacc[tk][2 * j + 1][1]};
                xv[j] = x1 + gg * pe; ss += (xv[j][0] * xv[j][0] + xv[j][1] * xv[j][1]) + (xv[j][2] * xv[j][2] + xv[j][3] * xv[j][3]); }
            const float rstd = rsqrtf(wave_sum(ss) * (1.f / 1024.f) + 1e-6f);
#pragma unroll
            for (int j = 0; j < 4; ++j) { const f32x4 fg = *(const f32x4*)(A.final_g + 16 * lane + 4 * j); *(f32x4*)(orow + 4 * j) = xv[j] * rstd * fg; }
        }
    }
    __syncthreads();
}


#define XB_TMO      128
#define XB_XCNT(j)  (256  + 64 * (j))
#define XB_XSUB(j)  (1280 + 64 * (j))
#define XB_XGEN(j)  (2304 + 64 * (j))
#define XB_TOP      3328
#define XB_TOPGEN   3392
#define XCD_BAR_WORDS 3456
#define XB_SPIN_CAP (1u << 18)

__device__ __forceinline__ unsigned xb_ld(unsigned* p)              { return __hip_atomic_load(p, __ATOMIC_RELAXED, __HIP_MEMORY_SCOPE_AGENT); }
__device__ __forceinline__ unsigned xb_add(unsigned* p, unsigned v) { return __hip_atomic_fetch_add(p, v, __ATOMIC_RELAXED, __HIP_MEMORY_SCOPE_AGENT); }
__device__ __forceinline__ unsigned xb_xcc_id() { return (unsigned)__builtin_amdgcn_s_getreg((3 << 11) | 20) & 0xFu; }
#define XB_SPIN(cond, bar) do { unsigned _sp = 0; while (cond) { __builtin_amdgcn_s_sleep(1); \
    if ((++_sp & 255u) == 0u) { if (xb_ld(&(bar)[XB_TMO])) break; if (_sp > XB_SPIN_CAP) { atomicAdd(&(bar)[XB_TMO], 1u); break; } } } } while (0)

struct XcdBarrier {
    unsigned* bar; unsigned x;
    volatile LAS unsigned* st;
};

__device__ __forceinline__ XcdBarrier xcd_barrier_post(unsigned* bar, volatile LAS unsigned* st) {
    XcdBarrier b; b.bar = bar; b.x = xb_xcc_id(); b.st = st;
    if (threadIdx.x == 0) (void)xb_add(&bar[XB_XCNT(b.x)], 1u);
    return b;
}
__device__ __forceinline__ void xcd_barrier_complete(unsigned* bar, unsigned x, unsigned& nloc, unsigned& nx) {
    const unsigned G = gridDim.x * gridDim.y * gridDim.z;
    unsigned sum, cnt, mine, sp = 0u;
    for (;;) {
        sum = 0u; cnt = 0u; mine = 0u;
#pragma unroll
        for (unsigned j = 0; j < 16; ++j) { const unsigned c = xb_ld(&bar[XB_XCNT(j)]); sum += c; cnt += (c > 0u) ? 1u : 0u; mine = (j == x) ? c : mine; }
        if (sum == G) break;
        __builtin_amdgcn_s_sleep(1);
        if ((++sp & 255u) == 0u) { if (xb_ld(&bar[XB_TMO])) break; if (sp > XB_SPIN_CAP) { atomicAdd(&bar[XB_TMO], 1u); break; } }
    }
    nloc = mine > 0u ? mine : 1u; nx = cnt > 0u ? cnt : 1u;
}

__device__ __forceinline__ void xcd_barrier(const XcdBarrier& b) {
    asm volatile("s_waitcnt vmcnt(0)" ::: "memory");
    __syncthreads();
    if (threadIdx.x == 0) {
        unsigned* bar = b.bar;
        __builtin_amdgcn_s_waitcnt(0);
        unsigned nloc = b.st[0], nx = b.st[1];
        if (nloc == 0u) { xcd_barrier_complete(bar, b.x, nloc, nx); b.st[0] = nloc; b.st[1] = nx; }
        const unsigned old = xb_add(&bar[XB_XSUB(b.x)], 1u);
        const unsigned gen = old / nloc;
        if (old + 1u == (gen + 1u) * nloc) {
            __builtin_amdgcn_fence(__ATOMIC_RELEASE, "agent");
            asm volatile("s_waitcnt vmcnt(0)" ::: "memory");
            const unsigned og = xb_add(&bar[XB_TOP], 1u);
            const unsigned tg = og / nx;
            if (og + 1u == (tg + 1u) * nx) xb_add(&bar[XB_TOPGEN], 1u);
            else XB_SPIN(xb_ld(&bar[XB_TOPGEN]) == tg, bar);
            __builtin_amdgcn_fence(__ATOMIC_ACQUIRE, "agent");
            xb_add(&bar[XB_XGEN(b.x)], 1u);
            asm volatile("s_waitcnt vmcnt(0)" ::: "memory");
        } else {
            XB_SPIN(xb_ld(&bar[XB_XGEN(b.x)]) == gen, bar);
            __builtin_amdgcn_fence(__ATOMIC_ACQUIRE, "agent");
            asm volatile("s_waitcnt vmcnt(0)" ::: "memory");
        }
    }
    __syncthreads();
}

__global__ void __launch_bounds__(512, 2) mega_fwd(Args A) {
    extern __shared__ __attribute__((aligned(16))) unsigned char lds_raw[];
    LAS unsigned char* lds = (LAS unsigned char*)lds_raw;
    cg::grid_group grid = cg::this_grid();
    const int G = gridDim.x;
    if (threadIdx.x < 4) ((LAS unsigned*)(lds + LDS_BYTES - 32))[threadIdx.x] = 0u;
    __syncthreads();
    if (A.ws == nullptr) grid.sync();
    const XcdBarrier xb = xcd_barrier_post((unsigned*)(A.ws + WS_BAR), (volatile LAS unsigned*)(lds + LDS_BYTES - 32));
    phase0(A, lds);
    xcd_barrier(xb);
    phase1(A, lds);
    phase0b(A, lds);
    xcd_barrier(xb);
    { pg8::Gemm gm{(const pg8::bf16_t*)(A.ws + WS_ACT), (const pg8::bf16_t*)(A.ws + WS_WIN), T, NP, DM}; pg8::StaticOrder S; S.init(T, NP, G, (int)blockIdx.x);
      pg8::EpiStoreBf16 E{(pg8::bf16_t*)(A.ws + WS_P), NP};
      pg8::gemm_phase<pg8::EpiStoreBf16, pg8::StaticOrder, true, true>((PG8_LAS unsigned char*)lds, gm, S, E); }
    { const int nshort = G - (896 % G == 0 ? 0 : 896 % G);
      const int first = G - nshort;
      if ((int)blockIdx.x >= first) quantise_tables(A, ((int)blockIdx.x - first) * 8 + (int)(threadIdx.x >> 6), nshort * 8, 0, 16384); }
    xcd_barrier(xb);
    phase3(A, lds);
    xcd_barrier(xb);
    phase3b(A, lds);
    xcd_barrier(xb);
    { pg8::Gemm gm{(const pg8::bf16_t*)(A.ws + WS_ACT), (const pg8::bf16_t*)(A.ws + WS_WOUT), T, DM, DM}; pg8::StaticOrder S; S.init(T, DM, G, (int)blockIdx.x);
      pg8::EpiResidNorm E{A.x, (const float*)(A.ws + WS_MOD), A.norm2_g, A.out, (pg8::bf16_t*)(A.ws + WS_A3), (float*)(A.ws + WS_RS)};
      pg8::gemm_phase<pg8::EpiResidNorm, pg8::StaticOrder, true, true>((PG8_LAS unsigned char*)lds, gm, S, E); }
    xcd_barrier(xb);
    { pg8::Gemm gm{(const pg8::bf16_t*)(A.ws + WS_A3), (const pg8::bf16_t*)(A.ws + WS_WQ), T, 2048, DM}; pg8::StaticOrder S; S.init(T, 2048, G, (int)blockIdx.x);
      pg8::EpiScoreF16 E{(pg8::bf16_t*)(A.ws + WS_QRY), 2048, (const float*)(A.ws + WS_RS), (const float*)(A.ws + WS_SB)};
      pg8::gemm_phase<pg8::EpiScoreF16, pg8::StaticOrder, true, true>((PG8_LAS unsigned char*)lds, gm, S, E); }
    xcd_barrier(xb);
    for (int tile = blockIdx.x; tile < T / 64; tile += G) peer_tile(A, lds, tile);
}

extern "C" void kernel_launch(void* const* d_in, const int* in_sizes, int n_in, void* d_out, int out_size, void* d_ws, size_t ws_size, hipStream_t stream) {
    static int grid = 0;
    if (grid == 0) {
        if (n_in != 22 || out_size != T * DM || ws_size < WS_END) { fprintf(stderr, "kernel_launch: unexpected shapes (n_in %d out %d ws %zu)\n", n_in, out_size, ws_size); grid = -1; return; }
        int dev = 0, cus = 0, per_cu = 0;
        if (hipGetDevice(&dev) != hipSuccess || hipDeviceGetAttribute(&cus, hipDeviceAttributeMultiprocessorCount, dev) != hipSuccess) { grid = -1; return; }
        if (hipFuncSetAttribute((const void*)mega_fwd, hipFuncAttributeMaxDynamicSharedMemorySize, LDS_BYTES) != hipSuccess) { fprintf(stderr, "kernel_launch: hipFuncSetAttribute failed\n"); grid = -1; return; }
        if (hipOccupancyMaxActiveBlocksPerMultiprocessor(&per_cu, (const void*)mega_fwd, 512, LDS_BYTES) != hipSuccess || per_cu < 1) { fprintf(stderr, "kernel_launch: occupancy query gave %d\n", per_cu); per_cu = 1; }
        (void)hipGetLastError();
        grid = cus * per_cu;
    }
    if (grid < 0) return;
    Args a{};
    const float** ap = (const float**)&a;
    for (int i = 0; i < 22; ++i) ap[i] = (const float*)d_in[i];
    a.out = (float*)d_out; a.ws = (unsigned char*)d_ws;
    if (hipMemsetAsync((unsigned char*)d_ws + WS_BAR, 0, XCD_BAR_WORDS * sizeof(unsigned), stream) != hipSuccess) { fprintf(stderr, "kernel_launch: memset of the barrier words failed\n"); return; }
    void* args[] = {&a};
    hipError_t e = hipLaunchCooperativeKernel((const void*)mega_fwd, dim3(grid), dim3(512), args, LDS_BYTES, stream);
    if (e != hipSuccess) fprintf(stderr, "kernel_launch: cooperative launch failed: %s (grid %d)\n", hipGetErrorString(e), grid);
}
```

```cpp
#include <hip/hip_runtime.h>
#include <hip/hip_cooperative_groups.h>
#include <cstdio>
#include <cstdint>
namespace cg = cooperative_groups;

namespace pg8 {
#define PG8_LAS __attribute__((address_space(3)))
typedef unsigned short bf16_t;
typedef short bf16x8 __attribute__((ext_vector_type(8)));
typedef float f32x4 __attribute__((ext_vector_type(4)));
typedef unsigned u32x4 __attribute__((ext_vector_type(4)));
constexpr int BM = 256, BK = 64, HALF = 128, HTB = HALF * BK * 2  , STAGE_BYTES = 8 * HTB, NXCD = 8, WGM = 8;

__host__ __device__ __forceinline__ int lds_byte(int r, int c) { const int st = (r >> 4) * 2 + (c >> 5), rr = r & 15, cc = c & 31, ob = rr * 64 + cc * 2; return st * 1024 + (ob ^ (((ob >> 9) & 1) << 5)); }
__host__ __device__ __forceinline__ void stage_rc(int b, int& R, int& C) { const int st = b / 1024, sb = b % 1024, swz = sb ^ (((sb >> 9) & 1) << 5); R = (st >> 1) * 16 + swz / 64; C = (st & 1) * 32 + (swz % 64) / 2; }
__host__ __device__ __forceinline__ int perm32(int rho) { const int n = rho >> 4, i = rho & 15; return 8 * (i >> 2) + 4 * n + (i & 3); }

struct Unit { int pm, pn; };
struct Gemm { const bf16_t* A; const bf16_t* Bt; int M, N, K; };

struct StaticOrder {
    int nM, nN, nwg, G, c;
    __host__ __device__ void init(int M, int N, int G_, int c_) { nM = M / BM; nN = N / BM; nwg = nM * nN; G = G_; c = c_; }
    __host__ __device__ bool next(int i, Unit& u) const {
        const long L = (long)i * G + c; if (L >= nwg) return false;
        int wgid = (int)L; { const int q = nwg / NXCD, r = nwg % NXCD, xcd = wgid % NXCD, off = wgid / NXCD; wgid = (xcd < r ? xcd * (q + 1) : r * (q + 1) + (xcd - r) * q) + off; }
        const int nig = WGM * nN, gid = wgid / nig, fm = gid * WGM, gsz = (nM - fm) < WGM ? (nM - fm) : WGM;
        u.pm = fm + ((wgid % nig) % gsz); u.pn = (wgid % nig) / gsz; return true;
    }
    __device__ __forceinline__ void a_ready(const Unit&) const {}
    __device__ __forceinline__ void done(const Unit&) const {}
};

__device__ __forceinline__ unsigned cvt_pk_bf16(float lo, float hi) { unsigned r; asm volatile("v_cvt_pk_bf16_f32 %0, %1, %2" : "=v"(r) : "v"(lo), "v"(hi)); return r; }

struct EpiStoreBf16 {
    static constexpr bool PERM = true, AFTER_DRAIN = false;
    bf16_t* O; int ldc;
    __device__ __forceinline__ void operator()(const f32x4 (&acc)[2][2][4][2], const Unit& u, int wr, int wc, int fr, int fq) const {
        const int row0 = u.pm * BM + wr * 64 + fr, col0 = u.pn * BM + wc * 32 + 8 * fq;
#pragma unroll
        for (int ai = 0; ai < 2; ++ai)
#pragma unroll
            for (int m = 0; m < 4; ++m) { bf16_t* rowp = O + (size_t)(row0 + ai * HALF + m * 16) * ldc + col0;
#pragma unroll
                for (int bj = 0; bj < 2; ++bj) { const f32x4 v0 = acc[ai][bj][m][0], v1 = acc[ai][bj][m][1];
                    u32x4 w; w.x = cvt_pk_bf16(v0[0], v0[1]); w.y = cvt_pk_bf16(v0[2], v0[3]); w.z = cvt_pk_bf16(v1[0], v1[1]); w.w = cvt_pk_bf16(v1[2], v1[3]);
                    *(u32x4*)(rowp + bj * HALF) = w; } }
    }
};
struct EpiStoreF16 {
    static constexpr bool PERM = true, AFTER_DRAIN = false;
    bf16_t* O; int ldc;
    static __device__ __forceinline__ unsigned pkh(float a, float b) { return (unsigned)__builtin_bit_cast(unsigned short, (_Float16)a) | ((unsigned)__builtin_bit_cast(unsigned short, (_Float16)b) << 16); }
    __device__ __forceinline__ void operator()(const f32x4 (&acc)[2][2][4][2], const Unit& u, int wr, int wc, int fr, int fq) const {
        const int row0 = u.pm * BM + wr * 64 + fr, col0 = u.pn * BM + wc * 32 + 8 * fq;
#pragma unroll
        for (int ai = 0; ai < 2; ++ai)
#pragma unroll
            for (int m = 0; m < 4; ++m) { bf16_t* rowp = O + (size_t)(row0 + ai * HALF + m * 16) * ldc + col0;
#pragma unroll
                for (int bj = 0; bj < 2; ++bj) { const f32x4 v0 = acc[ai][bj][m][0], v1 = acc[ai][bj][m][1];
                    u32x4 w; w.x = pkh(v0[0], v0[1]); w.y = pkh(v0[2], v0[3]); w.z = pkh(v1[0], v1[1]); w.w = pkh(v1[2], v1[3]);
                    *(u32x4*)(rowp + bj * HALF) = w; } }
    }
};
struct EpiResid {
    static constexpr bool PERM = true, AFTER_DRAIN = false;
    const float* x; const float* gate; float* out;
    __device__ __forceinline__ void operator()(const f32x4 (&acc)[2][2][4][2], const Unit& u, int wr, int wc, int fr, int fq) const {
        const int row0 = u.pm * BM + wr * 64 + fr, col0 = u.pn * BM + wc * 32 + 8 * fq;
#pragma unroll
        for (int ai = 0; ai < 2; ++ai)
#pragma unroll
            for (int m = 0; m < 4; ++m) { const int r = row0 + ai * HALF + m * 16; const float* gp = gate + (size_t)(r >> 11) * 6144;
#pragma unroll
                for (int bj = 0; bj < 2; ++bj) { const int c = col0 + bj * HALF;
                    const f32x4 xa = *(const f32x4*)(x + (size_t)r * 1024 + c), xb = *(const f32x4*)(x + (size_t)r * 1024 + c + 4);
                    const f32x4 ga = *(const f32x4*)(gp + c), gb = *(const f32x4*)(gp + c + 4);
                    *(f32x4*)(out + (size_t)r * 1024 + c) = xa + ga * acc[ai][bj][m][0];
                    *(f32x4*)(out + (size_t)r * 1024 + c + 4) = xb + gb * acc[ai][bj][m][1]; } }
    }
};
struct EpiResidNorm {
    static constexpr bool PERM = true, AFTER_DRAIN = false;
    const float* x; const float* mod; const float* ng; float* out; bf16_t* a3; float* rs;
    __device__ __forceinline__ void operator()(const f32x4 (&acc)[2][2][4][2], const Unit& u, int wr, int wc, int fr, int fq) const {
        const int row0 = u.pm * BM + wr * 64 + fr, col0 = u.pn * BM + wc * 32 + 8 * fq;
        const float* mp = mod + (size_t)((u.pm * BM) >> 11) * 6144;
        f32x4 g1v[2][2], csv[2][2];
#pragma unroll
        for (int bj = 0; bj < 2; ++bj)
#pragma unroll
            for (int n = 0; n < 2; ++n) { const int c = col0 + bj * HALF + 4 * n; g1v[bj][n] = *(const f32x4*)(mp + 2048 + c); csv[bj][n] = *(const f32x4*)(ng + c) * (*(const f32x4*)(mp + 4096 + c) + 1.0f); }
#pragma unroll
        for (int ai = 0; ai < 2; ++ai)
#pragma unroll
            for (int m = 0; m < 4; ++m) { const int r = row0 + ai * HALF + m * 16; float ss = 0.f;
#pragma unroll
                for (int bj = 0; bj < 2; ++bj) { const int c = col0 + bj * HALF;
                    const f32x4 xa = *(const f32x4*)(x + (size_t)r * 1024 + c), xb = *(const f32x4*)(x + (size_t)r * 1024 + c + 4);
                    const f32x4 v0 = xa + g1v[bj][0] * acc[ai][bj][m][0], v1 = xb + g1v[bj][1] * acc[ai][bj][m][1];
                    *(f32x4*)(out + (size_t)r * 1024 + c) = v0; *(f32x4*)(out + (size_t)r * 1024 + c + 4) = v1;
                    ss += (v0[0] * v0[0] + v0[1] * v0[1]) + (v0[2] * v0[2] + v0[3] * v0[3]) + (v1[0] * v1[0] + v1[1] * v1[1]) + (v1[2] * v1[2] + v1[3] * v1[3]);
                    const f32x4 a0 = v0 * csv[bj][0], a1 = v1 * csv[bj][1];
                    u32x4 w; w.x = cvt_pk_bf16(a0[0], a0[1]); w.y = cvt_pk_bf16(a0[2], a0[3]); w.z = cvt_pk_bf16(a1[0], a1[1]); w.w = cvt_pk_bf16(a1[2], a1[3]);
                    *(u32x4*)(a3 + (size_t)r * 1024 + c) = w; }
                ss += __shfl_xor(ss, 16); ss += __shfl_xor(ss, 32);
                if (fq == 0) rs[(size_t)r * 16 + (u.pn & 3) * 4 + wc] = ss; }
    }
};
struct EpiScoreF16 {
    static constexpr bool PERM = true, AFTER_DRAIN = false;
    bf16_t* O; int ldc; const float* rs; const float* sb;
    static __device__ __forceinline__ unsigned pkh(float a, float b) { return (unsigned)__builtin_bit_cast(unsigned short, (_Float16)a) | ((unsigned)__builtin_bit_cast(unsigned short, (_Float16)b) << 16); }
    __device__ __forceinline__ void operator()(const f32x4 (&acc)[2][2][4][2], const Unit& u, int wr, int wc, int fr, int fq) const {
        const int row0 = u.pm * BM + wr * 64 + fr, col0 = u.pn * BM + wc * 32 + 8 * fq;
        const float* sbp = sb + (size_t)((u.pm * BM) >> 11) * 2048;
        f32x4 bv[2][2];
#pragma unroll
        for (int bj = 0; bj < 2; ++bj)
#pragma unroll
            for (int n = 0; n < 2; ++n) bv[bj][n] = *(const f32x4*)(sbp + col0 + bj * HALF + 4 * n);
#pragma unroll
        for (int ai = 0; ai < 2; ++ai)
#pragma unroll
            for (int m = 0; m < 4; ++m) { const int r = row0 + ai * HALF + m * 16;
                float rstd; { const f32x4 p0 = *(const f32x4*)(rs + (size_t)r * 16), p1 = *(const f32x4*)(rs + (size_t)r * 16 + 4), p2 = *(const f32x4*)(rs + (size_t)r * 16 + 8), p3 = *(const f32x4*)(rs + (size_t)r * 16 + 12);
                  const f32x4 ps = (p0 + p1) + (p2 + p3); rstd = rsqrtf(((ps[0] + ps[1]) + (ps[2] + ps[3])) * (1.f / 1024.f) + 1e-6f); }
                bf16_t* rowp = O + (size_t)r * ldc + col0;
#pragma unroll
                for (int bj = 0; bj < 2; ++bj) { const f32x4 v0 = acc[ai][bj][m][0] * rstd + bv[bj][0], v1 = acc[ai][bj][m][1] * rstd + bv[bj][1];
                    u32x4 w; w.x = pkh(v0[0], v0[1]); w.y = pkh(v0[2], v0[3]); w.z = pkh(v1[0], v1[1]); w.w = pkh(v1[2], v1[3]);
                    *(u32x4*)(rowp + bj * HALF) = w; } }
    }
};
template <class Epi, class Sched, bool ALIGN_EPI = false, bool SP2 = false>
__device__ __forceinline__ void gemm_phase(PG8_LAS unsigned char* lds, const Gemm g, const Sched& S, const Epi& E) {
    int tid_o = threadIdx.x; asm volatile("" : "+v"(tid_o)); const int tid = tid_o, wid = __builtin_amdgcn_readfirstlane(tid >> 6), lane = tid & 63, wr = wid >> 2, wc = wid & 3, fr = lane & 15, fq = lane >> 4;
    const int K = g.K, nt = K / BK;
    unsigned voffA[2], voffB[2];
#pragma unroll
    for (int i = 0; i < 2; ++i) { int R, C; stage_rc(tid * 16 + i * 8192, R, C); const int Rb = Epi::PERM ? ((R & ~31) + perm32(R & 31)) : R;
        voffA[i] = (unsigned)(R * K + C) * 2u; voffB[i] = (unsigned)(Rb * K + C) * 2u; }
    const size_t kstep = (size_t)(BK * 2);
    const size_t hstep = (size_t)HALF * K * 2;
    const size_t tstep = 2 * hstep;
    const unsigned ldsw = (unsigned)wid * 1024u;
    const int aoff = lds_byte(wr * 64 + fr, fq * 8), boff = lds_byte(wc * 32 + fr, fq * 8);
#define PG8_SA(b, h) (((b) * 2 + (h)) * HTB)
#define PG8_SB(b, h) ((4 + (b) * 2 + (h)) * HTB)
#define PG8_STAGE(bufoff, gbase, voff) do { _Pragma("unroll") for (int _i = 0; _i < 2; ++_i) \
        __builtin_amdgcn_global_load_lds((const unsigned*)((const char*)(gbase) + (voff)[_i]), (PG8_LAS unsigned*)(lds + (bufoff) + ldsw + _i * 8192), 16, 0, 0); } while (0)
#define PG8_LDA(dst, b, h) do { _Pragma("unroll") for (int m = 0; m < 4; ++m) _Pragma("unroll") for (int k = 0; k < 2; ++k) dst[m][k] = *(const PG8_LAS bf16x8*)(lds + PG8_SA(b, h) + aoff + m * 2048 + k * 1024); } while (0)
#define PG8_LDB(dst, b, h) do { _Pragma("unroll") for (int n = 0; n < 2; ++n) _Pragma("unroll") for (int k = 0; k < 2; ++k) dst[n][k] = *(const PG8_LAS bf16x8*)(lds + PG8_SB(b, h) + boff + n * 2048 + k * 1024); } while (0)
#define PG8_MMA(ai, bj, At, Bt) do { __builtin_amdgcn_s_setprio(1); _Pragma("unroll") for (int m = 0; m < 4; ++m) _Pragma("unroll") for (int n = 0; n < 2; ++n) _Pragma("unroll") for (int k = 0; k < 2; ++k) \
        acc[ai][bj][m][n] = __builtin_amdgcn_mfma_f32_16x16x32_bf16(Bt[n][k], At[m][k], acc[ai][bj][m][n], 0, 0, 0); __builtin_amdgcn_s_setprio(0); } while (0)
#define PG8_WAIT_V(n) asm volatile("s_waitcnt vmcnt(" #n ")" ::: "memory")
#define PG8_WAIT_L(n) asm volatile("s_waitcnt lgkmcnt(" #n ")" ::: "memory")
#define PG8_BAR __builtin_amdgcn_s_barrier()
#define PG8_SCHED __builtin_amdgcn_sched_barrier(0)
    Unit cur, nxt; int ui = 0;
    if (!S.next(0, cur)) return;
    f32x4 acc[2][2][4][2];
#pragma unroll
    for (int a = 0; a < 2; ++a)
#pragma unroll
        for (int b = 0; b < 2; ++b)
#pragma unroll
            for (int m = 0; m < 4; ++m)
#pragma unroll
                for (int n = 0; n < 2; ++n) acc[a][b][m][n] = (f32x4){0.f, 0.f, 0.f, 0.f};
    bf16x8 At[4][2], B0[2][2], B1[2][2];
    const char* cA = (const char*)g.A + (size_t)cur.pm * tstep; const char* cB = (const char*)g.Bt + (size_t)cur.pn * tstep;
    S.a_ready(cur);
    if constexpr (SP2) {
        PG8_STAGE(PG8_SB(0, 0), cB, voffB); PG8_STAGE(PG8_SB(0, 1), cB + hstep, voffB); PG8_STAGE(PG8_SA(0, 0), cA, voffA); PG8_STAGE(PG8_SA(0, 1), cA + hstep, voffA);
        if (wr == 1) PG8_BAR;
        PG8_WAIT_V(2); PG8_BAR;
        PG8_STAGE(PG8_SB(1, 0), cB + kstep, voffB); PG8_STAGE(PG8_SA(1, 0), cA + kstep, voffA); PG8_STAGE(PG8_SB(1, 1), cB + hstep + kstep, voffB);
        PG8_WAIT_V(6); PG8_BAR;
    } else {
        PG8_STAGE(PG8_SB(0, 0), cB, voffB); PG8_STAGE(PG8_SA(0, 0), cA, voffA); PG8_STAGE(PG8_SB(0, 1), cB + hstep, voffB); PG8_STAGE(PG8_SA(0, 1), cA + hstep, voffA);
        if (wr == 1) PG8_BAR;
        PG8_WAIT_V(4); PG8_BAR;
        PG8_STAGE(PG8_SB(1, 0), cB + kstep, voffB); PG8_STAGE(PG8_SA(1, 0), cA + kstep, voffA); PG8_STAGE(PG8_SB(1, 1), cB + hstep + kstep, voffB);
        PG8_WAIT_V(6); PG8_BAR;
    }
    for (;;) {
        const bool has_next = S.next(ui + 1, nxt);
        const char* nA = has_next ? (const char*)g.A + (size_t)nxt.pm * tstep : cA; const char* nB = has_next ? (const char*)g.Bt + (size_t)nxt.pn * tstep : cB;
        for (int t = 0; t < nt; t += 2) {
            const bool last = (t == nt - 2);
            const char* a1 = cA + (size_t)(t + 1) * kstep;
            const char* a2 = last ? nA : cA + (size_t)(t + 2) * kstep; const char* b2 = last ? nB : cB + (size_t)(t + 2) * kstep;
            const char* a3 = a2 + kstep; const char* b3 = b2 + kstep;
            if (last && has_next) S.a_ready(nxt);
            if constexpr (SP2) {
            PG8_LDB(B0, 0, 0); PG8_LDB(B1, 0, 1); PG8_SCHED; PG8_LDA(At, 0, 0); PG8_STAGE(PG8_SA(1, 1), a1 + hstep, voffA);
            PG8_WAIT_V(8); PG8_WAIT_L(0); PG8_BAR; PG8_MMA(0, 0, At, B0); PG8_MMA(0, 1, At, B1); PG8_BAR; PG8_SCHED;
            PG8_LDA(At, 0, 1); PG8_STAGE(PG8_SB(0, 0), b2, voffB); PG8_STAGE(PG8_SB(0, 1), b2 + hstep, voffB); PG8_STAGE(PG8_SA(0, 0), a2, voffA);
            PG8_WAIT_V(8); PG8_WAIT_L(0); PG8_BAR; PG8_MMA(1, 0, At, B0); PG8_MMA(1, 1, At, B1); PG8_BAR; PG8_SCHED;
            PG8_LDB(B0, 1, 0); PG8_LDB(B1, 1, 1); PG8_SCHED; PG8_LDA(At, 1, 0); PG8_STAGE(PG8_SA(0, 1), a2 + hstep, voffA);
            PG8_WAIT_V(8); PG8_WAIT_L(0); PG8_BAR; PG8_MMA(0, 0, At, B0); PG8_MMA(0, 1, At, B1); PG8_BAR; PG8_SCHED;
            PG8_LDA(At, 1, 1); PG8_STAGE(PG8_SB(1, 0), b3, voffB); PG8_STAGE(PG8_SB(1, 1), b3 + hstep, voffB); PG8_STAGE(PG8_SA(1, 0), a3, voffA);
            PG8_WAIT_V(8); PG8_WAIT_L(0); PG8_BAR; PG8_MMA(1, 0, At, B0); PG8_MMA(1, 1, At, B1); PG8_BAR; PG8_SCHED;
            } else {
            PG8_LDB(B0, 0, 0); PG8_SCHED; PG8_LDA(At, 0, 0); PG8_STAGE(PG8_SA(1, 1), a1 + hstep, voffA);
            PG8_WAIT_L(8); PG8_BAR; PG8_WAIT_L(0); PG8_MMA(0, 0, At, B0); PG8_BAR; PG8_SCHED;
            PG8_LDB(B1, 0, 1); PG8_STAGE(PG8_SB(0, 0), b2, voffB);
            PG8_BAR; PG8_WAIT_L(0); PG8_MMA(0, 1, At, B1); PG8_BAR;
            PG8_LDA(At, 0, 1); PG8_STAGE(PG8_SA(0, 0), a2, voffA);
            PG8_BAR; PG8_WAIT_L(0); PG8_MMA(1, 0, At, B0); PG8_BAR; PG8_SCHED;
            PG8_STAGE(PG8_SB(0, 1), b2 + hstep, voffB);
            PG8_WAIT_V(6); PG8_BAR; PG8_MMA(1, 1, At, B1); PG8_BAR;
            PG8_LDB(B0, 1, 0); PG8_SCHED; PG8_LDA(At, 1, 0); PG8_STAGE(PG8_SA(0, 1), a2 + hstep, voffA);
            PG8_WAIT_L(8); PG8_BAR; PG8_WAIT_L(0); PG8_MMA(0, 0, At, B0); PG8_BAR; PG8_SCHED;
            PG8_LDB(B1, 1, 1); PG8_STAGE(PG8_SB(1, 0), b3, voffB);
            PG8_BAR; PG8_WAIT_L(0); PG8_MMA(0, 1, At, B1); PG8_BAR;
            PG8_LDA(At, 1, 1); PG8_STAGE(PG8_SA(1, 0), a3, voffA);
            PG8_BAR; PG8_WAIT_L(0); PG8_MMA(1, 0, At, B0); PG8_BAR; PG8_SCHED;
            PG8_STAGE(PG8_SB(1, 1), b3 + hstep, voffB);
            PG8_WAIT_V(6); PG8_BAR; PG8_MMA(1, 1, At, B1); PG8_BAR;
            }
        }
        if constexpr (ALIGN_EPI) { if (wr == 0) PG8_BAR; }
        if constexpr (!Epi::AFTER_DRAIN) { E(acc, cur, wr, wc, fr, fq); S.done(cur); }
        if (!has_next) break;
#pragma unroll
        for (int a = 0; a < 2; ++a)
#pragma unroll
            for (int b = 0; b < 2; ++b)
#pragma unroll
                for (int m = 0; m < 4; ++m)
#pragma unroll
                    for (int n = 0; n < 2; ++n) acc[a][b][m][n] = (f32x4){0.f, 0.f, 0.f, 0.f};
        cur = nxt; cA = nA; cB = nB; ++ui;
        if constexpr (ALIGN_EPI) { if (wr == 1) PG8_BAR; }
    }
    PG8_WAIT_V(0);
    if constexpr (!ALIGN_EPI) { if (wr == 0) PG8_BAR; }
    PG8_BAR;
    if constexpr (Epi::AFTER_DRAIN) { E.fused(acc, cur, wr, wc, fr, fq, lds, wid, lane); S.done(cur); }
#undef PG8_SA
#undef PG8_SB
#undef PG8_STAGE
#undef PG8_LDA
#undef PG8_LDB
#undef PG8_MMA
#undef PG8_WAIT_V
#undef PG8_WAIT_L
#undef PG8_BAR
#undef PG8_SCHED
}
}


#define LAS __attribute__((address_space(3)))
typedef unsigned short bf16_t;
typedef short bf16x8 __attribute__((ext_vector_type(8)));
typedef short s16x4 __attribute__((ext_vector_type(4)));
typedef short v4i16_t __attribute__((ext_vector_type(4)));
typedef float f32x4 __attribute__((ext_vector_type(4)));
typedef unsigned u32x4 __attribute__((ext_vector_type(4)));
typedef unsigned u32x2 __attribute__((ext_vector_type(2)));
typedef float f32x2 __attribute__((ext_vector_type(2)));

constexpr int T = 16384, DM = 1024, SEQ = 2048, NP = 3584;
constexpr size_t MiB = 1u << 20;
constexpr size_t WS_CTL = 0, WS_MOD = 4096, WS_GATES = 262144, WS_KEYS = 1 * MiB, WS_WIN = 2 * MiB, WS_WOUT = 9 * MiB, WS_WQ = 11 * MiB,
                 WS_T8 = 16 * MiB, WS_SC = 48 * MiB, WS_ACT = 80 * MiB, WS_P = 112 * MiB, WS_QRY = 112 * MiB, WS_END = 256 * MiB;
constexpr size_t WS_RS = 208 * MiB, WS_SB = 851968, WS_WGT = 917504, WS_A3 = 176 * MiB;
constexpr int LDS_BYTES = 147456;

__device__ __forceinline__ unsigned f2bf(float f) { unsigned u = __float_as_uint(f); return (u + 0x7fffu + ((u >> 16) & 1u)) >> 16; }
typedef __bf16 bf16x2_t __attribute__((ext_vector_type(2)));
__device__ __forceinline__ unsigned pk2(float lo, float hi) { const f32x2 v = {lo, hi}; const bf16x2_t b = __builtin_convertvector(v, bf16x2_t); return __builtin_bit_cast(unsigned, b); }
__device__ __forceinline__ float bflo(unsigned u) { return __uint_as_float(u << 16); }
__device__ __forceinline__ float bfhi(unsigned u) { return __uint_as_float(u & 0xffff0000u); }
__device__ __forceinline__ float wave_sum(float v) {
    { const auto r = __builtin_amdgcn_permlane32_swap(__float_as_uint(v), __float_as_uint(v), false, false); v = __uint_as_float(r[0]) + __uint_as_float(r[1]); }
    { const auto r = __builtin_amdgcn_permlane16_swap(__float_as_uint(v), __float_as_uint(v), false, false); v = __uint_as_float(r[0]) + __uint_as_float(r[1]); }
    v += __int_as_float(__builtin_amdgcn_mov_dpp(__float_as_int(v), 0xB1, 0xF, 0xF, true));
    v += __int_as_float(__builtin_amdgcn_mov_dpp(__float_as_int(v), 0x4E, 0xF, 0xF, true));
    v += __int_as_float(__builtin_amdgcn_mov_dpp(__float_as_int(v), 0x141, 0xF, 0xF, true));
    v += __int_as_float(__builtin_amdgcn_mov_dpp(__float_as_int(v), 0x140, 0xF, 0xF, true));
    return v;
}
__device__ __forceinline__ float xrow_max(float v) {
    { const auto r = __builtin_amdgcn_permlane16_swap(__float_as_uint(v), __float_as_uint(v), false, false); v = fmaxf(__uint_as_float(r[0]), __uint_as_float(r[1])); }
    { const auto r = __builtin_amdgcn_permlane32_swap(__float_as_uint(v), __float_as_uint(v), false, false); v = fmaxf(__uint_as_float(r[0]), __uint_as_float(r[1])); }
    return v;
}
__device__ __forceinline__ float xrow_sum(float v) {
    { const auto r = __builtin_amdgcn_permlane16_swap(__float_as_uint(v), __float_as_uint(v), false, false); v = __uint_as_float(r[0]) + __uint_as_float(r[1]); }
    { const auto r = __builtin_amdgcn_permlane32_swap(__float_as_uint(v), __float_as_uint(v), false, false); v = __uint_as_float(r[0]) + __uint_as_float(r[1]); }
    return v;
}
#define LDS_WAIT() asm volatile("s_waitcnt lgkmcnt(0)" ::: "memory")
__device__ __forceinline__ s16x4 vtr(LAS unsigned char* p) { return __builtin_bit_cast(s16x4, __builtin_amdgcn_ds_read_tr16_b64_v4i16((LAS v4i16_t*)p)); }
__device__ __forceinline__ bf16x8 cat8(s16x4 a, s16x4 b) { bf16x8 r; r[0] = a[0]; r[1] = a[1]; r[2] = a[2]; r[3] = a[3]; r[4] = b[0]; r[5] = b[1]; r[6] = b[2]; r[7] = b[3]; return r; }
__device__ __forceinline__ bf16x8 pack8(const f32x4 a, const f32x4 b) { u32x4 w; w.x = pk2(a[0], a[1]); w.y = pk2(a[2], a[3]); w.z = pk2(b[0], b[1]); w.w = pk2(b[2], b[3]); return __builtin_bit_cast(bf16x8, w); }
#define MFMA16(a, b, c) __builtin_amdgcn_mfma_f32_16x16x32_bf16((a), (b), (c), 0, 0, 0)

struct Args {
    const float *x, *c, *ada_w, *ada_b, *norm1_g, *w_in, *conv_w, *conv_b, *gate_b, *mnorm_g, *lq1, *lk1, *lq2, *lk2, *dnorm_g, *w_out, *norm2_g, *wq, *keys, *pu, *pv, *final_g;
    float* out; unsigned char* ws;
};

__device__ __forceinline__ void transpose_item(const float* W, int srcN, int soff, bf16_t* WT, LAS float* scr, int kb, int nb, int lane) {
    const int k0 = 64 * kb, n0 = 32 * nb;
    { f32x4 wv[8];
#pragma unroll
      for (int i = 0; i < 8; ++i) wv[i] = *(const f32x4*)(W + (size_t)(k0 + 8 * i + (lane >> 3)) * srcN + n0 + soff + 4 * (lane & 7));
#pragma unroll
      for (int i = 0; i < 8; ++i) { LAS float* d = scr + (8 * i + (lane >> 3)) * 33 + 4 * (lane & 7); d[0] = wv[i][0]; d[1] = wv[i][1]; d[2] = wv[i][2]; d[3] = wv[i][3]; } }
    LDS_WAIT(); asm volatile("" ::: "memory");
    const int c = lane & 7;
#pragma unroll
    for (int j = 0; j < 4; ++j) { const int n = (lane >> 3) + 8 * j; const LAS float* s = scr + (8 * c) * 33 + n;
        u32x4 o; o.x = pk2(s[0 * 33], s[1 * 33]); o.y = pk2(s[2 * 33], s[3 * 33]); o.z = pk2(s[4 * 33], s[5 * 33]); o.w = pk2(s[6 * 33], s[7 * 33]);
        *(u32x4*)(WT + (size_t)(n0 + n) * 1024 + k0 + 8 * c) = o; }
    LDS_WAIT(); asm volatile("" ::: "memory");
}

__device__ __forceinline__ bf16x8 pack8_sw(const f32x4 a, const f32x4 b) {
    u32x4 w; w.x = f2bf(a[0]) | (f2bf(a[1]) << 16); w.y = f2bf(a[2]) | (f2bf(a[3]) << 16); w.z = f2bf(b[0]) | (f2bf(b[1]) << 16); w.w = f2bf(b[2]) | (f2bf(b[3]) << 16); return __builtin_bit_cast(bf16x8, w); }
__device__ __forceinline__ void wprime_item(const Args& A, int hp, int kt, int lane) {
    const int g = lane >> 4, l15 = lane & 15;
    f32x4 acc[8];
#pragma unroll
    for (int nt = 0; nt < 8; ++nt) acc[nt] = (f32x4){0.f, 0.f, 0.f, 0.f};
#pragma unroll
    for (int ks = 0; ks < 4; ++ks) {
        const float* ap = A.wq + (size_t)(16 * kt + l15) * 2048 + hp * 128 + 32 * ks + 8 * g;
        const bf16x8 a = pack8(*(const f32x4*)ap, *(const f32x4*)(ap + 4));
#pragma unroll
        for (int nt = 0; nt < 8; ++nt) { const float* bp = A.keys + (size_t)(hp * 128 + 16 * nt + l15) * 128 + 32 * ks + 8 * g;
            const bf16x8 b = pack8(*(const f32x4*)bp, *(const f32x4*)(bp + 4)); acc[nt] = MFMA16(a, b, acc[nt]); }
    }
    bf16_t* WT = (bf16_t*)(A.ws + WS_WQ);
#pragma unroll
    for (int nt = 0; nt < 8; ++nt) { u32x2 o; o.x = pk2(acc[nt][0], acc[nt][1]); o.y = pk2(acc[nt][2], acc[nt][3]);
        *(u32x2*)(WT + (size_t)(hp * 128 + 16 * nt + l15) * 1024 + 16 * kt + 4 * g) = o; }
}

__device__ __forceinline__ void phase0(const Args& A, LAS unsigned char* lds) {
    int tid_o = threadIdx.x; asm volatile("" : "+v"(tid_o)); const int tid = tid_o, lane = tid & 63, wave = tid >> 6, G = gridDim.x;
    float* MOD = (float*)(A.ws + WS_MOD);
    if ((int)blockIdx.x < 192) {
        LAS float* sc = (LAS float*)lds;
        for (int i = tid; i < 8192; i += 512) { const float v = A.c[i]; sc[i] = v * __builtin_amdgcn_rcpf(1.f + __expf(-v)); }
        __syncthreads();
        for (int item = blockIdx.x; item < 192; item += G) {
            const int j0 = item * 32, kg = tid >> 3, cq = tid & 7;
            f32x4 wv[16];
#pragma unroll
            for (int kk = 0; kk < 16; ++kk) wv[kk] = *(const f32x4*)(A.ada_w + (size_t)(kg * 16 + kk) * 6144 + j0 + 4 * cq);
            f32x4 acc[8];
#pragma unroll
            for (int b = 0; b < 8; ++b) acc[b] = (f32x4){0.f, 0.f, 0.f, 0.f};
#pragma unroll
            for (int b = 0; b < 8; ++b)
#pragma unroll
                for (int k4 = 0; k4 < 4; ++k4) { const f32x4 s4 = *(const LAS f32x4*)(sc + b * 1024 + kg * 16 + 4 * k4);
                    acc[b] += wv[4 * k4] * s4[0]; acc[b] += wv[4 * k4 + 1] * s4[1]; acc[b] += wv[4 * k4 + 2] * s4[2]; acc[b] += wv[4 * k4 + 3] * s4[3]; }
            LAS float* part = (LAS float*)(lds + 32768);
#pragma unroll
            for (int b = 0; b < 8; ++b) *(LAS f32x4*)(part + (kg * 8 + b) * 32 + 4 * cq) = acc[b];
            __syncthreads();
            if (tid < 256) { const int b = tid >> 5, col = tid & 31; float s = A.ada_b[j0 + col];
              for (int k2 = 0; k2 < 64; ++k2) s += part[(k2 * 8 + b) * 32 + col];
              MOD[b * 6144 + j0 + col] = s; }
            __syncthreads();
        }
    }
    for (int i = (G - 1 - (int)blockIdx.x) * 512 + tid; i < 8192; i += G * 512) { const int gc = i >> 10, k = i & 1023; ((float*)(A.ws + WS_WGT))[i] = A.w_in[(size_t)k * 3592 + 2048 + gc]; }
    if (blockIdx.x == 0 && tid == 0) {
        float s1 = 0.f, s2 = 0.f;
        for (int i = 0; i < 64; ++i) { s1 += A.lq1[i] * A.lk1[i]; s2 += A.lq2[i] * A.lk2[i]; }
        ((float*)(A.ws + WS_CTL))[1] = expf(s1) - expf(s2) + 0.2f;
        ((unsigned*)(A.ws + WS_CTL))[0] = 0u; ((unsigned*)(A.ws + WS_CTL))[2] = 0u;
    }
}

__device__ __forceinline__ void phase0b(const Args& A, LAS unsigned char* lds) {
    int tid_o = threadIdx.x; asm volatile("" : "+v"(tid_o)); const int tid = tid_o, lane = tid & 63, wave = tid >> 6, G = gridDim.x;
    __syncthreads();
    {
        LAS float* scr = (LAS float*)(lds + wave * 16384);
        const int gw = blockIdx.x * 8 + wave, NGW = G * 8;
        for (int it = gw; it < 1792; it += NGW) { const int kb = it / 112, nb = it % 112; transpose_item(A.w_in, 3592, nb >= 64 ? 8 : 0, (bf16_t*)(A.ws + WS_WIN), scr, kb, nb, lane); }
    }
}

__device__ __forceinline__ void quantise_tables(const Args& A, int gw, int NGW, int row_lo, int row_hi) {
    int tid_o = threadIdx.x; asm volatile("" : "+v"(tid_o)); const int lane = tid_o & 63;
    unsigned char* T8 = A.ws + WS_T8; float* SC = (float*)(A.ws + WS_SC);
#pragma unroll 1
    for (int row = row_lo + gw; row < row_hi; row += 4 * NGW) {
        f32x4 v[4][4]; int rr[4];
#pragma unroll
        for (int q = 0; q < 4; ++q) { const int r = row + q * NGW; rr[q] = r; const int rc = r < row_hi ? r : row;
            const float* s = (rc < 16384 ? A.pu + (size_t)rc * 1024 : A.pv + (size_t)(rc - 16384) * 1024) + 16 * lane;
#pragma unroll
            for (int j = 0; j < 4; ++j) v[q][j] = *(const f32x4*)(s + 4 * j); }
#pragma unroll
        for (int q = 0; q < 4; ++q) {
            float mx = 0.f;
#pragma unroll
            for (int j = 0; j < 4; ++j)
#pragma unroll
                for (int e = 0; e < 4; ++e) mx = fmaxf(mx, fabsf(v[q][j][e]));
#pragma unroll
            for (int o = 1; o < 64; o <<= 1) mx = fmaxf(mx, __shfl_xor(mx, o));
            const float sc = fmaxf(mx, 1e-30f) * (1.f / 256.f), inv = 1.f / sc;
            u32x4 o4;
#pragma unroll
            for (int j = 0; j < 4; ++j) { int w0 = __builtin_amdgcn_cvt_pk_fp8_f32(v[q][j][0] * inv, v[q][j][1] * inv, 0, false); w0 = __builtin_amdgcn_cvt_pk_fp8_f32(v[q][j][2] * inv, v[q][j][3] * inv, w0, true); o4[j] = (unsigned)w0; }
            if (rr[q] < row_hi) { *(u32x4*)(T8 + (size_t)rr[q] * 1024 + 16 * lane) = o4; if (lane == 0) SC[rr[q]] = sc; }
        }
    }
}

__device__ __forceinline__ void phase1(const Args& A, LAS unsigned char* lds) {
    int tid_o = threadIdx.x; asm volatile("" : "+v"(tid_o)); const int tid = tid_o, lane = tid & 63, wave = tid >> 6, G = gridDim.x;
    const float* MOD = (const float*)(A.ws + WS_MOD);
    bf16_t* ACT = (bf16_t*)(A.ws + WS_ACT);
    float* GATES = (float*)(A.ws + WS_GATES);
    LAS float* WG = (LAS float*)lds;
    for (int i = tid; i < 8192; i += 512) WG[i] = ((const float*)(A.ws + WS_WGT))[i];
    __syncthreads();
    f32x4 vn[4];
    { const int m0 = (int)(blockIdx.x * 8 + wave) < T ? blockIdx.x * 8 + wave : 0; const f32x4* xr = (const f32x4*)(A.x + (size_t)m0 * 1024) + lane;
#pragma unroll
        for (int j = 0; j < 4; ++j) vn[j] = xr[64 * j]; }
    for (int m = blockIdx.x * 8 + wave; m < T; m += G * 8) {
        const int b = m >> 11;
        f32x4 v[4]; float ss = 0.f;
#pragma unroll
        for (int j = 0; j < 4; ++j) { v[j] = vn[j]; ss += (v[j][0] * v[j][0] + v[j][1] * v[j][1]) + (v[j][2] * v[j][2] + v[j][3] * v[j][3]); }
        { const int mn = (m + G * 8 < T) ? m + G * 8 : m; const f32x4* xr = (const f32x4*)(A.x + (size_t)mn * 1024) + lane;
#pragma unroll
            for (int j = 0; j < 4; ++j) vn[j] = xr[64 * j]; }
        f32x4 gg[4], scc[4], shh[4];
#pragma unroll
        for (int j = 0; j < 4; ++j) { const int col = 4 * lane + 256 * j; gg[j] = *(const f32x4*)(A.norm1_g + col); scc[j] = *(const f32x4*)(MOD + b * 6144 + 1024 + col); shh[j] = *(const f32x4*)(MOD + b * 6144 + col); }
        const float rstd = rsqrtf(wave_sum(ss) * (1.f / 1024.f) + 1e-6f);
        unsigned long long* o8 = (unsigned long long*)(ACT + (size_t)m * 1024) + lane;
#pragma unroll
        for (int j = 0; j < 4; ++j) { const f32x4 g = gg[j], sc = scc[j], sh = shh[j];
            v[j] = v[j] * rstd * g * (sc + 1.0f) + sh;
            o8[64 * j] = (unsigned long long)pk2(v[j][0], v[j][1]) | ((unsigned long long)pk2(v[j][2], v[j][3]) << 32); }
        float gd[8];
#pragma unroll
        for (int gc = 0; gc < 8; ++gc) { float d = 0.f;
#pragma unroll
            for (int j = 0; j < 4; ++j) { const f32x4 w = *(const LAS f32x4*)(WG + gc * 1024 + 256 * j + 4 * lane); d += (v[j][0] * w[0] + v[j][1] * w[1]) + (v[j][2] * w[2] + v[j][3] * w[3]); }
            gd[gc] = d; }
        {
            float a4[4];
#pragma unroll
            for (int i = 0; i < 4; ++i) { const auto r = __builtin_amdgcn_permlane32_swap(__float_as_uint(gd[i]), __float_as_uint(gd[i + 4]), false, false); a4[i] = __uint_as_float(r[0]) + __uint_as_float(r[1]); }
            float b2[2];
#pragma unroll
            for (int i = 0; i < 2; ++i) { const auto r = __builtin_amdgcn_permlane16_swap(__float_as_uint(a4[i]), __float_as_uint(a4[i + 2]), false, false); b2[i] = __uint_as_float(r[0]) + __uint_as_float(r[1]); }
#pragma unroll
            for (int i = 0; i < 2; ++i) { float s = b2[i];
                s += __int_as_float(__builtin_amdgcn_mov_dpp(__float_as_int(s), 0xB1, 0xF, 0xF, true));
                s += __int_as_float(__builtin_amdgcn_mov_dpp(__float_as_int(s), 0x4E, 0xF, 0xF, true));
                s += __int_as_float(__builtin_amdgcn_mov_dpp(__float_as_int(s), 0x141, 0xF, 0xF, true));
                s += __int_as_float(__builtin_amdgcn_mov_dpp(__float_as_int(s), 0x140, 0xF, 0xF, true)); b2[i] = s; }
            if ((lane & 15) == 0) { const int r2 = 2 * (lane >> 4); f32x2 o; o[0] = b2[0] + A.gate_b[r2]; o[1] = b2[1] + A.gate_b[r2 + 1]; *(f32x2*)(GATES + (size_t)m * 8 + r2) = o; }
        }
    }
}

constexpr int AK_STRIDE = 288  , AV_STRIDE = 288, AK_BYTES = 64 * AK_STRIDE, AV_BYTES = 64 * AV_STRIDE;
__device__ __forceinline__ void attn_item(const Args& A, LAS unsigned char* lds, int b, int h, int qb, float lam) {
    int tid_o = threadIdx.x; asm volatile("" : "+v"(tid_o)); const int tid = tid_o, lane = tid & 63, w = tid >> 6, g = lane >> 4, l15 = lane & 15;
    const bf16_t* P = (const bf16_t*)(A.ws + WS_P);
    bf16_t* ACT = (bf16_t*)(A.ws + WS_ACT);
    const int t0 = qb * 128, ntiles = 2 * (qb + 1);
    const size_t rowbase = (size_t)b * SEQ;
    bf16x8 qf[2][2];
    { const bf16_t* qp = P + (rowbase + t0 + 16 * w + l15) * NP + 2048 + h * 128 + 8 * g;
#pragma unroll
      for (int p = 0; p < 2; ++p)
#pragma unroll
          for (int ks = 0; ks < 2; ++ks) qf[p][ks] = *(const bf16x8*)(qp + p * 64 + ks * 32); }
    f32x4 o[2][8];
#pragma unroll
    for (int p = 0; p < 2; ++p)
#pragma unroll
        for (int vt = 0; vt < 8; ++vt) o[p][vt] = (f32x4){0.f, 0.f, 0.f, 0.f};
    float mrun[2] = {-1e30f, -1e30f}, lrun[2] = {0.f, 0.f};
    const int srow = tid >> 3, sseg = tid & 7;
    const bf16_t* kg = P + (rowbase + srow) * NP + 2560 + h * 128 + sseg * 16;
    const bf16_t* vg = P + (rowbase + srow) * NP + 3072 + h * 128 + sseg * 16;
    u32x4 kr0, kr1, vr0, vr1;
    kr0 = *(const u32x4*)(kg); kr1 = *(const u32x4*)(kg + 8); vr0 = *(const u32x4*)(vg); vr1 = *(const u32x4*)(vg + 8);
    { LAS unsigned char* kb = lds + srow * AK_STRIDE + sseg * 32; LAS unsigned char* vb = lds + 2 * AK_BYTES + srow * AV_STRIDE + sseg * 32;
      *(LAS u32x4*)kb = kr0; *(LAS u32x4*)(kb + 16) = kr1; *(LAS u32x4*)vb = vr0; *(LAS u32x4*)(vb + 16) = vr1; }
    __syncthreads();
    const float cs = 0.125f * 1.4426950408889634f;
    const int qabs = t0 + 16 * w + l15;
    for (int kt = 0; kt < ntiles; ++kt) {
        const int cur = kt & 1;
        if (kt + 1 < ntiles) { const size_t off = (size_t)(kt + 1) * 64 * NP;
            kr0 = *(const u32x4*)(kg + off); kr1 = *(const u32x4*)(kg + off + 8); vr0 = *(const u32x4*)(vg + off); vr1 = *(const u32x4*)(vg + off + 8); }
        if (64 * kt <= t0 + 16 * w + 15) {
            LAS unsigned char* Kb = lds + cur * AK_BYTES; LAS unsigned char* Vb = lds + 2 * AK_BYTES + cur * AV_BYTES;
            f32x4 s[2][4];
#pragma unroll
            for (int p = 0; p < 2; ++p)
#pragma unroll
                for (int k4 = 0; k4 < 4; ++k4) { f32x4 a = (f32x4){0.f, 0.f, 0.f, 0.f};
#pragma unroll
                    for (int ks = 0; ks < 2; ++ks) { const bf16x8 kf = *(const LAS bf16x8*)(Kb + (16 * k4 + l15) * AK_STRIDE + (p * 64 + ks * 32 + 8 * g) * 2); a = MFMA16(kf, qf[p][ks], a); }
                    s[p][k4] = a; }
            if (64 * kt + 63 > t0 + 16 * w) {
#pragma unroll
                for (int p = 0; p < 2; ++p)
#pragma unroll
                    for (int k4 = 0; k4 < 4; ++k4)
#pragma unroll
                        for (int r = 0; r < 4; ++r) { const int key = 64 * kt + 16 * k4 + 4 * g + r; if (key > qabs) s[p][k4][r] = -1e30f; }
            }
            bf16x8 pf[2][2];
#pragma unroll
            for (int p = 0; p < 2; ++p) {
                float mx = -1e30f;
#pragma unroll
                for (int k4 = 0; k4 < 4; ++k4)
#pragma unroll
                    for (int r = 0; r < 4; ++r) mx = fmaxf(mx, s[p][k4][r]);
                mx = xrow_max(mx);
                const float mnew = fmaxf(mrun[p], mx * cs), alpha = __builtin_amdgcn_exp2f(mrun[p] - mnew);
                mrun[p] = mnew;
                float ls = 0.f;
#pragma unroll
                for (int k4 = 0; k4 < 4; ++k4)
#pragma unroll
                    for (int r = 0; r < 4; ++r) { const float pv = __builtin_amdgcn_exp2f(s[p][k4][r] * cs - mnew); ls += pv; s[p][k4][r] = pv; }
                lrun[p] = lrun[p] * alpha + ls;
                if (__any(alpha != 1.f)) {
#pragma unroll
                    for (int vt = 0; vt < 8; ++vt) o[p][vt] = o[p][vt] * alpha; }
                pf[p][0] = pack8(s[p][0], s[p][1]); pf[p][1] = pack8(s[p][2], s[p][3]);
            }
#pragma unroll
            for (int ks2 = 0; ks2 < 2; ++ks2)
#pragma unroll
                for (int vt = 0; vt < 8; ++vt) {
                    LAS unsigned char* a0 = Vb + (32 * ks2 + 4 * g + (l15 >> 2)) * AV_STRIDE + (16 * vt + 4 * (lane & 3)) * 2;
                    const bf16x8 vf = cat8(vtr(a0), vtr(a0 + 16 * AV_STRIDE));
                    o[0][vt] = MFMA16(vf, pf[0][ks2], o[0][vt]);
                    o[1][vt] = MFMA16(vf, pf[1][ks2], o[1][vt]);
                }
        }
        if (kt + 1 < ntiles) { const int nx = cur ^ 1;
            LAS unsigned char* kb = lds + nx * AK_BYTES + srow * AK_STRIDE + sseg * 32; LAS unsigned char* vb = lds + 2 * AK_BYTES + nx * AV_BYTES + srow * AV_STRIDE + sseg * 32;
            *(LAS u32x4*)kb = kr0; *(LAS u32x4*)(kb + 16) = kr1; *(LAS u32x4*)vb = vr0; *(LAS u32x4*)(vb + 16) = vr1; }
        __syncthreads();
    }
    float inv[2];
#pragma unroll
    for (int p = 0; p < 2; ++p) { const float lt = xrow_sum(lrun[p]); inv[p] = 1.f / lt; }
    float ss = 0.f;
#pragma unroll
    for (int vt = 0; vt < 8; ++vt)
#pragma unroll
        for (int r = 0; r < 4; ++r) { const float ov = o[0][vt][r] * inv[0] - lam * (o[1][vt][r] * inv[1]); o[0][vt][r] = ov; ss += ov * ov; }
    ss = xrow_sum(ss);
    const float rstd = rsqrtf(ss * (1.f / 128.f) + 1e-6f) * 0.8f;
    bf16_t* op = ACT + (rowbase + qabs) * 1024 + 512 + h * 128 + 4 * g;
#pragma unroll
    for (int vt = 0; vt < 8; ++vt) { const f32x4 gn = *(const f32x4*)(A.dnorm_g + 16 * vt + 4 * g);
        u32x2 wv; wv.x = pk2(o[0][vt][0] * rstd * gn[0], o[0][vt][1] * rstd * gn[1]); wv.y = pk2(o[0][vt][2] * rstd * gn[2], o[0][vt][3] * rstd * gn[3]);
        *(u32x2*)(op + 16 * vt) = wv; }
}

constexpr int MQ_STRIDE = 272, MV_STRIDE = 288, MP_STRIDE = 144, MH_STRIDE = 132;
constexpr int ML_Q = 0, ML_K = 17408, ML_V = 34816, ML_P = 53248, ML_H = 62464, ML_CW = 96256, ML_SM = 101376;
constexpr int SM_E = 0, SM_G = 64, SM_B = 128, SM_W = 192, SM_I = 256, SM_R = 320, SM_N = 384, SM_NP = 512, SM_X = 1024;
constexpr size_t WS_CST = 224 * MiB, WS_NST = 15 * MiB, WS_MC = 15 * MiB + 512 * 1024, WS_BAR = 15 * MiB + 768 * 1024;

__device__ __forceinline__ void mlstm_state(const Args& A, LAS unsigned char* lds, int b, int h) {
    int tid_o = threadIdx.x; asm volatile("" : "+v"(tid_o)); const int tid = tid_o, lane = tid & 63, w = tid >> 6, g = lane >> 4, l15 = lane & 15;
    const bf16_t* P = (const bf16_t*)(A.ws + WS_P);
    const float* GATES = (const float*)(A.ws + WS_GATES);
    u32x4* CST = (u32x4*)(A.ws + WS_CST); float* NST = (float*)(A.ws + WS_NST); float* MCg = (float*)(A.ws + WS_MC);
    LAS float* sm = (LAS float*)(lds + ML_SM);
    LAS float* cw = (LAS float*)(lds + ML_CW);
    LAS unsigned char* Ks = lds + ML_K; LAS unsigned char* Vs = lds + ML_V;
    const size_t rowbase = (size_t)b * SEQ; const int bh = b * 4 + h;
    for (int i = tid; i < 640; i += 512) { const int j = i >> 7, ch = i & 127, cch = 512 + h * 128 + ch; cw[i] = (j < 4) ? A.conv_w[j * 1024 + cch] : A.conv_b[cch]; }
    if (tid < 128) sm[SM_N + tid] = 0.f;
    const int rg = tid >> 4, cs = tid & 15;
    const int ccol = 512 + h * 128 + 8 * cs;
    const int srow = tid >> 3, sseg = tid & 7;
    u32x4 cr[5], vr0, vr1; float gi = 0.f, gf = 0.f;
#define MS_PREFETCH(c) do { const int _r0 = (c) * 64 + 2 * rg - 3; \
        _Pragma("unroll") for (int _i = 0; _i < 5; ++_i) { const int _r = _r0 + _i; const u32x4 _v = *(const u32x4*)(P + (rowbase + (_r >= 0 ? _r : 0)) * NP + ccol); cr[_i] = (_r >= 0) ? _v : (u32x4){0u, 0u, 0u, 0u}; } \
        const bf16_t* _vp = P + (rowbase + (c) * 64 + srow) * NP + 1024 + h * 128 + sseg * 16; \
        vr0 = *(const u32x4*)(_vp); vr1 = *(const u32x4*)(_vp + 8); \
        } while (0)
    MS_PREFETCH(0);
    LAS float* Eall = (LAS float*)(lds + ML_Q);
#pragma unroll
    for (int cc = 0; cc < 4; ++cc) { const int c = w + 8 * cc;
        const float* gp = GATES + (rowbase + c * 64 + lane) * 8 + h; gi = gp[0]; { const float z = gp[4]; gf = fminf(z, 0.f) - log1pf(expf(-fabsf(z))); }
        float bc = gf;
#pragma unroll
        for (int o = 1; o < 64; o <<= 1) { const float t = __shfl_up(bc, o); if (lane >= o) bc += t; }
        const float e = gi - bc; float cm = e;
#pragma unroll
        for (int o = 1; o < 64; o <<= 1) { const float t = __shfl_up(cm, o); if (lane >= o) cm = fmaxf(cm, t); }
        Eall[c * 64 + lane] = e;
        if (lane == 63) { Eall[2048 + c] = bc; Eall[2048 + 32 + c] = cm; } }
    f32x4 C[8];
#pragma unroll
    for (int kt = 0; kt < 8; ++kt) C[kt] = (f32x4){0.f, 0.f, 0.f, 0.f};
    float mc = 0.f;
    __syncthreads();
    for (int c = 0; c < 32; ++c) {
        {
            float wt[5][8];
#pragma unroll
            for (int j = 0; j < 5; ++j) { const f32x4 a = *(const LAS f32x4*)(cw + j * 128 + 8 * cs), bb = *(const LAS f32x4*)(cw + j * 128 + 8 * cs + 4);
                wt[j][0] = a[0]; wt[j][1] = a[1]; wt[j][2] = a[2]; wt[j][3] = a[3]; wt[j][4] = bb[0]; wt[j][5] = bb[1]; wt[j][6] = bb[2]; wt[j][7] = bb[3]; }
            LAS unsigned char* dst = Ks + (2 * rg) * MQ_STRIDE + 16 * cs;
#pragma unroll
            for (int r = 0; r < 2; ++r) {
                float ov[8];
#pragma unroll
                for (int e = 0; e < 8; ++e) ov[e] = wt[4][e];
#pragma unroll
                for (int j = 0; j < 4; ++j) { const u32x4 x = cr[r + j];
                    ov[0] += wt[j][0] * bflo(x.x); ov[1] += wt[j][1] * bfhi(x.x); ov[2] += wt[j][2] * bflo(x.y); ov[3] += wt[j][3] * bfhi(x.y);
                    ov[4] += wt[j][4] * bflo(x.z); ov[5] += wt[j][5] * bfhi(x.z); ov[6] += wt[j][6] * bflo(x.w); ov[7] += wt[j][7] * bfhi(x.w); }
#pragma unroll
                for (int e = 0; e < 8; ++e) ov[e] = 0.08838834764831845f * ov[e] * __builtin_amdgcn_rcpf(1.f + __expf(-ov[e]));
                u32x4 o4; o4.x = pk2(ov[0], ov[1]); o4.y = pk2(ov[2], ov[3]); o4.z = pk2(ov[4], ov[5]); o4.w = pk2(ov[6], ov[7]);
                *(LAS u32x4*)(dst + r * MQ_STRIDE) = o4;
            }
            LAS unsigned char* vd = Vs + srow * MV_STRIDE + sseg * 32; *(LAS u32x4*)vd = vr0; *(LAS u32x4*)(vd + 16) = vr1;
            if (w == 0) {
                const float g63 = fmaxf(mc, Eall[2048 + 32 + c]);
                sm[SM_W + lane] = __expf(Eall[c * 64 + lane] - g63);
                if (lane == 63) { sm[SM_X] = __expf(mc - g63); sm[SM_X + 1] = Eall[2048 + c] + g63; }
            }
        }
        __syncthreads();
        { const int cn = (c + 1 < 32) ? c + 1 : 31; MS_PREFETCH(cn); }
        {
            const int item = bh * 32 + c;
#pragma unroll
            for (int k2 = 0; k2 < 4; ++k2) CST[((size_t)(item * 8 + w) * 4 + k2) * 64 + lane] = __builtin_bit_cast(u32x4, pack8(C[2 * k2], C[2 * k2 + 1]));
            if (tid < 128) NST[item * 128 + tid] = sm[SM_N + tid];
            if (tid == 0) MCg[item] = mc;
            LAS float* wS = sm + SM_W;
            const float decay = sm[SM_X];
            bf16x8 vfw[2];
#pragma unroll
            for (int ks = 0; ks < 2; ++ks) {
                LAS unsigned char* a0 = Vs + (32 * ks + 8 * g + (l15 >> 2)) * MV_STRIDE + (16 * w + 4 * (lane & 3)) * 2;
                const bf16x8 vf = cat8(vtr(a0), vtr(a0 + 4 * MV_STRIDE));
                const f32x4 w0 = *(const LAS f32x4*)(wS + 32 * ks + 8 * g), w1 = *(const LAS f32x4*)(wS + 32 * ks + 8 * g + 4);
                const u32x4 vu = __builtin_bit_cast(u32x4, vf);
                u32x4 o4; o4.x = pk2(bflo(vu.x) * w0[0], bfhi(vu.x) * w0[1]); o4.y = pk2(bflo(vu.y) * w0[2], bfhi(vu.y) * w0[3]);
                o4.z = pk2(bflo(vu.z) * w1[0], bfhi(vu.z) * w1[1]); o4.w = pk2(bflo(vu.w) * w1[2], bfhi(vu.w) * w1[3]);
                vfw[ks] = __builtin_bit_cast(bf16x8, o4);
            }
#pragma unroll
            for (int kt = 0; kt < 8; ++kt) C[kt] = C[kt] * decay;
#pragma unroll
            for (int ks = 0; ks < 2; ++ks)
#pragma unroll
                for (int kt = 0; kt < 8; ++kt) { LAS unsigned char* a0 = Ks + (32 * ks + 8 * g + (l15 >> 2)) * MQ_STRIDE + (16 * kt + 4 * (lane & 3)) * 2;
                    const bf16x8 ka = cat8(vtr(a0), vtr(a0 + 4 * MQ_STRIDE)); C[kt] = MFMA16(ka, vfw[ks], C[kt]); }
            { const int kd = tid & 127, sq = tid >> 7; float s = 0.f;
#pragma unroll
              for (int i = 0; i < 16; ++i) { const int s_ = 16 * sq + i; s += wS[s_] * __uint_as_float((unsigned)(*(const LAS bf16_t*)(Ks + s_ * MQ_STRIDE + kd * 2)) << 16); }
              sm[SM_NP + sq * 128 + kd] = s; }
            mc = sm[SM_X + 1];
            __syncthreads();
            if (tid < 128) sm[SM_N + tid] = decay * sm[SM_N + tid] + ((sm[SM_NP + tid] + sm[SM_NP + 128 + tid]) + (sm[SM_NP + 256 + tid] + sm[SM_NP + 384 + tid]));
        }
    }
#undef MS_PREFETCH
    __syncthreads();
}

__device__ __forceinline__ void mlstm_out(const Args& A, LAS unsigned char* lds, int item, int& last_h) {
    int tid_o = threadIdx.x; asm volatile("" : "+v"(tid_o)); const int tid = tid_o, lane = tid & 63, w = tid >> 6, g = lane >> 4, l15 = lane & 15;
    const int bh = item >> 5, c = item & 31, b = bh >> 2, h = bh & 3;
    const bf16_t* P = (const bf16_t*)(A.ws + WS_P);
    bf16_t* ACT = (bf16_t*)(A.ws + WS_ACT);
    const float* GATES = (const float*)(A.ws + WS_GATES);
    const u32x4* CST = (const u32x4*)(A.ws + WS_CST); const float* NST = (const float*)(A.ws + WS_NST); const float* MCg = (const float*)(A.ws + WS_MC);
    LAS float* sm = (LAS float*)(lds + ML_SM);
    LAS float* cw = (LAS float*)(lds + ML_CW);
    LAS unsigned char* Qs = lds + ML_Q; LAS unsigned char* Ks = lds + ML_K; LAS unsigned char* Vs = lds + ML_V; LAS unsigned char* Ps = lds + ML_P;
    LAS float* Hn = (LAS float*)(lds + ML_H);
    LAS float* eS = sm + SM_E; LAS float* gS = sm + SM_G; LAS float* bS = sm + SM_B; LAS float* iS = sm + SM_I; LAS float* nS = sm + SM_N;
    const size_t rowbase = (size_t)b * SEQ;
    const int rg = tid >> 5, cs = tid & 31;
    const int ccol = (cs < 16 ? 0 : 512) + h * 128 + 8 * (cs & 15);
    const int srow = tid >> 3, sseg = tid & 7;
    u32x4 cr[7], vr0, vr1, mc0, mc1, cfr[4]; float gi = 0.f, gf = 0.f, nval = 0.f;
    { const int r0 = c * 64 + 4 * rg - 3;
#pragma unroll
      for (int i = 0; i < 7; ++i) { const int r = r0 + i; const u32x4 v_ = *(const u32x4*)(P + (rowbase + (r >= 0 ? r : 0)) * NP + ccol); cr[i] = (r >= 0) ? v_ : (u32x4){0u, 0u, 0u, 0u}; }
      const bf16_t* vp = P + (rowbase + c * 64 + srow) * NP + h * 128 + sseg * 16;
      vr0 = *(const u32x4*)(vp + 1024); vr1 = *(const u32x4*)(vp + 1032); mc0 = *(const u32x4*)(vp + 1536); mc1 = *(const u32x4*)(vp + 1544);
      if (w == 0) { const float* gp = GATES + (rowbase + c * 64 + lane) * 8 + h; gi = gp[0]; const float z = gp[4]; gf = fminf(z, 0.f) - log1pf(expf(-fabsf(z))); }
#pragma unroll
      for (int k2 = 0; k2 < 4; ++k2) cfr[k2] = CST[((size_t)(item * 8 + w) * 4 + k2) * 64 + lane];
      if (tid < 128) nval = NST[item * 128 + tid]; }
    const float mc = MCg[item];
    if (h != last_h) {
        for (int i = tid; i < 1280; i += 512) { const int j = i >> 8, ch = i & 255, cch = (ch < 128 ? h * 128 + ch : 512 + h * 128 + ch - 128);
            cw[i] = (j < 4) ? A.conv_w[j * 1024 + cch] : A.conv_b[cch]; }
        last_h = h;
        __syncthreads();
    }
    {
        float wt[5][8];
#pragma unroll
        for (int j = 0; j < 5; ++j) { const f32x4 a = *(const LAS f32x4*)(cw + j * 256 + 8 * cs), bb = *(const LAS f32x4*)(cw + j * 256 + 8 * cs + 4);
            wt[j][0] = a[0]; wt[j][1] = a[1]; wt[j][2] = a[2]; wt[j][3] = a[3]; wt[j][4] = bb[0]; wt[j][5] = bb[1]; wt[j][6] = bb[2]; wt[j][7] = bb[3]; }
        const float osc = (cs < 16) ? 1.0f : 0.08838834764831845f;
        LAS unsigned char* dst = (cs < 16 ? Qs : Ks) + (4 * rg) * MQ_STRIDE + 16 * (cs & 15);
#pragma unroll
        for (int r = 0; r < 4; ++r) {
            float ov[8];
#pragma unroll
            for (int e = 0; e < 8; ++e) ov[e] = wt[4][e];
#pragma unroll
            for (int j = 0; j < 4; ++j) { const u32x4 x = cr[r + j];
                ov[0] += wt[j][0] * bflo(x.x); ov[1] += wt[j][1] * bfhi(x.x); ov[2] += wt[j][2] * bflo(x.y); ov[3] += wt[j][3] * bfhi(x.y);
                ov[4] += wt[j][4] * bflo(x.z); ov[5] += wt[j][5] * bfhi(x.z); ov[6] += wt[j][6] * bflo(x.w); ov[7] += wt[j][7] * bfhi(x.w); }
#pragma unroll
            for (int e = 0; e < 8; ++e) ov[e] = osc * ov[e] * __builtin_amdgcn_rcpf(1.f + __expf(-ov[e]));
            u32x4 o4; o4.x = pk2(ov[0], ov[1]); o4.y = pk2(ov[2], ov[3]); o4.z = pk2(ov[4], ov[5]); o4.w = pk2(ov[6], ov[7]);
            *(LAS u32x4*)(dst + r * MQ_STRIDE) = o4;
        }
        LAS unsigned char* vd = Vs + srow * MV_STRIDE + sseg * 32; *(LAS u32x4*)vd = vr0; *(LAS u32x4*)(vd + 16) = vr1;
        if (tid < 128) nS[tid] = nval;
        if (w == 0) {
            float bc = gf;
#pragma unroll
            for (int o = 1; o < 64; o <<= 1) { const float t = __shfl_up(bc, o); if (lane >= o) bc += t; }
            const float e = gi - bc; float cm = e;
#pragma unroll
            for (int o = 1; o < 64; o <<= 1) { const float t = __shfl_up(cm, o); if (lane >= o) cm = fmaxf(cm, t); }
            const float gt = fmaxf(mc, cm);
            eS[lane] = e; gS[lane] = gt; bS[lane] = bc; iS[lane] = __expf(mc - gt);
        }
    }
    __syncthreads();
    {
        const int st = w >> 1;
#pragma unroll
        for (int ti = 0; ti < 2; ++ti) { const int tt = 2 * (w & 1) + ti;
            f32x4 a = (f32x4){0.f, 0.f, 0.f, 0.f};
#pragma unroll
            for (int ks = 0; ks < 4; ++ks) { const bf16x8 kf = *(const LAS bf16x8*)(Ks + (16 * st + l15) * MQ_STRIDE + (32 * ks + 8 * g) * 2);
                const bf16x8 qf = *(const LAS bf16x8*)(Qs + (16 * tt + l15) * MQ_STRIDE + (32 * ks + 8 * g) * 2); a = MFMA16(kf, qf, a); }
            const int t = 16 * tt + l15; const float gt = gS[t];
            float pv[4];
#pragma unroll
            for (int r = 0; r < 4; ++r) { const int s_ = 16 * st + 4 * g + r; pv[r] = (s_ <= t) ? a[r] * __expf(eS[s_] - gt) : 0.f; }
            u32x2 pw; pw.x = pk2(pv[0], pv[1]); pw.y = pk2(pv[2], pv[3]);
            *(LAS u32x2*)(Ps + t * MP_STRIDE + (16 * st + 4 * g) * 2) = pw;
        }
    }
    __syncthreads();
    {
        f32x4 apv[4], aqc[4];
#pragma unroll
        for (int tt = 0; tt < 4; ++tt) { apv[tt] = (f32x4){0.f, 0.f, 0.f, 0.f}; aqc[tt] = (f32x4){0.f, 0.f, 0.f, 0.f}; }
#pragma unroll
        for (int ks = 0; ks < 2; ++ks) {
            LAS unsigned char* a0 = Vs + (32 * ks + 8 * g + (l15 >> 2)) * MV_STRIDE + (16 * w + 4 * (lane & 3)) * 2;
            const bf16x8 vf = cat8(vtr(a0), vtr(a0 + 4 * MV_STRIDE));
#pragma unroll
            for (int tt = 0; tt < 4; ++tt) { const bf16x8 pf = *(const LAS bf16x8*)(Ps + (16 * tt + l15) * MP_STRIDE + (32 * ks + 8 * g) * 2); apv[tt] = MFMA16(pf, vf, apv[tt]); }
        }
#pragma unroll
        for (int k2 = 0; k2 < 4; ++k2) {
            const bf16x8 cf = __builtin_bit_cast(bf16x8, cfr[k2]);
#pragma unroll
            for (int tt = 0; tt < 4; ++tt) { LAS unsigned char* qa = Qs + (16 * tt + l15) * MQ_STRIDE + (32 * k2 + 4 * g) * 2;
                const bf16x8 qf = cat8(*(const LAS s16x4*)qa, *(const LAS s16x4*)(qa + 32)); aqc[tt] = MFMA16(qf, cf, aqc[tt]); }
        }
#pragma unroll
        for (int tt = 0; tt < 4; ++tt)
#pragma unroll
            for (int r = 0; r < 4; ++r) { const int t = 16 * tt + 4 * g + r; Hn[t * MH_STRIDE + 16 * w + l15] = apv[tt][r] + iS[t] * aqc[tt][r]; }
        { const int t = srow, j = sseg;
          const u32x4 pr = *(const LAS u32x4*)(Ps + t * MP_STRIDE + 16 * j);
          float rs = (bflo(pr.x) + bfhi(pr.x)) + (bflo(pr.y) + bfhi(pr.y)) + (bflo(pr.z) + bfhi(pr.z)) + (bflo(pr.w) + bfhi(pr.w));
          const u32x4 q0 = *(const LAS u32x4*)(Qs + t * MQ_STRIDE + 32 * j), q1 = *(const LAS u32x4*)(Qs + t * MQ_STRIDE + 32 * j + 16);
          const f32x4 n0 = *(const LAS f32x4*)(nS + 16 * j), n1 = *(const LAS f32x4*)(nS + 16 * j + 4), n2 = *(const LAS f32x4*)(nS + 16 * j + 8), n3 = *(const LAS f32x4*)(nS + 16 * j + 12);
          float qn = bflo(q0.x) * n0[0] + bfhi(q0.x) * n0[1] + bflo(q0.y) * n0[2] + bfhi(q0.y) * n0[3] + bflo(q0.z) * n1[0] + bfhi(q0.z) * n1[1] + bflo(q0.w) * n1[2] + bfhi(q0.w) * n1[3]
                   + bflo(q1.x) * n2[0] + bfhi(q1.x) * n2[1] + bflo(q1.y) * n2[2] + bfhi(q1.y) * n2[3] + bflo(q1.z) * n3[0] + bfhi(q1.z) * n3[1] + bflo(q1.w) * n3[2] + bfhi(q1.w) * n3[3];
          float d = rs + iS[t] * qn;
          d += __shfl_xor(d, 1); d += __shfl_xor(d, 2); d += __shfl_xor(d, 4);
          if (j == 0) { const float fl = __expf(-(bS[t] + gS[t])); sm[SM_R + t] = 1.f / fmaxf(fabsf(d), fl); } }
    }
    __syncthreads();
    {
        const int t = srow, j = sseg; const float rd = sm[SM_R + t];
        float hv[16]; float ss = 0.f;
#pragma unroll
        for (int q = 0; q < 4; ++q) { const f32x4 x = *(const LAS f32x4*)(Hn + t * MH_STRIDE + 16 * j + 4 * q);
#pragma unroll
            for (int e = 0; e < 4; ++e) { const float v = x[e] * rd; hv[4 * q + e] = v; ss += v * v; } }
        ss += __shfl_xor(ss, 1); ss += __shfl_xor(ss, 2); ss += __shfl_xor(ss, 4);
        const float rstd = rsqrtf(ss * (1.f / 128.f) + 1e-6f);
        const unsigned mo[8] = {mc0.x, mc0.y, mc0.z, mc0.w, mc1.x, mc1.y, mc1.z, mc1.w};
        unsigned ow[8];
#pragma unroll
        for (int q = 0; q < 8; ++q) { const float g0 = A.mnorm_g[h * 128 + 16 * j + 2 * q], g1 = A.mnorm_g[h * 128 + 16 * j + 2 * q + 1];
            const float z0 = bflo(mo[q]), z1 = bfhi(mo[q]);
            ow[q] = pk2(hv[2 * q] * rstd * g0 * __builtin_amdgcn_rcpf(1.f + __expf(-z0)), hv[2 * q + 1] * rstd * g1 * __builtin_amdgcn_rcpf(1.f + __expf(-z1))); }
        bf16_t* op = ACT + (rowbase + c * 64 + t) * 1024 + h * 128 + 16 * j;
        *(u32x4*)op = (u32x4){ow[0], ow[1], ow[2], ow[3]}; *(u32x4*)(op + 8) = (u32x4){ow[4], ow[5], ow[6], ow[7]};
    }
}

__device__ __forceinline__ void phase3(const Args& A, LAS unsigned char* lds, int rep = 0) {
    const int tid = threadIdx.x;
    const float lam = ((const float*)(A.ws + WS_CTL))[1];
    unsigned* ctr = (unsigned*)(A.ws + WS_CTL) + 2 * rep;
    LAS int* slot = (LAS int*)(lds + LDS_BYTES - 64);
    const int nml = ((int)gridDim.x > 64) ? 32 : 1;
    if ((int)blockIdx.x < nml) for (int bh = blockIdx.x; bh < 32; bh += nml) mlstm_state(A, lds, bh >> 2, bh & 3);
    for (;;) {
        if (tid == 0) slot[0] = (int)atomicAdd(ctr, 1u);
        __syncthreads();
        const int it = slot[0];
        __syncthreads();
        if (it >= 512) break;
        attn_item(A, lds, (it & 31) >> 2, it & 3, 15 - (it >> 5), lam);
    }
    {
        const int lane = tid & 63, wave = tid >> 6;
        LAS float* scr = (LAS float*)(lds + wave * 16384);
        for (int r = blockIdx.x * 8 + wave; r < 1536; r += gridDim.x * 8) {
            if (r < 512) transpose_item(A.w_out, 1024, 0, (bf16_t*)(A.ws + WS_WOUT), scr, r / 32, r % 32, lane);
            else wprime_item(A, (r - 512) >> 6, (r - 512) & 63, lane);
        }
        quantise_tables(A, blockIdx.x * 8 + wave, gridDim.x * 8, 16384, 32768);
    }
}
__device__ __forceinline__ void phase3b(const Args& A, LAS unsigned char* lds) {
    const int tid = threadIdx.x;
    {
        const int lane = tid & 63, wave = tid >> 6;
        const bf16_t* WT = (const bf16_t*)(A.ws + WS_WQ); const float* MOD = (const float*)(A.ws + WS_MOD); float* SB = (float*)(A.ws + WS_SB);
        for (int n = blockIdx.x * 8 + wave; n < 2048; n += gridDim.x * 8) {
            const u32x4 w0 = *(const u32x4*)(WT + (size_t)n * 1024 + 16 * lane), w1 = *(const u32x4*)(WT + (size_t)n * 1024 + 16 * lane + 8);
            const unsigned ww[8] = {w0.x, w0.y, w0.z, w0.w, w1.x, w1.y, w1.z, w1.w};
            float sbv[8];
#pragma unroll
            for (int b = 0; b < 8; ++b) { const float* sp = MOD + b * 6144 + 3072 + 16 * lane; float d = 0.f;
#pragma unroll
                for (int q = 0; q < 4; ++q) { const f32x4 s4 = *(const f32x4*)(sp + 4 * q); d += bflo(ww[2 * q]) * s4[0] + bfhi(ww[2 * q]) * s4[1] + bflo(ww[2 * q + 1]) * s4[2] + bfhi(ww[2 * q + 1]) * s4[3]; }
                sbv[b] = wave_sum(d); }
            if (lane == 0) {
#pragma unroll
                for (int b = 0; b < 8; ++b) SB[b * 2048 + n] = sbv[b]; }
        }
    }
    int last_h = -1;
    for (int item = blockIdx.x; item < 1024; item += gridDim.x) mlstm_out(A, lds, item, last_h);
    __syncthreads();
}

__device__ __forceinline__ void phase5(const Args& A) {
    int tid_o = threadIdx.x; asm volatile("" : "+v"(tid_o)); const int tid = tid_o, lane = tid & 63, wave = tid >> 6, G = gridDim.x;
    const float* MOD = (const float*)(A.ws + WS_MOD);
    bf16_t* ACT = (bf16_t*)(A.ws + WS_ACT);
    for (int m = blockIdx.x * 8 + wave; m < T; m += G * 8) {
        const int b = m >> 11;
        const f32x4* xr = (const f32x4*)(A.out + (size_t)m * 1024) + lane;
        f32x4 v[4]; float ss = 0.f;
#pragma unroll
        for (int j = 0; j < 4; ++j) { v[j] = xr[64 * j]; ss += (v[j][0] * v[j][0] + v[j][1] * v[j][1]) + (v[j][2] * v[j][2] + v[j][3] * v[j][3]); }
        const float rstd = rsqrtf(wave_sum(ss) * (1.f / 1024.f) + 1e-6f);
        unsigned long long* o8 = (unsigned long long*)(ACT + (size_t)m * 1024) + lane;
#pragma unroll
        for (int j = 0; j < 4; ++j) { const int col = 4 * lane + 256 * j;
            const f32x4 g = *(const f32x4*)(A.norm2_g + col), sc = *(const f32x4*)(MOD + b * 6144 + 4096 + col), sh = *(const f32x4*)(MOD + b * 6144 + 3072 + col);
            v[j] = v[j] * rstd * g * (sc + 1.0f) + sh;
            o8[64 * j] = (unsigned long long)pk2(v[j][0], v[j][1]) | ((unsigned long long)pk2(v[j][2], v[j][3]) << 32); }
    }
}

__device__ __forceinline__ unsigned f2key(float f) { const unsigned u = __float_as_uint(f); return (u & 0x80000000u) ? ~u : (u | 0x80000000u); }
__device__ __forceinline__ float key2f(unsigned k) { const unsigned u = (k & 0x80000000u) ? (k & 0x7fffffffu) : ~k; return __uint_as_float(u); }
#define CE_DESC(a, b) do { const unsigned _mx = (a) > (b) ? (a) : (b), _mn = (a) > (b) ? (b) : (a); (a) = _mx; (b) = _mn; } while (0)
__device__ __forceinline__ void sort16_desc(unsigned (&k)[16]) {
#pragma unroll
    for (int size = 2; size <= 16; size <<= 1)
#pragma unroll
        for (int stride = size >> 1; stride > 0; stride >>= 1)
#pragma unroll
            for (int i = 0; i < 16; ++i) { const int j = i ^ stride;
                if (j > i) { if ((i & size) == 0) CE_DESC(k[i], k[j]); else CE_DESC(k[j], k[i]); } }
}
__device__ __forceinline__ void merge16(unsigned (&a)[16], const unsigned (&b)[16]) {
#pragma unroll
    for (int i = 0; i < 16; ++i) a[i] = a[i] > b[15 - i] ? a[i] : b[15 - i];
#pragma unroll
    for (int stride = 8; stride > 0; stride >>= 1)
#pragma unroll
        for (int i = 0; i < 16; ++i) { const int j = i ^ stride; if (j > i) CE_DESC(a[i], a[j]); }
}
constexpr int PE_IDX = 0, PE_SEL = 69632;
__device__ __forceinline__ float gelu_erf(float v) { return 0.5f * v * (1.f + erff(v * 0.70710678118654752f)); }
__device__ __forceinline__ float gelu_fast(float v) {
    const float av = fabsf(v), tt = __builtin_amdgcn_rcpf(av * 0.2316418882f + 1.0f);
    float q = tt * 0.5307027145f + (-0.7265760135f); q = q * tt + 0.7107068705f; q = q * tt + (-0.142248368f); q = q * tt + 0.127414796f; q = q * tt;
    const float e = __builtin_amdgcn_exp2f((v * v) * (-0.72134752044f));
    const float m = v * (q * e);
    return v < 0.f ? m : v - m;
}

__device__ __forceinline__ void peer_tile(const Args& A, LAS unsigned char* lds, int tile) {
    int tid_o = threadIdx.x; asm volatile("" : "+v"(tid_o)); const int tid = tid_o, lane = tid & 63, w = tid >> 6, g = lane >> 4, l15 = lane & 15;
    const bf16_t* QRY = (const bf16_t*)(A.ws + WS_QRY);
    const bf16_t* KEYS = (const bf16_t*)(A.ws + WS_KEYS);
    const bf16_t* ACT = (const bf16_t*)(A.ws + WS_ACT);
    const float* MOD = (const float*)(A.ws + WS_MOD);
    LAS unsigned* idx = (LAS unsigned*)(lds + PE_IDX) + (w * 64 + lane) * 33;
    LAS u32x2* SEL = (LAS u32x2*)(lds + PE_SEL);
    {
        const int tg = w & 3, hg = w >> 2, tl = 16 * tg + l15;
        const size_t m = (size_t)tile * 64 + tl;
        unsigned LA[4][2][16];
#pragma unroll
        for (int hh = 0; hh < 4; ++hh) {
            const int h = 4 * hg + hh;
#pragma unroll
            for (int p = 0; p < 2; ++p) {
                const int hp = 2 * h + p;
                unsigned k0[16], k1[16];
                { const bf16_t* sp = QRY + m * 2048 + hp * 128 + 32 * g;
                  const u32x4 s0 = *(const u32x4*)sp, s1 = *(const u32x4*)(sp + 8), s2 = *(const u32x4*)(sp + 16), s3 = *(const u32x4*)(sp + 24);
                  const unsigned sw[16] = {s0.x, s0.y, s0.z, s0.w, s1.x, s1.y, s1.z, s1.w, s2.x, s2.y, s2.z, s2.w, s3.x, s3.y, s3.z, s3.w};
#pragma unroll
                  for (int i = 0; i < 16; ++i) {
                      const float lo = (float)__builtin_bit_cast(_Float16, (unsigned short)(sw[i] & 0xffffu)), hi = (float)__builtin_bit_cast(_Float16, (unsigned short)(sw[i] >> 16));
                      const unsigned klo = (f2key(lo) & ~127u) | (unsigned)(127 - (32 * g + 2 * i)), khi = (f2key(hi) & ~127u) | (unsigned)(127 - (32 * g + 2 * i + 1));
                      if (i < 8) { k0[2 * i] = klo; k0[2 * i + 1] = khi; } else { k1[2 * (i - 8)] = klo; k1[2 * (i - 8) + 1] = khi; } } }
                sort16_desc(k0); sort16_desc(k1); merge16(k0, k1);
#pragma unroll
                for (int msk = 16; msk <= 32; msk <<= 1) {
#pragma unroll
                    for (int i = 0; i < 16; ++i) k1[i] = (unsigned)__shfl_xor((int)k0[i], msk);
                    merge16(k0, k1); }
#pragma unroll
                for (int i = 0; i < 16; ++i) LA[hh][p][i] = k0[i];
            }
        }
        {
            const int h = 4 * hg + g;
            unsigned L2[2][16];
#pragma unroll
            for (int p = 0; p < 2; ++p)
#pragma unroll
                for (int i = 0; i < 16; ++i) L2[p][i] = (g & 2) ? ((g & 1) ? LA[3][p][i] : LA[2][p][i]) : ((g & 1) ? LA[1][p][i] : LA[0][p][i]);
            float va[16], vb[16];
#pragma unroll
            for (int i = 0; i < 16; ++i) { va[i] = key2f(L2[0][i] & ~127u); vb[i] = key2f(L2[1][i] & ~127u); idx[i] = 127u - (L2[0][i] & 127u); idx[16 + i] = 127u - (L2[1][i] & 127u); }
#define CK(i, j) ((f2key(va[i] + vb[j]) & ~255u) | (unsigned)(255 - (16 * (i) + (j))))
            unsigned Lf[16], Bt[16];
#pragma unroll
            for (int j = 0; j < 16; ++j) Lf[j] = CK(0, j);
#pragma unroll
            for (int j = 0; j < 8; ++j) Bt[j] = CK(1, j);
#pragma unroll
            for (int j = 0; j < 5; ++j) Bt[8 + j] = CK(2, j);
#pragma unroll
            for (int j = 0; j < 3; ++j) Bt[13 + j] = CK(4, j);
            sort16_desc(Bt); merge16(Lf, Bt);
#pragma unroll
            for (int j = 0; j < 4; ++j) Bt[j] = CK(3, j);
            Bt[4] = CK(5, 0); Bt[5] = CK(5, 1); Bt[6] = CK(6, 0); Bt[7] = CK(6, 1); Bt[8] = CK(7, 0); Bt[9] = CK(7, 1);
            Bt[10] = CK(8, 0); Bt[11] = CK(9, 0); Bt[12] = CK(10, 0); Bt[13] = CK(11, 0); Bt[14] = CK(12, 0); Bt[15] = CK(13, 0);
            sort16_desc(Bt); merge16(Lf, Bt);
            { unsigned x0 = CK(14, 0), x1 = CK(15, 0);
#pragma unroll
              for (int i = 0; i < 16; ++i) CE_DESC(Lf[i], x0);
#pragma unroll
              for (int i = 0; i < 16; ++i) CE_DESC(Lf[i], x1); }
#undef CK
            float fv[16], den = 0.f; const float f0 = key2f(Lf[0] & ~255u);
#pragma unroll
            for (int k = 0; k < 16; ++k) { fv[k] = __expf(key2f(Lf[k] & ~255u) - f0); den += fv[k]; }
            const float rden = 1.f / den;
            LDS_WAIT();
#pragma unroll
            for (int k = 0; k < 16; ++k) { const unsigned code = 255u - (Lf[k] & 255u); const unsigned e = idx[code >> 4] * 128u + idx[16 + (code & 15u)];
                u32x2 sv; sv.x = e; sv.y = __float_as_uint(fv[k] * rden); SEL[(tl * 8 + h) * 16 + k] = sv; }
        }
    }
    __syncthreads();
    const unsigned char* T8 = A.ws + WS_T8; const float* SC = (const float*)(A.ws + WS_SC);
    LAS u32x2* SORT = (LAS u32x2*)(lds + PE_IDX);
    LAS int* OFFS = (LAS int*)(lds + PE_SEL + 65536);
    for (int ti = 0; ti < 8; ++ti) {
        const int tl = 8 * w + ti;
        const u32x2 e0 = SEL[tl * 128 + lane], e1 = SEL[tl * 128 + 64 + lane];
        const int p0 = (int)(e0.x >> 10), p1 = (int)(e1.x >> 10);
        int off = 0;
        for (int p = 0; p < 16; ++p) {
            const unsigned long long m0 = __ballot(p0 == p), m1 = __ballot(p1 == p);
            const int c0 = __popcll(m0), c1 = __popcll(m1);
            const int r0 = __builtin_amdgcn_mbcnt_hi((unsigned)(m0 >> 32), __builtin_amdgcn_mbcnt_lo((unsigned)m0, 0u));
            const int r1 = __builtin_amdgcn_mbcnt_hi((unsigned)(m1 >> 32), __builtin_amdgcn_mbcnt_lo((unsigned)m1, 0u));
            if (p0 == p) SORT[tl * 128 + off + r0] = e0;
            if (p1 == p) SORT[tl * 128 + off + c0 + r1] = e1;
            if (lane == 0) OFFS[tl * 17 + p] = off;
            off += c0 + c1;
        }
        if (lane == 0) OFFS[tl * 17 + 16] = off;
    }
    LDS_WAIT(); __builtin_amdgcn_wave_barrier();
    const unsigned char* T8v = T8 + (size_t)16384 * 1024;
    const bf16_t* A3 = (const bf16_t*)(A.ws + WS_A3); const float* RSq = (const float*)(A.ws + WS_RS);
    for (int pass = 0; pass < 2; ++pass) {
        const int tb = 8 * w + 4 * pass;
        u32x4 xpa[4], xpb[4]; f32x2 oacc[4][8];
#pragma unroll
        for (int tk = 0; tk < 4; ++tk) { const size_t m = (size_t)tile * 64 + tb + tk;
            { const u32x4 ra = *(const u32x4*)(A3 + m * 1024 + 16 * lane), rb = *(const u32x4*)(A3 + m * 1024 + 16 * lane + 8);
              float xr_; { const f32x4 p0 = *(const f32x4*)(RSq + m * 16), p1 = *(const f32x4*)(RSq + m * 16 + 4), p2 = *(const f32x4*)(RSq + m * 16 + 8), p3 = *(const f32x4*)(RSq + m * 16 + 12);
                const f32x4 ps = (p0 + p1) + (p2 + p3); xr_ = rsqrtf(((ps[0] + ps[1]) + (ps[2] + ps[3])) * (1.f / 1024.f) + 1e-6f); }
              const unsigned rr[8] = {ra.x, ra.y, ra.z, ra.w, rb.x, rb.y, rb.z, rb.w}; unsigned hh[8];
              const float* sp = MOD + (int)(m >> 11) * 6144 + 3072 + 16 * lane;
#pragma unroll
              for (int q = 0; q < 8; ++q) { const f32x2 sh = *(const f32x2*)(sp + 2 * q); hh[q] = pk2(bflo(rr[q]) * xr_ + sh[0], bfhi(rr[q]) * xr_ + sh[1]); }
              xpa[tk] = (u32x4){hh[0], hh[1], hh[2], hh[3]}; xpb[tk] = (u32x4){hh[4], hh[5], hh[6], hh[7]}; }
#pragma unroll
            for (int q = 0; q < 8; ++q) oacc[tk][q] = (f32x2){0.f, 0.f}; }
        int it_p = 0, it_tk = -1, it_j = 0, it_end = 0; bool it_done = false;
#define IT_ADVANCE() do { it_j += 4; while (it_j >= it_end) { if (it_done) break; ++it_tk; if (it_tk == 4) { it_tk = 0; ++it_p; if (it_p == 16) { it_done = true; it_p = 15; it_j = 0; it_end = 1; break; } } \
            it_j = __builtin_amdgcn_readfirstlane(OFFS[(tb + it_tk) * 17 + it_p]); it_end = __builtin_amdgcn_readfirstlane(OFFS[(tb + it_tk) * 17 + it_p + 1]); } } while (0)
#define LOAD_SET(U, V, CG, SU, SV) do { const int _tl = tb + it_tk; \
            _Pragma("unroll") for (int _k = 0; _k < 4; ++_k) { const int _jj = (it_j + _k < it_end) ? it_j + _k : it_end - 1; const unsigned _e = SORT[_tl * 128 + _jj].x; \
                U[_k] = *(const u32x4*)(T8 + (size_t)_e * 1024 + 16 * lane); V[_k] = *(const u32x4*)(T8v + (size_t)_e * 1024 + 16 * lane); } \
            const int _ms = lane >> 4; const bool _valid = it_j + _ms < it_end; const u32x2 _se = SORT[_tl * 128 + (_valid ? it_j + _ms : it_end - 1)]; \
            CG = _valid ? __uint_as_float(_se.y) : 0.f; SU = SC[_se.x]; SV = SC[16384 + _se.x]; } while (0)
        u32x4 uA[4], vA[4], uB[4], vB[4]; float cgA = 0.f, suA = 0.f, svA = 0.f, cgB = 0.f, suB = 0.f, svB = 0.f;
#pragma unroll
        for (int k = 0; k < 4; ++k) { uA[k] = (u32x4){0u, 0u, 0u, 0u}; vA[k] = uA[k]; uB[k] = uA[k]; vB[k] = uA[k]; }
        IT_ADVANCE();
        LOAD_SET(uA, vA, cgA, suA, svA);
        for (int p = 0; p < 16; ++p) {
#pragma unroll
            for (int tk = 0; tk < 4; ++tk) {
                const int tl = tb + tk;
                const int beg = __builtin_amdgcn_readfirstlane(OFFS[tl * 17 + p]), end = __builtin_amdgcn_readfirstlane(OFFS[tl * 17 + p + 1]);
                f32x2 xf[8];
                { const unsigned xx[8] = {xpa[tk].x, xpa[tk].y, xpa[tk].z, xpa[tk].w, xpb[tk].x, xpb[tk].y, xpb[tk].z, xpb[tk].w};
#pragma unroll
                  for (int q = 0; q < 8; ++q) xf[q] = (f32x2){bflo(xx[q]), bfhi(xx[q])}; }
#define COMPUTE_SET(U, V, CG, SU, SV) do { float pd[4]; \
                    _Pragma("unroll") for (int k = 0; k < 4; ++k) { f32x2 d = (f32x2){0.f, 0.f}; \
                        _Pragma("unroll") for (int q = 0; q < 4; ++q) { const int dw = (int)U[k][q]; \
                            d += __builtin_amdgcn_cvt_pk_f32_fp8(dw, false) * xf[2 * q]; d += __builtin_amdgcn_cvt_pk_f32_fp8(dw, true) * xf[2 * q + 1]; } \
                        pd[k] = d[0] + d[1]; } \
                    float s; \
                    { const auto r0 = __builtin_amdgcn_permlane32_swap(__float_as_uint(pd[0]), __float_as_uint(pd[2]), false, false); \
                      const auto r1 = __builtin_amdgcn_permlane32_swap(__float_as_uint(pd[1]), __float_as_uint(pd[3]), false, false); \
                      const float a0 = __uint_as_float(r0[0]) + __uint_as_float(r0[1]), a1 = __uint_as_float(r1[0]) + __uint_as_float(r1[1]); \
                      const auto r2 = __builtin_amdgcn_permlane16_swap(__float_as_uint(a0), __float_as_uint(a1), false, false); \
                      s = __uint_as_float(r2[0]) + __uint_as_float(r2[1]); \
                      s += __int_as_float(__builtin_amdgcn_mov_dpp(__float_as_int(s), 0xB1, 0xF, 0xF, true)); \
                      s += __int_as_float(__builtin_amdgcn_mov_dpp(__float_as_int(s), 0x4E, 0xF, 0xF, true)); \
                      s += __int_as_float(__builtin_amdgcn_mov_dpp(__float_as_int(s), 0x141, 0xF, 0xF, true)); \
                      s += __int_as_float(__builtin_amdgcn_mov_dpp(__float_as_int(s), 0x140, 0xF, 0xF, true)); } \
                    const float coef = CG * gelu_fast(s * SU) * SV; \
                    _Pragma("unroll") for (int k = 0; k < 4; ++k) { const float ck = __int_as_float(__builtin_amdgcn_readlane(__float_as_int(coef), 16 * k)); const f32x2 ck2 = (f32x2){ck, ck}; \
                        _Pragma("unroll") for (int qq = 0; qq < 4; ++qq) { const int dw = (int)V[k][qq]; \
                            oacc[tk][2 * qq] += ck2 * __builtin_amdgcn_cvt_pk_f32_fp8(dw, false); oacc[tk][2 * qq + 1] += ck2 * __builtin_amdgcn_cvt_pk_f32_fp8(dw, true); } } } while (0)
                for (int j0 = beg; j0 < end; j0 += 8) {
                    IT_ADVANCE();
                    LOAD_SET(uB, vB, cgB, suB, svB);
                    COMPUTE_SET(uA, vA, cgA, suA, svA);
                    if (j0 + 4 < end) {
                        IT_ADVANCE();
                        LOAD_SET(uA, vA, cgA, suA, svA);
                        COMPUTE_SET(uB, vB, cgB, suB, svB);
                    } else {
#pragma unroll
                        for (int k = 0; k < 4; ++k) { uA[k] = uB[k]; vA[k] = vB[k]; }
                        cgA = cgB; suA = suB; svA = svB;
                    }
                }
            }
        }
#undef COMPUTE_SET
#undef IT_ADVANCE
#undef LOAD_SET
#pragma unroll
        for (int tk = 0; tk < 4; ++tk) {
            const size_t m = (size_t)tile * 64 + tb + tk; const int b = (int)(m >> 11);
            float* orow = A.out + m * 1024 + 16 * lane;
            const float* g2 = MOD + b * 6144 + 5120 + 16 * lane;
            f32x4 xv[4]; float ss = 0.f;
#pragma unroll
            for (int j = 0; j < 4; ++j) { const f32x4 x1 = *(const f32x4*)(orow + 4 * j), gg = *(const f32x4*)(g2 + 4 * j);
                const f32x4 pe = (f32x4){oacc[tk][2 * j][0], oacc[tk][2 * j][1], oacc[tk][2 * j + 1][0], oacc[tk][2 * j + 1][1]};
                xv[j] = x1 + gg * pe; ss += (xv[j][0] * xv[j][0] + xv[j][1] * xv[j][1]) + (xv[j][2] * xv[j][2] + xv[j][3] * xv[j][3]); }
            const float rstd = rsqrtf(wave_sum(ss) * (1.f / 1024.f) + 1e-6f);
#pragma unroll
            for (int j = 0; j < 4; ++j) { const f32x4 fg = *(const f32x4*)(A.final_g + 16 * lane + 4 * j); *(f32x4*)(orow + 4 * j) = xv[j] * rstd * fg; }
        }
    }
    __syncthreads();
}


#define XB_TMO      128
#define XB_XCNT(j)  (256  + 64 * (j))
#define XB_XSUB(j)  (1280 + 64 * (j))
#define XB_XGEN(j)  (2304 + 64 * (j))
#define XB_TOP      3328
#define XB_TOPGEN   3392
#define XCD_BAR_WORDS 3456
#define XB_SPIN_CAP (1u << 18)

__device__ __forceinline__ unsigned xb_ld(unsigned* p)              { return __hip_atomic_load(p, __ATOMIC_RELAXED, __HIP_MEMORY_SCOPE_AGENT); }
__device__ __forceinline__ unsigned xb_add(unsigned* p, unsigned v) { return __hip_atomic_fetch_add(p, v, __ATOMIC_RELAXED, __HIP_MEMORY_SCOPE_AGENT); }
__device__ __forceinline__ unsigned xb_xcc_id() { return (unsigned)__builtin_amdgcn_s_getreg((3 << 11) | 20) & 0xFu; }
#define XB_SPIN(cond, bar) do { unsigned _sp = 0; while (cond) { __builtin_amdgcn_s_sleep(1); \
    if ((++_sp & 255u) == 0u) { if (xb_ld(&(bar)[XB_TMO])) break; if (_sp > XB_SPIN_CAP) { atomicAdd(&(bar)[XB_TMO], 1u); break; } } } } while (0)

struct XcdBarrier {
    unsigned* bar; unsigned x;
    volatile LAS unsigned* st;
};

__device__ __forceinline__ XcdBarrier xcd_barrier_post(unsigned* bar, volatile LAS unsigned* st) {
    XcdBarrier b; b.bar = bar; b.x = xb_xcc_id(); b.st = st;
    if (threadIdx.x == 0) (void)xb_add(&bar[XB_XCNT(b.x)], 1u);
    return b;
}
__device__ __forceinline__ void xcd_barrier_complete(unsigned* bar, unsigned x, unsigned& nloc, unsigned& nx) {
    const unsigned G = gridDim.x * gridDim.y * gridDim.z;
    unsigned sum, cnt, mine, sp = 0u;
    for (;;) {
        sum = 0u; cnt = 0u; mine = 0u;
#pragma unroll
        for (unsigned j = 0; j < 16; ++j) { const unsigned c = xb_ld(&bar[XB_XCNT(j)]); sum += c; cnt += (c > 0u) ? 1u : 0u; mine = (j == x) ? c : mine; }
        if (sum == G) break;
        __builtin_amdgcn_s_sleep(1);
        if ((++sp & 255u) == 0u) { if (xb_ld(&bar[XB_TMO])) break; if (sp > XB_SPIN_CAP) { atomicAdd(&bar[XB_TMO], 1u); break; } }
    }
    nloc = mine > 0u ? mine : 1u; nx = cnt > 0u ? cnt : 1u;
}

__device__ __forceinline__ void xcd_barrier(const XcdBarrier& b) {
    asm volatile("s_waitcnt vmcnt(0)" ::: "memory");
    __syncthreads();
    if (threadIdx.x == 0) {
        unsigned* bar = b.bar;
        __builtin_amdgcn_s_waitcnt(0);
        unsigned nloc = b.st[0], nx = b.st[1];
        if (nloc == 0u) { xcd_barrier_complete(bar, b.x, nloc, nx); b.st[0] = nloc; b.st[1] = nx; }
        const unsigned old = xb_add(&bar[XB_XSUB(b.x)], 1u);
        const unsigned gen = old / nloc;
        if (old + 1u == (gen + 1u) * nloc) {
            __builtin_amdgcn_fence(__ATOMIC_RELEASE, "agent");
            asm volatile("s_waitcnt vmcnt(0)" ::: "memory");
            const unsigned og = xb_add(&bar[XB_TOP], 1u);
            const unsigned tg = og / nx;
            if (og + 1u == (tg + 1u) * nx) xb_add(&bar[XB_TOPGEN], 1u);
            else XB_SPIN(xb_ld(&bar[XB_TOPGEN]) == tg, bar);
            __builtin_amdgcn_fence(__ATOMIC_ACQUIRE, "agent");
            xb_add(&bar[XB_XGEN(b.x)], 1u);
            asm volatile("s_waitcnt vmcnt(0)" ::: "memory");
        } else {
            XB_SPIN(xb_ld(&bar[XB_XGEN(b.x)]) == gen, bar);
            __builtin_amdgcn_fence(__ATOMIC_ACQUIRE, "agent");
            asm volatile("s_waitcnt vmcnt(0)" ::: "memory");
        }
    }
    __syncthreads();
}

__global__ void __launch_bounds__(512, 2) mega_fwd(Args A) {
    extern __shared__ __attribute__((aligned(16))) unsigned char lds_raw[];
    LAS unsigned char* lds = (LAS unsigned char*)lds_raw;
    cg::grid_group grid = cg::this_grid();
    const int G = gridDim.x;
    if (threadIdx.x < 4) ((LAS unsigned*)(lds + LDS_BYTES - 32))[threadIdx.x] = 0u;
    __syncthreads();
    if (A.ws == nullptr) grid.sync();
    const XcdBarrier xb = xcd_barrier_post((unsigned*)(A.ws + WS_BAR), (volatile LAS unsigned*)(lds + LDS_BYTES - 32));
    phase0(A, lds);
    xcd_barrier(xb);
    phase1(A, lds);
    phase0b(A, lds);
    xcd_barrier(xb);
    { pg8::Gemm gm{(const pg8::bf16_t*)(A.ws + WS_ACT), (const pg8::bf16_t*)(A.ws + WS_WIN), T, NP, DM}; pg8::StaticOrder S; S.init(T, NP, G, (int)blockIdx.x);
      pg8::EpiStoreBf16 E{(pg8::bf16_t*)(A.ws + WS_P), NP};
      pg8::gemm_phase<pg8::EpiStoreBf16, pg8::StaticOrder, true, true>((PG8_LAS unsigned char*)lds, gm, S, E); }
    { const int nshort = G - (896 % G == 0 ? 0 : 896 % G);
      const int first = G - nshort;
      if ((int)blockIdx.x >= first) quantise_tables(A, ((int)blockIdx.x - first) * 8 + (int)(threadIdx.x >> 6), nshort * 8, 0, 16384); }
    xcd_barrier(xb);
    phase3(A, lds);
    xcd_barrier(xb);
    phase3b(A, lds);
    xcd_barrier(xb);
    { pg8::Gemm gm{(const pg8::bf16_t*)(A.ws + WS_ACT), (const pg8::bf16_t*)(A.ws + WS_WOUT), T, DM, DM}; pg8::StaticOrder S; S.init(T, DM, G, (int)blockIdx.x);
      pg8::EpiResidNorm E{A.x, (const float*)(A.ws + WS_MOD), A.norm2_g, A.out, (pg8::bf16_t*)(A.ws + WS_A3), (float*)(A.ws + WS_RS)};
      pg8::gemm_phase<pg8::EpiResidNorm, pg8::StaticOrder, true, true>((PG8_LAS unsigned char*)lds, gm, S, E); }
    xcd_barrier(xb);
    { pg8::Gemm gm{(const pg8::bf16_t*)(A.ws + WS_A3), (const pg8::bf16_t*)(A.ws + WS_WQ), T, 2048, DM}; pg8::StaticOrder S; S.init(T, 2048, G, (int)blockIdx.x);
      pg8::EpiScoreF16 E{(pg8::bf16_t*)(A.ws + WS_QRY), 2048, (const float*)(A.ws + WS_RS), (const float*)(A.ws + WS_SB)};
      pg8::gemm_phase<pg8::EpiScoreF16, pg8::StaticOrder, true, true>((PG8_LAS unsigned char*)lds, gm, S, E); }
    xcd_barrier(xb);
    for (int tile = blockIdx.x; tile < T / 64; tile += G) peer_tile(A, lds, tile);
}

extern "C" void kernel_launch(void* const* d_in, const int* in_sizes, int n_in, void* d_out, int out_size, void* d_ws, size_t ws_size, hipStream_t stream) {
    static int grid = 0;
    if (grid == 0) {
        if (n_in != 22 || out_size != T * DM || ws_size < WS_END) { fprintf(stderr, "kernel_launch: unexpected shapes (n_in %d out %d ws %zu)\n", n_in, out_size, ws_size); grid = -1; return; }
        int dev = 0, cus = 0, per_cu = 0;
        if (hipGetDevice(&dev) != hipSuccess || hipDeviceGetAttribute(&cus, hipDeviceAttributeMultiprocessorCount, dev) != hipSuccess) { grid = -1; return; }
        if (hipFuncSetAttribute((const void*)mega_fwd, hipFuncAttributeMaxDynamicSharedMemorySize, LDS_BYTES) != hipSuccess) { fprintf(stderr, "kernel_launch: hipFuncSetAttribute failed\n"); grid = -1; return; }
        if (hipOccupancyMaxActiveBlocksPerMultiprocessor(&per_cu, (const void*)mega_fwd, 512, LDS_BYTES) != hipSuccess || per_cu < 1) { fprintf(stderr, "kernel_launch: occupancy query gave %d\n", per_cu); per_cu = 1; }
        (void)hipGetLastError();
        grid = cus * per_cu;
    }
    if (grid < 0) return;
    Args a{};
    const float** ap = (const float**)&a;
    for (int i = 0; i < 22; ++i) ap[i] = (const float*)d_in[i];
    a.out = (float*)d_out; a.ws = (unsigned char*)d_ws;
    if (hipMemsetAsync((unsigned char*)d_ws + WS_BAR, 0, XCD_BAR_WORDS * sizeof(unsigned), stream) != hipSuccess) { fprintf(stderr, "kernel_launch: memset of the barrier words failed\n"); return; }
    void* args[] = {&a};
    hipError_t e = hipLaunchCooperativeKernel((const void*)mega_fwd, dim3(grid), dim3(512), args, LDS_BYTES, stream);
    if (e != hipSuccess) fprintf(stderr, "kernel_launch: cooperative launch failed: %s (grid %d)\n", hipGetErrorString(e), grid);
}
```

```cpp
#include <hip/hip_runtime.h>
#include <hip/hip_cooperative_groups.h>
#include <cstdio>
#include <cstdint>
namespace cg = cooperative_groups;

namespace pg8 {
#define PG8_LAS __attribute__((address_space(3)))
typedef unsigned short bf16_t;
typedef short bf16x8 __attribute__((ext_vector_type(8)));
typedef float f32x4 __attribute__((ext_vector_type(4)));
typedef unsigned u32x4 __attribute__((ext_vector_type(4)));
constexpr int BM = 256, BK = 64, HALF = 128, HTB = HALF * BK * 2  , STAGE_BYTES = 8 * HTB, NXCD = 8, WGM = 8;

__host__ __device__ __forceinline__ int lds_byte(int r, int c) { const int st = (r >> 4) * 2 + (c >> 5), rr = r & 15, cc = c & 31, ob = rr * 64 + cc * 2; return st * 1024 + (ob ^ (((ob >> 9) & 1) << 5)); }
__host__ __device__ __forceinline__ void stage_rc(int b, int& R, int& C) { const int st = b / 1024, sb = b % 1024, swz = sb ^ (((sb >> 9) & 1) << 5); R = (st >> 1) * 16 + swz / 64; C = (st & 1) * 32 + (swz % 64) / 2; }
__host__ __device__ __forceinline__ int perm32(int rho) { const int n = rho >> 4, i = rho & 15; return 8 * (i >> 2) + 4 * n + (i & 3); }

struct Unit { int pm, pn; };
struct Gemm { const bf16_t* A; const bf16_t* Bt; int M, N, K; };

struct StaticOrder {
    int nM, nN, nwg, G, c;
    __host__ __device__ void init(int M, int N, int G_, int c_) { nM = M / BM; nN = N / BM; nwg = nM * nN; G = G_; c = c_; }
    __host__ __device__ bool next(int i, Unit& u) const {
        const long L = (long)i * G + c; if (L >= nwg) return false;
        int wgid = (int)L; { const int q = nwg / NXCD, r = nwg % NXCD, xcd = wgid % NXCD, off = wgid / NXCD; wgid = (xcd < r ? xcd * (q + 1) : r * (q + 1) + (xcd - r) * q) + off; }
        const int nig = WGM * nN, gid = wgid / nig, fm = gid * WGM, gsz = (nM - fm) < WGM ? (nM - fm) : WGM;
        u.pm = fm + ((wgid % nig) % gsz); u.pn = (wgid % nig) / gsz; return true;
    }
    __device__ __forceinline__ void a_ready(const Unit&) const {}
    __device__ __forceinline__ void done(const Unit&) const {}
};

__device__ __forceinline__ unsigned cvt_pk_bf16(float lo, float hi) { unsigned r; asm volatile("v_cvt_pk_bf16_f32 %0, %1, %2" : "=v"(r) : "v"(lo), "v"(hi)); return r; }

struct EpiStoreBf16 {
    static constexpr bool PERM = true, AFTER_DRAIN = false;
    bf16_t* O; int ldc;
    __device__ __forceinline__ void operator()(const f32x4 (&acc)[2][2][4][2], const Unit& u, int wr, int wc, int fr, int fq) const {
        const int row0 = u.pm * BM + wr * 64 + fr, col0 = u.pn * BM + wc * 32 + 8 * fq;
#pragma unroll
        for (int ai = 0; ai < 2; ++ai)
#pragma unroll
            for (int m = 0; m < 4; ++m) { bf16_t* rowp = O + (size_t)(row0 + ai * HALF + m * 16) * ldc + col0;
#pragma unroll
                for (int bj = 0; bj < 2; ++bj) { const f32x4 v0 = acc[ai][bj][m][0], v1 = acc[ai][bj][m][1];
                    u32x4 w; w.x = cvt_pk_bf16(v0[0], v0[1]); w.y = cvt_pk_bf16(v0[2], v0[3]); w.z = cvt_pk_bf16(v1[0], v1[1]); w.w = cvt_pk_bf16(v1[2], v1[3]);
                    *(u32x4*)(rowp + bj * HALF) = w; } }
    }
};
struct EpiStoreF16 {
    static constexpr bool PERM = true, AFTER_DRAIN = false;
    bf16_t* O; int ldc;
    static __device__ __forceinline__ unsigned pkh(float a, float b) { return (unsigned)__builtin_bit_cast(unsigned short, (_Float16)a) | ((unsigned)__builtin_bit_cast(unsigned short, (_Float16)b) << 16); }
    __device__ __forceinline__ void operator()(const f32x4 (&acc)[2][2][4][2], const Unit& u, int wr, int wc, int fr, int fq) const {
        const int row0 = u.pm * BM + wr * 64 + fr, col0 = u.pn * BM + wc * 32 + 8 * fq;
#pragma unroll
        for (int ai = 0; ai < 2; ++ai)
#pragma unroll
            for (int m = 0; m < 4; ++m) { bf16_t* rowp = O + (size_t)(row0 + ai * HALF + m * 16) * ldc + col0;
#pragma unroll
                for (int bj = 0; bj < 2; ++bj) { const f32x4 v0 = acc[ai][bj][m][0], v1 = acc[ai][bj][m][1];
                    u32x4 w; w.x = pkh(v0[0], v0[1]); w.y = pkh(v0[2], v0[3]); w.z = pkh(v1[0], v1[1]); w.w = pkh(v1[2], v1[3]);
                    *(u32x4*)(rowp + bj * HALF) = w; } }
    }
};
struct EpiResid {
    static constexpr bool PERM = true, AFTER_DRAIN = false;
    const float* x; const float* gate; float* out;
    __device__ __forceinline__ void operator()(const f32x4 (&acc)[2][2][4][2], const Unit& u, int wr, int wc, int fr, int fq) const {
        const int row0 = u.pm * BM + wr * 64 + fr, col0 = u.pn * BM + wc * 32 + 8 * fq;
#pragma unroll
        for (int ai = 0; ai < 2; ++ai)
#pragma unroll
            for (int m = 0; m < 4; ++m) { const int r = row0 + ai * HALF + m * 16; const float* gp = gate + (size_t)(r >> 11) * 6144;
#pragma unroll
                for (int bj = 0; bj < 2; ++bj) { const int c = col0 + bj * HALF;
                    const f32x4 xa = *(const f32x4*)(x + (size_t)r * 1024 + c), xb = *(const f32x4*)(x + (size_t)r * 1024 + c + 4);
                    const f32x4 ga = *(const f32x4*)(gp + c), gb = *(const f32x4*)(gp + c + 4);
                    *(f32x4*)(out + (size_t)r * 1024 + c) = xa + ga * acc[ai][bj][m][0];
                    *(f32x4*)(out + (size_t)r * 1024 + c + 4) = xb + gb * acc[ai][bj][m][1]; } }
    }
};
struct EpiResidNorm {
    static constexpr bool PERM = true, AFTER_DRAIN = false;
    const float* x; const float* mod; const float* ng; float* out; bf16_t* a3; float* rs;
    __device__ __forceinline__ void operator()(const f32x4 (&acc)[2][2][4][2], const Unit& u, int wr, int wc, int fr, int fq) const {
        const int row0 = u.pm * BM + wr * 64 + fr, col0 = u.pn * BM + wc * 32 + 8 * fq;
        const float* mp = mod + (size_t)((u.pm * BM) >> 11) * 6144;
        f32x4 g1v[2][2], csv[2][2];
#pragma unroll
        for (int bj = 0; bj < 2; ++bj)
#pragma unroll
            for (int n = 0; n < 2; ++n) { const int c = col0 + bj * HALF + 4 * n; g1v[bj][n] = *(const f32x4*)(mp + 2048 + c); csv[bj][n] = *(const f32x4*)(ng + c) * (*(const f32x4*)(mp + 4096 + c) + 1.0f); }
#pragma unroll
        for (int ai = 0; ai < 2; ++ai)
#pragma unroll
            for (int m = 0; m < 4; ++m) { const int r = row0 + ai * HALF + m * 16; float ss = 0.f;
#pragma unroll
                for (int bj = 0; bj < 2; ++bj) { const int c = col0 + bj * HALF;
                    const f32x4 xa = *(const f32x4*)(x + (size_t)r * 1024 + c), xb = *(const f32x4*)(x + (size_t)r * 1024 + c + 4);
                    const f32x4 v0 = xa + g1v[bj][0] * acc[ai][bj][m][0], v1 = xb + g1v[bj][1] * acc[ai][bj][m][1];
                    *(f32x4*)(out + (size_t)r * 1024 + c) = v0; *(f32x4*)(out + (size_t)r * 1024 + c + 4) = v1;
                    ss += (v0[0] * v0[0] + v0[1] * v0[1]) + (v0[2] * v0[2] + v0[3] * v0[3]) + (v1[0] * v1[0] + v1[1] * v1[1]) + (v1[2] * v1[2] + v1[3] * v1[3]);
                    const f32x4 a0 = v0 * csv[bj][0], a1 = v1 * csv[bj][1];
                    u32x4 w; w.x = cvt_pk_bf16(a0[0], a0[1]); w.y = cvt_pk_bf16(a0[2], a0[3]); w.z = cvt_pk_bf16(a1[0], a1[1]); w.w = cvt_pk_bf16(a1[2], a1[3]);
                    *(u32x4*)(a3 + (size_t)r * 1024 + c) = w; }
                ss += __shfl_xor(ss, 16); ss += __shfl_xor(ss, 32);
                if (fq == 0) rs[(size_t)r * 16 + (u.pn & 3) * 4 + wc] = ss; }
    }
};
struct EpiScoreF16 {
    static constexpr bool PERM = true, AFTER_DRAIN = false;
    bf16_t* O; int ldc; const float* rs; const float* sb;
    static __device__ __forceinline__ unsigned pkh(float a, float b) { return (unsigned)__builtin_bit_cast(unsigned short, (_Float16)a) | ((unsigned)__builtin_bit_cast(unsigned short, (_Float16)b) << 16); }
    __device__ __forceinline__ void operator()(const f32x4 (&acc)[2][2][4][2], const Unit& u, int wr, int wc, int fr, int fq) const {
        const int row0 = u.pm * BM + wr * 64 + fr, col0 = u.pn * BM + wc * 32 + 8 * fq;
        const float* sbp = sb + (size_t)((u.pm * BM) >> 11) * 2048;
        f32x4 bv[2][2];
#pragma unroll
        for (int bj = 0; bj < 2; ++bj)
#pragma unroll
            for (int n = 0; n < 2; ++n) bv[bj][n] = *(const f32x4*)(sbp + col0 + bj * HALF + 4 * n);
#pragma unroll
        for (int ai = 0; ai < 2; ++ai)
#pragma unroll
            for (int m = 0; m < 4; ++m) { const int r = row0 + ai * HALF + m * 16;
                float rstd; { const f32x4 p0 = *(const f32x4*)(rs + (size_t)r * 16), p1 = *(const f32x4*)(rs + (size_t)r * 16 + 4), p2 = *(const f32x4*)(rs + (size_t)r * 16 + 8), p3 = *(const f32x4*)(rs + (size_t)r * 16 + 12);
                  const f32x4 ps = (p0 + p1) + (p2 + p3); rstd = rsqrtf(((ps[0] + ps[1]) + (ps[2] + ps[3])) * (1.f / 1024.f) + 1e-6f); }
                bf16_t* rowp = O + (size_t)r * ldc + col0;
#pragma unroll
                for (int bj = 0; bj < 2; ++bj) { const f32x4 v0 = acc[ai][bj][m][0] * rstd + bv[bj][0], v1 = acc[ai][bj][m][1] * rstd + bv[bj][1];
                    u32x4 w; w.x = pkh(v0[0], v0[1]); w.y = pkh(v0[2], v0[3]); w.z = pkh(v1[0], v1[1]); w.w = pkh(v1[2], v1[3]);
                    *(u32x4*)(rowp + bj * HALF) = w; } }
    }
};
template <class Epi, class Sched, bool ALIGN_EPI = false, bool SP2 = false>
__device__ __forceinline__ void gemm_phase(PG8_LAS unsigned char* lds, const Gemm g, const Sched& S, const Epi& E) {
    int tid_o = threadIdx.x; asm volatile("" : "+v"(tid_o)); const int tid = tid_o, wid = __builtin_amdgcn_readfirstlane(tid >> 6), lane = tid & 63, wr = wid >> 2, wc = wid & 3, fr = lane & 15, fq = lane >> 4;
    const int K = g.K, nt = K / BK;
    unsigned voffA[2], voffB[2];
#pragma unroll
    for (int i = 0; i < 2; ++i) { int R, C; stage_rc(tid * 16 + i * 8192, R, C); const int Rb = Epi::PERM ? ((R & ~31) + perm32(R & 31)) : R;
        voffA[i] = (unsigned)(R * K + C) * 2u; voffB[i] = (unsigned)(Rb * K + C) * 2u; }
    const size_t kstep = (size_t)(BK * 2);
    const size_t hstep = (size_t)HALF * K * 2;
    const size_t tstep = 2 * hstep;
    const unsigned ldsw = (unsigned)wid * 1024u;
    const int aoff = lds_byte(wr * 64 + fr, fq * 8), boff = lds_byte(wc * 32 + fr, fq * 8);
#define PG8_SA(b, h) (((b) * 2 + (h)) * HTB)
#define PG8_SB(b, h) ((4 + (b) * 2 + (h)) * HTB)
#define PG8_STAGE(bufoff, gbase, voff) do { _Pragma("unroll") for (int _i = 0; _i < 2; ++_i) \
        __builtin_amdgcn_global_load_lds((const unsigned*)((const char*)(gbase) + (voff)[_i]), (PG8_LAS unsigned*)(lds + (bufoff) + ldsw + _i * 8192), 16, 0, 0); } while (0)
#define PG8_LDA(dst, b, h) do { _Pragma("unroll") for (int m = 0; m < 4; ++m) _Pragma("unroll") for (int k = 0; k < 2; ++k) dst[m][k] = *(const PG8_LAS bf16x8*)(lds + PG8_SA(b, h) + aoff + m * 2048 + k * 1024); } while (0)
#define PG8_LDB(dst, b, h) do { _Pragma("unroll") for (int n = 0; n < 2; ++n) _Pragma("unroll") for (int k = 0; k < 2; ++k) dst[n][k] = *(const PG8_LAS bf16x8*)(lds + PG8_SB(b, h) + boff + n * 2048 + k * 1024); } while (0)
#define PG8_MMA(ai, bj, At, Bt) do { __builtin_amdgcn_s_setprio(1); _Pragma("unroll") for (int m = 0; m < 4; ++m) _Pragma("unroll") for (int n = 0; n < 2; ++n) _Pragma("unroll") for (int k = 0; k < 2; ++k) \
        acc[ai][bj][m][n] = __builtin_amdgcn_mfma_f32_16x16x32_bf16(Bt[n][k], At[m][k], acc[ai][bj][m][n], 0, 0, 0); __builtin_amdgcn_s_setprio(0); } while (0)
#define PG8_WAIT_V(n) asm volatile("s_waitcnt vmcnt(" #n ")" ::: "memory")
#define PG8_WAIT_L(n) asm volatile("s_waitcnt lgkmcnt(" #n ")" ::: "memory")
#define PG8_BAR __builtin_amdgcn_s_barrier()
#define PG8_SCHED __builtin_amdgcn_sched_barrier(0)
    Unit cur, nxt; int ui = 0;
    if (!S.next(0, cur)) return;
    f32x4 acc[2][2][4][2];
#pragma unroll
    for (int a = 0; a < 2; ++a)
#pragma unroll
        for (int b = 0; b < 2; ++b)
#pragma unroll
            for (int m = 0; m < 4; ++m)
#pragma unroll
                for (int n = 0; n < 2; ++n) acc[a][b][m][n] = (f32x4){0.f, 0.f, 0.f, 0.f};
    bf16x8 At[4][2], B0[2][2], B1[2][2];
    const char* cA = (const char*)g.A + (size_t)cur.pm * tstep; const char* cB = (const char*)g.Bt + (size_t)cur.pn * tstep;
    S.a_ready(cur);
    if constexpr (SP2) {
        PG8_STAGE(PG8_SB(0, 0), cB, voffB); PG8_STAGE(PG8_SB(0, 1), cB + hstep, voffB); PG8_STAGE(PG8_SA(0, 0), cA, voffA); PG8_STAGE(PG8_SA(0, 1), cA + hstep, voffA);
        if (wr == 1) PG8_BAR;
        PG8_WAIT_V(2); PG8_BAR;
        PG8_STAGE(PG8_SB(1, 0), cB + kstep, voffB); PG8_STAGE(PG8_SA(1, 0), cA + kstep, voffA); PG8_STAGE(PG8_SB(1, 1), cB + hstep + kstep, voffB);
        PG8_WAIT_V(6); PG8_BAR;
    } else {
        PG8_STAGE(PG8_SB(0, 0), cB, voffB); PG8_STAGE(PG8_SA(0, 0), cA, voffA); PG8_STAGE(PG8_SB(0, 1), cB + hstep, voffB); PG8_STAGE(PG8_SA(0, 1), cA + hstep, voffA);
        if (wr == 1) PG8_BAR;
        PG8_WAIT_V(4); PG8_BAR;
        PG8_STAGE(PG8_SB(1, 0), cB + kstep, voffB); PG8_STAGE(PG8_SA(1, 0), cA + kstep, voffA); PG8_STAGE(PG8_SB(1, 1), cB + hstep + kstep, voffB);
        PG8_WAIT_V(6); PG8_BAR;
    }
    for (;;) {
        const bool has_next = S.next(ui + 1, nxt);
        const char* nA = has_next ? (const char*)g.A + (size_t)nxt.pm * tstep : cA; const char* nB = has_next ? (const char*)g.Bt + (size_t)nxt.pn * tstep : cB;
        for (int t = 0; t < nt; t += 2) {
            const bool last = (t == nt - 2);
            const char* a1 = cA + (size_t)(t + 1) * kstep;
            const char* a2 = last ? nA : cA + (size_t)(t + 2) * kstep; const char* b2 = last ? nB : cB + (size_t)(t + 2) * kstep;
            const char* a3 = a2 + kstep; const char* b3 = b2 + kstep;
            if (last && has_next) S.a_ready(nxt);
            if constexpr (SP2) {
            PG8_LDB(B0, 0, 0); PG8_LDB(B1, 0, 1); PG8_SCHED; PG8_LDA(At, 0, 0); PG8_STAGE(PG8_SA(1, 1), a1 + hstep, voffA);
            PG8_WAIT_V(8); PG8_WAIT_L(0); PG8_BAR; PG8_MMA(0, 0, At, B0); PG8_MMA(0, 1, At, B1); PG8_BAR; PG8_SCHED;
            PG8_LDA(At, 0, 1); PG8_STAGE(PG8_SB(0, 0), b2, voffB); PG8_STAGE(PG8_SB(0, 1), b2 + hstep, voffB); PG8_STAGE(PG8_SA(0, 0), a2, voffA);
            PG8_WAIT_V(8); PG8_WAIT_L(0); PG8_BAR; PG8_MMA(1, 0, At, B0); PG8_MMA(1, 1, At, B1); PG8_BAR; PG8_SCHED;
            PG8_LDB(B0, 1, 0); PG8_LDB(B1, 1, 1); PG8_SCHED; PG8_LDA(At, 1, 0); PG8_STAGE(PG8_SA(0, 1), a2 + hstep, voffA);
            PG8_WAIT_V(8); PG8_WAIT_L(0); PG8_BAR; PG8_MMA(0, 0, At, B0); PG8_MMA(0, 1, At, B1); PG8_BAR; PG8_SCHED;
            PG8_LDA(At, 1, 1); PG8_STAGE(PG8_SB(1, 0), b3, voffB); PG8_STAGE(PG8_SB(1, 1), b3 + hstep, voffB); PG8_STAGE(PG8_SA(1, 0), a3, voffA);
            PG8_WAIT_V(8); PG8_WAIT_L(0); PG8_BAR; PG8_MMA(1, 0, At, B0); PG8_MMA(1, 1, At, B1); PG8_BAR; PG8_SCHED;
            } else {
            PG8_LDB(B0, 0, 0); PG8_SCHED; PG8_LDA(At, 0, 0); PG8_STAGE(PG8_SA(1, 1), a1 + hstep, voffA);
            PG8_WAIT_L(8); PG8_BAR; PG8_WAIT_L(0); PG8_MMA(0, 0, At, B0); PG8_BAR; PG8_SCHED;
            PG8_LDB(B1, 0, 1); PG8_STAGE(PG8_SB(0, 0), b2, voffB);
            PG8_BAR; PG8_WAIT_L(0); PG8_MMA(0, 1, At, B1); PG8_BAR;
            PG8_LDA(At, 0, 1); PG8_STAGE(PG8_SA(0, 0), a2, voffA);
            PG8_BAR; PG8_WAIT_L(0); PG8_MMA(1, 0, At, B0); PG8_BAR; PG8_SCHED;
            PG8_STAGE(PG8_SB(0, 1), b2 + hstep, voffB);
            PG8_WAIT_V(6); PG8_BAR; PG8_MMA(1, 1, At, B1); PG8_BAR;
            PG8_LDB(B0, 1, 0); PG8_SCHED; PG8_LDA(At, 1, 0); PG8_STAGE(PG8_SA(0, 1), a2 + hstep, voffA);
            PG8_WAIT_L(8); PG8_BAR; PG8_WAIT_L(0); PG8_MMA(0, 0, At, B0); PG8_BAR; PG8_SCHED;
            PG8_LDB(B1, 1, 1); PG8_STAGE(PG8_SB(1, 0), b3, voffB);
            PG8_BAR; PG8_WAIT_L(0); PG8_MMA(0, 1, At, B1); PG8_BAR;
            PG8_LDA(At, 1, 1); PG8_STAGE(PG8_SA(1, 0), a3, voffA);
            PG8_BAR; PG8_WAIT_L(0); PG8_MMA(1, 0, At, B0); PG8_BAR; PG8_SCHED;
            PG8_STAGE(PG8_SB(1, 1), b3 + hstep, voffB);
            PG8_WAIT_V(6); PG8_BAR; PG8_MMA(1, 1, At, B1); PG8_BAR;
            }
        }
        if constexpr (ALIGN_EPI) { if (wr == 0) PG8_BAR; }
        if constexpr (!Epi::AFTER_DRAIN) { E(acc, cur, wr, wc, fr, fq); S.done(cur); }
        if (!has_next) break;
#pragma unroll
        for (int a = 0; a < 2; ++a)
#pragma unroll
            for (int b = 0; b < 2; ++b)
#pragma unroll
                for (int m = 0; m < 4; ++m)
#pragma unroll
                    for (int n = 0; n < 2; ++n) acc[a][b][m][n] = (f32x4){0.f, 0.f, 0.f, 0.f};
        cur = nxt; cA = nA; cB = nB; ++ui;
        if constexpr (ALIGN_EPI) { if (wr == 1) PG8_BAR; }
    }
    PG8_WAIT_V(0);
    if constexpr (!ALIGN_EPI) { if (wr == 0) PG8_BAR; }
    PG8_BAR;
    if constexpr (Epi::AFTER_DRAIN) { E.fused(acc, cur, wr, wc, fr, fq, lds, wid, lane); S.done(cur); }
#undef PG8_SA
#undef PG8_SB
#undef PG8_STAGE
#undef PG8_LDA
#undef PG8_LDB
#undef PG8_MMA
#undef PG8_WAIT_V
#undef PG8_WAIT_L
#undef PG8_BAR
#undef PG8_SCHED
}
}


#define LAS __attribute__((address_space(3)))
typedef unsigned short bf16_t;
typedef short bf16x8 __attribute__((ext_vector_type(8)));
typedef short s16x4 __attribute__((ext_vector_type(4)));
typedef short v4i16_t __attribute__((ext_vector_type(4)));
typedef float f32x4 __attribute__((ext_vector_type(4)));
typedef unsigned u32x4 __attribute__((ext_vector_type(4)));
typedef unsigned u32x2 __attribute__((ext_vector_type(2)));
typedef float f32x2 __attribute__((ext_vector_type(2)));

constexpr int T = 16384, DM = 1024, SEQ = 2048, NP = 3584;
constexpr size_t MiB = 1u << 20;
constexpr size_t WS_CTL = 0, WS_MOD = 4096, WS_GATES = 262144, WS_KEYS = 1 * MiB, WS_WIN = 2 * MiB, WS_WOUT = 9 * MiB, WS_WQ = 11 * MiB,
                 WS_T8 = 16 * MiB, WS_SC = 48 * MiB, WS_ACT = 80 * MiB, WS_P = 112 * MiB, WS_QRY = 112 * MiB, WS_END = 256 * MiB;
constexpr size_t WS_RS = 208 * MiB, WS_SB = 851968, WS_WGT = 917504, WS_A3 = 176 * MiB;
constexpr int LDS_BYTES = 147456;

__device__ __forceinline__ unsigned f2bf(float f) { unsigned u = __float_as_uint(f); return (u + 0x7fffu + ((u >> 16) & 1u)) >> 16; }
typedef __bf16 bf16x2_t __attribute__((ext_vector_type(2)));
__device__ __forceinline__ unsigned pk2(float lo, float hi) { const f32x2 v = {lo, hi}; const bf16x2_t b = __builtin_convertvector(v, bf16x2_t); return __builtin_bit_cast(unsigned, b); }
__device__ __forceinline__ float bflo(unsigned u) { return __uint_as_float(u << 16); }
__device__ __forceinline__ float bfhi(unsigned u) { return __uint_as_float(u & 0xffff0000u); }
__device__ __forceinline__ float wave_sum(float v) {
    { const auto r = __builtin_amdgcn_permlane32_swap(__float_as_uint(v), __float_as_uint(v), false, false); v = __uint_as_float(r[0]) + __uint_as_float(r[1]); }
    { const auto r = __builtin_amdgcn_permlane16_swap(__float_as_uint(v), __float_as_uint(v), false, false); v = __uint_as_float(r[0]) + __uint_as_float(r[1]); }
    v += __int_as_float(__builtin_amdgcn_mov_dpp(__float_as_int(v), 0xB1, 0xF, 0xF, true));
    v += __int_as_float(__builtin_amdgcn_mov_dpp(__float_as_int(v), 0x4E, 0xF, 0xF, true));
    v += __int_as_float(__builtin_amdgcn_mov_dpp(__float_as_int(v), 0x141, 0xF, 0xF, true));
    v += __int_as_float(__builtin_amdgcn_mov_dpp(__float_as_int(v), 0x140, 0xF, 0xF, true));
    return v;
}
__device__ __forceinline__ float xrow_max(float v) {
    { const auto r = __builtin_amdgcn_permlane16_swap(__float_as_uint(v), __float_as_uint(v), false, false); v = fmaxf(__uint_as_float(r[0]), __uint_as_float(r[1])); }
    { const auto r = __builtin_amdgcn_permlane32_swap(__float_as_uint(v), __float_as_uint(v), false, false); v = fmaxf(__uint_as_float(r[0]), __uint_as_float(r[1])); }
    return v;
}
__device__ __forceinline__ float xrow_sum(float v) {
    { const auto r = __builtin_amdgcn_permlane16_swap(__float_as_uint(v), __float_as_uint(v), false, false); v = __uint_as_float(r[0]) + __uint_as_float(r[1]); }
    { const auto r = __builtin_amdgcn_permlane32_swap(__float_as_uint(v), __float_as_uint(v), false, false); v = __uint_as_float(r[0]) + __uint_as_float(r[1]); }
    return v;
}
#define LDS_WAIT() asm volatile("s_waitcnt lgkmcnt(0)" ::: "memory")
__device__ __forceinline__ s16x4 vtr(LAS unsigned char* p) { return __builtin_bit_cast(s16x4, __builtin_amdgcn_ds_read_tr16_b64_v4i16((LAS v4i16_t*)p)); }
__device__ __forceinline__ bf16x8 cat8(s16x4 a, s16x4 b) { bf16x8 r; r[0] = a[0]; r[1] = a[1]; r[2] = a[2]; r[3] = a[3]; r[4] = b[0]; r[5] = b[1]; r[6] = b[2]; r[7] = b[3]; return r; }
__device__ __forceinline__ bf16x8 pack8(const f32x4 a, const f32x4 b) { u32x4 w; w.x = pk2(a[0], a[1]); w.y = pk2(a[2], a[3]); w.z = pk2(b[0], b[1]); w.w = pk2(b[2], b[3]); return __builtin_bit_cast(bf16x8, w); }
#define MFMA16(a, b, c) __builtin_amdgcn_mfma_f32_16x16x32_bf16((a), (b), (c), 0, 0, 0)

struct Args {
    const float *x, *c, *ada_w, *ada_b, *norm1_g, *w_in, *conv_w, *conv_b, *gate_b, *mnorm_g, *lq1, *lk1, *lq2, *lk2, *dnorm_g, *w_out, *norm2_g, *wq, *keys, *pu, *pv, *final_g;
    float* out; unsigned char* ws;
};

__device__ __forceinline__ void transpose_item(const float* W, int srcN, int soff, bf16_t* WT, LAS float* scr, int kb, int nb, int lane) {
    const int k0 = 64 * kb, n0 = 32 * nb;
    { f32x4 wv[8];
#pragma unroll
      for (int i = 0; i < 8; ++i) wv[i] = *(const f32x4*)(W + (size_t)(k0 + 8 * i + (lane >> 3)) * srcN + n0 + soff + 4 * (lane & 7));
#pragma unroll
      for (int i = 0; i < 8; ++i) { LAS float* d = scr + (8 * i + (lane >> 3)) * 33 + 4 * (lane & 7); d[0] = wv[i][0]; d[1] = wv[i][1]; d[2] = wv[i][2]; d[3] = wv[i][3]; } }
    LDS_WAIT(); asm volatile("" ::: "memory");
    const int c = lane & 7;
#pragma unroll
    for (int j = 0; j < 4; ++j) { const int n = (lane >> 3) + 8 * j; const LAS float* s = scr + (8 * c) * 33 + n;
        u32x4 o; o.x = pk2(s[0 * 33], s[1 * 33]); o.y = pk2(s[2 * 33], s[3 * 33]); o.z = pk2(s[4 * 33], s[5 * 33]); o.w = pk2(s[6 * 33], s[7 * 33]);
        *(u32x4*)(WT + (size_t)(n0 + n) * 1024 + k0 + 8 * c) = o; }
    LDS_WAIT(); asm volatile("" ::: "memory");
}

__device__ __forceinline__ bf16x8 pack8_sw(const f32x4 a, const f32x4 b) {
    u32x4 w; w.x = f2bf(a[0]) | (f2bf(a[1]) << 16); w.y = f2bf(a[2]) | (f2bf(a[3]) << 16); w.z = f2bf(b[0]) | (f2bf(b[1]) << 16); w.w = f2bf(b[2]) | (f2bf(b[3]) << 16); return __builtin_bit_cast(bf16x8, w); }
__device__ __forceinline__ void wprime_item(const Args& A, int hp, int kt, int lane) {
    const int g = lane >> 4, l15 = lane & 15;
    f32x4 acc[8];
#pragma unroll
    for (int nt = 0; nt < 8; ++nt) acc[nt] = (f32x4){0.f, 0.f, 0.f, 0.f};
#pragma unroll
    for (int ks = 0; ks < 4; ++ks) {
        const float* ap = A.wq + (size_t)(16 * kt + l15) * 2048 + hp * 128 + 32 * ks + 8 * g;
        const bf16x8 a = pack8(*(const f32x4*)ap, *(const f32x4*)(ap + 4));
#pragma unroll
        for (int nt = 0; nt < 8; ++nt) { const float* bp = A.keys + (size_t)(hp * 128 + 16 * nt + l15) * 128 + 32 * ks + 8 * g;
            const bf16x8 b = pack8(*(const f32x4*)bp, *(const f32x4*)(bp + 4)); acc[nt] = MFMA16(a, b, acc[nt]); }
    }
    bf16_t* WT = (bf16_t*)(A.ws + WS_WQ);
#pragma unroll
    for (int nt = 0; nt < 8; ++nt) { u32x2 o; o.x = pk2(acc[nt][0], acc[nt][1]); o.y = pk2(acc[nt][2], acc[nt][3]);
        *(u32x2*)(WT + (size_t)(hp * 128 + 16 * nt + l15) * 1024 + 16 * kt + 4 * g) = o; }
}

__device__ __forceinline__ void phase0(const Args& A, LAS unsigned char* lds) {
    int tid_o = threadIdx.x; asm volatile("" : "+v"(tid_o)); const int tid = tid_o, lane = tid & 63, wave = tid >> 6, G = gridDim.x;
    float* MOD = (float*)(A.ws + WS_MOD);
    if ((int)blockIdx.x < 192) {
        LAS float* sc = (LAS float*)lds;
        for (int i = tid; i < 8192; i += 512) { const float v = A.c[i]; sc[i] = v * __builtin_amdgcn_rcpf(1.f + __expf(-v)); }
        __syncthreads();
        for (int item = blockIdx.x; item < 192; item += G) {
            const int j0 = item * 32, kg = tid >> 3, cq = tid & 7;
            f32x4 wv[16];
#pragma unroll
            for (int kk = 0; kk < 16; ++kk) wv[kk] = *(const f32x4*)(A.ada_w + (size_t)(kg * 16 + kk) * 6144 + j0 + 4 * cq);
            f32x4 acc[8];
#pragma unroll
            for (int b = 0; b < 8; ++b) acc[b] = (f32x4){0.f, 0.f, 0.f, 0.f};
#pragma unroll
            for (int b = 0; b < 8; ++b)
#pragma unroll
                for (int k4 = 0; k4 < 4; ++k4) { const f32x4 s4 = *(const LAS f32x4*)(sc + b * 1024 + kg * 16 + 4 * k4);
                    acc[b] += wv[4 * k4] * s4[0]; acc[b] += wv[4 * k4 + 1] * s4[1]; acc[b] += wv[4 * k4 + 2] * s4[2]; acc[b] += wv[4 * k4 + 3] * s4[3]; }
            LAS float* part = (LAS float*)(lds + 32768);
#pragma unroll
            for (int b = 0; b < 8; ++b) *(LAS f32x4*)(part + (kg * 8 + b) * 32 + 4 * cq) = acc[b];
            __syncthreads();
            if (tid < 256) { const int b = tid >> 5, col = tid & 31; float s = A.ada_b[j0 + col];
              for (int k2 = 0; k2 < 64; ++k2) s += part[(k2 * 8 + b) * 32 + col];
              MOD[b * 6144 + j0 + col] = s; }
            __syncthreads();
        }
    }
    for (int i = (G - 1 - (int)blockIdx.x) * 512 + tid; i < 8192; i += G * 512) { const int gc = i >> 10, k = i & 1023; ((float*)(A.ws + WS_WGT))[i] = A.w_in[(size_t)k * 3592 + 2048 + gc]; }
    if (blockIdx.x == 0 && tid == 0) {
        float s1 = 0.f, s2 = 0.f;
        for (int i = 0; i < 64; ++i) { s1 += A.lq1[i] * A.lk1[i]; s2 += A.lq2[i] * A.lk2[i]; }
        ((float*)(A.ws + WS_CTL))[1] = expf(s1) - expf(s2) + 0.2f;
        ((unsigned*)(A.ws + WS_CTL))[0] = 0u; ((unsigned*)(A.ws + WS_CTL))[2] = 0u;
    }
}

__device__ __forceinline__ void phase0b(const Args& A, LAS unsigned char* lds) {
    int tid_o = threadIdx.x; asm volatile("" : "+v"(tid_o)); const int tid = tid_o, lane = tid & 63, wave = tid >> 6, G = gridDim.x;
    __syncthreads();
    {
        LAS float* scr = (LAS float*)(lds + wave * 16384);
        const int gw = blockIdx.x * 8 + wave, NGW = G * 8;
        for (int it = gw; it < 1792; it += NGW) { const int kb = it / 112, nb = it % 112; transpose_item(A.w_in, 3592, nb >= 64 ? 8 : 0, (bf16_t*)(A.ws + WS_WIN), scr, kb, nb, lane); }
    }
}

__device__ __forceinline__ void quantise_tables(const Args& A, int gw, int NGW, int row_lo, int row_hi) {
    int tid_o = threadIdx.x; asm volatile("" : "+v"(tid_o)); const int lane = tid_o & 63;
    unsigned char* T8 = A.ws + WS_T8; float* SC = (float*)(A.ws + WS_SC);
#pragma unroll 1
    for (int row = row_lo + gw; row < row_hi; row += 4 * NGW) {
        f32x4 v[4][4]; int rr[4];
#pragma unroll
        for (int q = 0; q < 4; ++q) { const int r = row + q * NGW; rr[q] = r; const int rc = r < row_hi ? r : row;
            const float* s = (rc < 16384 ? A.pu + (size_t)rc * 1024 : A.pv + (size_t)(rc - 16384) * 1024) + 16 * lane;
#pragma unroll
            for (int j = 0; j < 4; ++j) v[q][j] = *(const f32x4*)(s + 4 * j); }
#pragma unroll
        for (int q = 0; q < 4; ++q) {
            float mx = 0.f;
#pragma unroll
            for (int j = 0; j < 4; ++j)
#pragma unroll
                for (int e = 0; e < 4; ++e) mx = fmaxf(mx, fabsf(v[q][j][e]));
#pragma unroll
            for (int o = 1; o < 64; o <<= 1) mx = fmaxf(mx, __shfl_xor(mx, o));
            const float sc = fmaxf(mx, 1e-30f) * (1.f / 256.f), inv = 1.f / sc;
            u32x4 o4;
#pragma unroll
            for (int j = 0; j < 4; ++j) { int w0 = __builtin_amdgcn_cvt_pk_fp8_f32(v[q][j][0] * inv, v[q][j][1] * inv, 0, false); w0 = __builtin_amdgcn_cvt_pk_fp8_f32(v[q][j][2] * inv, v[q][j][3] * inv, w0, true); o4[j] = (unsigned)w0; }
            if (rr[q] < row_hi) { *(u32x4*)(T8 + (size_t)rr[q] * 1024 + 16 * lane) = o4; if (lane == 0) SC[rr[q]] = sc; }
        }
    }
}

__device__ __forceinline__ void phase1(const Args& A, LAS unsigned char* lds) {
    int tid_o = threadIdx.x; asm volatile("" : "+v"(tid_o)); const int tid = tid_o, lane = tid & 63, wave = tid >> 6, G = gridDim.x;
    const float* MOD = (const float*)(A.ws + WS_MOD);
    bf16_t* ACT = (bf16_t*)(A.ws + WS_ACT);
    float* GATES = (float*)(A.ws + WS_GATES);
    LAS float* WG = (LAS float*)lds;
    for (int i = tid; i < 8192; i += 512) WG[i] = ((const float*)(A.ws + WS_WGT))[i];
    __syncthreads();
    f32x4 vn[4];
    { const int m0 = (int)(blockIdx.x * 8 + wave) < T ? blockIdx.x * 8 + wave : 0; const f32x4* xr = (const f32x4*)(A.x + (size_t)m0 * 1024) + lane;
#pragma unroll
        for (int j = 0; j < 4; ++j) vn[j] = xr[64 * j]; }
    for (int m = blockIdx.x * 8 + wave; m < T; m += G * 8) {
        const int b = m >> 11;
        f32x4 v[4]; float ss = 0.f;
#pragma unroll
        for (int j = 0; j < 4; ++j) { v[j] = vn[j]; ss += (v[j][0] * v[j][0] + v[j][1] * v[j][1]) + (v[j][2] * v[j][2] + v[j][3] * v[j][3]); }
        { const int mn = (m + G * 8 < T) ? m + G * 8 : m; const f32x4* xr = (const f32x4*)(A.x + (size_t)mn * 1024) + lane;
#pragma unroll
            for (int j = 0; j < 4; ++j) vn[j] = xr[64 * j]; }
        f32x4 gg[4], scc[4], shh[4];
#pragma unroll
        for (int j = 0; j < 4; ++j) { const int col = 4 * lane + 256 * j; gg[j] = *(const f32x4*)(A.norm1_g + col); scc[j] = *(const f32x4*)(MOD + b * 6144 + 1024 + col); shh[j] = *(const f32x4*)(MOD + b * 6144 + col); }
        const float rstd = rsqrtf(wave_sum(ss) * (1.f / 1024.f) + 1e-6f);
        unsigned long long* o8 = (unsigned long long*)(ACT + (size_t)m * 1024) + lane;
#pragma unroll
        for (int j = 0; j < 4; ++j) { const f32x4 g = gg[j], sc = scc[j], sh = shh[j];
            v[j] = v[j] * rstd * g * (sc + 1.0f) + sh;
            o8[64 * j] = (unsigned long long)pk2(v[j][0], v[j][1]) | ((unsigned long long)pk2(v[j][2], v[j][3]) << 32); }
        float gd[8];
#pragma unroll
        for (int gc = 0; gc < 8; ++gc) { float d = 0.f;
#pragma unroll
            for (int j = 0; j < 4; ++j) { const f32x4 w = *(const LAS f32x4*)(WG + gc * 1024 + 256 * j + 4 * lane); d += (v[j][0] * w[0] + v[j][1] * w[1]) + (v[j][2] * w[2] + v[j][3] * w[3]); }
            gd[gc] = d; }
        {
            float a4[4];
#pragma unroll
            for (int i = 0; i < 4; ++i) { const auto r = __builtin_amdgcn_permlane32_swap(__float_as_uint(gd[i]), __float_as_uint(gd[i + 4]), false, false); a4[i] = __uint_as_float(r[0]) + __uint_as_float(r[1]); }
            float b2[2];
#pragma unroll
            for (int i = 0; i < 2; ++i) { const auto r = __builtin_amdgcn_permlane16_swap(__float_as_uint(a4[i]), __float_as_uint(a4[i + 2]), false, false); b2[i] = __uint_as_float(r[0]) + __uint_as_float(r[1]); }
#pragma unroll
            for (int i = 0; i < 2; ++i) { float s = b2[i];
                s += __int_as_float(__builtin_amdgcn_mov_dpp(__float_as_int(s), 0xB1, 0xF, 0xF, true));
                s += __int_as_float(__builtin_amdgcn_mov_dpp(__float_as_int(s), 0x4E, 0xF, 0xF, true));
                s += __int_as_float(__builtin_amdgcn_mov_dpp(__float_as_int(s), 0x141, 0xF, 0xF, true));
                s += __int_as_float(__builtin_amdgcn_mov_dpp(__float_as_int(s), 0x140, 0xF, 0xF, true)); b2[i] = s; }
            if ((lane & 15) == 0) { const int r2 = 2 * (lane >> 4); f32x2 o; o[0] = b2[0] + A.gate_b[r2]; o[1] = b2[1] + A.gate_b[r2 + 1]; *(f32x2*)(GATES + (size_t)m * 8 + r2) = o; }
        }
    }
}

constexpr int AK_STRIDE = 288  , AV_STRIDE = 288, AK_BYTES = 64 * AK_STRIDE, AV_BYTES = 64 * AV_STRIDE;
__device__ __forceinline__ void attn_item(const Args& A, LAS unsigned char* lds, int b, int h, int qb, float lam) {
    int tid_o = threadIdx.x; asm volatile("" : "+v"(tid_o)); const int tid = tid_o, lane = tid & 63, w = tid >> 6, g = lane >> 4, l15 = lane & 15;
    const bf16_t* P = (const bf16_t*)(A.ws + WS_P);
    bf16_t* ACT = (bf16_t*)(A.ws + WS_ACT);
    const int t0 = qb * 128, ntiles = 2 * (qb + 1);
    const size_t rowbase = (size_t)b * SEQ;
    bf16x8 qf[2][2];
    { const bf16_t* qp = P + (rowbase + t0 + 16 * w + l15) * NP + 2048 + h * 128 + 8 * g;
#pragma unroll
      for (int p = 0; p < 2; ++p)
#pragma unroll
          for (int ks = 0; ks < 2; ++ks) qf[p][ks] = *(const bf16x8*)(qp + p * 64 + ks * 32); }
    f32x4 o[2][8];
#pragma unroll
    for (int p = 0; p < 2; ++p)
#pragma unroll
        for (int vt = 0; vt < 8; ++vt) o[p][vt] = (f32x4){0.f, 0.f, 0.f, 0.f};
    float mrun[2] = {-1e30f, -1e30f}, lrun[2] = {0.f, 0.f};
    const int srow = tid >> 3, sseg = tid & 7;
    const bf16_t* kg = P + (rowbase + srow) * NP + 2560 + h * 128 + sseg * 16;
    const bf16_t* vg = P + (rowbase + srow) * NP + 3072 + h * 128 + sseg * 16;
    u32x4 kr0, kr1, vr0, vr1;
    kr0 = *(const u32x4*)(kg); kr1 = *(const u32x4*)(kg + 8); vr0 = *(const u32x4*)(vg); vr1 = *(const u32x4*)(vg + 8);
    { LAS unsigned char* kb = lds + srow * AK_STRIDE + sseg * 32; LAS unsigned char* vb = lds + 2 * AK_BYTES + srow * AV_STRIDE + sseg * 32;
      *(LAS u32x4*)kb = kr0; *(LAS u32x4*)(kb + 16) = kr1; *(LAS u32x4*)vb = vr0; *(LAS u32x4*)(vb + 16) = vr1; }
    __syncthreads();
    const float cs = 0.125f * 1.4426950408889634f;
    const int qabs = t0 + 16 * w + l15;
    for (int kt = 0; kt < ntiles; ++kt) {
        const int cur = kt & 1;
        if (kt + 1 < ntiles) { const size_t off = (size_t)(kt + 1) * 64 * NP;
            kr0 = *(const u32x4*)(kg + off); kr1 = *(const u32x4*)(kg + off + 8); vr0 = *(const u32x4*)(vg + off); vr1 = *(const u32x4*)(vg + off + 8); }
        if (64 * kt <= t0 + 16 * w + 15) {
            LAS unsigned char* Kb = lds + cur * AK_BYTES; LAS unsigned char* Vb = lds + 2 * AK_BYTES + cur * AV_BYTES;
            f32x4 s[2][4];
#pragma unroll
            for (int p = 0; p < 2; ++p)
#pragma unroll
                for (int k4 = 0; k4 < 4; ++k4) { f32x4 a = (f32x4){0.f, 0.f, 0.f, 0.f};
#pragma unroll
                    for (int ks = 0; ks < 2; ++ks) { const bf16x8 kf = *(const LAS bf16x8*)(Kb + (16 * k4 + l15) * AK_STRIDE + (p * 64 + ks * 32 + 8 * g) * 2); a = MFMA16(kf, qf[p][ks], a); }
                    s[p][k4] = a; }
            if (64 * kt + 63 > t0 + 16 * w) {
#pragma unroll
                for (int p = 0; p < 2; ++p)
#pragma unroll
                    for (int k4 = 0; k4 < 4; ++k4)
#pragma unroll
                        for (int r = 0; r < 4; ++r) { const int key = 64 * kt + 16 * k4 + 4 * g + r; if (key > qabs) s[p][k4][r] = -1e30f; }
            }
            bf16x8 pf[2][2];
#pragma unroll
            for (int p = 0; p < 2; ++p) {
                float mx = -1e30f;
#pragma unroll
                for (int k4 = 0; k4 < 4; ++k4)
#pragma unroll
                    for (int r = 0; r < 4; ++r) mx = fmaxf(mx, s[p][k4][r]);
                mx = xrow_max(mx);
                const float mnew = fmaxf(mrun[p], mx * cs), alpha = __builtin_amdgcn_exp2f(mrun[p] - mnew);
                mrun[p] = mnew;
                float ls = 0.f;
#pragma unroll
                for (int k4 = 0; k4 < 4; ++k4)
#pragma unroll
                    for (int r = 0; r < 4; ++r) { const float pv = __builtin_amdgcn_exp2f(s[p][k4][r] * cs - mnew); ls += pv; s[p][k4][r] = pv; }
                lrun[p] = lrun[p] * alpha + ls;
                if (__any(alpha != 1.f)) {
#pragma unroll
                    for (int vt = 0; vt < 8; ++vt) o[p][vt] = o[p][vt] * alpha; }
                pf[p][0] = pack8(s[p][0], s[p][1]); pf[p][1] = pack8(s[p][2], s[p][3]);
            }
#pragma unroll
            for (int ks2 = 0; ks2 < 2; ++ks2)
#pragma unroll
                for (int vt = 0; vt < 8; ++vt) {
                    LAS unsigned char* a0 = Vb + (32 * ks2 + 4 * g + (l15 >> 2)) * AV_STRIDE + (16 * vt + 4 * (lane & 3)) * 2;
                    const bf16x8 vf = cat8(vtr(a0), vtr(a0 + 16 * AV_STRIDE));
                    o[0][vt] = MFMA16(vf, pf[0][ks2], o[0][vt]);
                    o[1][vt] = MFMA16(vf, pf[1][ks2], o[1][vt]);
                }
        }
        if (kt + 1 < ntiles) { const int nx = cur ^ 1;
            LAS unsigned char* kb = lds + nx * AK_BYTES + srow * AK_STRIDE + sseg * 32; LAS unsigned char* vb = lds + 2 * AK_BYTES + nx * AV_BYTES + srow * AV_STRIDE + sseg * 32;
            *(LAS u32x4*)kb = kr0; *(LAS u32x4*)(kb + 16) = kr1; *(LAS u32x4*)vb = vr0; *(LAS u32x4*)(vb + 16) = vr1; }
        __syncthreads();
    }
    float inv[2];
#pragma unroll
    for (int p = 0; p < 2; ++p) { const float lt = xrow_sum(lrun[p]); inv[p] = 1.f / lt; }
    float ss = 0.f;
#pragma unroll
    for (int vt = 0; vt < 8; ++vt)
#pragma unroll
        for (int r = 0; r < 4; ++r) { const float ov = o[0][vt][r] * inv[0] - lam * (o[1][vt][r] * inv[1]); o[0][vt][r] = ov; ss += ov * ov; }
    ss = xrow_sum(ss);
    const float rstd = rsqrtf(ss * (1.f / 128.f) + 1e-6f) * 0.8f;
    bf16_t* op = ACT + (rowbase + qabs) * 1024 + 512 + h * 128 + 4 * g;
#pragma unroll
    for (int vt = 0; vt < 8; ++vt) { const f32x4 gn = *(const f32x4*)(A.dnorm_g + 16 * vt + 4 * g);
        u32x2 wv; wv.x = pk2(o[0][vt][0] * rstd * gn[0], o[0][vt][1] * rstd * gn[1]); wv.y = pk2(o[0][vt][2] * rstd * gn[2], o[0][vt][3] * rstd * gn[3]);
        *(u32x2*)(op + 16 * vt) = wv; }
}

constexpr int MQ_STRIDE = 272, MV_STRIDE = 288, MP_STRIDE = 144, MH_STRIDE = 132;
constexpr int ML_Q = 0, ML_K = 17408, ML_V = 34816, ML_P = 53248, ML_H = 62464, ML_CW = 96256, ML_SM = 101376;
constexpr int SM_E = 0, SM_G = 64, SM_B = 128, SM_W = 192, SM_I = 256, SM_R = 320, SM_N = 384, SM_NP = 512, SM_X = 1024;
constexpr size_t WS_CST = 224 * MiB, WS_NST = 15 * MiB, WS_MC = 15 * MiB + 512 * 1024, WS_BAR = 15 * MiB + 768 * 1024;

__device__ __forceinline__ void mlstm_state(const Args& A, LAS unsigned char* lds, int b, int h) {
    int tid_o = threadIdx.x; asm volatile("" : "+v"(tid_o)); const int tid = tid_o, lane = tid & 63, w = tid >> 6, g = lane >> 4, l15 = lane & 15;
    const bf16_t* P = (const bf16_t*)(A.ws + WS_P);
    const float* GATES = (const float*)(A.ws + WS_GATES);
    u32x4* CST = (u32x4*)(A.ws + WS_CST); float* NST = (float*)(A.ws + WS_NST); float* MCg = (float*)(A.ws + WS_MC);
    LAS float* sm = (LAS float*)(lds + ML_SM);
    LAS float* cw = (LAS float*)(lds + ML_CW);
    LAS unsigned char* Ks = lds + ML_K; LAS unsigned char* Vs = lds + ML_V;
    const size_t rowbase = (size_t)b * SEQ; const int bh = b * 4 + h;
    for (int i = tid; i < 640; i += 512) { const int j = i >> 7, ch = i & 127, cch = 512 + h * 128 + ch; cw[i] = (j < 4) ? A.conv_w[j * 1024 + cch] : A.conv_b[cch]; }
    if (tid < 128) sm[SM_N + tid] = 0.f;
    const int rg = tid >> 4, cs = tid & 15;
    const int ccol = 512 + h * 128 + 8 * cs;
    const int srow = tid >> 3, sseg = tid & 7;
    u32x4 cr[5], vr0, vr1; float gi = 0.f, gf = 0.f;
#define MS_PREFETCH(c) do { const int _r0 = (c) * 64 + 2 * rg - 3; \
        _Pragma("unroll") for (int _i = 0; _i < 5; ++_i) { const int _r = _r0 + _i; const u32x4 _v = *(const u32x4*)(P + (rowbase + (_r >= 0 ? _r : 0)) * NP + ccol); cr[_i] = (_r >= 0) ? _v : (u32x4){0u, 0u, 0u, 0u}; } \
        const bf16_t* _vp = P + (rowbase + (c) * 64 + srow) * NP + 1024 + h * 128 + sseg * 16; \
        vr0 = *(const u32x4*)(_vp); vr1 = *(const u32x4*)(_vp + 8); \
        } while (0)
    MS_PREFETCH(0);
    LAS float* Eall = (LAS float*)(lds + ML_Q);
#pragma unroll
    for (int cc = 0; cc < 4; ++cc) { const int c = w + 8 * cc;
        const float* gp = GATES + (rowbase + c * 64 + lane) * 8 + h; gi = gp[0]; { const float z = gp[4]; gf = fminf(z, 0.f) - log1pf(expf(-fabsf(z))); }
        float bc = gf;
#pragma unroll
        for (int o = 1; o < 64; o <<= 1) { const float t = __shfl_up(bc, o); if (lane >= o) bc += t; }
        const float e = gi - bc; float cm = e;
#pragma unroll
        for (int o = 1; o < 64; o <<= 1) { const float t = __shfl_up(cm, o); if (lane >= o) cm = fmaxf(cm, t); }
        Eall[c * 64 + lane] = e;
        if (lane == 63) { Eall[2048 + c] = bc; Eall[2048 + 32 + c] = cm; } }
    f32x4 C[8];
#pragma unroll
    for (int kt = 0; kt < 8; ++kt) C[kt] = (f32x4){0.f, 0.f, 0.f, 0.f};
    float mc = 0.f;
    __syncthreads();
    float wt[5][8];
#pragma unroll
    for (int j = 0; j < 5; ++j) { const f32x4 a = *(const LAS f32x4*)(cw + j * 128 + 8 * cs), bb = *(const LAS f32x4*)(cw + j * 128 + 8 * cs + 4);
        wt[j][0] = a[0]; wt[j][1] = a[1]; wt[j][2] = a[2]; wt[j][3] = a[3]; wt[j][4] = bb[0]; wt[j][5] = bb[1]; wt[j][6] = bb[2]; wt[j][7] = bb[3]; }
    for (int c = 0; c < 32; ++c) {
        {
            LAS unsigned char* dst = Ks + (2 * rg) * MQ_STRIDE + 16 * cs;
#pragma unroll
            for (int r = 0; r < 2; ++r) {
                float ov[8];
#pragma unroll
                for (int e = 0; e < 8; ++e) ov[e] = wt[4][e];
#pragma unroll
                for (int j = 0; j < 4; ++j) { const u32x4 x = cr[r + j];
                    ov[0] += wt[j][0] * bflo(x.x); ov[1] += wt[j][1] * bfhi(x.x); ov[2] += wt[j][2] * bflo(x.y); ov[3] += wt[j][3] * bfhi(x.y);
                    ov[4] += wt[j][4] * bflo(x.z); ov[5] += wt[j][5] * bfhi(x.z); ov[6] += wt[j][6] * bflo(x.w); ov[7] += wt[j][7] * bfhi(x.w); }
#pragma unroll
                for (int e = 0; e < 8; ++e) ov[e] = 0.08838834764831845f * ov[e] * __builtin_amdgcn_rcpf(1.f + __expf(-ov[e]));
                u32x4 o4; o4.x = pk2(ov[0], ov[1]); o4.y = pk2(ov[2], ov[3]); o4.z = pk2(ov[4], ov[5]); o4.w = pk2(ov[6], ov[7]);
                *(LAS u32x4*)(dst + r * MQ_STRIDE) = o4;
            }
            LAS unsigned char* vd = Vs + srow * MV_STRIDE + sseg * 32; *(LAS u32x4*)vd = vr0; *(LAS u32x4*)(vd + 16) = vr1;
            if (w == 0) {
                const float g63 = fmaxf(mc, Eall[2048 + 32 + c]);
                sm[SM_W + lane] = __expf(Eall[c * 64 + lane] - g63);
                if (lane == 63) { sm[SM_X] = __expf(mc - g63); sm[SM_X + 1] = Eall[2048 + c] + g63; }
            }
        }
        __syncthreads();
        { const int cn = (c + 1 < 32) ? c + 1 : 31; MS_PREFETCH(cn); }
        {
            const int item = bh * 32 + c;
#pragma unroll
            for (int k2 = 0; k2 < 4; ++k2) CST[((size_t)(item * 8 + w) * 4 + k2) * 64 + lane] = __builtin_bit_cast(u32x4, pack8(C[2 * k2], C[2 * k2 + 1]));
            if (tid < 128) NST[item * 128 + tid] = sm[SM_N + tid];
            if (tid == 0) MCg[item] = mc;
            LAS float* wS = sm + SM_W;
            const float decay = sm[SM_X];
            bf16x8 vfw[2];
#pragma unroll
            for (int ks = 0; ks < 2; ++ks) {
                LAS unsigned char* a0 = Vs + (32 * ks + 8 * g + (l15 >> 2)) * MV_STRIDE + (16 * w + 4 * (lane & 3)) * 2;
                const bf16x8 vf = cat8(vtr(a0), vtr(a0 + 4 * MV_STRIDE));
                const f32x4 w0 = *(const LAS f32x4*)(wS + 32 * ks + 8 * g), w1 = *(const LAS f32x4*)(wS + 32 * ks + 8 * g + 4);
                const u32x4 vu = __builtin_bit_cast(u32x4, vf);
                u32x4 o4; o4.x = pk2(bflo(vu.x) * w0[0], bfhi(vu.x) * w0[1]); o4.y = pk2(bflo(vu.y) * w0[2], bfhi(vu.y) * w0[3]);
                o4.z = pk2(bflo(vu.z) * w1[0], bfhi(vu.z) * w1[1]); o4.w = pk2(bflo(vu.w) * w1[2], bfhi(vu.w) * w1[3]);
                vfw[ks] = __builtin_bit_cast(bf16x8, o4);
            }
#pragma unroll
            for (int kt = 0; kt < 8; ++kt) C[kt] = C[kt] * decay;
#pragma unroll
            for (int ks = 0; ks < 2; ++ks)
#pragma unroll
                for (int kt = 0; kt < 8; ++kt) { LAS unsigned char* a0 = Ks + (32 * ks + 8 * g + (l15 >> 2)) * MQ_STRIDE + (16 * kt + 4 * (lane & 3)) * 2;
                    const bf16x8 ka = cat8(vtr(a0), vtr(a0 + 4 * MQ_STRIDE)); C[kt] = MFMA16(ka, vfw[ks], C[kt]); }
            { const int kd = tid & 127, sq = tid >> 7; float s = 0.f;
#pragma unroll
              for (int i = 0; i < 16; ++i) { const int s_ = 16 * sq + i; s += wS[s_] * __uint_as_float((unsigned)(*(const LAS bf16_t*)(Ks + s_ * MQ_STRIDE + kd * 2)) << 16); }
              sm[SM_NP + sq * 128 + kd] = s; }
            mc = sm[SM_X + 1];
            __syncthreads();
            if (tid < 128) sm[SM_N + tid] = decay * sm[SM_N + tid] + ((sm[SM_NP + tid] + sm[SM_NP + 128 + tid]) + (sm[SM_NP + 256 + tid] + sm[SM_NP + 384 + tid]));
        }
    }
#undef MS_PREFETCH
    __syncthreads();
}

__device__ __forceinline__ void mlstm_out(const Args& A, LAS unsigned char* lds, int item, int& last_h) {
    int tid_o = threadIdx.x; asm volatile("" : "+v"(tid_o)); const int tid = tid_o, lane = tid & 63, w = tid >> 6, g = lane >> 4, l15 = lane & 15;
    const int bh = item >> 5, c = item & 31, b = bh >> 2, h = bh & 3;
    const bf16_t* P = (const bf16_t*)(A.ws + WS_P);
    bf16_t* ACT = (bf16_t*)(A.ws + WS_ACT);
    const float* GATES = (const float*)(A.ws + WS_GATES);
    const u32x4* CST = (const u32x4*)(A.ws + WS_CST); const float* NST = (const float*)(A.ws + WS_NST); const float* MCg = (const float*)(A.ws + WS_MC);
    LAS float* sm = (LAS float*)(lds + ML_SM);
    LAS float* cw = (LAS float*)(lds + ML_CW);
    LAS unsigned char* Qs = lds + ML_Q; LAS unsigned char* Ks = lds + ML_K; LAS unsigned char* Vs = lds + ML_V; LAS unsigned char* Ps = lds + ML_P;
    LAS float* Hn = (LAS float*)(lds + ML_H);
    LAS float* eS = sm + SM_E; LAS float* gS = sm + SM_G; LAS float* bS = sm + SM_B; LAS float* iS = sm + SM_I; LAS float* nS = sm + SM_N;
    const size_t rowbase = (size_t)b * SEQ;
    const int rg = tid >> 5, cs = tid & 31;
    const int ccol = (cs < 16 ? 0 : 512) + h * 128 + 8 * (cs & 15);
    const int srow = tid >> 3, sseg = tid & 7;
    u32x4 cr[7], vr0, vr1, mc0, mc1, cfr[4]; float gi = 0.f, gf = 0.f, nval = 0.f;
    { const int r0 = c * 64 + 4 * rg - 3;
#pragma unroll
      for (int i = 0; i < 7; ++i) { const int r = r0 + i; const u32x4 v_ = *(const u32x4*)(P + (rowbase + (r >= 0 ? r : 0)) * NP + ccol); cr[i] = (r >= 0) ? v_ : (u32x4){0u, 0u, 0u, 0u}; }
      const bf16_t* vp = P + (rowbase + c * 64 + srow) * NP + h * 128 + sseg * 16;
      vr0 = *(const u32x4*)(vp + 1024); vr1 = *(const u32x4*)(vp + 1032); mc0 = *(const u32x4*)(vp + 1536); mc1 = *(const u32x4*)(vp + 1544);
      if (w == 0) { const float* gp = GATES + (rowbase + c * 64 + lane) * 8 + h; gi = gp[0]; const float z = gp[4]; gf = fminf(z, 0.f) - log1pf(expf(-fabsf(z))); }
#pragma unroll
      for (int k2 = 0; k2 < 4; ++k2) cfr[k2] = CST[((size_t)(item * 8 + w) * 4 + k2) * 64 + lane];
      if (tid < 128) nval = NST[item * 128 + tid]; }
    const float mc = MCg[item];
    if (h != last_h) {
        for (int i = tid; i < 1280; i += 512) { const int j = i >> 8, ch = i & 255, cch = (ch < 128 ? h * 128 + ch : 512 + h * 128 + ch - 128);
            cw[i] = (j < 4) ? A.conv_w[j * 1024 + cch] : A.conv_b[cch]; }
        last_h = h;
        __syncthreads();
    }
    {
        float wt[5][8];
#pragma unroll
        for (int j = 0; j < 5; ++j) { const f32x4 a = *(const LAS f32x4*)(cw + j * 256 + 8 * cs), bb = *(const LAS f32x4*)(cw + j * 256 + 8 * cs + 4);
            wt[j][0] = a[0]; wt[j][1] = a[1]; wt[j][2] = a[2]; wt[j][3] = a[3]; wt[j][4] = bb[0]; wt[j][5] = bb[1]; wt[j][6] = bb[2]; wt[j][7] = bb[3]; }
        const float osc = (cs < 16) ? 1.0f : 0.08838834764831845f;
        LAS unsigned char* dst = (cs < 16 ? Qs : Ks) + (4 * rg) * MQ_STRIDE + 16 * (cs & 15);
#pragma unroll
        for (int r = 0; r < 4; ++r) {
            float ov[8];
#pragma unroll
            for (int e = 0; e < 8; ++e) ov[e] = wt[4][e];
#pragma unroll
            for (int j = 0; j < 4; ++j) { const u32x4 x = cr[r + j];
                ov[0] += wt[j][0] * bflo(x.x); ov[1] += wt[j][1] * bfhi(x.x); ov[2] += wt[j][2] * bflo(x.y); ov[3] += wt[j][3] * bfhi(x.y);
                ov[4] += wt[j][4] * bflo(x.z); ov[5] += wt[j][5] * bfhi(x.z); ov[6] += wt[j][6] * bflo(x.w); ov[7] += wt[j][7] * bfhi(x.w); }
#pragma unroll
            for (int e = 0; e < 8; ++e) ov[e] = osc * ov[e] * __builtin_amdgcn_rcpf(1.f + __expf(-ov[e]));
            u32x4 o4; o4.x = pk2(ov[0], ov[1]); o4.y = pk2(ov[2], ov[3]); o4.z = pk2(ov[4], ov[5]); o4.w = pk2(ov[6], ov[7]);
            *(LAS u32x4*)(dst + r * MQ_STRIDE) = o4;
        }
        LAS unsigned char* vd = Vs + srow * MV_STRIDE + sseg * 32; *(LAS u32x4*)vd = vr0; *(LAS u32x4*)(vd + 16) = vr1;
        if (tid < 128) nS[tid] = nval;
        if (w == 0) {
            float bc = gf;
#pragma unroll
            for (int o = 1; o < 64; o <<= 1) { const float t = __shfl_up(bc, o); if (lane >= o) bc += t; }
            const float e = gi - bc; float cm = e;
#pragma unroll
            for (int o = 1; o < 64; o <<= 1) { const float t = __shfl_up(cm, o); if (lane >= o) cm = fmaxf(cm, t); }
            const float gt = fmaxf(mc, cm);
            eS[lane] = e; gS[lane] = gt; bS[lane] = bc; iS[lane] = __expf(mc - gt);
        }
    }
    __syncthreads();
    {
        const int st = w >> 1;
#pragma unroll
        for (int ti = 0; ti < 2; ++ti) { const int tt = 2 * (w & 1) + ti;
            f32x4 a = (f32x4){0.f, 0.f, 0.f, 0.f};
#pragma unroll
            for (int ks = 0; ks < 4; ++ks) { const bf16x8 kf = *(const LAS bf16x8*)(Ks + (16 * st + l15) * MQ_STRIDE + (32 * ks + 8 * g) * 2);
                const bf16x8 qf = *(const LAS bf16x8*)(Qs + (16 * tt + l15) * MQ_STRIDE + (32 * ks + 8 * g) * 2); a = MFMA16(kf, qf, a); }
            const int t = 16 * tt + l15; const float gt = gS[t];
            float pv[4];
#pragma unroll
            for (int r = 0; r < 4; ++r) { const int s_ = 16 * st + 4 * g + r; pv[r] = (s_ <= t) ? a[r] * __expf(eS[s_] - gt) : 0.f; }
            u32x2 pw; pw.x = pk2(pv[0], pv[1]); pw.y = pk2(pv[2], pv[3]);
            *(LAS u32x2*)(Ps + t * MP_STRIDE + (16 * st + 4 * g) * 2) = pw;
        }
    }
    __syncthreads();
    {
        f32x4 apv[4], aqc[4];
#pragma unroll
        for (int tt = 0; tt < 4; ++tt) { apv[tt] = (f32x4){0.f, 0.f, 0.f, 0.f}; aqc[tt] = (f32x4){0.f, 0.f, 0.f, 0.f}; }
#pragma unroll
        for (int ks = 0; ks < 2; ++ks) {
            LAS unsigned char* a0 = Vs + (32 * ks + 8 * g + (l15 >> 2)) * MV_STRIDE + (16 * w + 4 * (lane & 3)) * 2;
            const bf16x8 vf = cat8(vtr(a0), vtr(a0 + 4 * MV_STRIDE));
#pragma unroll
            for (int tt = 0; tt < 4; ++tt) { const bf16x8 pf = *(const LAS bf16x8*)(Ps + (16 * tt + l15) * MP_STRIDE + (32 * ks + 8 * g) * 2); apv[tt] = MFMA16(pf, vf, apv[tt]); }
        }
#pragma unroll
        for (int k2 = 0; k2 < 4; ++k2) {
            const bf16x8 cf = __builtin_bit_cast(bf16x8, cfr[k2]);
#pragma unroll
            for (int tt = 0; tt < 4; ++tt) { LAS unsigned char* qa = Qs + (16 * tt + l15) * MQ_STRIDE + (32 * k2 + 4 * g) * 2;
                const bf16x8 qf = cat8(*(const LAS s16x4*)qa, *(const LAS s16x4*)(qa + 32)); aqc[tt] = MFMA16(qf, cf, aqc[tt]); }
        }
#pragma unroll
        for (int tt = 0; tt < 4; ++tt)
#pragma unroll
            for (int r = 0; r < 4; ++r) { const int t = 16 * tt + 4 * g + r; Hn[t * MH_STRIDE + 16 * w + l15] = apv[tt][r] + iS[t] * aqc[tt][r]; }
        { const int t = srow, j = sseg;
          const u32x4 pr = *(const LAS u32x4*)(Ps + t * MP_STRIDE + 16 * j);
          float rs = (bflo(pr.x) + bfhi(pr.x)) + (bflo(pr.y) + bfhi(pr.y)) + (bflo(pr.z) + bfhi(pr.z)) + (bflo(pr.w) + bfhi(pr.w));
          const u32x4 q0 = *(const LAS u32x4*)(Qs + t * MQ_STRIDE + 32 * j), q1 = *(const LAS u32x4*)(Qs + t * MQ_STRIDE + 32 * j + 16);
          const f32x4 n0 = *(const LAS f32x4*)(nS + 16 * j), n1 = *(const LAS f32x4*)(nS + 16 * j + 4), n2 = *(const LAS f32x4*)(nS + 16 * j + 8), n3 = *(const LAS f32x4*)(nS + 16 * j + 12);
          float qn = bflo(q0.x) * n0[0] + bfhi(q0.x) * n0[1] + bflo(q0.y) * n0[2] + bfhi(q0.y) * n0[3] + bflo(q0.z) * n1[0] + bfhi(q0.z) * n1[1] + bflo(q0.w) * n1[2] + bfhi(q0.w) * n1[3]
                   + bflo(q1.x) * n2[0] + bfhi(q1.x) * n2[1] + bflo(q1.y) * n2[2] + bfhi(q1.y) * n2[3] + bflo(q1.z) * n3[0] + bfhi(q1.z) * n3[1] + bflo(q1.w) * n3[2] + bfhi(q1.w) * n3[3];
          float d = rs + iS[t] * qn;
          d += __int_as_float(__builtin_amdgcn_mov_dpp(__float_as_int(d), 0xB1, 0xF, 0xF, true)); d += __int_as_float(__builtin_amdgcn_mov_dpp(__float_as_int(d), 0x4E, 0xF, 0xF, true)); d += __int_as_float(__builtin_amdgcn_mov_dpp(__float_as_int(d), 0x141, 0xF, 0xF, true));
          if (j == 0) { const float fl = __expf(-(bS[t] + gS[t])); sm[SM_R + t] = 1.f / fmaxf(fabsf(d), fl); } }
    }
    __syncthreads();
    {
        const int t = srow, j = sseg; const float rd = sm[SM_R + t];
        float hv[16]; float ss = 0.f;
#pragma unroll
        for (int q = 0; q < 4; ++q) { const f32x4 x = *(const LAS f32x4*)(Hn + t * MH_STRIDE + 16 * j + 4 * q);
#pragma unroll
            for (int e = 0; e < 4; ++e) { const float v = x[e] * rd; hv[4 * q + e] = v; ss += v * v; } }
        ss += __int_as_float(__builtin_amdgcn_mov_dpp(__float_as_int(ss), 0xB1, 0xF, 0xF, true)); ss += __int_as_float(__builtin_amdgcn_mov_dpp(__float_as_int(ss), 0x4E, 0xF, 0xF, true)); ss += __int_as_float(__builtin_amdgcn_mov_dpp(__float_as_int(ss), 0x141, 0xF, 0xF, true));
        const float rstd = rsqrtf(ss * (1.f / 128.f) + 1e-6f);
        const unsigned mo[8] = {mc0.x, mc0.y, mc0.z, mc0.w, mc1.x, mc1.y, mc1.z, mc1.w};
        unsigned ow[8];
#pragma unroll
        for (int q = 0; q < 8; ++q) { const float g0 = A.mnorm_g[h * 128 + 16 * j + 2 * q], g1 = A.mnorm_g[h * 128 + 16 * j + 2 * q + 1];
            const float z0 = bflo(mo[q]), z1 = bfhi(mo[q]);
            ow[q] = pk2(hv[2 * q] * rstd * g0 * __builtin_amdgcn_rcpf(1.f + __expf(-z0)), hv[2 * q + 1] * rstd * g1 * __builtin_amdgcn_rcpf(1.f + __expf(-z1))); }
        bf16_t* op = ACT + (rowbase + c * 64 + t) * 1024 + h * 128 + 16 * j;
        *(u32x4*)op = (u32x4){ow[0], ow[1], ow[2], ow[3]}; *(u32x4*)(op + 8) = (u32x4){ow[4], ow[5], ow[6], ow[7]};
    }
}

__device__ __forceinline__ void phase3(const Args& A, LAS unsigned char* lds, int rep = 0) {
    const int tid = threadIdx.x;
    const float lam = ((const float*)(A.ws + WS_CTL))[1];
    unsigned* ctr = (unsigned*)(A.ws + WS_CTL) + 2 * rep;
    LAS int* slot = (LAS int*)(lds + LDS_BYTES - 64);
    const int nml = ((int)gridDim.x > 64) ? 32 : 1;
    if ((int)blockIdx.x < nml) for (int bh = blockIdx.x; bh < 32; bh += nml) mlstm_state(A, lds, bh >> 2, bh & 3);
    for (;;) {
        if (tid == 0) slot[0] = (int)atomicAdd(ctr, 1u);
        __syncthreads();
        const int it = slot[0];
        __syncthreads();
        if (it >= 512) break;
        attn_item(A, lds, (it & 31) >> 2, it & 3, 15 - (it >> 5), lam);
    }
    {
        const int lane = tid & 63, wave = tid >> 6;
        LAS float* scr = (LAS float*)(lds + wave * 16384);
        for (int r = blockIdx.x * 8 + wave; r < 1536; r += gridDim.x * 8) {
            if (r < 512) transpose_item(A.w_out, 1024, 0, (bf16_t*)(A.ws + WS_WOUT), scr, r / 32, r % 32, lane);
            else wprime_item(A, (r - 512) >> 6, (r - 512) & 63, lane);
        }
        quantise_tables(A, blockIdx.x * 8 + wave, gridDim.x * 8, 16384, 32768);
    }
}
__device__ __forceinline__ void phase3b(const Args& A, LAS unsigned char* lds) {
    const int tid = threadIdx.x;
    {
        const int lane = tid & 63, wave = tid >> 6;
        const bf16_t* WT = (const bf16_t*)(A.ws + WS_WQ); const float* MOD = (const float*)(A.ws + WS_MOD); float* SB = (float*)(A.ws + WS_SB);
        for (int n = blockIdx.x * 8 + wave; n < 2048; n += gridDim.x * 8) {
            const u32x4 w0 = *(const u32x4*)(WT + (size_t)n * 1024 + 16 * lane), w1 = *(const u32x4*)(WT + (size_t)n * 1024 + 16 * lane + 8);
            const unsigned ww[8] = {w0.x, w0.y, w0.z, w0.w, w1.x, w1.y, w1.z, w1.w};
            float sbv[8];
#pragma unroll
            for (int b = 0; b < 8; ++b) { const float* sp = MOD + b * 6144 + 3072 + 16 * lane; float d = 0.f;
#pragma unroll
                for (int q = 0; q < 4; ++q) { const f32x4 s4 = *(const f32x4*)(sp + 4 * q); d += bflo(ww[2 * q]) * s4[0] + bfhi(ww[2 * q]) * s4[1] + bflo(ww[2 * q + 1]) * s4[2] + bfhi(ww[2 * q + 1]) * s4[3]; }
                sbv[b] = wave_sum(d); }
            if (lane == 0) {
#pragma unroll
                for (int b = 0; b < 8; ++b) SB[b * 2048 + n] = sbv[b]; }
        }
    }
    int last_h = -1;
    for (int item = blockIdx.x; item < 1024; item += gridDim.x) mlstm_out(A, lds, item, last_h);
    __syncthreads();
}

__device__ __forceinline__ void phase5(const Args& A) {
    int tid_o = threadIdx.x; asm volatile("" : "+v"(tid_o)); const int tid = tid_o, lane = tid & 63, wave = tid >> 6, G = gridDim.x;
    const float* MOD = (const float*)(A.ws + WS_MOD);
    bf16_t* ACT = (bf16_t*)(A.ws + WS_ACT);
    for (int m = blockIdx.x * 8 + wave; m < T; m += G * 8) {
        const int b = m >> 11;
        const f32x4* xr = (const f32x4*)(A.out + (size_t)m * 1024) + lane;
        f32x4 v[4]; float ss = 0.f;
#pragma unroll
        for (int j = 0; j < 4; ++j) { v[j] = xr[64 * j]; ss += (v[j][0] * v[j][0] + v[j][1] * v[j][1]) + (v[j][2] * v[j][2] + v[j][3] * v[j][3]); }
        const float rstd = rsqrtf(wave_sum(ss) * (1.f / 1024.f) + 1e-6f);
        unsigned long long* o8 = (unsigned long long*)(ACT + (size_t)m * 1024) + lane;
#pragma unroll
        for (int j = 0; j < 4; ++j) { const int col = 4 * lane + 256 * j;
            const f32x4 g = *(const f32x4*)(A.norm2_g + col), sc = *(const f32x4*)(MOD + b * 6144 + 4096 + col), sh = *(const f32x4*)(MOD + b * 6144 + 3072 + col);
            v[j] = v[j] * rstd * g * (sc + 1.0f) + sh;
            o8[64 * j] = (unsigned long long)pk2(v[j][0], v[j][1]) | ((unsigned long long)pk2(v[j][2], v[j][3]) << 32); }
    }
}

__device__ __forceinline__ unsigned f2key(float f) { const unsigned u = __float_as_uint(f); return (u & 0x80000000u) ? ~u : (u | 0x80000000u); }
__device__ __forceinline__ float key2f(unsigned k) { const unsigned u = (k & 0x80000000u) ? (k & 0x7fffffffu) : ~k; return __uint_as_float(u); }
#define CE_DESC(a, b) do { const unsigned _mx = (a) > (b) ? (a) : (b), _mn = (a) > (b) ? (b) : (a); (a) = _mx; (b) = _mn; } while (0)
__device__ __forceinline__ void sort16_desc(unsigned (&k)[16]) {
#pragma unroll
    for (int size = 2; size <= 16; size <<= 1)
#pragma unroll
        for (int stride = size >> 1; stride > 0; stride >>= 1)
#pragma unroll
            for (int i = 0; i < 16; ++i) { const int j = i ^ stride;
                if (j > i) { if ((i & size) == 0) CE_DESC(k[i], k[j]); else CE_DESC(k[j], k[i]); } }
}
__device__ __forceinline__ void merge16(unsigned (&a)[16], const unsigned (&b)[16]) {
#pragma unroll
    for (int i = 0; i < 16; ++i) a[i] = a[i] > b[15 - i] ? a[i] : b[15 - i];
#pragma unroll
    for (int stride = 8; stride > 0; stride >>= 1)
#pragma unroll
        for (int i = 0; i < 16; ++i) { const int j = i ^ stride; if (j > i) CE_DESC(a[i], a[j]); }
}
constexpr int PE_IDX = 0, PE_SEL = 69632;
__device__ __forceinline__ float gelu_erf(float v) { return 0.5f * v * (1.f + erff(v * 0.70710678118654752f)); }
__device__ __forceinline__ float gelu_fast(float v) {
    const float av = fabsf(v), tt = __builtin_amdgcn_rcpf(av * 0.2316418882f + 1.0f);
    float q = tt * 0.5307027145f + (-0.7265760135f); q = q * tt + 0.7107068705f; q = q * tt + (-0.142248368f); q = q * tt + 0.127414796f; q = q * tt;
    const float e = __builtin_amdgcn_exp2f((v * v) * (-0.72134752044f));
    const float m = v * (q * e);
    return v < 0.f ? m : v - m;
}

__device__ __forceinline__ void peer_tile(const Args& A, LAS unsigned char* lds, int tile) {
    int tid_o = threadIdx.x; asm volatile("" : "+v"(tid_o)); const int tid = tid_o, lane = tid & 63, w = tid >> 6, g = lane >> 4, l15 = lane & 15;
    const bf16_t* QRY = (const bf16_t*)(A.ws + WS_QRY);
    const bf16_t* KEYS = (const bf16_t*)(A.ws + WS_KEYS);
    const bf16_t* ACT = (const bf16_t*)(A.ws + WS_ACT);
    const float* MOD = (const float*)(A.ws + WS_MOD);
    LAS unsigned* idx = (LAS unsigned*)(lds + PE_IDX) + (w * 64 + lane) * 33;
    LAS u32x2* SEL = (LAS u32x2*)(lds + PE_SEL);
    {
        const int tg = w & 3, hg = w >> 2, tl = 16 * tg + l15;
        const size_t m = (size_t)tile * 64 + tl;
        unsigned LA[4][2][16];
#pragma unroll
        for (int hh = 0; hh < 4; ++hh) {
            const int h = 4 * hg + hh;
#pragma unroll
            for (int p = 0; p < 2; ++p) {
                const int hp = 2 * h + p;
                unsigned k0[16], k1[16];
                { const bf16_t* sp = QRY + m * 2048 + hp * 128 + 32 * g;
                  const u32x4 s0 = *(const u32x4*)sp, s1 = *(const u32x4*)(sp + 8), s2 = *(const u32x4*)(sp + 16), s3 = *(const u32x4*)(sp + 24);
                  const unsigned sw[16] = {s0.x, s0.y, s0.z, s0.w, s1.x, s1.y, s1.z, s1.w, s2.x, s2.y, s2.z, s2.w, s3.x, s3.y, s3.z, s3.w};
#pragma unroll
                  for (int i = 0; i < 16; ++i) {
                      const float lo = (float)__builtin_bit_cast(_Float16, (unsigned short)(sw[i] & 0xffffu)), hi = (float)__builtin_bit_cast(_Float16, (unsigned short)(sw[i] >> 16));
                      const unsigned klo = (f2key(lo) & ~127u) | (unsigned)(127 - (32 * g + 2 * i)), khi = (f2key(hi) & ~127u) | (unsigned)(127 - (32 * g + 2 * i + 1));
                      if (i < 8) { k0[2 * i] = klo; k0[2 * i + 1] = khi; } else { k1[2 * (i - 8)] = klo; k1[2 * (i - 8) + 1] = khi; } } }
                sort16_desc(k0); sort16_desc(k1); merge16(k0, k1);
#pragma unroll
                for (int msk = 16; msk <= 32; msk <<= 1) {
#pragma unroll
                    for (int i = 0; i < 16; ++i) k1[i] = (unsigned)__shfl_xor((int)k0[i], msk);
                    merge16(k0, k1); }
#pragma unroll
                for (int i = 0; i < 16; ++i) LA[hh][p][i] = k0[i];
            }
        }
        {
            const int h = 4 * hg + g;
            unsigned L2[2][16];
#pragma unroll
            for (int p = 0; p < 2; ++p)
#pragma unroll
                for (int i = 0; i < 16; ++i) L2[p][i] = (g & 2) ? ((g & 1) ? LA[3][p][i] : LA[2][p][i]) : ((g & 1) ? LA[1][p][i] : LA[0][p][i]);
            float va[16], vb[16];
#pragma unroll
            for (int i = 0; i < 16; ++i) { va[i] = key2f(L2[0][i] & ~127u); vb[i] = key2f(L2[1][i] & ~127u); idx[i] = 127u - (L2[0][i] & 127u); idx[16 + i] = 127u - (L2[1][i] & 127u); }
#define CK(i, j) ((f2key(va[i] + vb[j]) & ~255u) | (unsigned)(255 - (16 * (i) + (j))))
            unsigned Lf[16], Bt[16];
#pragma unroll
            for (int j = 0; j < 16; ++j) Lf[j] = CK(0, j);
#pragma unroll
            for (int j = 0; j < 8; ++j) Bt[j] = CK(1, j);
#pragma unroll
            for (int j = 0; j < 5; ++j) Bt[8 + j] = CK(2, j);
#pragma unroll
            for (int j = 0; j < 3; ++j) Bt[13 + j] = CK(4, j);
            sort16_desc(Bt); merge16(Lf, Bt);
#pragma unroll
            for (int j = 0; j < 4; ++j) Bt[j] = CK(3, j);
            Bt[4] = CK(5, 0); Bt[5] = CK(5, 1); Bt[6] = CK(6, 0); Bt[7] = CK(6, 1); Bt[8] = CK(7, 0); Bt[9] = CK(7, 1);
            Bt[10] = CK(8, 0); Bt[11] = CK(9, 0); Bt[12] = CK(10, 0); Bt[13] = CK(11, 0); Bt[14] = CK(12, 0); Bt[15] = CK(13, 0);
            sort16_desc(Bt); merge16(Lf, Bt);
            { unsigned x0 = CK(14, 0), x1 = CK(15, 0);
#pragma unroll
              for (int i = 0; i < 16; ++i) CE_DESC(Lf[i], x0);
#pragma unroll
              for (int i = 0; i < 16; ++i) CE_DESC(Lf[i], x1); }
#undef CK
            float fv[16], den = 0.f; const float f0 = key2f(Lf[0] & ~255u);
#pragma unroll
            for (int k = 0; k < 16; ++k) { fv[k] = __expf(key2f(Lf[k] & ~255u) - f0); den += fv[k]; }
            const float rden = 1.f / den;
            LDS_WAIT();
#pragma unroll
            for (int k = 0; k < 16; ++k) { const unsigned code = 255u - (Lf[k] & 255u); const unsigned e = idx[code >> 4] * 128u + idx[16 + (code & 15u)];
                u32x2 sv; sv.x = e; sv.y = __float_as_uint(fv[k] * rden); SEL[(tl * 8 + h) * 16 + k] = sv; }
        }
    }
    __syncthreads();
    const unsigned char* T8 = A.ws + WS_T8; const float* SC = (const float*)(A.ws + WS_SC);
    LAS u32x2* SORT = (LAS u32x2*)(lds + PE_IDX);
    LAS int* OFFS = (LAS int*)(lds + PE_SEL + 65536);
    for (int ti = 0; ti < 8; ++ti) {
        const int tl = 8 * w + ti;
        const u32x2 e0 = SEL[tl * 128 + lane], e1 = SEL[tl * 128 + 64 + lane];
        const int p0 = (int)(e0.x >> 10), p1 = (int)(e1.x >> 10);
        int off = 0;
        for (int p = 0; p < 16; ++p) {
            const unsigned long long m0 = __ballot(p0 == p), m1 = __ballot(p1 == p);
            const int c0 = __popcll(m0), c1 = __popcll(m1);
            const int r0 = __builtin_amdgcn_mbcnt_hi((unsigned)(m0 >> 32), __builtin_amdgcn_mbcnt_lo((unsigned)m0, 0u));
            const int r1 = __builtin_amdgcn_mbcnt_hi((unsigned)(m1 >> 32), __builtin_amdgcn_mbcnt_lo((unsigned)m1, 0u));
            if (p0 == p) SORT[tl * 128 + off + r0] = e0;
            if (p1 == p) SORT[tl * 128 + off + c0 + r1] = e1;
            if (lane == 0) OFFS[tl * 17 + p] = off;
            off += c0 + c1;
        }
        if (lane == 0) OFFS[tl * 17 + 16] = off;
    }
    LDS_WAIT(); __builtin_amdgcn_wave_barrier();
    const unsigned char* T8v = T8 + (size_t)16384 * 1024;
    const bf16_t* A3 = (const bf16_t*)(A.ws + WS_A3); const float* RSq = (const float*)(A.ws + WS_RS);
    for (int pass = 0; pass < 2; ++pass) {
        const int tb = 8 * w + 4 * pass;
        u32x4 xpa[4], xpb[4]; f32x2 oacc[4][8];
#pragma unroll
        for (int tk = 0; tk < 4; ++tk) { const size_t m = (size_t)tile * 64 + tb + tk;
            { const u32x4 ra = *(const u32x4*)(A3 + m * 1024 + 16 * lane), rb = *(const u32x4*)(A3 + m * 1024 + 16 * lane + 8);
              float xr_; { const f32x4 p0 = *(const f32x4*)(RSq + m * 16), p1 = *(const f32x4*)(RSq + m * 16 + 4), p2 = *(const f32x4*)(RSq + m * 16 + 8), p3 = *(const f32x4*)(RSq + m * 16 + 12);
                const f32x4 ps = (p0 + p1) + (p2 + p3); xr_ = rsqrtf(((ps[0] + ps[1]) + (ps[2] + ps[3])) * (1.f / 1024.f) + 1e-6f); }
              const unsigned rr[8] = {ra.x, ra.y, ra.z, ra.w, rb.x, rb.y, rb.z, rb.w}; unsigned hh[8];
              const float* sp = MOD + (int)(m >> 11) * 6144 + 3072 + 16 * lane;
#pragma unroll
              for (int q = 0; q < 8; ++q) { const f32x2 sh = *(const f32x2*)(sp + 2 * q); hh[q] = pk2(bflo(rr[q]) * xr_ + sh[0], bfhi(rr[q]) * xr_ + sh[1]); }
              xpa[tk] = (u32x4){hh[0], hh[1], hh[2], hh[3]}; xpb[tk] = (u32x4){hh[4], hh[5], hh[6], hh[7]}; }
#pragma unroll
            for (int q = 0; q < 8; ++q) oacc[tk][q] = (f32x2){0.f, 0.f}; }
        int it_p = 0, it_tk = -1, it_j = 0, it_end = 0; bool it_done = false;
#define IT_ADVANCE() do { it_j += 4; while (it_j >= it_end) { if (it_done) break; ++it_tk; if (it_tk == 4) { it_tk = 0; ++it_p; if (it_p == 16) { it_done = true; it_p = 15; it_j = 0; it_end = 1; break; } } \
            it_j = __builtin_amdgcn_readfirstlane(OFFS[(tb + it_tk) * 17 + it_p]); it_end = __builtin_amdgcn_readfirstlane(OFFS[(tb + it_tk) * 17 + it_p + 1]); } } while (0)
#define LOAD_SET(U, V, CG, SU, SV) do { const int _tl = tb + it_tk; \
            _Pragma("unroll") for (int _k = 0; _k < 4; ++_k) { const int _jj = (it_j + _k < it_end) ? it_j + _k : it_end - 1; const unsigned _e = SORT[_tl * 128 + _jj].x; \
                U[_k] = *(const u32x4*)(T8 + (size_t)_e * 1024 + 16 * lane); V[_k] = *(const u32x4*)(T8v + (size_t)_e * 1024 + 16 * lane); } \
            const int _ms = lane >> 4; const bool _valid = it_j + _ms < it_end; const u32x2 _se = SORT[_tl * 128 + (_valid ? it_j + _ms : it_end - 1)]; \
            CG = _valid ? __uint_as_float(_se.y) : 0.f; SU = SC[_se.x]; SV = SC[16384 + _se.x]; } while (0)
        u32x4 uA[4], vA[4], uB[4], vB[4]; float cgA = 0.f, suA = 0.f, svA = 0.f, cgB = 0.f, suB = 0.f, svB = 0.f;
#pragma unroll
        for (int k = 0; k < 4; ++k) { uA[k] = (u32x4){0u, 0u, 0u, 0u}; vA[k] = uA[k]; uB[k] = uA[k]; vB[k] = uA[k]; }
        IT_ADVANCE();
        LOAD_SET(uA, vA, cgA, suA, svA);
        for (int p = 0; p < 16; ++p) {
#pragma unroll
            for (int tk = 0; tk < 4; ++tk) {
                const int tl = tb + tk;
                const int beg = __builtin_amdgcn_readfirstlane(OFFS[tl * 17 + p]), end = __builtin_amdgcn_readfirstlane(OFFS[tl * 17 + p + 1]);
                f32x2 xf[8];
                { const unsigned xx[8] = {xpa[tk].x, xpa[tk].y, xpa[tk].z, xpa[tk].w, xpb[tk].x, xpb[tk].y, xpb[tk].z, xpb[tk].w};
#pragma unroll
                  for (int q = 0; q < 8; ++q) xf[q] = (f32x2){bflo(xx[q]), bfhi(xx[q])}; }
#define COMPUTE_SET(U, V, CG, SU, SV) do { float pd[4]; \
                    _Pragma("unroll") for (int k = 0; k < 4; ++k) { f32x2 d = (f32x2){0.f, 0.f}; \
                        _Pragma("unroll") for (int q = 0; q < 4; ++q) { const int dw = (int)U[k][q]; \
                            d += __builtin_amdgcn_cvt_pk_f32_fp8(dw, false) * xf[2 * q]; d += __builtin_amdgcn_cvt_pk_f32_fp8(dw, true) * xf[2 * q + 1]; } \
                        pd[k] = d[0] + d[1]; } \
                    float s; \
                    { const auto r0 = __builtin_amdgcn_permlane32_swap(__float_as_uint(pd[0]), __float_as_uint(pd[2]), false, false); \
                      const auto r1 = __builtin_amdgcn_permlane32_swap(__float_as_uint(pd[1]), __float_as_uint(pd[3]), false, false); \
                      const float a0 = __uint_as_float(r0[0]) + __uint_as_float(r0[1]), a1 = __uint_as_float(r1[0]) + __uint_as_float(r1[1]); \
                      const auto r2 = __builtin_amdgcn_permlane16_swap(__float_as_uint(a0), __float_as_uint(a1), false, false); \
                      s = __uint_as_float(r2[0]) + __uint_as_float(r2[1]); \
                      s += __int_as_float(__builtin_amdgcn_mov_dpp(__float_as_int(s), 0xB1, 0xF, 0xF, true)); \
                      s += __int_as_float(__builtin_amdgcn_mov_dpp(__float_as_int(s), 0x4E, 0xF, 0xF, true)); \
                      s += __int_as_float(__builtin_amdgcn_mov_dpp(__float_as_int(s), 0x141, 0xF, 0xF, true)); \
                      s += __int_as_float(__builtin_amdgcn_mov_dpp(__float_as_int(s), 0x140, 0xF, 0xF, true)); } \
                    const float coef = CG * gelu_fast(s * SU) * SV; \
                    _Pragma("unroll") for (int k = 0; k < 4; ++k) { const float ck = __int_as_float(__builtin_amdgcn_readlane(__float_as_int(coef), 16 * k)); const f32x2 ck2 = (f32x2){ck, ck}; \
                        _Pragma("unroll") for (int qq = 0; qq < 4; ++qq) { const int dw = (int)V[k][qq]; \
                            oacc[tk][2 * qq] += ck2 * __builtin_amdgcn_cvt_pk_f32_fp8(dw, false); oacc[tk][2 * qq + 1] += ck2 * __builtin_amdgcn_cvt_pk_f32_fp8(dw, true); } } } while (0)
                for (int j0 = beg; j0 < end; j0 += 8) {
                    IT_ADVANCE();
                    LOAD_SET(uB, vB, cgB, suB, svB);
                    COMPUTE_SET(uA, vA, cgA, suA, svA);
                    if (j0 + 4 < end) {
                        IT_ADVANCE();
                        LOAD_SET(uA, vA, cgA, suA, svA);
                        COMPUTE_SET(uB, vB, cgB, suB, svB);
                    } else {
#pragma unroll
                        for (int k = 0; k < 4; ++k) { uA[k] = uB[k]; vA[k] = vB[k]; }
                        cgA = cgB; suA = suB; svA = svB;
                    }
                }
            }
        }
#undef COMPUTE_SET
#undef IT_ADVANCE
#undef LOAD_SET
#pragma unroll
        for (int tk = 0; tk < 4; ++tk) {
            const size_t m = (size_t)tile * 64 + tb + tk; const int b = (int)(m >> 11);
            float* orow = A.out + m * 1024 + 16 * lane;
            const float* g2 = MOD + b * 6144 + 5120 + 16 * lane;
            f32x4 xv[4]; float ss = 0.f;
#pragma unroll
            for (int j = 0; j < 4; ++j) { const f32x4 x1 = *(const f32x4*)(orow + 4 * j), gg = *(const f32x4*)(g2 + 4 * j);
                const f32x4 pe = (f32x4){oacc[tk][2 * j][0], oacc[tk][2 * j][1], oacc[tk][2 * j + 1][0], oacc[tk][2 * j + 1][1]};
                xv[j] = x1 + gg * pe; ss += (xv[j][0] * xv[j][0] + xv[j][1] * xv[j][1]) + (xv[j][2] * xv[j][2] + xv[j][3] * xv[j][3]); }
            const float rstd = rsqrtf(wave_sum(ss) * (1.f / 1024.f) + 1e-6f);
#pragma unroll
            for (int j = 0; j < 4; ++j) { const f32x4 fg = *(const f32x4*)(A.final_g + 16 * lane + 4 * j); *(f32x4*)(orow + 4 * j) = xv[j] * rstd * fg; }
        }
    }
    __syncthreads();
}


#define XB_TMO      128
#define XB_XCNT(j)  (256  + 64 * (j))
#define XB_XSUB(j)  (1280 + 64 * (j))
#define XB_XGEN(j)  (2304 + 64 * (j))
#define XB_TOP      3328
#define XB_TOPGEN   3392
#define XCD_BAR_WORDS 3456
#define XB_SPIN_CAP (1u << 18)

__device__ __forceinline__ unsigned xb_ld(unsigned* p)              { return __hip_atomic_load(p, __ATOMIC_RELAXED, __HIP_MEMORY_SCOPE_AGENT); }
__device__ __forceinline__ unsigned xb_add(unsigned* p, unsigned v) { return __hip_atomic_fetch_add(p, v, __ATOMIC_RELAXED, __HIP_MEMORY_SCOPE_AGENT); }
__device__ __forceinline__ unsigned xb_xcc_id() { return (unsigned)__builtin_amdgcn_s_getreg((3 << 11) | 20) & 0xFu; }
#define XB_SPIN(cond, bar) do { unsigned _sp = 0; while (cond) { __builtin_amdgcn_s_sleep(1); \
    if ((++_sp & 255u) == 0u) { if (xb_ld(&(bar)[XB_TMO])) break; if (_sp > XB_SPIN_CAP) { atomicAdd(&(bar)[XB_TMO], 1u); break; } } } } while (0)

struct XcdBarrier {
    unsigned* bar; unsigned x;
    volatile LAS unsigned* st;
};

__device__ __forceinline__ XcdBarrier xcd_barrier_post(unsigned* bar, volatile LAS unsigned* st) {
    XcdBarrier b; b.bar = bar; b.x = xb_xcc_id(); b.st = st;
    if (threadIdx.x == 0) (void)xb_add(&bar[XB_XCNT(b.x)], 1u);
    return b;
}
__device__ __forceinline__ void xcd_barrier_complete(unsigned* bar, unsigned x, unsigned& nloc, unsigned& nx) {
    const unsigned G = gridDim.x * gridDim.y * gridDim.z;
    unsigned sum, cnt, mine, sp = 0u;
    for (;;) {
        sum = 0u; cnt = 0u; mine = 0u;
#pragma unroll
        for (unsigned j = 0; j < 16; ++j) { const unsigned c = xb_ld(&bar[XB_XCNT(j)]); sum += c; cnt += (c > 0u) ? 1u : 0u; mine = (j == x) ? c : mine; }
        if (sum == G) break;
        __builtin_amdgcn_s_sleep(1);
        if ((++sp & 255u) == 0u) { if (xb_ld(&bar[XB_TMO])) break; if (sp > XB_SPIN_CAP) { atomicAdd(&bar[XB_TMO], 1u); break; } }
    }
    nloc = mine > 0u ? mine : 1u; nx = cnt > 0u ? cnt : 1u;
}

__device__ __forceinline__ void xcd_barrier(const XcdBarrier& b) {
    asm volatile("s_waitcnt vmcnt(0)" ::: "memory");
    __syncthreads();
    if (threadIdx.x == 0) {
        unsigned* bar = b.bar;
        __builtin_amdgcn_s_waitcnt(0);
        unsigned nloc = b.st[0], nx = b.st[1];
        if (nloc == 0u) { xcd_barrier_complete(bar, b.x, nloc, nx); b.st[0] = nloc; b.st[1] = nx; }
        const unsigned old = xb_add(&bar[XB_XSUB(b.x)], 1u);
        const unsigned gen = old / nloc;
        if (old + 1u == (gen + 1u) * nloc) {
            __builtin_amdgcn_fence(__ATOMIC_RELEASE, "agent");
            asm volatile("s_waitcnt vmcnt(0)" ::: "memory");
            const unsigned og = xb_add(&bar[XB_TOP], 1u);
            const unsigned tg = og / nx;
            if (og + 1u == (tg + 1u) * nx) xb_add(&bar[XB_TOPGEN], 1u);
            else XB_SPIN(xb_ld(&bar[XB_TOPGEN]) == tg, bar);
            __builtin_amdgcn_fence(__ATOMIC_ACQUIRE, "agent");
            xb_add(&bar[XB_XGEN(b.x)], 1u);
            asm volatile("s_waitcnt vmcnt(0)" ::: "memory");
        } else {
            XB_SPIN(xb_ld(&bar[XB_XGEN(b.x)]) == gen, bar);
            __builtin_amdgcn_fence(__ATOMIC_ACQUIRE, "agent");
            asm volatile("s_waitcnt vmcnt(0)" ::: "memory");
        }
    }
    __syncthreads();
}

__global__ void __launch_bounds__(512, 2) mega_fwd(Args A) {
    extern __shared__ __attribute__((aligned(16))) unsigned char lds_raw[];
    LAS unsigned char* lds = (LAS unsigned char*)lds_raw;
    cg::grid_group grid = cg::this_grid();
    const int G = gridDim.x;
    if (threadIdx.x < 4) ((LAS unsigned*)(lds + LDS_BYTES - 32))[threadIdx.x] = 0u;
    __syncthreads();
    if (A.ws == nullptr) grid.sync();
    const XcdBarrier xb = xcd_barrier_post((unsigned*)(A.ws + WS_BAR), (volatile LAS unsigned*)(lds + LDS_BYTES - 32));
    phase0(A, lds);
    xcd_barrier(xb);
    phase1(A, lds);
    phase0b(A, lds);
    xcd_barrier(xb);
    { pg8::Gemm gm{(const pg8::bf16_t*)(A.ws + WS_ACT), (const pg8::bf16_t*)(A.ws + WS_WIN), T, NP, DM}; pg8::StaticOrder S; S.init(T, NP, G, (int)blockIdx.x);
      pg8::EpiStoreBf16 E{(pg8::bf16_t*)(A.ws + WS_P), NP};
      pg8::gemm_phase<pg8::EpiStoreBf16, pg8::StaticOrder, true, true>((PG8_LAS unsigned char*)lds, gm, S, E); }
    { const int nshort = G - (896 % G == 0 ? 0 : 896 % G);
      const int first = G - nshort;
      if ((int)blockIdx.x >= first) quantise_tables(A, ((int)blockIdx.x - first) * 8 + (int)(threadIdx.x >> 6), nshort * 8, 0, 16384); }
    xcd_barrier(xb);
    phase3(A, lds);
    xcd_barrier(xb);
    phase3b(A, lds);
    xcd_barrier(xb);
    { pg8::Gemm gm{(const pg8::bf16_t*)(A.ws + WS_ACT), (const pg8::bf16_t*)(A.ws + WS_WOUT), T, DM, DM}; pg8::StaticOrder S; S.init(T, DM, G, (int)blockIdx.x);
      pg8::EpiResidNorm E{A.x, (const float*)(A.ws + WS_MOD), A.norm2_g, A.out, (pg8::bf16_t*)(A.ws + WS_A3), (float*)(A.ws + WS_RS)};
      pg8::gemm_phase<pg8::EpiResidNorm, pg8::StaticOrder, true, true>((PG8_LAS unsigned char*)lds, gm, S, E); }
    xcd_barrier(xb);
    { pg8::Gemm gm{(const pg8::bf16_t*)(A.ws + WS_A3), (const pg8::bf16_t*)(A.ws + WS_WQ), T, 2048, DM}; pg8::StaticOrder S; S.init(T, 2048, G, (int)blockIdx.x);
      pg8::EpiScoreF16 E{(pg8::bf16_t*)(A.ws + WS_QRY), 2048, (const float*)(A.ws + WS_RS), (const float*)(A.ws + WS_SB)};
      pg8::gemm_phase<pg8::EpiScoreF16, pg8::StaticOrder, true, true>((PG8_LAS unsigned char*)lds, gm, S, E); }
    xcd_barrier(xb);
    for (int tile = blockIdx.x; tile < T / 64; tile += G) peer_tile(A, lds, tile);
}

extern "C" void kernel_launch(void* const* d_in, const int* in_sizes, int n_in, void* d_out, int out_size, void* d_ws, size_t ws_size, hipStream_t stream) {
    static int grid = 0;
    if (grid == 0) {
        if (n_in != 22 || out_size != T * DM || ws_size < WS_END) { fprintf(stderr, "kernel_launch: unexpected shapes (n_in %d out %d ws %zu)\n", n_in, out_size, ws_size); grid = -1; return; }
        int dev = 0, cus = 0, per_cu = 0;
        if (hipGetDevice(&dev) != hipSuccess || hipDeviceGetAttribute(&cus, hipDeviceAttributeMultiprocessorCount, dev) != hipSuccess) { grid = -1; return; }
        if (hipFuncSetAttribute((const void*)mega_fwd, hipFuncAttributeMaxDynamicSharedMemorySize, LDS_BYTES) != hipSuccess) { fprintf(stderr, "kernel_launch: hipFuncSetAttribute failed\n"); grid = -1; return; }
        if (hipOccupancyMaxActiveBlocksPerMultiprocessor(&per_cu, (const void*)mega_fwd, 512, LDS_BYTES) != hipSuccess || per_cu < 1) { fprintf(stderr, "kernel_launch: occupancy query gave %d\n", per_cu); per_cu = 1; }
        (void)hipGetLastError();
        grid = cus * per_cu;
    }
    if (grid < 0) return;
    Args a{};
    const float** ap = (const float**)&a;
    for (int i = 0; i < 22; ++i) ap[i] = (const float*)d_in[i];
    a.out = (float*)d_out; a.ws = (unsigned char*)d_ws;
    if (hipMemsetAsync((unsigned char*)d_ws + WS_BAR, 0, XCD_BAR_WORDS * sizeof(unsigned), stream) != hipSuccess) { fprintf(stderr, "kernel_launch: memset of the barrier words failed\n"); return; }
    void* args[] = {&a};
    hipError_t e = hipLaunchCooperativeKernel((const void*)mega_fwd, dim3(grid), dim3(512), args, LDS_BYTES, stream);
    if (e != hipSuccess) fprintf(stderr, "kernel_launch: cooperative launch failed: %s (grid %d)\n", hipGetErrorString(e), grid);
}
```
